# Optimizing an MI355X kernel written in HIP

```python
import jax, jax.numpy as jnp
from jax import lax
import numpy as np

D_MODEL = 2048
BATCH = 32
SEQ = 256
DEPTH = 4
DEC_BATCH = 2
DEC_SEQ = 1024
PAST_LEN = 512

GRID_W = 64
ADA_CHUNKS = 6
NORM_EPS = 1e-6
Q_BLOCK = 128
ROPE_THETA = 10000.0

MLA_HEADS = 8
MLA_NOPE = 128
MLA_ROPE = 64
MLA_QK_DIM = MLA_NOPE + MLA_ROPE
MLA_V_DIM = 128
MLA_Q_LORA = 512
MLA_KV_LORA = 256
MLA_WIDTH = MLA_HEADS * MLA_V_DIM

NA_HEADS = 4
NA_HEAD_DIM = 128
NA_WIDTH = NA_HEADS * NA_HEAD_DIM
NA_KR = 8
NA_KC = 16
NA_BAND = 2 * NA_KC
NA_NCB = GRID_W // NA_KC

CONV_CH = 512
CONV_K = 3

D_MIX = MLA_WIDTH + NA_WIDTH + CONV_CH
IN_SIZES = (MLA_Q_LORA, MLA_KV_LORA, MLA_ROPE, NA_WIDTH, NA_WIDTH, NA_WIDTH, CONV_CH, CONV_CH, CONV_CH)
D_IN = MLA_Q_LORA + MLA_KV_LORA + MLA_ROPE + 3 * NA_WIDTH + 3 * CONV_CH

PEER_HEADS = 8
PEER_N_KEYS = 128
PEER_N_EXPERTS = PEER_N_KEYS * PEER_N_KEYS
PEER_KEY_DIM = 256
PEER_KEY_HALF = PEER_KEY_DIM // 2
PEER_TOPK = 16
PEER_TOKEN_BLOCK = 128

kernel_name = "hybrid_mla_natten_shortconv_peer_dit_step"


def rms_norm(x, g):
    xf = x.astype(jnp.float32)
    y = xf * lax.rsqrt(jnp.mean(xf * xf, axis=-1, keepdims=True) + NORM_EPS)
    return (y * g.astype(jnp.float32)).astype(x.dtype)


def split_heads(x, n_heads):
    b, s, _ = x.shape
    return x.reshape(b, s, n_heads, -1).transpose(0, 2, 1, 3)


def merge_heads(x):
    b, n, s, d = x.shape
    return x.transpose(0, 2, 1, 3).reshape(b, s, n * d)


def ada_modulation(cvec, w, b):
    m = jnp.dot(jax.nn.silu(cvec), w) + b
    return jnp.split(m[:, None, :], ADA_CHUNKS, axis=-1)


def modulate(x, g, shift, scale):
    return rms_norm(x, g) * (1 + scale) + shift


def axial_rope_tables(n_tokens):
    t = jnp.arange(n_tokens)
    row = (t // GRID_W).astype(jnp.float32)
    col = (t % GRID_W).astype(jnp.float32)
    n_freq = MLA_ROPE // 4
    inv = ROPE_THETA ** (-jnp.arange(n_freq, dtype=jnp.float32) / n_freq)
    ang = jnp.concatenate([row[:, None] * inv, col[:, None] * inv], axis=-1)
    return jnp.cos(ang), jnp.sin(ang)


def rope_tail(x, cos, sin):
    x_pass, x_rot = x[..., :-MLA_ROPE], x[..., -MLA_ROPE:]
    xf = x_rot.astype(jnp.float32)
    half = MLA_ROPE // 2
    x1, x2 = xf[..., :half], xf[..., half:]
    rot = jnp.concatenate([x1 * cos - x2 * sin, x1 * sin + x2 * cos], axis=-1)
    return jnp.concatenate([x_pass, rot.astype(x.dtype)], axis=-1)


def blocked_attention(q, k, v, scale):
    b, h, sq, dq = q.shape
    nb = sq // Q_BLOCK
    qb = q.reshape(b, h, nb, Q_BLOCK, dq).transpose(2, 0, 1, 3, 4)

    def one_block(q_blk):
        s = jnp.einsum('bhqd,bhkd->bhqk', q_blk, k).astype(jnp.float32) * scale
        p = jax.nn.softmax(s, axis=-1).astype(v.dtype)
        return jnp.einsum('bhqk,bhkd->bhqd', p, v)

    o = lax.map(one_block, qb)
    return o.transpose(1, 2, 0, 3, 4).reshape(b, h, sq, v.shape[-1])


def neighbourhood_attention(q, k, v, k_ctx, v_ctx, rel_bias):
    b, h, t, d = q.shape
    rows = t // GRID_W
    kr = min(NA_KR, rows)
    r = jnp.arange(rows)
    row_start = jnp.clip(r - kr // 2, 0, rows - kr)
    row_idx = row_start[:, None] + jnp.arange(kr)[None, :]
    row_off = row_idx - r[:, None] + (NA_KR - 1)
    j = jnp.arange(NA_NCB)
    band_start = jnp.clip(j * NA_KC - NA_KC // 2, 0, GRID_W - NA_BAND)
    key_col = band_start[:, None] + jnp.arange(NA_BAND)[None, :]
    q_col = j[:, None] * NA_KC + jnp.arange(NA_KC)[None, :]
    col_start = jnp.clip(q_col - NA_KC // 2, 0, GRID_W - NA_KC)
    kc3 = key_col[:, None, :]
    valid = (kc3 >= col_start[..., None]) & (kc3 < col_start[..., None] + NA_KC)
    col_off = jnp.clip(kc3 - q_col[..., None], -(NA_KC - 1), NA_KC - 1) + (NA_KC - 1)
    k_grid = k.reshape(b, h, rows, GRID_W, d)
    v_grid = v.reshape(b, h, rows, GRID_W, d)
    q_rows = q.reshape(b, h, rows, NA_NCB, NA_KC, d).transpose(2, 0, 1, 3, 4, 5)
    scale = NA_HEAD_DIM ** -0.5
    n_loc = kr * NA_BAND

    def one_row(args):
        q_r, ridx, roff = args
        kb = jnp.take(k_grid, ridx, axis=2)[:, :, :, key_col]
        vb = jnp.take(v_grid, ridx, axis=2)[:, :, :, key_col]
        bias = rel_bias[:, roff[None, None, :, None], col_off[:, :, None, :]]
        s_loc = jnp.einsum('bhjqd,bhajcd->bhjqac', q_r, kb).astype(jnp.float32) * scale
        s_loc = jnp.where(valid[:, :, None, :], s_loc + bias.astype(jnp.float32), -jnp.inf)
        s_ctx = jnp.einsum('bhjqd,bhkd->bhjqk', q_r, k_ctx).astype(jnp.float32) * scale
        s = jnp.concatenate([s_loc.reshape(b, h, NA_NCB, NA_KC, n_loc), s_ctx], axis=-1)
        p = jax.nn.softmax(s, axis=-1).astype(v.dtype)
        p_loc = p[..., :n_loc].reshape(b, h, NA_NCB, NA_KC, kr, NA_BAND)
        return (jnp.einsum('bhjqac,bhajcd->bhjqd', p_loc, vb)
                + jnp.einsum('bhjqk,bhkd->bhjqd', p[..., n_loc:], v_ctx))

    o = lax.map(one_row, (q_rows, row_idx, row_off))
    return o.transpose(1, 2, 0, 3, 4, 5).reshape(b, h, t, d)


def short_conv(u, w):
    s = u.shape[1]
    up = jnp.pad(u, ((0, 0), (1, 1), (0, 0)))
    return up[:, :s] * w[:, 0] + up[:, 1:s + 1] * w[:, 1] + up[:, 2:] * w[:, 2]


def mla_queries(cq, lp):
    q = jnp.dot(rms_norm(cq, lp['mla_q_norm_g']), lp['mla_w_uq'])
    return rms_norm(split_heads(q, MLA_HEADS), lp['mla_q_head_g'])


def mla_keys_values(ckv_n, kpe, lp):
    b, l, _ = ckv_n.shape
    kv = jnp.dot(ckv_n, lp['mla_w_ukv']).reshape(b, l, MLA_HEADS, MLA_NOPE + MLA_V_DIM)
    k_nope, v = kv[..., :MLA_NOPE], kv[..., MLA_NOPE:]
    k_pe = jnp.broadcast_to(kpe[:, :, None, :], (b, l, MLA_HEADS, MLA_ROPE))
    k = jnp.concatenate([k_nope, k_pe], axis=-1).transpose(0, 2, 1, 3)
    return rms_norm(k, lp['mla_k_head_g']), v.transpose(0, 2, 1, 3)


def project_mixers(h, lp):
    z = jnp.dot(h, lp['w_in'])
    offs, acc = [], 0
    for sz in IN_SIZES[:-1]:
        acc += sz
        offs.append(acc)
    cq, ckv, kpe, na_q, na_k, na_v, g_b, g_c, u = jnp.split(z, offs, axis=-1)
    q_mla = mla_queries(cq, lp)
    ckv_n = rms_norm(ckv, lp['mla_kv_norm_g'])
    q_na = rms_norm(split_heads(na_q, NA_HEADS), lp['na_q_head_g'])
    k_na = rms_norm(split_heads(na_k, NA_HEADS), lp['na_k_head_g'])
    v_na = split_heads(na_v, NA_HEADS)
    conv_out = g_b * short_conv(g_c * u, lp['conv_w'])
    return q_mla, ckv_n, kpe, q_na, k_na, v_na, conv_out


def peer(h, lp):
    b, s, dm = h.shape
    x = h.reshape(b * s, dm)
    t = x.shape[0]
    q = jnp.dot(x, lp['peer_w_q']).reshape(t, PEER_HEADS, 2, PEER_KEY_HALF)
    sc = jnp.einsum('thpd,hpnd->thpn', q, lp['peer_sub_keys']).astype(jnp.float32)
    s1, i1 = lax.top_k(sc[:, :, 0], PEER_TOPK)
    s2, i2 = lax.top_k(sc[:, :, 1], PEER_TOPK)
    cand = (s1[..., :, None] + s2[..., None, :]).reshape(t, PEER_HEADS, PEER_TOPK * PEER_TOPK)
    cidx = (i1[..., :, None] * PEER_N_KEYS + i2[..., None, :]).reshape(t, PEER_HEADS, PEER_TOPK * PEER_TOPK)
    top_s, pos = lax.top_k(cand, PEER_TOPK)
    eidx = jnp.take_along_axis(cidx, pos, axis=-1)
    gate = jax.nn.softmax(top_s, axis=-1)
    nb = t // PEER_TOKEN_BLOCK
    ne = PEER_HEADS * PEER_TOPK

    def one_block(args):
        xb, eb, gb = args
        e = eb.reshape(PEER_TOKEN_BLOCK, ne)
        u = jnp.take(lp['peer_u'], e, axis=0)
        a = jax.nn.gelu(jnp.einsum('td,ted->te', xb, u), approximate=False)
        wgt = gb.reshape(PEER_TOKEN_BLOCK, ne).astype(a.dtype) * a
        v = jnp.take(lp['peer_v'], e, axis=0)
        return jnp.einsum('te,ted->td', wgt, v)

    out = lax.map(one_block, (x.reshape(nb, PEER_TOKEN_BLOCK, dm),
                              eidx.reshape(nb, PEER_TOKEN_BLOCK, PEER_HEADS, PEER_TOPK),
                              gate.reshape(nb, PEER_TOKEN_BLOCK, PEER_HEADS, PEER_TOPK)))
    return out.reshape(b, s, dm)


def context_layer(x, c_ctx, lp):
    sh1, sc1, g1, sh2, sc2, g2 = ada_modulation(c_ctx[None, :], lp['ada_w'], lp['ada_b'])
    h = modulate(x, lp['norm_mix_g'], sh1, sc1)
    q_mla, ckv_n, kpe, q_na, k_na, v_na, conv_out = project_mixers(h, lp)
    k_mla, v_mla = mla_keys_values(ckv_n, kpe, lp)
    o_mla = blocked_attention(q_mla, k_mla, v_mla, MLA_QK_DIM ** -0.5)
    o_na = blocked_attention(q_na, k_na, v_na, NA_HEAD_DIM ** -0.5)
    mix = jnp.concatenate([merge_heads(o_mla), merge_heads(o_na), conv_out], axis=-1)
    x = x + g1 * jnp.dot(mix, lp['w_out'])
    x = x + g2 * peer(modulate(x, lp['norm_ffn_g'], sh2, sc2), lp)
    return x, ckv_n, kpe, k_na, v_na


def latent_layer(x, c, lp, ckv_ctx, kpe_ctx, k_na_ctx, v_na_ctx, cos, sin):
    sh1, sc1, g1, sh2, sc2, g2 = ada_modulation(c, lp['ada_w'], lp['ada_b'])
    h = modulate(x, lp['norm_mix_g'], sh1, sc1)
    q_mla, ckv_n, kpe, q_na, k_na, v_na, conv_out = project_mixers(h, lp)
    q_mla = rope_tail(q_mla, cos, sin)
    k_lat, v_lat = mla_keys_values(ckv_n, kpe, lp)
    k_lat = rope_tail(k_lat, cos, sin)
    k_ctx, v_ctx = mla_keys_values(ckv_ctx, kpe_ctx, lp)
    o_mla = blocked_attention(q_mla, jnp.concatenate([k_ctx, k_lat], axis=2),
                              jnp.concatenate([v_ctx, v_lat], axis=2), MLA_QK_DIM ** -0.5)
    o_na = neighbourhood_attention(q_na, k_na, v_na, k_na_ctx, v_na_ctx, lp['na_rel_bias'])
    mix = jnp.concatenate([merge_heads(o_mla), merge_heads(o_na), conv_out], axis=-1)
    x = x + g1 * jnp.dot(mix, lp['w_out'])
    x = x + g2 * peer(modulate(x, lp['norm_ffn_g'], sh2, sc2), lp)
    return x


def setup_inputs(seed: int = 0) -> dict:
    key = jax.random.key(seed)
    ks = jax.random.split(key, 32)
    f32 = jnp.float32

    def nrm(k, shape, scale):
        return jax.random.normal(k, shape, f32) * scale

    def gain(k, shape):
        return 1.0 + 0.02 * jax.random.normal(k, shape, f32)

    return {
        "x_prompt": nrm(ks[0], (BATCH, SEQ, D_MODEL), 1.0),
        "x_sample": nrm(ks[1], (DEC_BATCH, DEC_SEQ, D_MODEL), 1.0),
        "cache_mla_ckv": nrm(ks[2], (DEC_BATCH, DEPTH, PAST_LEN, MLA_KV_LORA), 1.0),
        "cache_mla_kpe": nrm(ks[3], (DEC_BATCH, DEPTH, PAST_LEN, MLA_ROPE), 1.0),
        "cache_na_k": nrm(ks[4], (DEC_BATCH, DEPTH, NA_HEADS, PAST_LEN, NA_HEAD_DIM), 1.0),
        "cache_na_v": nrm(ks[5], (DEC_BATCH, DEPTH, NA_HEADS, PAST_LEN, NA_HEAD_DIM), 1.0),
        "c": nrm(ks[6], (DEC_BATCH, D_MODEL), 1.0),
        "c_ctx": nrm(ks[7], (D_MODEL,), 1.0),
        "ada_w": nrm(ks[8], (DEPTH, D_MODEL, ADA_CHUNKS * D_MODEL), D_MODEL ** -0.5),
        "ada_b": nrm(ks[9], (DEPTH, ADA_CHUNKS * D_MODEL), 0.02),
        "norm_mix_g": gain(ks[10], (DEPTH, D_MODEL)),
        "norm_ffn_g": gain(ks[11], (DEPTH, D_MODEL)),
        "w_in": nrm(ks[12], (DEPTH, D_MODEL, D_IN), D_MODEL ** -0.5),
        "mla_q_norm_g": gain(ks[13], (DEPTH, MLA_Q_LORA)),
        "mla_w_uq": nrm(ks[14], (DEPTH, MLA_Q_LORA, MLA_HEADS * MLA_QK_DIM), MLA_Q_LORA ** -0.5),
        "mla_kv_norm_g": gain(ks[15], (DEPTH, MLA_KV_LORA)),
        "mla_w_ukv": nrm(ks[16], (DEPTH, MLA_KV_LORA, MLA_HEADS * (MLA_NOPE + MLA_V_DIM)), MLA_KV_LORA ** -0.5),
        "mla_q_head_g": gain(ks[17], (DEPTH, MLA_QK_DIM)),
        "mla_k_head_g": gain(ks[18], (DEPTH, MLA_QK_DIM)),
        "na_q_head_g": gain(ks[19], (DEPTH, NA_HEAD_DIM)),
        "na_k_head_g": gain(ks[20], (DEPTH, NA_HEAD_DIM)),
        "na_rel_bias": nrm(ks[21], (DEPTH, NA_HEADS, 2 * NA_KR - 1, 2 * NA_KC - 1), 0.02),
        "conv_w": nrm(ks[22], (DEPTH, CONV_CH, CONV_K), CONV_K ** -0.5),
        "w_out": nrm(ks[23], (DEPTH, D_MIX, D_MODEL), D_MIX ** -0.5),
        "peer_w_q": nrm(ks[24], (DEPTH, D_MODEL, PEER_HEADS * PEER_KEY_DIM), D_MODEL ** -0.5),
        "peer_sub_keys": nrm(ks[25], (DEPTH, PEER_HEADS, 2, PEER_N_KEYS, PEER_KEY_HALF), PEER_KEY_HALF ** -0.5),
        "peer_u": nrm(ks[26], (DEPTH, PEER_N_EXPERTS, D_MODEL), D_MODEL ** -0.5),
        "peer_v": nrm(ks[27], (DEPTH, PEER_N_EXPERTS, D_MODEL), 0.05),
    }


def reference(x_prompt, x_sample, cache_mla_ckv, cache_mla_kpe, cache_na_k, cache_na_v, c, c_ctx,
              ada_w, ada_b, norm_mix_g, norm_ffn_g, w_in, mla_q_norm_g, mla_w_uq, mla_kv_norm_g,
              mla_w_ukv, mla_q_head_g, mla_k_head_g, na_q_head_g, na_k_head_g, na_rel_bias, conv_w,
              w_out, peer_w_q, peer_sub_keys, peer_u, peer_v):
    y_prompt = x_prompt
    y_sample = x_sample
    cos, sin = axial_rope_tables(x_sample.shape[1])
    ckv_list, kpe_list, nak_list, nav_list = [], [], [], []
    for i in range(DEPTH):
        lp = {
            'ada_w': ada_w[i], 'ada_b': ada_b[i], 'norm_mix_g': norm_mix_g[i], 'norm_ffn_g': norm_ffn_g[i],
            'w_in': w_in[i], 'mla_q_norm_g': mla_q_norm_g[i], 'mla_w_uq': mla_w_uq[i],
            'mla_kv_norm_g': mla_kv_norm_g[i], 'mla_w_ukv': mla_w_ukv[i],
            'mla_q_head_g': mla_q_head_g[i], 'mla_k_head_g': mla_k_head_g[i],
            'na_q_head_g': na_q_head_g[i], 'na_k_head_g': na_k_head_g[i], 'na_rel_bias': na_rel_bias[i],
            'conv_w': conv_w[i], 'w_out': w_out[i], 'peer_w_q': peer_w_q[i],
            'peer_sub_keys': peer_sub_keys[i], 'peer_u': peer_u[i], 'peer_v': peer_v[i],
        }
        y_prompt, ckv_n, kpe, k_na, v_na = context_layer(y_prompt, c_ctx, lp)
        ckv_list.append(ckv_n)
        kpe_list.append(kpe)
        nak_list.append(k_na)
        nav_list.append(v_na)
        y_sample = latent_layer(y_sample, c, lp, cache_mla_ckv[:, i], cache_mla_kpe[:, i],
                                cache_na_k[:, i], cache_na_v[:, i], cos, sin)
    new_mla_ckv = jnp.stack(ckv_list, axis=1)
    new_mla_kpe = jnp.stack(kpe_list, axis=1)
    new_na_k = jnp.stack(nak_list, axis=1)
    new_na_v = jnp.stack(nav_list, axis=1)
    return (y_prompt, y_sample, new_mla_ckv, new_mla_kpe, new_na_k, new_na_v)
```

```cpp
#include <hip/hip_runtime.h>
#include <stdint.h>

#define DEVI __device__ __forceinline__

namespace {

constexpr int D = 2048, BATCH = 32, SEQ = 256, DEPTH = 4, DB = 2, DS = 1024, PAST = 512;
constexpr int NCTX = BATCH * SEQ, NLAT = DB * DS, T = NCTX + NLAT, TKV = T + DB * PAST;
constexpr int DIN = 3904;
constexpr int O_CQ = 0, O_CKV = 512, O_KPE = 768, O_NAQ = 832, O_NAK = 1344, O_NAV = 1856, O_GB = 2368, O_GC = 2880, O_U = 3392;
constexpr float EPS = 1e-6f;
constexpr int NTHREADS = 512, NWAVES = NTHREADS / 64;

struct Params {
    const float *x_prompt, *x_sample, *cache_ckv, *cache_kpe, *cache_nak, *cache_nav, *c, *c_ctx;
    const float *ada_w, *ada_b, *norm_mix_g, *norm_ffn_g, *w_in, *q_norm_g, *w_uq, *kv_norm_g, *w_ukv;
    const float *q_head_g, *k_head_g, *naq_g, *nak_g, *rel_bias, *conv_w, *w_out, *peer_wq, *sub_keys, *peer_u, *peer_v;
    float* out;
    float *o_ckv, *o_kpe, *o_nak, *o_nav;
    unsigned* bar;
    float *ada, *hn, *z, *cqn, *ckv, *qm, *kvr, *km, *qna, *kna, *mix, *qp, *sc, *gate;
    int* eidx;
};

DEVI float wave_sum(float v) {
#pragma unroll
    for (int o = 32; o > 0; o >>= 1) v += __shfl_xor(v, o);
    return v;
}
DEVI float wave_max(float v) {
#pragma unroll
    for (int o = 32; o > 0; o >>= 1) v = fmaxf(v, __shfl_xor(v, o));
    return v;
}
DEVI void wave_argmax(float& v, int& idx) {
#pragma unroll
    for (int o = 32; o > 0; o >>= 1) {
        float ov = __shfl_xor(v, o); int oi = __shfl_xor(idx, o);
        if (ov > v || (ov == v && oi < idx)) { v = ov; idx = oi; }
    }
}
DEVI int cond_of(int t) { return t < NCTX ? 2 : (t - NCTX) / DS; }
DEVI const float* xrow(const Params& p, int layer, int t) {
    if (layer == 0) return t < NCTX ? p.x_prompt + (size_t)t * D : p.x_sample + (size_t)(t - NCTX) * D;
    return p.out + (size_t)t * D;
}

DEVI void phase_ada(const Params& p, int bid, int nb, float* lds) {
    float* sv = lds;
    float* red = lds + 3 * D;
    const int tid = threadIdx.x, lane = tid & 63, w = tid >> 6;
    for (int i = tid; i < 3 * D; i += NTHREADS) {
        int j = i / D, k = i % D;
        float v = j < 2 ? p.c[j * D + k] : p.c_ctx[k];
        sv[i] = v / (1.f + __expf(-v));
    }
    __syncthreads();
    const int nitems = DEPTH * (6 * D / 64);
    for (int it = bid; it < nitems; it += nb) {
        const int l = it / (6 * D / 64), n = (it % (6 * D / 64)) * 64 + lane;
        const float* W = p.ada_w + (size_t)l * D * 6 * D + n;
        float a0 = 0.f, a1 = 0.f, a2 = 0.f;
        const int k0 = w * (D / NWAVES);
#pragma unroll 8
        for (int k = k0; k < k0 + D / NWAVES; ++k) {
            float wv = W[(size_t)k * 6 * D];
            a0 += sv[k] * wv; a1 += sv[D + k] * wv; a2 += sv[2 * D + k] * wv;
        }
        red[(w * 3 + 0) * 64 + lane] = a0; red[(w * 3 + 1) * 64 + lane] = a1; red[(w * 3 + 2) * 64 + lane] = a2;
        __syncthreads();
        if (tid < 192) {
            int j = tid / 64, ln = tid % 64;
            float s = 0.f;
            for (int ww = 0; ww < NWAVES; ++ww) s += red[(ww * 3 + j) * 64 + ln];
            int nn = (it % (6 * D / 64)) * 64 + ln;
            p.ada[((size_t)l * 3 + j) * 6 * D + nn] = s + p.ada_b[(size_t)l * 6 * D + nn];
        }
        __syncthreads();
    }
}

DEVI void phase_modnorm(const Params& p, int layer, int which, int bid, int nb) {
    const int lane = threadIdx.x & 63, w = threadIdx.x >> 6;
    const float* g = (which == 0 ? p.norm_mix_g : p.norm_ffn_g) + (size_t)layer * D;
    for (int t = bid * NWAVES + w; t < T; t += nb * NWAVES) {
        const float* x = which == 0 ? xrow(p, layer, t) : p.out + (size_t)t * D;
        const float* ad = p.ada + ((size_t)layer * 3 + cond_of(t)) * 6 * D + (which == 0 ? 0 : 3 * D);
        float4 v[8]; float ss = 0.f;
#pragma unroll
        for (int i = 0; i < 8; ++i) { v[i] = *(const float4*)(x + i * 256 + lane * 4); ss += v[i].x * v[i].x + v[i].y * v[i].y + v[i].z * v[i].z + v[i].w * v[i].w; }
        ss = wave_sum(ss);
        const float r = rsqrtf(ss / D + EPS);
#pragma unroll
        for (int i = 0; i < 8; ++i) {
            const int c = i * 256 + lane * 4;
            float4 gg = *(const float4*)(g + c), sh = *(const float4*)(ad + c), sc = *(const float4*)(ad + D + c), o;
            o.x = v[i].x * r * gg.x * (1.f + sc.x) + sh.x; o.y = v[i].y * r * gg.y * (1.f + sc.y) + sh.y;
            o.z = v[i].z * r * gg.z * (1.f + sc.z) + sh.z; o.w = v[i].w * r * gg.w * (1.f + sc.w) + sh.w;
            *(float4*)(p.hn + (size_t)t * D + c) = o;
        }
    }
}

template <bool BT, class Epi>
DEVI void gemm_tile(const float* A, int lda, const float* W, int ldw, int K, int m0, int n0, const Epi& epi, float* lds) {
    float (*As)[132] = (float (*)[132])lds;
    float (*Bs)[68] = (float (*)[68])(lds + 16 * 132);
    const int tid = threadIdx.x, tx = tid & 15, ty = tid >> 4;
    float acc[4][4];
#pragma unroll
    for (int i = 0; i < 4; ++i)
#pragma unroll
        for (int j = 0; j < 4; ++j) acc[i][j] = 0.f;
    for (int k0 = 0; k0 < K; k0 += 16) {
        {
            const int row = tid >> 2, kq = tid & 3;
            float4 v = *(const float4*)(A + (size_t)(m0 + row) * lda + k0 + kq * 4);
            As[kq * 4 + 0][row] = v.x; As[kq * 4 + 1][row] = v.y; As[kq * 4 + 2][row] = v.z; As[kq * 4 + 3][row] = v.w;
        }
        if (tid < 256) {
            if (!BT) {
                const int k = tid >> 4, n4 = tid & 15;
                float4 v = *(const float4*)(W + (size_t)(k0 + k) * ldw + n0 + n4 * 4);
                *(float4*)&Bs[k][n4 * 4] = v;
            } else {
                const int n = tid >> 2, kq = tid & 3;
                float4 v = *(const float4*)(W + (size_t)(n0 + n) * ldw + k0 + kq * 4);
                Bs[kq * 4 + 0][n] = v.x; Bs[kq * 4 + 1][n] = v.y; Bs[kq * 4 + 2][n] = v.z; Bs[kq * 4 + 3][n] = v.w;
            }
        }
        __syncthreads();
#pragma unroll
        for (int k = 0; k < 16; ++k) {
            float4 a = *(const float4*)&As[k][ty * 4], b = *(const float4*)&Bs[k][tx * 4];
            const float av[4] = {a.x, a.y, a.z, a.w}, bv[4] = {b.x, b.y, b.z, b.w};
#pragma unroll
            for (int i = 0; i < 4; ++i)
#pragma unroll
                for (int j = 0; j < 4; ++j) acc[i][j] += av[i] * bv[j];
        }
        __syncthreads();
    }
#pragma unroll
    for (int i = 0; i < 4; ++i) epi(m0 + ty * 4 + i, n0 + tx * 4, make_float4(acc[i][0], acc[i][1], acc[i][2], acc[i][3]));
}
template <bool BT, class Epi>
DEVI void gemm_f32(const float* A, int lda, const float* W, int ldw, int M, int N, int K, const Epi& epi, int bid, int nb, float* lds) {
    const int nn = N / 64, nt = (M / 128) * nn;
    for (int tile = bid; tile < nt; tile += nb) gemm_tile<BT>(A, lda, W, ldw, K, (tile / nn) * 128, (tile % nn) * 64, epi, lds);
}
struct EpiStore { float* C; int ldc; DEVI void operator()(int r, int c, float4 v) const { *(float4*)(C + (size_t)r * ldc + c) = v; } };
struct EpiResid {
    const Params* p; int layer;
    DEVI void operator()(int r, int c, float4 v) const {
        const float* x = xrow(*p, layer, r) + c;
        const float* g1 = p->ada + ((size_t)layer * 3 + cond_of(r)) * 6 * D + 2 * D + c;
        float4 xv = *(const float4*)x, gv = *(const float4*)g1, o;
        o.x = xv.x + gv.x * v.x; o.y = xv.y + gv.y * v.y; o.z = xv.z + gv.z * v.z; o.w = xv.w + gv.w * v.w;
        *(float4*)(p->out + (size_t)r * D + c) = o;
    }
};

DEVI void phase_postz(const Params& p, int layer, int bid, int nb) {
    const int lane = threadIdx.x & 63, w = threadIdx.x >> 6;
    for (int r = bid * NWAVES + w; r < TKV; r += nb * NWAVES) {
        if (r >= T) {
            const int b = (r - T) / PAST, j = (r - T) % PAST;
            const float* src = p.cache_ckv + (((size_t)b * DEPTH + layer) * PAST + j) * 256;
            *(float4*)(p.ckv + (size_t)r * 256 + lane * 4) = *(const float4*)(src + lane * 4);
            continue;
        }
        const float* z = p.z + (size_t)r * DIN;
        const bool ctx = r < NCTX;
        const int b = ctx ? r / SEQ : (r - NCTX) / DS, s = ctx ? r % SEQ : (r - NCTX) % DS;
        {
            float v[8], ss = 0.f;
#pragma unroll
            for (int i = 0; i < 8; ++i) { v[i] = z[O_CQ + i * 64 + lane]; ss += v[i] * v[i]; }
            ss = wave_sum(ss); const float rr = rsqrtf(ss / 512.f + EPS);
#pragma unroll
            for (int i = 0; i < 8; ++i) p.cqn[(size_t)r * 512 + i * 64 + lane] = v[i] * rr * p.q_norm_g[layer * 512 + i * 64 + lane];
        }
        {
            float v[4], ss = 0.f;
#pragma unroll
            for (int i = 0; i < 4; ++i) { v[i] = z[O_CKV + i * 64 + lane]; ss += v[i] * v[i]; }
            ss = wave_sum(ss); const float rr = rsqrtf(ss / 256.f + EPS);
#pragma unroll
            for (int i = 0; i < 4; ++i) {
                const float o = v[i] * rr * p.kv_norm_g[layer * 256 + i * 64 + lane];
                p.ckv[(size_t)r * 256 + i * 64 + lane] = o;
                if (ctx) p.o_ckv[(((size_t)b * DEPTH + layer) * SEQ + s) * 256 + i * 64 + lane] = o;
            }
        }
        if (ctx) p.o_kpe[(((size_t)b * DEPTH + layer) * SEQ + s) * 64 + lane] = z[O_KPE + lane];
#pragma unroll
        for (int h = 0; h < 4; ++h) {
            float q0 = z[O_NAQ + h * 128 + lane], q1 = z[O_NAQ + h * 128 + 64 + lane];
            float ss = wave_sum(q0 * q0 + q1 * q1); float rr = rsqrtf(ss / 128.f + EPS);
            p.qna[(size_t)r * 512 + h * 128 + lane] = q0 * rr * p.naq_g[layer * 128 + lane];
            p.qna[(size_t)r * 512 + h * 128 + 64 + lane] = q1 * rr * p.naq_g[layer * 128 + 64 + lane];
            float k0 = z[O_NAK + h * 128 + lane], k1 = z[O_NAK + h * 128 + 64 + lane];
            ss = wave_sum(k0 * k0 + k1 * k1); rr = rsqrtf(ss / 128.f + EPS);
            k0 = k0 * rr * p.nak_g[layer * 128 + lane]; k1 = k1 * rr * p.nak_g[layer * 128 + 64 + lane];
            p.kna[(size_t)r * 512 + h * 128 + lane] = k0; p.kna[(size_t)r * 512 + h * 128 + 64 + lane] = k1;
            if (ctx) {
                const size_t o = ((((size_t)b * DEPTH + layer) * 4 + h) * SEQ + s) * 128;
                p.o_nak[o + lane] = k0; p.o_nak[o + 64 + lane] = k1;
                p.o_nav[o + lane] = z[O_NAV + h * 128 + lane]; p.o_nav[o + 64 + lane] = z[O_NAV + h * 128 + 64 + lane];
            }
        }
        {
            const int S = ctx ? SEQ : DS;
#pragma unroll
            for (int i = 0; i < 8; ++i) {
                const int ch = i * 64 + lane;
                const float* cw = p.conv_w + ((size_t)layer * 512 + ch) * 3;
                float acc = z[O_GC + ch] * z[O_U + ch] * cw[1];
                if (s > 0) acc += (z - DIN)[O_GC + ch] * (z - DIN)[O_U + ch] * cw[0];
                if (s < S - 1) acc += (z + DIN)[O_GC + ch] * (z + DIN)[O_U + ch] * cw[2];
                p.mix[(size_t)r * D + 1536 + ch] = z[O_GB + ch] * acc;
            }
        }
    }
}

DEVI float rope_angle(int pos, int j) {
    const int row = pos / 64, col = pos % 64;
    const int f = j & 15;
    const float inv = powf(10000.f, -(float)f / 16.f);
    return (j < 16 ? (float)row : (float)col) * inv;
}

DEVI void phase_headnorm(const Params& p, int layer, int bid, int nb) {
    const int lane = threadIdx.x & 63, w = threadIdx.x >> 6;
    const int nq = T * 8, nk = TKV * 8;
    for (int it = bid * NWAVES + w; it < nq + nk; it += nb * NWAVES) {
        const bool isq = it < nq;
        const int r = isq ? it / 8 : (it - nq) / 8, h = it % 8;
        float v0, v1, v2; const float* g; float* dst; int pos = -1;
        if (isq) {
            float* q = p.qm + (size_t)r * 1536 + h * 192;
            v0 = q[lane]; v1 = q[64 + lane]; v2 = q[128 + lane]; g = p.q_head_g + layer * 192; dst = q;
            if (r >= NCTX) pos = (r - NCTX) % DS;
        } else {
            const float* kv = p.kvr + (size_t)r * 2048 + h * 256;
            v0 = kv[lane]; v1 = kv[64 + lane];
            if (r < T) v2 = p.z[(size_t)r * DIN + O_KPE + lane];
            else { const int b = (r - T) / PAST, j = (r - T) % PAST; v2 = p.cache_kpe[(((size_t)b * DEPTH + layer) * PAST + j) * 64 + lane]; }
            g = p.k_head_g + layer * 192; dst = p.km + (size_t)r * 1536 + h * 192;
            if (r >= NCTX && r < T) pos = (r - NCTX) % DS;
        }
        const float ss = wave_sum(v0 * v0 + v1 * v1 + v2 * v2);
        const float rr = rsqrtf(ss / 192.f + EPS);
        v0 *= rr * g[lane]; v1 *= rr * g[64 + lane]; v2 *= rr * g[128 + lane];
        if (pos >= 0) {
            const float other = __shfl_xor(v2, 32);
            const float ang = rope_angle(pos, lane & 31);
            const float cs = cosf(ang), sn = sinf(ang);
            v2 = lane < 32 ? v2 * cs - other * sn : other * sn + v2 * cs;
        }
        dst[lane] = v0; dst[64 + lane] = v1; dst[128 + lane] = v2;
    }
}

DEVI void phase_attn(const Params& p, int layer, int bid, int nb, float* lds) {
    const int lane = threadIdx.x & 63, w = threadIdx.x >> 6;
    float* sq = lds + w * 1792;
    float* ss = sq + 192;
    for (int it = bid * NWAVES + w; it < T * 12; it += nb * NWAVES) {
        const int t = it / 12, hs = it % 12;
        const bool ctx = t < NCTX, mla = hs < 8;
        const int h = mla ? hs : hs - 8;
        const int b = ctx ? t / SEQ : (t - NCTX) / DS, s = ctx ? t % SEQ : (t - NCTX) % DS;
        const int dq = mla ? 192 : 128;
        const float scale = mla ? 0.07216878364870322f : 0.08838834764831845f;
        const float* q = mla ? p.qm + (size_t)t * 1536 + h * 192 : p.qna + (size_t)t * 512 + h * 128;
        for (int i = lane; i < dq; i += 64) sq[i] = q[i];
        __builtin_amdgcn_wave_barrier();
        int nkeys, rs = 0, cs = 0;
        if (ctx) nkeys = SEQ;
        else if (mla) nkeys = PAST + DS;
        else { nkeys = 128 + PAST; const int r = s / 64, qc = s % 64; rs = min(max(r - 4, 0), 8); cs = min(max(qc - 8, 0), 48); }
        auto kv_ptrs = [&](int j, const float*& kp, const float*& vp, float& bias) {
            bias = 0.f;
            if (mla) {
                int row;
                if (ctx) row = b * SEQ + j;
                else row = j < PAST ? T + b * PAST + j : NCTX + b * DS + (j - PAST);
                kp = p.km + (size_t)row * 1536 + h * 192; vp = p.kvr + (size_t)row * 2048 + h * 256 + 128;
            } else if (ctx) {
                const int row = b * SEQ + j;
                kp = p.kna + (size_t)row * 512 + h * 128; vp = p.z + (size_t)row * DIN + O_NAV + h * 128;
            } else if (j < 128) {
                const int kr = rs + j / 16, kc = cs + j % 16, row = NCTX + b * DS + kr * 64 + kc;
                kp = p.kna + (size_t)row * 512 + h * 128; vp = p.z + (size_t)row * DIN + O_NAV + h * 128;
                bias = p.rel_bias[(((size_t)layer * 4 + h) * 15 + (kr - s / 64 + 7)) * 31 + (kc - s % 64 + 15)];
            } else {
                const size_t o = ((((size_t)b * DEPTH + layer) * 4 + h) * PAST + (j - 128)) * 128;
                kp = p.cache_nak + o; vp = p.cache_nav + o;
            }
        };
        const int sub = lane & 15, kk = lane >> 4, per = dq / 16;
        for (int j0 = 0; j0 < nkeys; j0 += 4) {
            const float *kp, *vp; float bias;
            kv_ptrs(j0 + kk, kp, vp, bias);
            float part = 0.f;
            for (int d = 0; d < per; d += 4) {
                float4 kvv = *(const float4*)(kp + sub * per + d);
                const float* qq = sq + sub * per + d;
                part += kvv.x * qq[0] + kvv.y * qq[1] + kvv.z * qq[2] + kvv.w * qq[3];
            }
            part += __shfl_xor(part, 1); part += __shfl_xor(part, 2); part += __shfl_xor(part, 4); part += __shfl_xor(part, 8);
            if (sub == 0) ss[j0 + kk] = part * scale + bias;
        }
        __builtin_amdgcn_wave_barrier();
        float m = -INFINITY;
        for (int j = lane; j < nkeys; j += 64) m = fmaxf(m, ss[j]);
        m = wave_max(m);
        float sum = 0.f;
        for (int j = lane; j < nkeys; j += 64) { const float e = __expf(ss[j] - m); ss[j] = e; sum += e; }
        sum = wave_sum(sum);
        __builtin_amdgcn_wave_barrier();
        const float inv = 1.f / sum;
        float o0 = 0.f, o1 = 0.f;
        for (int j = 0; j < nkeys; ++j) {
            const float *kp, *vp; float bias;
            kv_ptrs(j, kp, vp, bias);
            const float pj = ss[j];
            o0 += pj * vp[lane]; o1 += pj * vp[64 + lane];
        }
        float* dst = p.mix + (size_t)t * D + (mla ? h * 128 : 1024 + h * 128);
        dst[lane] = o0 * inv; dst[64 + lane] = o1 * inv;
        __builtin_amdgcn_wave_barrier();
    }
}

DEVI void phase_route(const Params& p, int bid, int nb) {
    const int lane = threadIdx.x & 63, w = threadIdx.x >> 6;
    for (int it = bid * NWAVES + w; it < T * 8; it += nb * NWAVES) {
        const int t = it / 8, h = it % 8;
        const float* sc = p.sc + (size_t)t * 2048 + h * 256;
        float keepS[2]; int keepI[2];
#pragma unroll
        for (int pp = 0; pp < 2; ++pp) {
            float x0 = sc[pp * 128 + lane], x1 = sc[pp * 128 + 64 + lane];
            float ks = 0.f; int ki = 0;
            for (int r = 0; r < 16; ++r) {
                float bv; int bi;
                if (x0 >= x1) { bv = x0; bi = lane; } else { bv = x1; bi = lane + 64; }
                wave_argmax(bv, bi);
                if (lane == r) { ks = bv; ki = bi; }
                if ((bi & 63) == lane) { if (bi < 64) x0 = -INFINITY; else x1 = -INFINITY; }
            }
            keepS[pp] = ks; keepI[pp] = ki;
        }
        const int a = lane >> 2, b0 = (lane & 3) * 4;
        const float s1a = __shfl(keepS[0], a);
        float c0 = s1a + __shfl(keepS[1], b0 + 0), c1 = s1a + __shfl(keepS[1], b0 + 1), c2 = s1a + __shfl(keepS[1], b0 + 2), c3 = s1a + __shfl(keepS[1], b0 + 3);
        float topS = 0.f; int topE = 0; float mx = 0.f;
        for (int r = 0; r < 16; ++r) {
            float bv = c0; int bi = lane * 4;
            if (c1 > bv) { bv = c1; bi = lane * 4 + 1; }
            if (c2 > bv) { bv = c2; bi = lane * 4 + 2; }
            if (c3 > bv) { bv = c3; bi = lane * 4 + 3; }
            wave_argmax(bv, bi);
            const int e = __shfl(keepI[0], bi >> 4) * 128 + __shfl(keepI[1], bi & 15);
            if (r == 0) mx = bv;
            if (lane == r) { topS = bv; topE = e; }
            if ((bi >> 2) == lane) { const int c = bi & 3; if (c == 0) c0 = -INFINITY; else if (c == 1) c1 = -INFINITY; else if (c == 2) c2 = -INFINITY; else c3 = -INFINITY; }
        }
        float e = lane < 16 ? __expf(topS - mx) : 0.f;
        const float sum = wave_sum(e);
        if (lane < 16) { p.gate[(size_t)t * 128 + h * 16 + lane] = e / sum; p.eidx[(size_t)t * 128 + h * 16 + lane] = topE; }
    }
}

DEVI void phase_experts(const Params& p, int layer, int bid, int nb, float* lds) {
    const int lane = threadIdx.x & 63, w = threadIdx.x >> 6;
    float* wgt = lds + w * 128;
    const float* U = p.peer_u + (size_t)layer * 16384 * D;
    const float* V = p.peer_v + (size_t)layer * 16384 * D;
    for (int t = bid * NWAVES + w; t < T; t += nb * NWAVES) {
        float4 x[8];
#pragma unroll
        for (int i = 0; i < 8; ++i) x[i] = *(const float4*)(p.hn + (size_t)t * D + i * 256 + lane * 4);
        for (int e = 0; e < 128; ++e) {
            const int idx = p.eidx[(size_t)t * 128 + e];
            const float* u = U + (size_t)idx * D;
            float d = 0.f;
#pragma unroll
            for (int i = 0; i < 8; ++i) { float4 uv = *(const float4*)(u + i * 256 + lane * 4); d += uv.x * x[i].x + uv.y * x[i].y + uv.z * x[i].z + uv.w * x[i].w; }
            d = wave_sum(d);
            const float a = 0.5f * d * (1.f + erff(d * 0.70710678118654752f));
            if (lane == 0) wgt[e] = a * p.gate[(size_t)t * 128 + e];
        }
        __builtin_amdgcn_wave_barrier();
        float4 o[8];
#pragma unroll
        for (int i = 0; i < 8; ++i) o[i] = make_float4(0.f, 0.f, 0.f, 0.f);
        for (int e = 0; e < 128; ++e) {
            const int idx = p.eidx[(size_t)t * 128 + e];
            const float* v = V + (size_t)idx * D;
            const float wg = wgt[e];
#pragma unroll
            for (int i = 0; i < 8; ++i) { float4 vv = *(const float4*)(v + i * 256 + lane * 4); o[i].x += wg * vv.x; o[i].y += wg * vv.y; o[i].z += wg * vv.z; o[i].w += wg * vv.w; }
        }
        const float* g2 = p.ada + ((size_t)layer * 3 + cond_of(t)) * 6 * D + 5 * D;
        float* xo = p.out + (size_t)t * D;
#pragma unroll
        for (int i = 0; i < 8; ++i) {
            const int c = i * 256 + lane * 4;
            float4 xv = *(const float4*)(xo + c), gv = *(const float4*)(g2 + c);
            xv.x += gv.x * o[i].x; xv.y += gv.y * o[i].y; xv.z += gv.z * o[i].z; xv.w += gv.w * o[i].w;
            *(float4*)(xo + c) = xv;
        }
    }
}

enum { PH_ADA = 0, PH_NORM1, PH_WIN, PH_POSTZ, PH_UQKV, PH_HEADNORM, PH_ATTN, PH_WOUT, PH_NORM2, PH_WQ, PH_SCORES, PH_ROUTE, PH_EXPERTS, PH_COUNT };

template <int PH>
DEVI void run_phase(const Params& p, int layer, int bid, int nb, float* lds) {
    if constexpr (PH == PH_ADA) phase_ada(p, bid, nb, lds);
    if constexpr (PH == PH_NORM1) phase_modnorm(p, layer, 0, bid, nb);
    if constexpr (PH == PH_WIN) gemm_f32<false>(p.hn, D, p.w_in + (size_t)layer * D * DIN, DIN, T, DIN, D, EpiStore{p.z, DIN}, bid, nb, lds);
    if constexpr (PH == PH_POSTZ) phase_postz(p, layer, bid, nb);
    if constexpr (PH == PH_UQKV) {
        gemm_f32<false>(p.cqn, 512, p.w_uq + (size_t)layer * 512 * 1536, 1536, T, 1536, 512, EpiStore{p.qm, 1536}, bid, nb, lds);
        gemm_f32<false>(p.ckv, 256, p.w_ukv + (size_t)layer * 256 * 2048, 2048, TKV, 2048, 256, EpiStore{p.kvr, 2048}, bid, nb, lds);
    }
    if constexpr (PH == PH_HEADNORM) phase_headnorm(p, layer, bid, nb);
    if constexpr (PH == PH_ATTN) phase_attn(p, layer, bid, nb, lds);
    if constexpr (PH == PH_WOUT) gemm_f32<false>(p.mix, D, p.w_out + (size_t)layer * D * D, D, T, D, D, EpiResid{&p, layer}, bid, nb, lds);
    if constexpr (PH == PH_NORM2) phase_modnorm(p, layer, 1, bid, nb);
    if constexpr (PH == PH_WQ) gemm_f32<false>(p.hn, D, p.peer_wq + (size_t)layer * D * D, D, T, D, D, EpiStore{p.qp, D}, bid, nb, lds);
    if constexpr (PH == PH_SCORES) {
        for (int hp = 0; hp < 16; ++hp)
            gemm_f32<true>(p.qp + hp * 128, D, p.sub_keys + ((size_t)layer * 16 + hp) * 128 * 128, 128, T, 128, 128, EpiStore{p.sc + hp * 128, D}, bid, nb, lds);
    }
    if constexpr (PH == PH_ROUTE) phase_route(p, bid, nb);
    if constexpr (PH == PH_EXPERTS) phase_experts(p, layer, bid, nb, lds);
}

template <int PH>
__global__ void __launch_bounds__(NTHREADS, 1) k_phase(Params p, int layer) {
    extern __shared__ float4 lds4[];
    run_phase<PH>(p, layer, blockIdx.x, gridDim.x, (float*)lds4);
}

constexpr size_t LDS_BYTES = 60 * 1024;

template <int PH>
void launch_phase(const Params& p, int layer, hipStream_t stream) {
    hipLaunchKernelGGL(k_phase<PH>, dim3(1024), dim3(NTHREADS), LDS_BYTES, stream, p, layer);
}

}

extern "C" void kernel_launch(void* const* d_in, const int* in_sizes, int n_in, void* d_out, int out_size, void* d_ws, size_t ws_size, hipStream_t stream) {
    Params p{};
    const float* const* in = (const float* const*)d_in;
    p.x_prompt = in[0]; p.x_sample = in[1]; p.cache_ckv = in[2]; p.cache_kpe = in[3]; p.cache_nak = in[4]; p.cache_nav = in[5]; p.c = in[6]; p.c_ctx = in[7];
    p.ada_w = in[8]; p.ada_b = in[9]; p.norm_mix_g = in[10]; p.norm_ffn_g = in[11]; p.w_in = in[12]; p.q_norm_g = in[13]; p.w_uq = in[14]; p.kv_norm_g = in[15]; p.w_ukv = in[16];
    p.q_head_g = in[17]; p.k_head_g = in[18]; p.naq_g = in[19]; p.nak_g = in[20]; p.rel_bias = in[21]; p.conv_w = in[22]; p.w_out = in[23]; p.peer_wq = in[24]; p.sub_keys = in[25];
    p.peer_u = in[26]; p.peer_v = in[27];
    float* out = (float*)d_out;
    p.out = out;
    p.o_ckv = out + (size_t)T * D;
    p.o_kpe = p.o_ckv + (size_t)BATCH * DEPTH * SEQ * 256;
    p.o_nak = p.o_kpe + (size_t)BATCH * DEPTH * SEQ * 64;
    p.o_nav = p.o_nak + (size_t)BATCH * DEPTH * 4 * SEQ * 128;
    char* ws = (char*)d_ws; size_t off = 0;
    auto carve = [&](size_t bytes) { void* r = ws + off; off += (bytes + 255) & ~(size_t)255; return r; };
    p.bar = (unsigned*)carve(16384);
    p.ada = (float*)carve((size_t)DEPTH * 3 * 6 * D * 4);
    p.hn = (float*)carve((size_t)T * D * 4);
    p.z = (float*)carve((size_t)(T + 1) * DIN * 4);
    p.cqn = (float*)carve((size_t)T * 512 * 4);
    p.ckv = (float*)carve((size_t)TKV * 256 * 4);
    p.qm = (float*)carve((size_t)T * 1536 * 4);
    p.kvr = (float*)carve((size_t)TKV * 2048 * 4);
    p.km = (float*)carve((size_t)TKV * 1536 * 4);
    p.qna = (float*)carve((size_t)T * 512 * 4);
    p.kna = (float*)carve((size_t)T * 512 * 4);
    p.mix = (float*)carve((size_t)T * D * 4);
    p.qp = (float*)carve((size_t)T * D * 4);
    p.sc = (float*)carve((size_t)T * D * 4);
    p.gate = (float*)carve((size_t)T * 128 * 4);
    p.eidx = (int*)carve((size_t)T * 128 * 4);

    static bool attr_done = false;
    if (!attr_done) {
        attr_done = true;
    }
    launch_phase<PH_ADA>(p, 0, stream);
    for (int l = 0; l < DEPTH; ++l) {
        launch_phase<PH_NORM1>(p, l, stream);
        launch_phase<PH_WIN>(p, l, stream);
        launch_phase<PH_POSTZ>(p, l, stream);
        launch_phase<PH_UQKV>(p, l, stream);
        launch_phase<PH_HEADNORM>(p, l, stream);
        launch_phase<PH_ATTN>(p, l, stream);
        launch_phase<PH_WOUT>(p, l, stream);
        launch_phase<PH_NORM2>(p, l, stream);
        launch_phase<PH_WQ>(p, l, stream);
        launch_phase<PH_SCORES>(p, l, stream);
        launch_phase<PH_ROUTE>(p, l, stream);
        launch_phase<PH_EXPERTS>(p, l, stream);
    }
}
```

```cpp
#include <hip/hip_runtime.h>
#include <stdint.h>

#define DEVI __device__ __forceinline__

#define XB_TMO      128
#define XB_XCNT(j)  (256  + 64 * (j))
#define XB_XSUB(j)  (1280 + 64 * (j))
#define XB_XGEN(j)  (2304 + 64 * (j))
#define XB_TOP      3328
#define XB_TOPGEN   3392
#define XCD_BAR_WORDS 3456
#define XB_SPIN_CAP (1u << 18)
#define LAS __attribute__((address_space(3)))

__device__ __forceinline__ unsigned xb_ld(unsigned* p)              { return __hip_atomic_load(p, __ATOMIC_RELAXED, __HIP_MEMORY_SCOPE_AGENT); }
__device__ __forceinline__ unsigned xb_add(unsigned* p, unsigned v) { return __hip_atomic_fetch_add(p, v, __ATOMIC_RELAXED, __HIP_MEMORY_SCOPE_AGENT); }
__device__ __forceinline__ unsigned xb_xcc_id() { return (unsigned)__builtin_amdgcn_s_getreg((3 << 11) | 20) & 0xFu; }
#define XB_SPIN(cond, bar) do { unsigned _sp = 0; while (cond) { __builtin_amdgcn_s_sleep(1); \
    if ((++_sp & 255u) == 0u) { if (xb_ld(&(bar)[XB_TMO])) break; if (_sp > XB_SPIN_CAP) { atomicAdd(&(bar)[XB_TMO], 1u); break; } } } } while (0)

struct XcdBarrier {
    unsigned* bar; unsigned x;
    volatile LAS unsigned* st;
};

__device__ __forceinline__ XcdBarrier xcd_barrier_post(unsigned* bar, volatile LAS unsigned* st) {
    XcdBarrier b; b.bar = bar; b.x = xb_xcc_id(); b.st = st;
    if (threadIdx.x == 0) (void)xb_add(&bar[XB_XCNT(b.x)], 1u);
    return b;
}
__device__ __forceinline__ void xcd_barrier_complete(unsigned* bar, unsigned x, unsigned& nloc, unsigned& nx) {
    const unsigned G = gridDim.x * gridDim.y * gridDim.z;
    unsigned sum, cnt, mine, sp = 0u;
    for (;;) {
        sum = 0u; cnt = 0u; mine = 0u;
#pragma unroll
        for (unsigned j = 0; j < 16; ++j) { const unsigned c = xb_ld(&bar[XB_XCNT(j)]); sum += c; cnt += (c > 0u) ? 1u : 0u; mine = (j == x) ? c : mine; }
        if (sum == G) break;
        __builtin_amdgcn_s_sleep(1);
        if ((++sp & 255u) == 0u) { if (xb_ld(&bar[XB_TMO])) break; if (sp > XB_SPIN_CAP) { atomicAdd(&bar[XB_TMO], 1u); break; } }
    }
    nloc = mine > 0u ? mine : 1u; nx = cnt > 0u ? cnt : 1u;
}

__device__ __forceinline__ void xcd_barrier(const XcdBarrier& b) {
    asm volatile("s_waitcnt vmcnt(0)" ::: "memory");
    __syncthreads();
    if (threadIdx.x == 0) {
        unsigned* bar = b.bar;
        __builtin_amdgcn_s_waitcnt(0);
        unsigned nloc = b.st[0], nx = b.st[1];
        if (nloc == 0u) { xcd_barrier_complete(bar, b.x, nloc, nx); b.st[0] = nloc; b.st[1] = nx; }
        const unsigned old = xb_add(&bar[XB_XSUB(b.x)], 1u);
        const unsigned gen = old / nloc;
        if (old + 1u == (gen + 1u) * nloc) {
            __builtin_amdgcn_fence(__ATOMIC_RELEASE, "agent");
            asm volatile("s_waitcnt vmcnt(0)" ::: "memory");
            const unsigned og = xb_add(&bar[XB_TOP], 1u);
            const unsigned tg = og / nx;
            if (og + 1u == (tg + 1u) * nx) xb_add(&bar[XB_TOPGEN], 1u);
            else XB_SPIN(xb_ld(&bar[XB_TOPGEN]) == tg, bar);
            __builtin_amdgcn_fence(__ATOMIC_ACQUIRE, "agent");
            xb_add(&bar[XB_XGEN(b.x)], 1u);
            asm volatile("s_waitcnt vmcnt(0)" ::: "memory");
        } else {
            XB_SPIN(xb_ld(&bar[XB_XGEN(b.x)]) == gen, bar);
            __builtin_amdgcn_fence(__ATOMIC_ACQUIRE, "agent");
            asm volatile("s_waitcnt vmcnt(0)" ::: "memory");
        }
    }
    __syncthreads();
}


namespace {

constexpr int D = 2048, BATCH = 32, SEQ = 256, DEPTH = 4, DB = 2, DS = 1024, PAST = 512;
constexpr int NCTX = BATCH * SEQ, NLAT = DB * DS, T = NCTX + NLAT, TKV = T + DB * PAST;
constexpr int DIN = 3904;
constexpr int O_CQ = 0, O_CKV = 512, O_KPE = 768, O_NAQ = 832, O_NAK = 1344, O_NAV = 1856, O_GB = 2368, O_GC = 2880, O_U = 3392;
constexpr float EPS = 1e-6f;
constexpr int NTHREADS = 512, NWAVES = NTHREADS / 64;

struct Params {
    const float *x_prompt, *x_sample, *cache_ckv, *cache_kpe, *cache_nak, *cache_nav, *c, *c_ctx;
    const float *ada_w, *ada_b, *norm_mix_g, *norm_ffn_g, *w_in, *q_norm_g, *w_uq, *kv_norm_g, *w_ukv;
    const float *q_head_g, *k_head_g, *naq_g, *nak_g, *rel_bias, *conv_w, *w_out, *peer_wq, *sub_keys, *peer_u, *peer_v;
    float* out;
    float *o_ckv, *o_kpe, *o_nak, *o_nav;
    unsigned* bar;
    float *ada, *hn, *z, *cqn, *ckv, *qm, *kvr, *km, *qna, *kna, *mix, *qp, *sc, *gate;
    int* eidx;
};

typedef const __attribute__((address_space(4))) Params CParams;

DEVI float wave_sum(float v) {
#pragma unroll
    for (int o = 32; o > 0; o >>= 1) v += __shfl_xor(v, o);
    return v;
}
DEVI float wave_max(float v) {
#pragma unroll
    for (int o = 32; o > 0; o >>= 1) v = fmaxf(v, __shfl_xor(v, o));
    return v;
}
DEVI void wave_argmax(float& v, int& idx) {
#pragma unroll
    for (int o = 32; o > 0; o >>= 1) {
        float ov = __shfl_xor(v, o); int oi = __shfl_xor(idx, o);
        if (ov > v || (ov == v && oi < idx)) { v = ov; idx = oi; }
    }
}
DEVI int cond_of(int t) { return t < NCTX ? 2 : (t - NCTX) / DS; }
DEVI const float* xrow(CParams& p, int layer, int t) {
    if (layer == 0) return t < NCTX ? p.x_prompt + (size_t)t * D : p.x_sample + (size_t)(t - NCTX) * D;
    return p.out + (size_t)t * D;
}

DEVI void phase_ada(CParams& p, int bid, int nb, float* lds) {
    float* sv = lds;
    float* red = lds + 3 * D;
    const int tid = threadIdx.x, lane = tid & 63, w = tid >> 6;
    for (int i = tid; i < 3 * D; i += NTHREADS) {
        int j = i / D, k = i % D;
        float v = j < 2 ? p.c[j * D + k] : p.c_ctx[k];
        sv[i] = v / (1.f + __expf(-v));
    }
    __syncthreads();
    const int nitems = DEPTH * (6 * D / 64);
    for (int it = bid; it < nitems; it += nb) {
        const int l = it / (6 * D / 64), n = (it % (6 * D / 64)) * 64 + lane;
        const float* W = p.ada_w + (size_t)l * D * 6 * D + n;
        float a0 = 0.f, a1 = 0.f, a2 = 0.f;
        const int k0 = w * (D / NWAVES);
#pragma unroll 8
        for (int k = k0; k < k0 + D / NWAVES; ++k) {
            float wv = W[(size_t)k * 6 * D];
            a0 += sv[k] * wv; a1 += sv[D + k] * wv; a2 += sv[2 * D + k] * wv;
        }
        red[(w * 3 + 0) * 64 + lane] = a0; red[(w * 3 + 1) * 64 + lane] = a1; red[(w * 3 + 2) * 64 + lane] = a2;
        __syncthreads();
        if (tid < 192) {
            int j = tid / 64, ln = tid % 64;
            float s = 0.f;
            for (int ww = 0; ww < NWAVES; ++ww) s += red[(ww * 3 + j) * 64 + ln];
            int nn = (it % (6 * D / 64)) * 64 + ln;
            p.ada[((size_t)l * 3 + j) * 6 * D + nn] = s + p.ada_b[(size_t)l * 6 * D + nn];
        }
        __syncthreads();
    }
}

DEVI void phase_modnorm(CParams& p, int layer, int which, int bid, int nb) {
    const int lane = threadIdx.x & 63, w = threadIdx.x >> 6;
    const float* g = (which == 0 ? p.norm_mix_g : p.norm_ffn_g) + (size_t)layer * D;
    for (int t = bid * NWAVES + w; t < T; t += nb * NWAVES) {
        const float* x = which == 0 ? xrow(p, layer, t) : p.out + (size_t)t * D;
        const float* ad = p.ada + ((size_t)layer * 3 + cond_of(t)) * 6 * D + (which == 0 ? 0 : 3 * D);
        float4 v[8]; float ss = 0.f;
#pragma unroll
        for (int i = 0; i < 8; ++i) { v[i] = *(const float4*)(x + i * 256 + lane * 4); ss += v[i].x * v[i].x + v[i].y * v[i].y + v[i].z * v[i].z + v[i].w * v[i].w; }
        ss = wave_sum(ss);
        const float r = rsqrtf(ss / D + EPS);
#pragma unroll
        for (int i = 0; i < 8; ++i) {
            const int c = i * 256 + lane * 4;
            float4 gg = *(const float4*)(g + c), sh = *(const float4*)(ad + c), sc = *(const float4*)(ad + D + c), o;
            o.x = v[i].x * r * gg.x * (1.f + sc.x) + sh.x; o.y = v[i].y * r * gg.y * (1.f + sc.y) + sh.y;
            o.z = v[i].z * r * gg.z * (1.f + sc.z) + sh.z; o.w = v[i].w * r * gg.w * (1.f + sc.w) + sh.w;
            *(float4*)(p.hn + (size_t)t * D + c) = o;
        }
    }
}

template <bool BT, class Epi>
DEVI void gemm_tile(const float* A, int lda, const float* W, int ldw, int K, int m0, int n0, const Epi& epi, float* lds) {
    float (*As)[132] = (float (*)[132])lds;
    float (*Bs)[68] = (float (*)[68])(lds + 16 * 132);
    const int tid = threadIdx.x, tx = tid & 15, ty = tid >> 4;
    float acc[4][4];
#pragma unroll
    for (int i = 0; i < 4; ++i)
#pragma unroll
        for (int j = 0; j < 4; ++j) acc[i][j] = 0.f;
    for (int k0 = 0; k0 < K; k0 += 16) {
        {
            const int row = tid >> 2, kq = tid & 3;
            float4 v = *(const float4*)(A + (size_t)(m0 + row) * lda + k0 + kq * 4);
            As[kq * 4 + 0][row] = v.x; As[kq * 4 + 1][row] = v.y; As[kq * 4 + 2][row] = v.z; As[kq * 4 + 3][row] = v.w;
        }
        if (tid < 256) {
            if (!BT) {
                const int k = tid >> 4, n4 = tid & 15;
                float4 v = *(const float4*)(W + (size_t)(k0 + k) * ldw + n0 + n4 * 4);
                *(float4*)&Bs[k][n4 * 4] = v;
            } else {
                const int n = tid >> 2, kq = tid & 3;
                float4 v = *(const float4*)(W + (size_t)(n0 + n) * ldw + k0 + kq * 4);
                Bs[kq * 4 + 0][n] = v.x; Bs[kq * 4 + 1][n] = v.y; Bs[kq * 4 + 2][n] = v.z; Bs[kq * 4 + 3][n] = v.w;
            }
        }
        __syncthreads();
#pragma unroll
        for (int k = 0; k < 16; ++k) {
            float4 a = *(const float4*)&As[k][ty * 4], b = *(const float4*)&Bs[k][tx * 4];
            const float av[4] = {a.x, a.y, a.z, a.w}, bv[4] = {b.x, b.y, b.z, b.w};
#pragma unroll
            for (int i = 0; i < 4; ++i)
#pragma unroll
                for (int j = 0; j < 4; ++j) acc[i][j] += av[i] * bv[j];
        }
        __syncthreads();
    }
#pragma unroll
    for (int i = 0; i < 4; ++i) epi(m0 + ty * 4 + i, n0 + tx * 4, make_float4(acc[i][0], acc[i][1], acc[i][2], acc[i][3]));
}
template <bool BT, class Epi>
DEVI void gemm_f32(const float* A, int lda, const float* W, int ldw, int M, int N, int K, const Epi& epi, int bid, int nb, float* lds) {
    const int nn = N / 64, nt = (M / 128) * nn;
    for (int tile = bid; tile < nt; tile += nb) gemm_tile<BT>(A, lda, W, ldw, K, (tile / nn) * 128, (tile % nn) * 64, epi, lds);
}
struct EpiStore { float* C; int ldc; DEVI void operator()(int r, int c, float4 v) const { *(float4*)(C + (size_t)r * ldc + c) = v; } };
struct EpiResid {
    CParams* p; int layer;
    DEVI void operator()(int r, int c, float4 v) const {
        const float* x = xrow(*p, layer, r) + c;
        const float* g1 = p->ada + ((size_t)layer * 3 + cond_of(r)) * 6 * D + 2 * D + c;
        float4 xv = *(const float4*)x, gv = *(const float4*)g1, o;
        o.x = xv.x + gv.x * v.x; o.y = xv.y + gv.y * v.y; o.z = xv.z + gv.z * v.z; o.w = xv.w + gv.w * v.w;
        *(float4*)(p->out + (size_t)r * D + c) = o;
    }
};

DEVI void phase_postz(CParams& p, int layer, int bid, int nb) {
    const int lane = threadIdx.x & 63, w = threadIdx.x >> 6;
    for (int r = bid * NWAVES + w; r < TKV; r += nb * NWAVES) {
        if (r >= T) {
            const int b = (r - T) / PAST, j = (r - T) % PAST;
            const float* src = p.cache_ckv + (((size_t)b * DEPTH + layer) * PAST + j) * 256;
            *(float4*)(p.ckv + (size_t)r * 256 + lane * 4) = *(const float4*)(src + lane * 4);
            continue;
        }
        const float* z = p.z + (size_t)r * DIN;
        const bool ctx = r < NCTX;
        const int b = ctx ? r / SEQ : (r - NCTX) / DS, s = ctx ? r % SEQ : (r - NCTX) % DS;
        {
            float v[8], ss = 0.f;
#pragma unroll
            for (int i = 0; i < 8; ++i) { v[i] = z[O_CQ + i * 64 + lane]; ss += v[i] * v[i]; }
            ss = wave_sum(ss); const float rr = rsqrtf(ss / 512.f + EPS);
#pragma unroll
            for (int i = 0; i < 8; ++i) p.cqn[(size_t)r * 512 + i * 64 + lane] = v[i] * rr * p.q_norm_g[layer * 512 + i * 64 + lane];
        }
        {
            float v[4], ss = 0.f;
#pragma unroll
            for (int i = 0; i < 4; ++i) { v[i] = z[O_CKV + i * 64 + lane]; ss += v[i] * v[i]; }
            ss = wave_sum(ss); const float rr = rsqrtf(ss / 256.f + EPS);
#pragma unroll
            for (int i = 0; i < 4; ++i) {
                const float o = v[i] * rr * p.kv_norm_g[layer * 256 + i * 64 + lane];
                p.ckv[(size_t)r * 256 + i * 64 + lane] = o;
                if (ctx) p.o_ckv[(((size_t)b * DEPTH + layer) * SEQ + s) * 256 + i * 64 + lane] = o;
            }
        }
        if (ctx) p.o_kpe[(((size_t)b * DEPTH + layer) * SEQ + s) * 64 + lane] = z[O_KPE + lane];
#pragma unroll
        for (int h = 0; h < 4; ++h) {
            float q0 = z[O_NAQ + h * 128 + lane], q1 = z[O_NAQ + h * 128 + 64 + lane];
            float ss = wave_sum(q0 * q0 + q1 * q1); float rr = rsqrtf(ss / 128.f + EPS);
            p.qna[(size_t)r * 512 + h * 128 + lane] = q0 * rr * p.naq_g[layer * 128 + lane];
            p.qna[(size_t)r * 512 + h * 128 + 64 + lane] = q1 * rr * p.naq_g[layer * 128 + 64 + lane];
            float k0 = z[O_NAK + h * 128 + lane], k1 = z[O_NAK + h * 128 + 64 + lane];
            ss = wave_sum(k0 * k0 + k1 * k1); rr = rsqrtf(ss / 128.f + EPS);
            k0 = k0 * rr * p.nak_g[layer * 128 + lane]; k1 = k1 * rr * p.nak_g[layer * 128 + 64 + lane];
            p.kna[(size_t)r * 512 + h * 128 + lane] = k0; p.kna[(size_t)r * 512 + h * 128 + 64 + lane] = k1;
            if (ctx) {
                const size_t o = ((((size_t)b * DEPTH + layer) * 4 + h) * SEQ + s) * 128;
                p.o_nak[o + lane] = k0; p.o_nak[o + 64 + lane] = k1;
                p.o_nav[o + lane] = z[O_NAV + h * 128 + lane]; p.o_nav[o + 64 + lane] = z[O_NAV + h * 128 + 64 + lane];
            }
        }
        {
            const int S = ctx ? SEQ : DS;
#pragma unroll
            for (int i = 0; i < 8; ++i) {
                const int ch = i * 64 + lane;
                const float* cw = p.conv_w + ((size_t)layer * 512 + ch) * 3;
                float acc = z[O_GC + ch] * z[O_U + ch] * cw[1];
                if (s > 0) acc += (z - DIN)[O_GC + ch] * (z - DIN)[O_U + ch] * cw[0];
                if (s < S - 1) acc += (z + DIN)[O_GC + ch] * (z + DIN)[O_U + ch] * cw[2];
                p.mix[(size_t)r * D + 1536 + ch] = z[O_GB + ch] * acc;
            }
        }
    }
}

DEVI float rope_angle(int pos, int j) {
    const int row = pos / 64, col = pos % 64;
    const int f = j & 15;
    const float inv = powf(10000.f, -(float)f / 16.f);
    return (j < 16 ? (float)row : (float)col) * inv;
}

DEVI void phase_headnorm(CParams& p, int layer, int bid, int nb) {
    const int lane = threadIdx.x & 63, w = threadIdx.x >> 6;
    const int nq = T * 8, nk = TKV * 8;
    for (int it = bid * NWAVES + w; it < nq + nk; it += nb * NWAVES) {
        const bool isq = it < nq;
        const int r = isq ? it / 8 : (it - nq) / 8, h = it % 8;
        float v0, v1, v2; const float* g; float* dst; int pos = -1;
        if (isq) {
            float* q = p.qm + (size_t)r * 1536 + h * 192;
            v0 = q[lane]; v1 = q[64 + lane]; v2 = q[128 + lane]; g = p.q_head_g + layer * 192; dst = q;
            if (r >= NCTX) pos = (r - NCTX) % DS;
        } else {
            const float* kv = p.kvr + (size_t)r * 2048 + h * 256;
            v0 = kv[lane]; v1 = kv[64 + lane];
            if (r < T) v2 = p.z[(size_t)r * DIN + O_KPE + lane];
            else { const int b = (r - T) / PAST, j = (r - T) % PAST; v2 = p.cache_kpe[(((size_t)b * DEPTH + layer) * PAST + j) * 64 + lane]; }
            g = p.k_head_g + layer * 192; dst = p.km + (size_t)r * 1536 + h * 192;
            if (r >= NCTX && r < T) pos = (r - NCTX) % DS;
        }
        const float ss = wave_sum(v0 * v0 + v1 * v1 + v2 * v2);
        const float rr = rsqrtf(ss / 192.f + EPS);
        v0 *= rr * g[lane]; v1 *= rr * g[64 + lane]; v2 *= rr * g[128 + lane];
        if (pos >= 0) {
            const float other = __shfl_xor(v2, 32);
            const float ang = rope_angle(pos, lane & 31);
            const float cs = cosf(ang), sn = sinf(ang);
            v2 = lane < 32 ? v2 * cs - other * sn : other * sn + v2 * cs;
        }
        dst[lane] = v0; dst[64 + lane] = v1; dst[128 + lane] = v2;
    }
}

DEVI void phase_attn(CParams& p, int layer, int bid, int nb, float* lds) {
    const int lane = threadIdx.x & 63, w = threadIdx.x >> 6;
    float* sq = lds + w * 1792;
    float* ss = sq + 192;
    for (int it = bid * NWAVES + w; it < T * 12; it += nb * NWAVES) {
        const int t = it / 12, hs = it % 12;
        const bool ctx = t < NCTX, mla = hs < 8;
        const int h = mla ? hs : hs - 8;
        const int b = ctx ? t / SEQ : (t - NCTX) / DS, s = ctx ? t % SEQ : (t - NCTX) % DS;
        const int dq = mla ? 192 : 128;
        const float scale = mla ? 0.07216878364870322f : 0.08838834764831845f;
        const float* q = mla ? p.qm + (size_t)t * 1536 + h * 192 : p.qna + (size_t)t * 512 + h * 128;
        for (int i = lane; i < dq; i += 64) sq[i] = q[i];
        __builtin_amdgcn_wave_barrier();
        int nkeys, rs = 0, cs = 0;
        if (ctx) nkeys = SEQ;
        else if (mla) nkeys = PAST + DS;
        else { nkeys = 128 + PAST; const int r = s / 64, qc = s % 64; rs = min(max(r - 4, 0), 8); cs = min(max(qc - 8, 0), 48); }
        auto kv_ptrs = [&](int j, const float*& kp, const float*& vp, float& bias) {
            bias = 0.f;
            if (mla) {
                int row;
                if (ctx) row = b * SEQ + j;
                else row = j < PAST ? T + b * PAST + j : NCTX + b * DS + (j - PAST);
                kp = p.km + (size_t)row * 1536 + h * 192; vp = p.kvr + (size_t)row * 2048 + h * 256 + 128;
            } else if (ctx) {
                const int row = b * SEQ + j;
                kp = p.kna + (size_t)row * 512 + h * 128; vp = p.z + (size_t)row * DIN + O_NAV + h * 128;
            } else if (j < 128) {
                const int kr = rs + j / 16, kc = cs + j % 16, row = NCTX + b * DS + kr * 64 + kc;
                kp = p.kna + (size_t)row * 512 + h * 128; vp = p.z + (size_t)row * DIN + O_NAV + h * 128;
                bias = p.rel_bias[(((size_t)layer * 4 + h) * 15 + (kr - s / 64 + 7)) * 31 + (kc - s % 64 + 15)];
            } else {
                const size_t o = ((((size_t)b * DEPTH + layer) * 4 + h) * PAST + (j - 128)) * 128;
                kp = p.cache_nak + o; vp = p.cache_nav + o;
            }
        };
        const int sub = lane & 15, kk = lane >> 4, per = dq / 16;
        for (int j0 = 0; j0 < nkeys; j0 += 4) {
            const float *kp, *vp; float bias;
            kv_ptrs(j0 + kk, kp, vp, bias);
            float part = 0.f;
            for (int d = 0; d < per; d += 4) {
                float4 kvv = *(const float4*)(kp + sub * per + d);
                const float* qq = sq + sub * per + d;
                part += kvv.x * qq[0] + kvv.y * qq[1] + kvv.z * qq[2] + kvv.w * qq[3];
            }
            part += __shfl_xor(part, 1); part += __shfl_xor(part, 2); part += __shfl_xor(part, 4); part += __shfl_xor(part, 8);
            if (sub == 0) ss[j0 + kk] = part * scale + bias;
        }
        __builtin_amdgcn_wave_barrier();
        float m = -INFINITY;
        for (int j = lane; j < nkeys; j += 64) m = fmaxf(m, ss[j]);
        m = wave_max(m);
        float sum = 0.f;
        for (int j = lane; j < nkeys; j += 64) { const float e = __expf(ss[j] - m); ss[j] = e; sum += e; }
        sum = wave_sum(sum);
        __builtin_amdgcn_wave_barrier();
        const float inv = 1.f / sum;
        float o0 = 0.f, o1 = 0.f;
        for (int j = 0; j < nkeys; ++j) {
            const float *kp, *vp; float bias;
            kv_ptrs(j, kp, vp, bias);
            const float pj = ss[j];
            o0 += pj * vp[lane]; o1 += pj * vp[64 + lane];
        }
        float* dst = p.mix + (size_t)t * D + (mla ? h * 128 : 1024 + h * 128);
        dst[lane] = o0 * inv; dst[64 + lane] = o1 * inv;
        __builtin_amdgcn_wave_barrier();
    }
}

DEVI void phase_route(CParams& p, int bid, int nb) {
    const int lane = threadIdx.x & 63, w = threadIdx.x >> 6;
    for (int it = bid * NWAVES + w; it < T * 8; it += nb * NWAVES) {
        const int t = it / 8, h = it % 8;
        const float* sc = p.sc + (size_t)t * 2048 + h * 256;
        float keepS[2]; int keepI[2];
#pragma unroll
        for (int pp = 0; pp < 2; ++pp) {
            float x0 = sc[pp * 128 + lane], x1 = sc[pp * 128 + 64 + lane];
            float ks = 0.f; int ki = 0;
            for (int r = 0; r < 16; ++r) {
                float bv; int bi;
                if (x0 >= x1) { bv = x0; bi = lane; } else { bv = x1; bi = lane + 64; }
                wave_argmax(bv, bi);
                if (lane == r) { ks = bv; ki = bi; }
                if ((bi & 63) == lane) { if (bi < 64) x0 = -INFINITY; else x1 = -INFINITY; }
            }
            keepS[pp] = ks; keepI[pp] = ki;
        }
        const int a = lane >> 2, b0 = (lane & 3) * 4;
        const float s1a = __shfl(keepS[0], a);
        float c0 = s1a + __shfl(keepS[1], b0 + 0), c1 = s1a + __shfl(keepS[1], b0 + 1), c2 = s1a + __shfl(keepS[1], b0 + 2), c3 = s1a + __shfl(keepS[1], b0 + 3);
        float topS = 0.f; int topE = 0; float mx = 0.f;
        for (int r = 0; r < 16; ++r) {
            float bv = c0; int bi = lane * 4;
            if (c1 > bv) { bv = c1; bi = lane * 4 + 1; }
            if (c2 > bv) { bv = c2; bi = lane * 4 + 2; }
            if (c3 > bv) { bv = c3; bi = lane * 4 + 3; }
            wave_argmax(bv, bi);
            const int e = __shfl(keepI[0], bi >> 4) * 128 + __shfl(keepI[1], bi & 15);
            if (r == 0) mx = bv;
            if (lane == r) { topS = bv; topE = e; }
            if ((bi >> 2) == lane) { const int c = bi & 3; if (c == 0) c0 = -INFINITY; else if (c == 1) c1 = -INFINITY; else if (c == 2) c2 = -INFINITY; else c3 = -INFINITY; }
        }
        float e = lane < 16 ? __expf(topS - mx) : 0.f;
        const float sum = wave_sum(e);
        if (lane < 16) { p.gate[(size_t)t * 128 + h * 16 + lane] = e / sum; p.eidx[(size_t)t * 128 + h * 16 + lane] = topE; }
    }
}

DEVI void phase_experts(CParams& p, int layer, int bid, int nb, float* lds) {
    const int lane = threadIdx.x & 63, w = threadIdx.x >> 6;
    float* wgt = lds + w * 128;
    const float* U = p.peer_u + (size_t)layer * 16384 * D;
    const float* V = p.peer_v + (size_t)layer * 16384 * D;
    for (int t = bid * NWAVES + w; t < T; t += nb * NWAVES) {
        float4 x[8];
#pragma unroll
        for (int i = 0; i < 8; ++i) x[i] = *(const float4*)(p.hn + (size_t)t * D + i * 256 + lane * 4);
        for (int e = 0; e < 128; ++e) {
            const int idx = p.eidx[(size_t)t * 128 + e];
            const float* u = U + (size_t)idx * D;
            float d = 0.f;
#pragma unroll
            for (int i = 0; i < 8; ++i) { float4 uv = *(const float4*)(u + i * 256 + lane * 4); d += uv.x * x[i].x + uv.y * x[i].y + uv.z * x[i].z + uv.w * x[i].w; }
            d = wave_sum(d);
            const float a = 0.5f * d * (1.f + erff(d * 0.70710678118654752f));
            if (lane == 0) wgt[e] = a * p.gate[(size_t)t * 128 + e];
        }
        __builtin_amdgcn_wave_barrier();
        float4 o[8];
#pragma unroll
        for (int i = 0; i < 8; ++i) o[i] = make_float4(0.f, 0.f, 0.f, 0.f);
        for (int e = 0; e < 128; ++e) {
            const int idx = p.eidx[(size_t)t * 128 + e];
            const float* v = V + (size_t)idx * D;
            const float wg = wgt[e];
#pragma unroll
            for (int i = 0; i < 8; ++i) { float4 vv = *(const float4*)(v + i * 256 + lane * 4); o[i].x += wg * vv.x; o[i].y += wg * vv.y; o[i].z += wg * vv.z; o[i].w += wg * vv.w; }
        }
        const float* g2 = p.ada + ((size_t)layer * 3 + cond_of(t)) * 6 * D + 5 * D;
        float* xo = p.out + (size_t)t * D;
#pragma unroll
        for (int i = 0; i < 8; ++i) {
            const int c = i * 256 + lane * 4;
            float4 xv = *(const float4*)(xo + c), gv = *(const float4*)(g2 + c);
            xv.x += gv.x * o[i].x; xv.y += gv.y * o[i].y; xv.z += gv.z * o[i].z; xv.w += gv.w * o[i].w;
            *(float4*)(xo + c) = xv;
        }
    }
}

enum { PH_ADA = 0, PH_NORM1, PH_WIN, PH_POSTZ, PH_UQKV, PH_HEADNORM, PH_ATTN, PH_WOUT, PH_NORM2, PH_WQ, PH_SCORES, PH_ROUTE, PH_EXPERTS, PH_COUNT };

template <int PH>
DEVI void run_phase(CParams& p, int layer, int bid, int nb, float* lds) {
    if constexpr (PH == PH_ADA) phase_ada(p, bid, nb, lds);
    if constexpr (PH == PH_NORM1) phase_modnorm(p, layer, 0, bid, nb);
    if constexpr (PH == PH_WIN) gemm_f32<false>(p.hn, D, p.w_in + (size_t)layer * D * DIN, DIN, T, DIN, D, EpiStore{p.z, DIN}, bid, nb, lds);
    if constexpr (PH == PH_POSTZ) phase_postz(p, layer, bid, nb);
    if constexpr (PH == PH_UQKV) {
        gemm_f32<false>(p.cqn, 512, p.w_uq + (size_t)layer * 512 * 1536, 1536, T, 1536, 512, EpiStore{p.qm, 1536}, bid, nb, lds);
        gemm_f32<false>(p.ckv, 256, p.w_ukv + (size_t)layer * 256 * 2048, 2048, TKV, 2048, 256, EpiStore{p.kvr, 2048}, bid, nb, lds);
    }
    if constexpr (PH == PH_HEADNORM) phase_headnorm(p, layer, bid, nb);
    if constexpr (PH == PH_ATTN) phase_attn(p, layer, bid, nb, lds);
    if constexpr (PH == PH_WOUT) gemm_f32<false>(p.mix, D, p.w_out + (size_t)layer * D * D, D, T, D, D, EpiResid{&p, layer}, bid, nb, lds);
    if constexpr (PH == PH_NORM2) phase_modnorm(p, layer, 1, bid, nb);
    if constexpr (PH == PH_WQ) gemm_f32<false>(p.hn, D, p.peer_wq + (size_t)layer * D * D, D, T, D, D, EpiStore{p.qp, D}, bid, nb, lds);
    if constexpr (PH == PH_SCORES) {
        for (int hp = 0; hp < 16; ++hp)
            gemm_f32<true>(p.qp + hp * 128, D, p.sub_keys + ((size_t)layer * 16 + hp) * 128 * 128, 128, T, 128, 128, EpiStore{p.sc + hp * 128, D}, bid, nb, lds);
    }
    if constexpr (PH == PH_ROUTE) phase_route(p, bid, nb);
    if constexpr (PH == PH_EXPERTS) phase_experts(p, layer, bid, nb, lds);
}

#ifndef MK_ONE_LAUNCH
#define MK_ONE_LAUNCH 1
#endif
constexpr size_t LDS_BYTES = 60 * 1024;

#if MK_ONE_LAUNCH
#define PHASE(PH, l) do { CParams* q_ = pp; asm volatile("" : "+s"(q_)); run_phase<PH>(*q_, l, (int)blockIdx.x, (int)gridDim.x, lds); xcd_barrier(bar); } while (0)
__global__ void __launch_bounds__(NTHREADS, 2) k_fwd(Params p_unused) {
    CParams* pp = (CParams*)__builtin_amdgcn_kernarg_segment_ptr();
    extern __shared__ float4 lds4[];
    float* lds = (float*)lds4;
    __shared__ uint4 xb_words;
    if (threadIdx.x == 0) xb_words = make_uint4(0u, 0u, 0u, 0u);
    __syncthreads();
    XcdBarrier bar = xcd_barrier_post(pp->bar, (volatile LAS unsigned*)&xb_words);
    PHASE(PH_ADA, 0);
    for (int l = 0; l < DEPTH; ++l) {
        PHASE(PH_NORM1, l);
        PHASE(PH_WIN, l);
        PHASE(PH_POSTZ, l);
        PHASE(PH_UQKV, l);
        PHASE(PH_HEADNORM, l);
        PHASE(PH_ATTN, l);
        PHASE(PH_WOUT, l);
        PHASE(PH_NORM2, l);
        PHASE(PH_WQ, l);
        PHASE(PH_SCORES, l);
        PHASE(PH_ROUTE, l);
        PHASE(PH_EXPERTS, l);
    }
}
#else
template <int PH>
__global__ void __launch_bounds__(NTHREADS, 4) k_phase(Params p, int layer) {
    extern __shared__ float4 lds4[];
    CParams* pp = (CParams*)__builtin_amdgcn_kernarg_segment_ptr();
    run_phase<PH>(*pp, layer, blockIdx.x, gridDim.x, (float*)lds4);
}
template <int PH>
void launch_phase(const Params& p, int layer, hipStream_t stream) {
    hipLaunchKernelGGL(k_phase<PH>, dim3(1024), dim3(NTHREADS), LDS_BYTES, stream, p, layer);
}
#endif

}

extern "C" void kernel_launch(void* const* d_in, const int* in_sizes, int n_in, void* d_out, int out_size, void* d_ws, size_t ws_size, hipStream_t stream) {
    Params p{};
    const float* const* in = (const float* const*)d_in;
    p.x_prompt = in[0]; p.x_sample = in[1]; p.cache_ckv = in[2]; p.cache_kpe = in[3]; p.cache_nak = in[4]; p.cache_nav = in[5]; p.c = in[6]; p.c_ctx = in[7];
    p.ada_w = in[8]; p.ada_b = in[9]; p.norm_mix_g = in[10]; p.norm_ffn_g = in[11]; p.w_in = in[12]; p.q_norm_g = in[13]; p.w_uq = in[14]; p.kv_norm_g = in[15]; p.w_ukv = in[16];
    p.q_head_g = in[17]; p.k_head_g = in[18]; p.naq_g = in[19]; p.nak_g = in[20]; p.rel_bias = in[21]; p.conv_w = in[22]; p.w_out = in[23]; p.peer_wq = in[24]; p.sub_keys = in[25];
    p.peer_u = in[26]; p.peer_v = in[27];
    float* out = (float*)d_out;
    p.out = out;
    p.o_ckv = out + (size_t)T * D;
    p.o_kpe = p.o_ckv + (size_t)BATCH * DEPTH * SEQ * 256;
    p.o_nak = p.o_kpe + (size_t)BATCH * DEPTH * SEQ * 64;
    p.o_nav = p.o_nak + (size_t)BATCH * DEPTH * 4 * SEQ * 128;
    char* ws = (char*)d_ws; size_t off = 0;
    auto carve = [&](size_t bytes) { void* r = ws + off; off += (bytes + 255) & ~(size_t)255; return r; };
    p.bar = (unsigned*)carve(16384);
    p.ada = (float*)carve((size_t)DEPTH * 3 * 6 * D * 4);
    p.hn = (float*)carve((size_t)T * D * 4);
    p.z = (float*)carve((size_t)(T + 1) * DIN * 4);
    p.cqn = (float*)carve((size_t)T * 512 * 4);
    p.ckv = (float*)carve((size_t)TKV * 256 * 4);
    p.qm = (float*)carve((size_t)T * 1536 * 4);
    p.kvr = (float*)carve((size_t)TKV * 2048 * 4);
    p.km = (float*)carve((size_t)TKV * 1536 * 4);
    p.qna = (float*)carve((size_t)T * 512 * 4);
    p.kna = (float*)carve((size_t)T * 512 * 4);
    p.mix = (float*)carve((size_t)T * D * 4);
    p.qp = (float*)carve((size_t)T * D * 4);
    p.sc = (float*)carve((size_t)T * D * 4);
    p.gate = (float*)carve((size_t)T * 128 * 4);
    p.eidx = (int*)carve((size_t)T * 128 * 4);

#if MK_ONE_LAUNCH
    static int grid = 0;
    if (!grid) {
        int dev = 0, cus = 0, per_cu = 0;
        hipGetDevice(&dev);
        hipDeviceGetAttribute(&cus, hipDeviceAttributeMultiprocessorCount, dev);
        hipFuncSetAttribute((const void*)k_fwd, hipFuncAttributeMaxDynamicSharedMemorySize, (int)LDS_BYTES);
        hipOccupancyMaxActiveBlocksPerMultiprocessor(&per_cu, k_fwd, NTHREADS, LDS_BYTES);
        if (per_cu < 1) per_cu = 1;
        grid = cus * (per_cu < 1 ? per_cu : 1);
    }
    hipMemsetAsync(p.bar, 0, XCD_BAR_WORDS * sizeof(unsigned), stream);
    hipLaunchKernelGGL(k_fwd, dim3(grid), dim3(NTHREADS), LDS_BYTES, stream, p);
#else
    launch_phase<PH_ADA>(p, 0, stream);
    for (int l = 0; l < DEPTH; ++l) {
        launch_phase<PH_NORM1>(p, l, stream);
        launch_phase<PH_WIN>(p, l, stream);
        launch_phase<PH_POSTZ>(p, l, stream);
        launch_phase<PH_UQKV>(p, l, stream);
        launch_phase<PH_HEADNORM>(p, l, stream);
        launch_phase<PH_ATTN>(p, l, stream);
        launch_phase<PH_WOUT>(p, l, stream);
        launch_phase<PH_NORM2>(p, l, stream);
        launch_phase<PH_WQ>(p, l, stream);
        launch_phase<PH_SCORES>(p, l, stream);
        launch_phase<PH_ROUTE>(p, l, stream);
        launch_phase<PH_EXPERTS>(p, l, stream);
    }
#endif
}
```

```cpp
#include <hip/hip_runtime.h>
#include <stdint.h>

#define DEVI __device__ __forceinline__

#define XB_TMO      128
#define XB_XCNT(j)  (256  + 64 * (j))
#define XB_XSUB(j)  (1280 + 64 * (j))
#define XB_XGEN(j)  (2304 + 64 * (j))
#define XB_TOP      3328
#define XB_TOPGEN   3392
#define XCD_BAR_WORDS 3456
#define XB_SPIN_CAP (1u << 18)
#define LAS __attribute__((address_space(3)))

__device__ __forceinline__ unsigned xb_ld(unsigned* p)              { return __hip_atomic_load(p, __ATOMIC_RELAXED, __HIP_MEMORY_SCOPE_AGENT); }
__device__ __forceinline__ unsigned xb_add(unsigned* p, unsigned v) { return __hip_atomic_fetch_add(p, v, __ATOMIC_RELAXED, __HIP_MEMORY_SCOPE_AGENT); }
__device__ __forceinline__ unsigned xb_xcc_id() { return (unsigned)__builtin_amdgcn_s_getreg((3 << 11) | 20) & 0xFu; }
#define XB_SPIN(cond, bar) do { unsigned _sp = 0; while (cond) { __builtin_amdgcn_s_sleep(1); \
    if ((++_sp & 255u) == 0u) { if (xb_ld(&(bar)[XB_TMO])) break; if (_sp > XB_SPIN_CAP) { atomicAdd(&(bar)[XB_TMO], 1u); break; } } } } while (0)

struct XcdBarrier {
    unsigned* bar; unsigned x;
    volatile LAS unsigned* st;
};

__device__ __forceinline__ XcdBarrier xcd_barrier_post(unsigned* bar, volatile LAS unsigned* st) {
    XcdBarrier b; b.bar = bar; b.x = xb_xcc_id(); b.st = st;
    if (threadIdx.x == 0) (void)xb_add(&bar[XB_XCNT(b.x)], 1u);
    return b;
}
__device__ __forceinline__ void xcd_barrier_complete(unsigned* bar, unsigned x, unsigned& nloc, unsigned& nx) {
    const unsigned G = gridDim.x * gridDim.y * gridDim.z;
    unsigned sum, cnt, mine, sp = 0u;
    for (;;) {
        sum = 0u; cnt = 0u; mine = 0u;
#pragma unroll
        for (unsigned j = 0; j < 16; ++j) { const unsigned c = xb_ld(&bar[XB_XCNT(j)]); sum += c; cnt += (c > 0u) ? 1u : 0u; mine = (j == x) ? c : mine; }
        if (sum == G) break;
        __builtin_amdgcn_s_sleep(1);
        if ((++sp & 255u) == 0u) { if (xb_ld(&bar[XB_TMO])) break; if (sp > XB_SPIN_CAP) { atomicAdd(&bar[XB_TMO], 1u); break; } }
    }
    nloc = mine > 0u ? mine : 1u; nx = cnt > 0u ? cnt : 1u;
}

__device__ __forceinline__ void xcd_barrier(const XcdBarrier& b) {
    asm volatile("s_waitcnt vmcnt(0)" ::: "memory");
    __syncthreads();
    if (threadIdx.x == 0) {
        unsigned* bar = b.bar;
        __builtin_amdgcn_s_waitcnt(0);
        unsigned nloc = b.st[0], nx = b.st[1];
        if (nloc == 0u) { xcd_barrier_complete(bar, b.x, nloc, nx); b.st[0] = nloc; b.st[1] = nx; }
        const unsigned old = xb_add(&bar[XB_XSUB(b.x)], 1u);
        const unsigned gen = old / nloc;
        if (old + 1u == (gen + 1u) * nloc) {
            __builtin_amdgcn_fence(__ATOMIC_RELEASE, "agent");
            asm volatile("s_waitcnt vmcnt(0)" ::: "memory");
            const unsigned og = xb_add(&bar[XB_TOP], 1u);
            const unsigned tg = og / nx;
            if (og + 1u == (tg + 1u) * nx) xb_add(&bar[XB_TOPGEN], 1u);
            else XB_SPIN(xb_ld(&bar[XB_TOPGEN]) == tg, bar);
            __builtin_amdgcn_fence(__ATOMIC_ACQUIRE, "agent");
            xb_add(&bar[XB_XGEN(b.x)], 1u);
            asm volatile("s_waitcnt vmcnt(0)" ::: "memory");
        } else {
            XB_SPIN(xb_ld(&bar[XB_XGEN(b.x)]) == gen, bar);
            __builtin_amdgcn_fence(__ATOMIC_ACQUIRE, "agent");
            asm volatile("s_waitcnt vmcnt(0)" ::: "memory");
        }
    }
    __syncthreads();
}


namespace pg8 {
#define PG8_LAS __attribute__((address_space(3)))
typedef unsigned short bf16_t;
typedef short bf16x8 __attribute__((ext_vector_type(8)));
typedef float f32x4 __attribute__((ext_vector_type(4)));
typedef unsigned u32x4 __attribute__((ext_vector_type(4)));
constexpr int BM = 256, BK = 64, HALF = 128, HTB = HALF * BK * 2  , STAGE_BYTES = 8 * HTB, NXCD = 8, WGM = 8;

__host__ __device__ __forceinline__ int lds_byte(int r, int c) { const int st = (r >> 4) * 2 + (c >> 5), rr = r & 15, cc = c & 31, ob = rr * 64 + cc * 2; return st * 1024 + (ob ^ (((ob >> 9) & 1) << 5)); }
__host__ __device__ __forceinline__ void stage_rc(int b, int& R, int& C) { const int st = b / 1024, sb = b % 1024, swz = sb ^ (((sb >> 9) & 1) << 5); R = (st >> 1) * 16 + swz / 64; C = (st & 1) * 32 + (swz % 64) / 2; }
__host__ __device__ __forceinline__ int perm32(int rho) { const int n = rho >> 4, i = rho & 15; return 8 * (i >> 2) + 4 * n + (i & 3); }

struct Unit { int pm, pn; };
struct Gemm { const bf16_t* A; const bf16_t* Bt; int M, N, K; };

struct StaticOrder {
    int nM, nN, nwg, G, c;
    __host__ __device__ void init(int M, int N, int G_, int c_) { nM = M / BM; nN = N / BM; nwg = nM * nN; G = G_; c = c_; }
    __host__ __device__ bool next(int i, Unit& u) const {
        const long L = (long)i * G + c; if (L >= nwg) return false;
        int wgid = (int)L; { const int q = nwg / NXCD, r = nwg % NXCD, xcd = wgid % NXCD, off = wgid / NXCD; wgid = (xcd < r ? xcd * (q + 1) : r * (q + 1) + (xcd - r) * q) + off; }
        const int nig = WGM * nN, gid = wgid / nig, fm = gid * WGM, gsz = (nM - fm) < WGM ? (nM - fm) : WGM;
        u.pm = fm + ((wgid % nig) % gsz); u.pn = (wgid % nig) / gsz; return true;
    }
    __device__ __forceinline__ void a_ready(const Unit&) const {}
    __device__ __forceinline__ void done(const Unit&) const {}
};

__device__ __forceinline__ unsigned cvt_pk_bf16(float lo, float hi) { unsigned r; asm volatile("v_cvt_pk_bf16_f32 %0, %1, %2" : "=v"(r) : "v"(lo), "v"(hi)); return r; }
typedef float f32x2 __attribute__((ext_vector_type(2)));
template <class Epi, class Sched, bool ALIGN_EPI = false, bool SP2 = false>
__device__ __forceinline__ void gemm_phase(PG8_LAS unsigned char* lds, const Gemm g, const Sched& S, const Epi& E) {
    int tid = threadIdx.x; asm volatile("" : "+v"(tid));
    const int wid = __builtin_amdgcn_readfirstlane(tid >> 6), lane = tid & 63, wr = wid >> 2, wc = wid & 3, fr = lane & 15, fq = lane >> 4;
    const int K = g.K, nt = K / BK;
    unsigned voffA[2], voffB[2];
#pragma unroll
    for (int i = 0; i < 2; ++i) { int R, C; stage_rc(tid * 16 + i * 8192, R, C); const int Rb = Epi::PERM ? ((R & ~31) + perm32(R & 31)) : R;
        voffA[i] = (unsigned)(R * K + C) * 2u; voffB[i] = (unsigned)(Rb * K + C) * 2u; }
    const size_t kstep = (size_t)(BK * 2);
    const size_t hstep = (size_t)HALF * K * 2;
    const size_t tstep = 2 * hstep;
    const unsigned ldsw = (unsigned)wid * 1024u;
    const int aoff = lds_byte(wr * 64 + fr, fq * 8), boff = lds_byte(wc * 32 + fr, fq * 8);
#define PG8_SA(b, h) (((b) * 2 + (h)) * HTB)
#define PG8_SB(b, h) ((4 + (b) * 2 + (h)) * HTB)
#define PG8_STAGE(bufoff, gbase, voff) do { _Pragma("unroll") for (int _i = 0; _i < 2; ++_i) \
        __builtin_amdgcn_global_load_lds((const unsigned*)((const char*)(gbase) + (voff)[_i]), (PG8_LAS unsigned*)(lds + (bufoff) + ldsw + _i * 8192), 16, 0, 0); } while (0)
#define PG8_LDA(dst, b, h) do { _Pragma("unroll") for (int m = 0; m < 4; ++m) _Pragma("unroll") for (int k = 0; k < 2; ++k) dst[m][k] = *(const PG8_LAS bf16x8*)(lds + PG8_SA(b, h) + aoff + m * 2048 + k * 1024); } while (0)
#define PG8_LDB(dst, b, h) do { _Pragma("unroll") for (int n = 0; n < 2; ++n) _Pragma("unroll") for (int k = 0; k < 2; ++k) dst[n][k] = *(const PG8_LAS bf16x8*)(lds + PG8_SB(b, h) + boff + n * 2048 + k * 1024); } while (0)
#define PG8_MMA(ai, bj, At, Bt) do { __builtin_amdgcn_s_setprio(1); _Pragma("unroll") for (int m = 0; m < 4; ++m) _Pragma("unroll") for (int n = 0; n < 2; ++n) _Pragma("unroll") for (int k = 0; k < 2; ++k) \
        acc[ai][bj][m][n] = __builtin_amdgcn_mfma_f32_16x16x32_bf16(Bt[n][k], At[m][k], acc[ai][bj][m][n], 0, 0, 0); __builtin_amdgcn_s_setprio(0); } while (0)
#define PG8_WAIT_V(n) asm volatile("s_waitcnt vmcnt(" #n ")" ::: "memory")
#define PG8_WAIT_L(n) asm volatile("s_waitcnt lgkmcnt(" #n ")" ::: "memory")
#define PG8_BAR __builtin_amdgcn_s_barrier()
#define PG8_SCHED __builtin_amdgcn_sched_barrier(0)
    Unit cur, nxt; int ui = 0;
    if (!S.next(0, cur)) return;
    f32x4 acc[2][2][4][2];
#pragma unroll
    for (int a = 0; a < 2; ++a)
#pragma unroll
        for (int b = 0; b < 2; ++b)
#pragma unroll
            for (int m = 0; m < 4; ++m)
#pragma unroll
                for (int n = 0; n < 2; ++n) acc[a][b][m][n] = (f32x4){0.f, 0.f, 0.f, 0.f};
    bf16x8 At[4][2], B0[2][2], B1[2][2];
    const char* cA = (const char*)g.A + (size_t)cur.pm * tstep; const char* cB = (const char*)g.Bt + (size_t)cur.pn * tstep;
    S.a_ready(cur);
    if constexpr (SP2) {
        PG8_STAGE(PG8_SB(0, 0), cB, voffB); PG8_STAGE(PG8_SB(0, 1), cB + hstep, voffB); PG8_STAGE(PG8_SA(0, 0), cA, voffA); PG8_STAGE(PG8_SA(0, 1), cA + hstep, voffA);
        if (wr == 1) PG8_BAR;
        PG8_WAIT_V(2); PG8_BAR;
        PG8_STAGE(PG8_SB(1, 0), cB + kstep, voffB); PG8_STAGE(PG8_SA(1, 0), cA + kstep, voffA); PG8_STAGE(PG8_SB(1, 1), cB + hstep + kstep, voffB);
        PG8_WAIT_V(6); PG8_BAR;
    } else {
        PG8_STAGE(PG8_SB(0, 0), cB, voffB); PG8_STAGE(PG8_SA(0, 0), cA, voffA); PG8_STAGE(PG8_SB(0, 1), cB + hstep, voffB); PG8_STAGE(PG8_SA(0, 1), cA + hstep, voffA);
        if (wr == 1) PG8_BAR;
        PG8_WAIT_V(4); PG8_BAR;
        PG8_STAGE(PG8_SB(1, 0), cB + kstep, voffB); PG8_STAGE(PG8_SA(1, 0), cA + kstep, voffA); PG8_STAGE(PG8_SB(1, 1), cB + hstep + kstep, voffB);
        PG8_WAIT_V(6); PG8_BAR;
    }
    for (;;) {
        const bool has_next = S.next(ui + 1, nxt);
        const char* nA = has_next ? (const char*)g.A + (size_t)nxt.pm * tstep : cA; const char* nB = has_next ? (const char*)g.Bt + (size_t)nxt.pn * tstep : cB;
        for (int t = 0; t < nt; t += 2) {
            const bool last = (t == nt - 2);
            const char* a1 = cA + (size_t)(t + 1) * kstep;
            const char* a2 = last ? nA : cA + (size_t)(t + 2) * kstep; const char* b2 = last ? nB : cB + (size_t)(t + 2) * kstep;
            const char* a3 = a2 + kstep; const char* b3 = b2 + kstep;
            if (last && has_next) S.a_ready(nxt);
            if constexpr (SP2) {
            PG8_LDB(B0, 0, 0); PG8_LDB(B1, 0, 1); PG8_SCHED; PG8_LDA(At, 0, 0); PG8_STAGE(PG8_SA(1, 1), a1 + hstep, voffA);
            PG8_WAIT_V(8); PG8_WAIT_L(0); PG8_BAR; PG8_MMA(0, 0, At, B0); PG8_MMA(0, 1, At, B1); PG8_BAR; PG8_SCHED;
            PG8_LDA(At, 0, 1); PG8_STAGE(PG8_SB(0, 0), b2, voffB); PG8_STAGE(PG8_SB(0, 1), b2 + hstep, voffB); PG8_STAGE(PG8_SA(0, 0), a2, voffA);
            PG8_WAIT_V(8); PG8_WAIT_L(0); PG8_BAR; PG8_MMA(1, 0, At, B0); PG8_MMA(1, 1, At, B1); PG8_BAR; PG8_SCHED;
            PG8_LDB(B0, 1, 0); PG8_LDB(B1, 1, 1); PG8_SCHED; PG8_LDA(At, 1, 0); PG8_STAGE(PG8_SA(0, 1), a2 + hstep, voffA);
            PG8_WAIT_V(8); PG8_WAIT_L(0); PG8_BAR; PG8_MMA(0, 0, At, B0); PG8_MMA(0, 1, At, B1); PG8_BAR; PG8_SCHED;
            PG8_LDA(At, 1, 1); PG8_STAGE(PG8_SB(1, 0), b3, voffB); PG8_STAGE(PG8_SB(1, 1), b3 + hstep, voffB); PG8_STAGE(PG8_SA(1, 0), a3, voffA);
            PG8_WAIT_V(8); PG8_WAIT_L(0); PG8_BAR; PG8_MMA(1, 0, At, B0); PG8_MMA(1, 1, At, B1); PG8_BAR; PG8_SCHED;
            } else {
            PG8_LDB(B0, 0, 0); PG8_SCHED; PG8_LDA(At, 0, 0); PG8_STAGE(PG8_SA(1, 1), a1 + hstep, voffA);
            PG8_WAIT_L(8); PG8_BAR; PG8_WAIT_L(0); PG8_MMA(0, 0, At, B0); PG8_BAR; PG8_SCHED;
            PG8_LDB(B1, 0, 1); PG8_STAGE(PG8_SB(0, 0), b2, voffB);
            PG8_BAR; PG8_WAIT_L(0); PG8_MMA(0, 1, At, B1); PG8_BAR;
            PG8_LDA(At, 0, 1); PG8_STAGE(PG8_SA(0, 0), a2, voffA);
            PG8_BAR; PG8_WAIT_L(0); PG8_MMA(1, 0, At, B0); PG8_BAR; PG8_SCHED;
            PG8_STAGE(PG8_SB(0, 1), b2 + hstep, voffB);
            PG8_WAIT_V(6); PG8_BAR; PG8_MMA(1, 1, At, B1); PG8_BAR;
            PG8_LDB(B0, 1, 0); PG8_SCHED; PG8_LDA(At, 1, 0); PG8_STAGE(PG8_SA(0, 1), a2 + hstep, voffA);
            PG8_WAIT_L(8); PG8_BAR; PG8_WAIT_L(0); PG8_MMA(0, 0, At, B0); PG8_BAR; PG8_SCHED;
            PG8_LDB(B1, 1, 1); PG8_STAGE(PG8_SB(1, 0), b3, voffB);
            PG8_BAR; PG8_WAIT_L(0); PG8_MMA(0, 1, At, B1); PG8_BAR;
            PG8_LDA(At, 1, 1); PG8_STAGE(PG8_SA(1, 0), a3, voffA);
            PG8_BAR; PG8_WAIT_L(0); PG8_MMA(1, 0, At, B0); PG8_BAR; PG8_SCHED;
            PG8_STAGE(PG8_SB(1, 1), b3 + hstep, voffB);
            PG8_WAIT_V(6); PG8_BAR; PG8_MMA(1, 1, At, B1); PG8_BAR;
            }
        }
        if constexpr (ALIGN_EPI) { if (wr == 0) PG8_BAR; }
        if constexpr (!Epi::AFTER_DRAIN) { E(acc, cur, wr, wc, fr, fq); S.done(cur); }
        if (!has_next) break;
#pragma unroll
        for (int a = 0; a < 2; ++a)
#pragma unroll
            for (int b = 0; b < 2; ++b)
#pragma unroll
                for (int m = 0; m < 4; ++m)
#pragma unroll
                    for (int n = 0; n < 2; ++n) acc[a][b][m][n] = (f32x4){0.f, 0.f, 0.f, 0.f};
        cur = nxt; cA = nA; cB = nB; ++ui;
        if constexpr (ALIGN_EPI) { if (wr == 1) PG8_BAR; }
    }
    PG8_WAIT_V(0);
    if constexpr (!ALIGN_EPI) { if (wr == 0) PG8_BAR; }
    PG8_BAR;
    if constexpr (Epi::AFTER_DRAIN) { E.fused(acc, cur, wr, wc, fr, fq, lds, wid, lane); S.done(cur); }
#undef PG8_SA
#undef PG8_SB
#undef PG8_STAGE
#undef PG8_LDA
#undef PG8_LDB
#undef PG8_MMA
#undef PG8_WAIT_V
#undef PG8_WAIT_L
#undef PG8_BAR
#undef PG8_SCHED
}
}


namespace {

constexpr int D = 2048, BATCH = 32, SEQ = 256, DEPTH = 4, DB = 2, DS = 1024, PAST = 512;
constexpr int NCTX = BATCH * SEQ, NLAT = DB * DS, T = NCTX + NLAT, TKV = T + DB * PAST;
constexpr int DIN = 3904, DINP = 4096;
constexpr int RING_OFF = 0, MISC_OFF = 131072, LDS_TOTAL = 147456;
typedef unsigned short bf16_t;
constexpr int O_CQ = 0, O_CKV = 512, O_KPE = 768, O_NAQ = 832, O_NAK = 1344, O_NAV = 1856, O_GB = 2368, O_GC = 2880, O_U = 3392;
constexpr float EPS = 1e-6f;
constexpr int NTHREADS = 512, NWAVES = NTHREADS / 64;

struct Params {
    const float *x_prompt, *x_sample, *cache_ckv, *cache_kpe, *cache_nak, *cache_nav, *c, *c_ctx;
    const float *ada_w, *ada_b, *norm_mix_g, *norm_ffn_g, *w_in, *q_norm_g, *w_uq, *kv_norm_g, *w_ukv;
    const float *q_head_g, *k_head_g, *naq_g, *nak_g, *rel_bias, *conv_w, *w_out, *peer_wq, *sub_keys, *peer_u, *peer_v;
    float* out;
    float *o_ckv, *o_kpe, *o_nak, *o_nav;
    unsigned* bar;
    float *ada, *hn, *z, *cqn, *ckv, *qm, *kvr, *km, *qna, *kna, *mix, *qp, *sc, *gate;
    int* eidx;
    unsigned short *wt_in, *wt_uq, *wt_ukv, *wt_out, *wt_q;
    unsigned short *hn_b, *cqn_b, *ckv_b, *mix_b;
};

typedef const __attribute__((address_space(4))) Params CParams;

DEVI int tidx() { int t = threadIdx.x; asm volatile("" : "+v"(t)); return t; }
DEVI float wave_sum(float v) {
#pragma unroll
    for (int o = 32; o > 0; o >>= 1) v += __shfl_xor(v, o);
    return v;
}
DEVI float wave_max(float v) {
#pragma unroll
    for (int o = 32; o > 0; o >>= 1) v = fmaxf(v, __shfl_xor(v, o));
    return v;
}
DEVI void wave_argmax(float& v, int& idx) {
#pragma unroll
    for (int o = 32; o > 0; o >>= 1) {
        float ov = __shfl_xor(v, o); int oi = __shfl_xor(idx, o);
        if (ov > v || (ov == v && oi < idx)) { v = ov; idx = oi; }
    }
}
DEVI bf16_t f2bf(float v) { return (bf16_t)(pg8::cvt_pk_bf16(v, 0.f) & 0xffffu); }
DEVI int cond_of(int t) { return t < NCTX ? 2 : (t - NCTX) / DS; }
DEVI const float* xrow(CParams& p, int layer, int t) {
    if (layer == 0) return t < NCTX ? p.x_prompt + (size_t)t * D : p.x_sample + (size_t)(t - NCTX) * D;
    return p.out + (size_t)t * D;
}

DEVI void phase_ada(CParams& p, int bid, int nb, float* lds) {
    float* sv = lds;
    float* red = lds + 3 * D;
    const int tid = tidx(), lane = tid & 63, w = tid >> 6;
    for (int i = tid; i < 3 * D; i += NTHREADS) {
        int j = i / D, k = i % D;
        float v = j < 2 ? p.c[j * D + k] : p.c_ctx[k];
        sv[i] = v / (1.f + __expf(-v));
    }
    __syncthreads();
    const int nitems = DEPTH * (6 * D / 64);
    for (int it = bid; it < nitems; it += nb) {
        const int l = it / (6 * D / 64), n = (it % (6 * D / 64)) * 64 + lane;
        const float* W = p.ada_w + (size_t)l * D * 6 * D + n;
        float a0 = 0.f, a1 = 0.f, a2 = 0.f;
        const int k0 = w * (D / NWAVES);
#pragma unroll 8
        for (int k = k0; k < k0 + D / NWAVES; ++k) {
            float wv = W[(size_t)k * 6 * D];
            a0 += sv[k] * wv; a1 += sv[D + k] * wv; a2 += sv[2 * D + k] * wv;
        }
        red[(w * 3 + 0) * 64 + lane] = a0; red[(w * 3 + 1) * 64 + lane] = a1; red[(w * 3 + 2) * 64 + lane] = a2;
        __syncthreads();
        if (tid < 192) {
            int j = tid / 64, ln = tid % 64;
            float s = 0.f;
            for (int ww = 0; ww < NWAVES; ++ww) s += red[(ww * 3 + j) * 64 + ln];
            int nn = (it % (6 * D / 64)) * 64 + ln;
            p.ada[((size_t)l * 3 + j) * 6 * D + nn] = s + p.ada_b[(size_t)l * 6 * D + nn];
        }
        __syncthreads();
    }
}

DEVI void phase_modnorm(CParams& p, int layer, int which, int bid, int nb) {
    const int lane = tidx() & 63, w = tidx() >> 6;
    const float* g = (which == 0 ? p.norm_mix_g : p.norm_ffn_g) + (size_t)layer * D;
    for (int t = bid * NWAVES + w; t < T; t += nb * NWAVES) {
        const float* x = which == 0 ? xrow(p, layer, t) : p.out + (size_t)t * D;
        const float* ad = p.ada + ((size_t)layer * 3 + cond_of(t)) * 6 * D + (which == 0 ? 0 : 3 * D);
        float4 v[8]; float ss = 0.f;
#pragma unroll
        for (int i = 0; i < 8; ++i) { v[i] = *(const float4*)(x + i * 256 + lane * 4); ss += v[i].x * v[i].x + v[i].y * v[i].y + v[i].z * v[i].z + v[i].w * v[i].w; }
        ss = wave_sum(ss);
        const float r = rsqrtf(ss / D + EPS);
#pragma unroll
        for (int i = 0; i < 8; ++i) {
            const int c = i * 256 + lane * 4;
            float4 gg = *(const float4*)(g + c), sh = *(const float4*)(ad + c), sc = *(const float4*)(ad + D + c), o;
            o.x = v[i].x * r * gg.x * (1.f + sc.x) + sh.x; o.y = v[i].y * r * gg.y * (1.f + sc.y) + sh.y;
            o.z = v[i].z * r * gg.z * (1.f + sc.z) + sh.z; o.w = v[i].w * r * gg.w * (1.f + sc.w) + sh.w;
            *(float4*)(p.hn + (size_t)t * D + c) = o;
            *(uint2*)(p.hn_b + (size_t)t * D + c) = make_uint2(pg8::cvt_pk_bf16(o.x, o.y), pg8::cvt_pk_bf16(o.z, o.w));
        }
    }
}

template <bool BT, class Epi>
DEVI void gemm_tile(const float* A, int lda, const float* W, int ldw, int K, int m0, int n0, const Epi& epi, float* lds) {
    float (*As)[132] = (float (*)[132])lds;
    float (*Bs)[68] = (float (*)[68])(lds + 16 * 132);
    const int tid = tidx(), tx = tid & 15, ty = tid >> 4;
    float acc[4][4];
#pragma unroll
    for (int i = 0; i < 4; ++i)
#pragma unroll
        for (int j = 0; j < 4; ++j) acc[i][j] = 0.f;
    for (int k0 = 0; k0 < K; k0 += 16) {
        {
            const int row = tid >> 2, kq = tid & 3;
            float4 v = *(const float4*)(A + (size_t)(m0 + row) * lda + k0 + kq * 4);
            As[kq * 4 + 0][row] = v.x; As[kq * 4 + 1][row] = v.y; As[kq * 4 + 2][row] = v.z; As[kq * 4 + 3][row] = v.w;
        }
        if (tid < 256) {
            if (!BT) {
                const int k = tid >> 4, n4 = tid & 15;
                float4 v = *(const float4*)(W + (size_t)(k0 + k) * ldw + n0 + n4 * 4);
                *(float4*)&Bs[k][n4 * 4] = v;
            } else {
                const int n = tid >> 2, kq = tid & 3;
                float4 v = *(const float4*)(W + (size_t)(n0 + n) * ldw + k0 + kq * 4);
                Bs[kq * 4 + 0][n] = v.x; Bs[kq * 4 + 1][n] = v.y; Bs[kq * 4 + 2][n] = v.z; Bs[kq * 4 + 3][n] = v.w;
            }
        }
        __syncthreads();
#pragma unroll
        for (int k = 0; k < 16; ++k) {
            float4 a = *(const float4*)&As[k][ty * 4], b = *(const float4*)&Bs[k][tx * 4];
            const float av[4] = {a.x, a.y, a.z, a.w}, bv[4] = {b.x, b.y, b.z, b.w};
#pragma unroll
            for (int i = 0; i < 4; ++i)
#pragma unroll
                for (int j = 0; j < 4; ++j) acc[i][j] += av[i] * bv[j];
        }
        __syncthreads();
    }
#pragma unroll
    for (int i = 0; i < 4; ++i) epi(m0 + ty * 4 + i, n0 + tx * 4, make_float4(acc[i][0], acc[i][1], acc[i][2], acc[i][3]));
}
template <bool BT, class Epi>
DEVI void gemm_f32(const float* A, int lda, const float* W, int ldw, int M, int N, int K, const Epi& epi, int bid, int nb, float* lds) {
    const int nn = N / 64, nt = (M / 128) * nn;
    for (int tile = bid; tile < nt; tile += nb) gemm_tile<BT>(A, lda, W, ldw, K, (tile / nn) * 128, (tile % nn) * 64, epi, lds);
}
struct EpiStore { float* C; int ldc; DEVI void operator()(int r, int c, float4 v) const { *(float4*)(C + (size_t)r * ldc + c) = v; } };
struct EpiResid {
    CParams* p; int layer;
    DEVI void operator()(int r, int c, float4 v) const {
        const float* x = xrow(*p, layer, r) + c;
        const float* g1 = p->ada + ((size_t)layer * 3 + cond_of(r)) * 6 * D + 2 * D + c;
        float4 xv = *(const float4*)x, gv = *(const float4*)g1, o;
        o.x = xv.x + gv.x * v.x; o.y = xv.y + gv.y * v.y; o.z = xv.z + gv.z * v.z; o.w = xv.w + gv.w * v.w;
        *(float4*)(p->out + (size_t)r * D + c) = o;
    }
};


struct EpiF32 {
    static constexpr bool PERM = false, AFTER_DRAIN = false;
    float* C; int ldc, ncols;
    DEVI void operator()(const pg8::f32x4 (&acc)[2][2][4][2], const pg8::Unit& u, int wr, int wc, int fr, int fq) const {
        const int row0 = u.pm * 256 + wr * 64 + fr, col0 = u.pn * 256 + wc * 32 + 4 * fq;
#pragma unroll
        for (int ai = 0; ai < 2; ++ai)
#pragma unroll
            for (int m = 0; m < 4; ++m) { float* rowp = C + (size_t)(row0 + ai * 128 + m * 16) * ldc;
#pragma unroll
                for (int bj = 0; bj < 2; ++bj)
#pragma unroll
                    for (int n = 0; n < 2; ++n) { const int c = col0 + bj * 128 + n * 16; if (c < ncols) *(pg8::f32x4*)(rowp + c) = acc[ai][bj][m][n]; } }
    }
};
struct EpiResidMF {
    static constexpr bool PERM = false, AFTER_DRAIN = false;
    CParams* p; int layer;
    DEVI void operator()(const pg8::f32x4 (&acc)[2][2][4][2], const pg8::Unit& u, int wr, int wc, int fr, int fq) const {
        const int row0 = u.pm * 256 + wr * 64 + fr, col0 = u.pn * 256 + wc * 32 + 4 * fq;
#pragma unroll
        for (int ai = 0; ai < 2; ++ai)
#pragma unroll
            for (int m = 0; m < 4; ++m) {
                const int r = row0 + ai * 128 + m * 16;
                const float* x = xrow(*p, layer, r);
                const float* g1 = p->ada + ((size_t)layer * 3 + cond_of(r)) * 6 * D + 2 * D;
                float* o = p->out + (size_t)r * D;
#pragma unroll
                for (int bj = 0; bj < 2; ++bj)
#pragma unroll
                    for (int n = 0; n < 2; ++n) { const int c = col0 + bj * 128 + n * 16;
                        const pg8::f32x4 xv = *(const pg8::f32x4*)(x + c), gv = *(const pg8::f32x4*)(g1 + c);
                        *(pg8::f32x4*)(o + c) = xv + gv * acc[ai][bj][m][n]; } }
    }
};
template <class Epi>
DEVI void mfma_gemm(const bf16_t* A, const bf16_t* Bt, int M, int N, int K, const Epi& E, int bid, int nb, float* lds) {
    pg8::Gemm g{A, Bt, M, N, K};
    pg8::StaticOrder S; S.init(M, N, nb, bid);
    pg8::gemm_phase<Epi, pg8::StaticOrder, true, true>((PG8_LAS unsigned char*)lds + RING_OFF, g, S, E);
    __syncthreads();
}

DEVI void transpose_tile(const float* W, int ldw, bf16_t* Wt, int ldt, int k0, int n0, float* lds) {
    float (*tl)[65] = (float (*)[65])lds;
    const int tid = tidx();
#pragma unroll
    for (int rep = 0; rep < 2; ++rep) {
        const int k = (tid >> 4) + rep * 32, n4 = (tid & 15) * 4;
        const float4 v = *(const float4*)(W + (size_t)(k0 + k) * ldw + n0 + n4);
        tl[k][n4] = v.x; tl[k][n4 + 1] = v.y; tl[k][n4 + 2] = v.z; tl[k][n4 + 3] = v.w;
    }
    __syncthreads();
    {
        const int n = tid >> 3, k8 = (tid & 7) * 8;
        uint4 o;
        o.x = pg8::cvt_pk_bf16(tl[k8 + 0][n], tl[k8 + 1][n]); o.y = pg8::cvt_pk_bf16(tl[k8 + 2][n], tl[k8 + 3][n]);
        o.z = pg8::cvt_pk_bf16(tl[k8 + 4][n], tl[k8 + 5][n]); o.w = pg8::cvt_pk_bf16(tl[k8 + 6][n], tl[k8 + 7][n]);
        *(uint4*)(Wt + (size_t)(n0 + n) * ldt + k0 + k8) = o;
    }
    __syncthreads();
}
DEVI void phase_weights(CParams& p, int bid, int nb, float* lds) {
    constexpr int N_IN = 32 * 61, N_UQ = 8 * 24, N_UKV = 4 * 32, N_SQ = 32 * 32, PER = N_IN + N_UQ + N_UKV + 2 * N_SQ;
    for (int it = bid; it < DEPTH * PER; it += nb) {
        const int l = it / PER; int j = it % PER;
        if (j < N_IN) { transpose_tile(p.w_in + (size_t)l * D * DIN, DIN, p.wt_in + (size_t)l * DINP * D, D, (j / 61) * 64, (j % 61) * 64, lds); continue; }
        j -= N_IN;
        if (j < N_UQ) { transpose_tile(p.w_uq + (size_t)l * 512 * 1536, 1536, p.wt_uq + (size_t)l * 1536 * 512, 512, (j / 24) * 64, (j % 24) * 64, lds); continue; }
        j -= N_UQ;
        if (j < N_UKV) { transpose_tile(p.w_ukv + (size_t)l * 256 * 2048, 2048, p.wt_ukv + (size_t)l * 2048 * 256, 256, (j / 32) * 64, (j % 32) * 64, lds); continue; }
        j -= N_UKV;
        if (j < N_SQ) { transpose_tile(p.w_out + (size_t)l * D * D, D, p.wt_out + (size_t)l * D * D, D, (j / 32) * 64, (j % 32) * 64, lds); continue; }
        j -= N_SQ;
        transpose_tile(p.peer_wq + (size_t)l * D * D, D, p.wt_q + (size_t)l * D * D, D, (j / 32) * 64, (j % 32) * 64, lds);
    }
    const int nz = DEPTH * (DINP - DIN) * D / 8;
    for (int i = bid * NTHREADS + tidx(); i < nz; i += nb * NTHREADS) {
        const int per = (DINP - DIN) * D / 8, l = i / per, r = i % per;
        *(uint4*)(p.wt_in + ((size_t)l * DINP + DIN) * D + (size_t)r * 8) = make_uint4(0u, 0u, 0u, 0u);
    }
}

DEVI void phase_postz(CParams& p, int layer, int bid, int nb) {
    const int lane = tidx() & 63, w = tidx() >> 6;
    for (int r = bid * NWAVES + w; r < TKV; r += nb * NWAVES) {
        if (r >= T) {
            const int b = (r - T) / PAST, j = (r - T) % PAST;
            const float* src = p.cache_ckv + (((size_t)b * DEPTH + layer) * PAST + j) * 256;
            { float4 v = *(const float4*)(src + lane * 4); *(uint2*)(p.ckv_b + (size_t)r * 256 + lane * 4) = make_uint2(pg8::cvt_pk_bf16(v.x, v.y), pg8::cvt_pk_bf16(v.z, v.w)); }
            continue;
        }
        const float* z = p.z + (size_t)r * DIN;
        const bool ctx = r < NCTX;
        const int b = ctx ? r / SEQ : (r - NCTX) / DS, s = ctx ? r % SEQ : (r - NCTX) % DS;
        {
            float v[8], ss = 0.f;
#pragma unroll
            for (int i = 0; i < 8; ++i) { v[i] = z[O_CQ + i * 64 + lane]; ss += v[i] * v[i]; }
            ss = wave_sum(ss); const float rr = rsqrtf(ss / 512.f + EPS);
#pragma unroll
            for (int i = 0; i < 8; ++i) p.cqn_b[(size_t)r * 512 + i * 64 + lane] = f2bf(v[i] * rr * p.q_norm_g[layer * 512 + i * 64 + lane]);
        }
        {
            float v[4], ss = 0.f;
#pragma unroll
            for (int i = 0; i < 4; ++i) { v[i] = z[O_CKV + i * 64 + lane]; ss += v[i] * v[i]; }
            ss = wave_sum(ss); const float rr = rsqrtf(ss / 256.f + EPS);
#pragma unroll
            for (int i = 0; i < 4; ++i) {
                const float o = v[i] * rr * p.kv_norm_g[layer * 256 + i * 64 + lane];
                p.ckv_b[(size_t)r * 256 + i * 64 + lane] = f2bf(o);
                if (ctx) p.o_ckv[(((size_t)b * DEPTH + layer) * SEQ + s) * 256 + i * 64 + lane] = o;
            }
        }
        if (ctx) p.o_kpe[(((size_t)b * DEPTH + layer) * SEQ + s) * 64 + lane] = z[O_KPE + lane];
#pragma unroll
        for (int h = 0; h < 4; ++h) {
            float q0 = z[O_NAQ + h * 128 + lane], q1 = z[O_NAQ + h * 128 + 64 + lane];
            float ss = wave_sum(q0 * q0 + q1 * q1); float rr = rsqrtf(ss / 128.f + EPS);
            p.qna[(size_t)r * 512 + h * 128 + lane] = q0 * rr * p.naq_g[layer * 128 + lane];
            p.qna[(size_t)r * 512 + h * 128 + 64 + lane] = q1 * rr * p.naq_g[layer * 128 + 64 + lane];
            float k0 = z[O_NAK + h * 128 + lane], k1 = z[O_NAK + h * 128 + 64 + lane];
            ss = wave_sum(k0 * k0 + k1 * k1); rr = rsqrtf(ss / 128.f + EPS);
            k0 = k0 * rr * p.nak_g[layer * 128 + lane]; k1 = k1 * rr * p.nak_g[layer * 128 + 64 + lane];
            p.kna[(size_t)r * 512 + h * 128 + lane] = k0; p.kna[(size_t)r * 512 + h * 128 + 64 + lane] = k1;
            if (ctx) {
                const size_t o = ((((size_t)b * DEPTH + layer) * 4 + h) * SEQ + s) * 128;
                p.o_nak[o + lane] = k0; p.o_nak[o + 64 + lane] = k1;
                p.o_nav[o + lane] = z[O_NAV + h * 128 + lane]; p.o_nav[o + 64 + lane] = z[O_NAV + h * 128 + 64 + lane];
            }
        }
        {
            const int S = ctx ? SEQ : DS;
#pragma unroll
            for (int i = 0; i < 8; ++i) {
                const int ch = i * 64 + lane;
                const float* cw = p.conv_w + ((size_t)layer * 512 + ch) * 3;
                float acc = z[O_GC + ch] * z[O_U + ch] * cw[1];
                if (s > 0) acc += (z - DIN)[O_GC + ch] * (z - DIN)[O_U + ch] * cw[0];
                if (s < S - 1) acc += (z + DIN)[O_GC + ch] * (z + DIN)[O_U + ch] * cw[2];
                p.mix_b[(size_t)r * D + 1536 + ch] = f2bf(z[O_GB + ch] * acc);
            }
        }
    }
}

DEVI float rope_angle(int pos, int j) {
    const int row = pos / 64, col = pos % 64;
    const int f = j & 15;
    const float inv = powf(10000.f, -(float)f / 16.f);
    return (j < 16 ? (float)row : (float)col) * inv;
}

DEVI void phase_headnorm(CParams& p, int layer, int bid, int nb) {
    const int lane = tidx() & 63, w = tidx() >> 6;
    const int nq = T * 8, nk = TKV * 8;
    for (int it = bid * NWAVES + w; it < nq + nk; it += nb * NWAVES) {
        const bool isq = it < nq;
        const int r = isq ? it / 8 : (it - nq) / 8, h = it % 8;
        float v0, v1, v2; const float* g; float* dst; int pos = -1;
        if (isq) {
            float* q = p.qm + (size_t)r * 1536 + h * 192;
            v0 = q[lane]; v1 = q[64 + lane]; v2 = q[128 + lane]; g = p.q_head_g + layer * 192; dst = q;
            if (r >= NCTX) pos = (r - NCTX) % DS;
        } else {
            const float* kv = p.kvr + (size_t)r * 2048 + h * 256;
            v0 = kv[lane]; v1 = kv[64 + lane];
            if (r < T) v2 = p.z[(size_t)r * DIN + O_KPE + lane];
            else { const int b = (r - T) / PAST, j = (r - T) % PAST; v2 = p.cache_kpe[(((size_t)b * DEPTH + layer) * PAST + j) * 64 + lane]; }
            g = p.k_head_g + layer * 192; dst = p.km + (size_t)r * 1536 + h * 192;
            if (r >= NCTX && r < T) pos = (r - NCTX) % DS;
        }
        const float ss = wave_sum(v0 * v0 + v1 * v1 + v2 * v2);
        const float rr = rsqrtf(ss / 192.f + EPS);
        v0 *= rr * g[lane]; v1 *= rr * g[64 + lane]; v2 *= rr * g[128 + lane];
        if (pos >= 0) {
            const float other = __shfl_xor(v2, 32);
            const float ang = rope_angle(pos, lane & 31);
            const float cs = cosf(ang), sn = sinf(ang);
            v2 = lane < 32 ? v2 * cs - other * sn : other * sn + v2 * cs;
        }
        dst[lane] = v0; dst[64 + lane] = v1; dst[128 + lane] = v2;
    }
}

DEVI void phase_attn(CParams& p, int layer, int bid, int nb, float* lds) {
    const int lane = tidx() & 63, w = tidx() >> 6;
    float* sq = lds + w * 1792;
    float* ss = sq + 192;
    for (int it = bid * NWAVES + w; it < T * 12; it += nb * NWAVES) {
        const int t = it / 12, hs = it % 12;
        const bool ctx = t < NCTX, mla = hs < 8;
        const int h = mla ? hs : hs - 8;
        const int b = ctx ? t / SEQ : (t - NCTX) / DS, s = ctx ? t % SEQ : (t - NCTX) % DS;
        const int dq = mla ? 192 : 128;
        const float scale = mla ? 0.07216878364870322f : 0.08838834764831845f;
        const float* q = mla ? p.qm + (size_t)t * 1536 + h * 192 : p.qna + (size_t)t * 512 + h * 128;
        for (int i = lane; i < dq; i += 64) sq[i] = q[i];
        __builtin_amdgcn_wave_barrier();
        int nkeys, rs = 0, cs = 0;
        if (ctx) nkeys = SEQ;
        else if (mla) nkeys = PAST + DS;
        else { nkeys = 128 + PAST; const int r = s / 64, qc = s % 64; rs = min(max(r - 4, 0), 8); cs = min(max(qc - 8, 0), 48); }
        auto kv_ptrs = [&](int j, const float*& kp, const float*& vp, float& bias) {
            bias = 0.f;
            if (mla) {
                int row;
                if (ctx) row = b * SEQ + j;
                else row = j < PAST ? T + b * PAST + j : NCTX + b * DS + (j - PAST);
                kp = p.km + (size_t)row * 1536 + h * 192; vp = p.kvr + (size_t)row * 2048 + h * 256 + 128;
            } else if (ctx) {
                const int row = b * SEQ + j;
                kp = p.kna + (size_t)row * 512 + h * 128; vp = p.z + (size_t)row * DIN + O_NAV + h * 128;
            } else if (j < 128) {
                const int kr = rs + j / 16, kc = cs + j % 16, row = NCTX + b * DS + kr * 64 + kc;
                kp = p.kna + (size_t)row * 512 + h * 128; vp = p.z + (size_t)row * DIN + O_NAV + h * 128;
                bias = p.rel_bias[(((size_t)layer * 4 + h) * 15 + (kr - s / 64 + 7)) * 31 + (kc - s % 64 + 15)];
            } else {
                const size_t o = ((((size_t)b * DEPTH + layer) * 4 + h) * PAST + (j - 128)) * 128;
                kp = p.cache_nak + o; vp = p.cache_nav + o;
            }
        };
        const int sub = lane & 15, kk = lane >> 4, per = dq / 16;
        for (int j0 = 0; j0 < nkeys; j0 += 4) {
            const float *kp, *vp; float bias;
            kv_ptrs(j0 + kk, kp, vp, bias);
            float part = 0.f;
            for (int d = 0; d < per; d += 4) {
                float4 kvv = *(const float4*)(kp + sub * per + d);
                const float* qq = sq + sub * per + d;
                part += kvv.x * qq[0] + kvv.y * qq[1] + kvv.z * qq[2] + kvv.w * qq[3];
            }
            part += __shfl_xor(part, 1); part += __shfl_xor(part, 2); part += __shfl_xor(part, 4); part += __shfl_xor(part, 8);
            if (sub == 0) ss[j0 + kk] = part * scale + bias;
        }
        __builtin_amdgcn_wave_barrier();
        float m = -INFINITY;
        for (int j = lane; j < nkeys; j += 64) m = fmaxf(m, ss[j]);
        m = wave_max(m);
        float sum = 0.f;
        for (int j = lane; j < nkeys; j += 64) { const float e = __expf(ss[j] - m); ss[j] = e; sum += e; }
        sum = wave_sum(sum);
        __builtin_amdgcn_wave_barrier();
        const float inv = 1.f / sum;
        float o0 = 0.f, o1 = 0.f;
        for (int j = 0; j < nkeys; ++j) {
            const float *kp, *vp; float bias;
            kv_ptrs(j, kp, vp, bias);
            const float pj = ss[j];
            o0 += pj * vp[lane]; o1 += pj * vp[64 + lane];
        }
        bf16_t* dst = p.mix_b + (size_t)t * D + (mla ? h * 128 : 1024 + h * 128);
        dst[lane] = f2bf(o0 * inv); dst[64 + lane] = f2bf(o1 * inv);
        __builtin_amdgcn_wave_barrier();
    }
}

DEVI void phase_route(CParams& p, int bid, int nb) {
    const int lane = tidx() & 63, w = tidx() >> 6;
    for (int it = bid * NWAVES + w; it < T * 8; it += nb * NWAVES) {
        const int t = it / 8, h = it % 8;
        const float* sc = p.sc + (size_t)t * 2048 + h * 256;
        float keepS[2]; int keepI[2];
#pragma unroll
        for (int pp = 0; pp < 2; ++pp) {
            float x0 = sc[pp * 128 + lane], x1 = sc[pp * 128 + 64 + lane];
            float ks = 0.f; int ki = 0;
            for (int r = 0; r < 16; ++r) {
                float bv; int bi;
                if (x0 >= x1) { bv = x0; bi = lane; } else { bv = x1; bi = lane + 64; }
                wave_argmax(bv, bi);
                if (lane == r) { ks = bv; ki = bi; }
                if ((bi & 63) == lane) { if (bi < 64) x0 = -INFINITY; else x1 = -INFINITY; }
            }
            keepS[pp] = ks; keepI[pp] = ki;
        }
        const int a = lane >> 2, b0 = (lane & 3) * 4;
        const float s1a = __shfl(keepS[0], a);
        float c0 = s1a + __shfl(keepS[1], b0 + 0), c1 = s1a + __shfl(keepS[1], b0 + 1), c2 = s1a + __shfl(keepS[1], b0 + 2), c3 = s1a + __shfl(keepS[1], b0 + 3);
        float topS = 0.f; int topE = 0; float mx = 0.f;
        for (int r = 0; r < 16; ++r) {
            float bv = c0; int bi = lane * 4;
            if (c1 > bv) { bv = c1; bi = lane * 4 + 1; }
            if (c2 > bv) { bv = c2; bi = lane * 4 + 2; }
            if (c3 > bv) { bv = c3; bi = lane * 4 + 3; }
            wave_argmax(bv, bi);
            const int e = __shfl(keepI[0], bi >> 4) * 128 + __shfl(keepI[1], bi & 15);
            if (r == 0) mx = bv;
            if (lane == r) { topS = bv; topE = e; }
            if ((bi >> 2) == lane) { const int c = bi & 3; if (c == 0) c0 = -INFINITY; else if (c == 1) c1 = -INFINITY; else if (c == 2) c2 = -INFINITY; else c3 = -INFINITY; }
        }
        float e = lane < 16 ? __expf(topS - mx) : 0.f;
        const float sum = wave_sum(e);
        if (lane < 16) { p.gate[(size_t)t * 128 + h * 16 + lane] = e / sum; p.eidx[(size_t)t * 128 + h * 16 + lane] = topE; }
    }
}

DEVI void phase_experts(CParams& p, int layer, int bid, int nb, float* lds) {
    const int lane = tidx() & 63, w = tidx() >> 6;
    float* wgt = lds + w * 128;
    const float* U = p.peer_u + (size_t)layer * 16384 * D;
    const float* V = p.peer_v + (size_t)layer * 16384 * D;
    for (int t = bid * NWAVES + w; t < T; t += nb * NWAVES) {
        float4 x[8];
#pragma unroll
        for (int i = 0; i < 8; ++i) x[i] = *(const float4*)(p.hn + (size_t)t * D + i * 256 + lane * 4);
        for (int e = 0; e < 128; ++e) {
            const int idx = p.eidx[(size_t)t * 128 + e];
            const float* u = U + (size_t)idx * D;
            float d = 0.f;
#pragma unroll
            for (int i = 0; i < 8; ++i) { float4 uv = *(const float4*)(u + i * 256 + lane * 4); d += uv.x * x[i].x + uv.y * x[i].y + uv.z * x[i].z + uv.w * x[i].w; }
            d = wave_sum(d);
            const float a = 0.5f * d * (1.f + erff(d * 0.70710678118654752f));
            if (lane == 0) wgt[e] = a * p.gate[(size_t)t * 128 + e];
        }
        __builtin_amdgcn_wave_barrier();
        float4 o[8];
#pragma unroll
        for (int i = 0; i < 8; ++i) o[i] = make_float4(0.f, 0.f, 0.f, 0.f);
        for (int e = 0; e < 128; ++e) {
            const int idx = p.eidx[(size_t)t * 128 + e];
            const float* v = V + (size_t)idx * D;
            const float wg = wgt[e];
#pragma unroll
            for (int i = 0; i < 8; ++i) { float4 vv = *(const float4*)(v + i * 256 + lane * 4); o[i].x += wg * vv.x; o[i].y += wg * vv.y; o[i].z += wg * vv.z; o[i].w += wg * vv.w; }
        }
        const float* g2 = p.ada + ((size_t)layer * 3 + cond_of(t)) * 6 * D + 5 * D;
        float* xo = p.out + (size_t)t * D;
#pragma unroll
        for (int i = 0; i < 8; ++i) {
            const int c = i * 256 + lane * 4;
            float4 xv = *(const float4*)(xo + c), gv = *(const float4*)(g2 + c);
            xv.x += gv.x * o[i].x; xv.y += gv.y * o[i].y; xv.z += gv.z * o[i].z; xv.w += gv.w * o[i].w;
            *(float4*)(xo + c) = xv;
        }
    }
}

enum { PH_ADA = 0, PH_NORM1, PH_WIN, PH_POSTZ, PH_UQKV, PH_HEADNORM, PH_ATTN, PH_WOUT, PH_NORM2, PH_WQ, PH_SCORES, PH_ROUTE, PH_EXPERTS, PH_COUNT };

template <int PH>
DEVI void run_phase(CParams& p, int layer, int bid, int nb, float* lds) {
    if constexpr (PH == PH_ADA) { phase_ada(p, bid, nb, lds); phase_weights(p, bid, nb, lds); }
    if constexpr (PH == PH_NORM1) phase_modnorm(p, layer, 0, bid, nb);
    if constexpr (PH == PH_WIN) mfma_gemm(p.hn_b, p.wt_in + (size_t)layer * DINP * D, T, DINP, D, EpiF32{p.z, DIN, DIN}, bid, nb, lds);
    if constexpr (PH == PH_POSTZ) phase_postz(p, layer, bid, nb);
    if constexpr (PH == PH_UQKV) {
        mfma_gemm(p.cqn_b, p.wt_uq + (size_t)layer * 1536 * 512, T, 1536, 512, EpiF32{p.qm, 1536, 1536}, bid, nb, lds);
        mfma_gemm(p.ckv_b, p.wt_ukv + (size_t)layer * 2048 * 256, TKV, 2048, 256, EpiF32{p.kvr, 2048, 2048}, bid, nb, lds);
    }
    if constexpr (PH == PH_HEADNORM) phase_headnorm(p, layer, bid, nb);
    if constexpr (PH == PH_ATTN) phase_attn(p, layer, bid, nb, lds);
    if constexpr (PH == PH_WOUT) mfma_gemm(p.mix_b, p.wt_out + (size_t)layer * D * D, T, D, D, EpiResidMF{&p, layer}, bid, nb, lds);
    if constexpr (PH == PH_NORM2) phase_modnorm(p, layer, 1, bid, nb);
    if constexpr (PH == PH_WQ) mfma_gemm(p.hn_b, p.wt_q + (size_t)layer * D * D, T, D, D, EpiF32{p.qp, D, D}, bid, nb, lds);
    if constexpr (PH == PH_SCORES) {
        for (int hp = 0; hp < 16; ++hp)
            gemm_f32<true>(p.qp + hp * 128, D, p.sub_keys + ((size_t)layer * 16 + hp) * 128 * 128, 128, T, 128, 128, EpiStore{p.sc + hp * 128, D}, bid, nb, lds);
    }
    if constexpr (PH == PH_ROUTE) phase_route(p, bid, nb);
    if constexpr (PH == PH_EXPERTS) phase_experts(p, layer, bid, nb, lds);
}

#ifndef MK_ONE_LAUNCH
#define MK_ONE_LAUNCH 1
#endif
constexpr size_t LDS_BYTES = LDS_TOTAL;

#if MK_ONE_LAUNCH
#define PHASE(PH, l) do { CParams* q_ = pp; asm volatile("" : "+s"(q_)); run_phase<PH>(*q_, l, (int)blockIdx.x, (int)gridDim.x, lds); xcd_barrier(bar); } while (0)
__global__ void __launch_bounds__(NTHREADS, 2) k_fwd(Params p_unused) {
    CParams* pp = (CParams*)__builtin_amdgcn_kernarg_segment_ptr();
    extern __shared__ __attribute__((aligned(16))) unsigned char lds_raw[];
    float* lds = (float*)lds_raw;
    if (threadIdx.x == 0) *(uint4*)(lds_raw + MISC_OFF) = make_uint4(0u, 0u, 0u, 0u);
    __syncthreads();
    XcdBarrier bar = xcd_barrier_post(pp->bar, (volatile LAS unsigned*)(lds_raw + MISC_OFF));
    PHASE(PH_ADA, 0);
    for (int l = 0; l < DEPTH; ++l) {
        PHASE(PH_NORM1, l);
        PHASE(PH_WIN, l);
        PHASE(PH_POSTZ, l);
        PHASE(PH_UQKV, l);
        PHASE(PH_HEADNORM, l);
        PHASE(PH_ATTN, l);
        PHASE(PH_WOUT, l);
        PHASE(PH_NORM2, l);
        PHASE(PH_WQ, l);
        PHASE(PH_SCORES, l);
        PHASE(PH_ROUTE, l);
        PHASE(PH_EXPERTS, l);
    }
}
#else
template <int PH>
__global__ void __launch_bounds__(NTHREADS, 4) k_phase(Params p, int layer) {
    extern __shared__ float4 lds4[];
    CParams* pp = (CParams*)__builtin_amdgcn_kernarg_segment_ptr();
    run_phase<PH>(*pp, layer, blockIdx.x, gridDim.x, (float*)lds4);
}
template <int PH>
void launch_phase(const Params& p, int layer, hipStream_t stream) {
    hipLaunchKernelGGL(k_phase<PH>, dim3(1024), dim3(NTHREADS), LDS_BYTES, stream, p, layer);
}
#endif

}

extern "C" void kernel_launch(void* const* d_in, const int* in_sizes, int n_in, void* d_out, int out_size, void* d_ws, size_t ws_size, hipStream_t stream) {
    Params p{};
    const float* const* in = (const float* const*)d_in;
    p.x_prompt = in[0]; p.x_sample = in[1]; p.cache_ckv = in[2]; p.cache_kpe = in[3]; p.cache_nak = in[4]; p.cache_nav = in[5]; p.c = in[6]; p.c_ctx = in[7];
    p.ada_w = in[8]; p.ada_b = in[9]; p.norm_mix_g = in[10]; p.norm_ffn_g = in[11]; p.w_in = in[12]; p.q_norm_g = in[13]; p.w_uq = in[14]; p.kv_norm_g = in[15]; p.w_ukv = in[16];
    p.q_head_g = in[17]; p.k_head_g = in[18]; p.naq_g = in[19]; p.nak_g = in[20]; p.rel_bias = in[21]; p.conv_w = in[22]; p.w_out = in[23]; p.peer_wq = in[24]; p.sub_keys = in[25];
    p.peer_u = in[26]; p.peer_v = in[27];
    float* out = (float*)d_out;
    p.out = out;
    p.o_ckv = out + (size_t)T * D;
    p.o_kpe = p.o_ckv + (size_t)BATCH * DEPTH * SEQ * 256;
    p.o_nak = p.o_kpe + (size_t)BATCH * DEPTH * SEQ * 64;
    p.o_nav = p.o_nak + (size_t)BATCH * DEPTH * 4 * SEQ * 128;
    char* ws = (char*)d_ws; size_t off = 0;
    auto carve = [&](size_t bytes) { void* r = ws + off; off += (bytes + 255) & ~(size_t)255; return r; };
    p.bar = (unsigned*)carve(16384);
    p.ada = (float*)carve((size_t)DEPTH * 3 * 6 * D * 4);
    p.hn = (float*)carve((size_t)T * D * 4);
    p.z = (float*)carve((size_t)(T + 1) * DIN * 4);
    p.cqn = (float*)carve((size_t)T * 512 * 4);
    p.ckv = (float*)carve((size_t)TKV * 256 * 4);
    p.qm = (float*)carve((size_t)T * 1536 * 4);
    p.kvr = (float*)carve((size_t)TKV * 2048 * 4);
    p.km = (float*)carve((size_t)TKV * 1536 * 4);
    p.qna = (float*)carve((size_t)T * 512 * 4);
    p.kna = (float*)carve((size_t)T * 512 * 4);
    p.mix = (float*)carve((size_t)T * D * 4);
    p.qp = (float*)carve((size_t)T * D * 4);
    p.sc = (float*)carve((size_t)T * D * 4);
    p.gate = (float*)carve((size_t)T * 128 * 4);
    p.eidx = (int*)carve((size_t)T * 128 * 4);
    p.wt_in = (bf16_t*)carve((size_t)DEPTH * DINP * D * 2);
    p.wt_uq = (bf16_t*)carve((size_t)DEPTH * 1536 * 512 * 2);
    p.wt_ukv = (bf16_t*)carve((size_t)DEPTH * 2048 * 256 * 2);
    p.wt_out = (bf16_t*)carve((size_t)DEPTH * D * D * 2);
    p.wt_q = (bf16_t*)carve((size_t)DEPTH * D * D * 2);
    p.hn_b = (bf16_t*)carve((size_t)T * D * 2);
    p.cqn_b = (bf16_t*)carve((size_t)T * 512 * 2);
    p.ckv_b = (bf16_t*)carve((size_t)TKV * 256 * 2);
    p.mix_b = (bf16_t*)carve((size_t)T * D * 2);

#if MK_ONE_LAUNCH
    static int grid = 0;
    if (!grid) {
        int dev = 0, cus = 0, per_cu = 0;
        hipGetDevice(&dev);
        hipDeviceGetAttribute(&cus, hipDeviceAttributeMultiprocessorCount, dev);
        hipFuncSetAttribute((const void*)k_fwd, hipFuncAttributeMaxDynamicSharedMemorySize, (int)LDS_BYTES);
        hipOccupancyMaxActiveBlocksPerMultiprocessor(&per_cu, k_fwd, NTHREADS, LDS_BYTES);
        if (per_cu < 1) per_cu = 1;
        grid = cus * (per_cu < 1 ? per_cu : 1);
    }
    hipMemsetAsync(p.bar, 0, XCD_BAR_WORDS * sizeof(unsigned), stream);
    hipLaunchKernelGGL(k_fwd, dim3(grid), dim3(NTHREADS), LDS_BYTES, stream, p);
#else
    launch_phase<PH_ADA>(p, 0, stream);
    for (int l = 0; l < DEPTH; ++l) {
        launch_phase<PH_NORM1>(p, l, stream);
        launch_phase<PH_WIN>(p, l, stream);
        launch_phase<PH_POSTZ>(p, l, stream);
        launch_phase<PH_UQKV>(p, l, stream);
        launch_phase<PH_HEADNORM>(p, l, stream);
        launch_phase<PH_ATTN>(p, l, stream);
        launch_phase<PH_WOUT>(p, l, stream);
        launch_phase<PH_NORM2>(p, l, stream);
        launch_phase<PH_WQ>(p, l, stream);
        launch_phase<PH_SCORES>(p, l, stream);
        launch_phase<PH_ROUTE>(p, l, stream);
        launch_phase<PH_EXPERTS>(p, l, stream);
    }
#endif
}
```

```cpp
#include <hip/hip_runtime.h>
#include <stdint.h>

#define DEVI __device__ __forceinline__

#define XB_TMO      128
#define XB_XCNT(j)  (256  + 64 * (j))
#define XB_XSUB(j)  (1280 + 64 * (j))
#define XB_XGEN(j)  (2304 + 64 * (j))
#define XB_TOP      3328
#define XB_TOPGEN   3392
#define XCD_BAR_WORDS 3456
#define XB_SPIN_CAP (1u << 18)
#define LAS __attribute__((address_space(3)))

__device__ __forceinline__ unsigned xb_ld(unsigned* p)              { return __hip_atomic_load(p, __ATOMIC_RELAXED, __HIP_MEMORY_SCOPE_AGENT); }
__device__ __forceinline__ unsigned xb_add(unsigned* p, unsigned v) { return __hip_atomic_fetch_add(p, v, __ATOMIC_RELAXED, __HIP_MEMORY_SCOPE_AGENT); }
__device__ __forceinline__ unsigned xb_xcc_id() { return (unsigned)__builtin_amdgcn_s_getreg((3 << 11) | 20) & 0xFu; }
#define XB_SPIN(cond, bar) do { unsigned _sp = 0; while (cond) { __builtin_amdgcn_s_sleep(1); \
    if ((++_sp & 255u) == 0u) { if (xb_ld(&(bar)[XB_TMO])) break; if (_sp > XB_SPIN_CAP) { atomicAdd(&(bar)[XB_TMO], 1u); break; } } } } while (0)

struct XcdBarrier {
    unsigned* bar; unsigned x;
    volatile LAS unsigned* st;
};

__device__ __forceinline__ XcdBarrier xcd_barrier_post(unsigned* bar, volatile LAS unsigned* st) {
    XcdBarrier b; b.bar = bar; b.x = xb_xcc_id(); b.st = st;
    if (threadIdx.x == 0) (void)xb_add(&bar[XB_XCNT(b.x)], 1u);
    return b;
}
__device__ __forceinline__ void xcd_barrier_complete(unsigned* bar, unsigned x, unsigned& nloc, unsigned& nx) {
    const unsigned G = gridDim.x * gridDim.y * gridDim.z;
    unsigned sum, cnt, mine, sp = 0u;
    for (;;) {
        sum = 0u; cnt = 0u; mine = 0u;
#pragma unroll
        for (unsigned j = 0; j < 16; ++j) { const unsigned c = xb_ld(&bar[XB_XCNT(j)]); sum += c; cnt += (c > 0u) ? 1u : 0u; mine = (j == x) ? c : mine; }
        if (sum == G) break;
        __builtin_amdgcn_s_sleep(1);
        if ((++sp & 255u) == 0u) { if (xb_ld(&bar[XB_TMO])) break; if (sp > XB_SPIN_CAP) { atomicAdd(&bar[XB_TMO], 1u); break; } }
    }
    nloc = mine > 0u ? mine : 1u; nx = cnt > 0u ? cnt : 1u;
}

__device__ __forceinline__ void xcd_barrier(const XcdBarrier& b) {
    asm volatile("s_waitcnt vmcnt(0)" ::: "memory");
    __syncthreads();
    if (threadIdx.x == 0) {
        unsigned* bar = b.bar;
        __builtin_amdgcn_s_waitcnt(0);
        unsigned nloc = b.st[0], nx = b.st[1];
        if (nloc == 0u) { xcd_barrier_complete(bar, b.x, nloc, nx); b.st[0] = nloc; b.st[1] = nx; }
        const unsigned old = xb_add(&bar[XB_XSUB(b.x)], 1u);
        const unsigned gen = old / nloc;
        if (old + 1u == (gen + 1u) * nloc) {
            __builtin_amdgcn_fence(__ATOMIC_RELEASE, "agent");
            asm volatile("s_waitcnt vmcnt(0)" ::: "memory");
            const unsigned og = xb_add(&bar[XB_TOP], 1u);
            const unsigned tg = og / nx;
            if (og + 1u == (tg + 1u) * nx) xb_add(&bar[XB_TOPGEN], 1u);
            else XB_SPIN(xb_ld(&bar[XB_TOPGEN]) == tg, bar);
            __builtin_amdgcn_fence(__ATOMIC_ACQUIRE, "agent");
            xb_add(&bar[XB_XGEN(b.x)], 1u);
            asm volatile("s_waitcnt vmcnt(0)" ::: "memory");
        } else {
            XB_SPIN(xb_ld(&bar[XB_XGEN(b.x)]) == gen, bar);
            __builtin_amdgcn_fence(__ATOMIC_ACQUIRE, "agent");
            asm volatile("s_waitcnt vmcnt(0)" ::: "memory");
        }
    }
    __syncthreads();
}


namespace pg8 {
#define PG8_LAS __attribute__((address_space(3)))
typedef unsigned short bf16_t;
typedef short bf16x8 __attribute__((ext_vector_type(8)));
typedef float f32x4 __attribute__((ext_vector_type(4)));
typedef unsigned u32x4 __attribute__((ext_vector_type(4)));
constexpr int BM = 256, BK = 64, HALF = 128, HTB = HALF * BK * 2  , STAGE_BYTES = 8 * HTB, NXCD = 8, WGM = 8;

__host__ __device__ __forceinline__ int lds_byte(int r, int c) { const int st = (r >> 4) * 2 + (c >> 5), rr = r & 15, cc = c & 31, ob = rr * 64 + cc * 2; return st * 1024 + (ob ^ (((ob >> 9) & 1) << 5)); }
__host__ __device__ __forceinline__ void stage_rc(int b, int& R, int& C) { const int st = b / 1024, sb = b % 1024, swz = sb ^ (((sb >> 9) & 1) << 5); R = (st >> 1) * 16 + swz / 64; C = (st & 1) * 32 + (swz % 64) / 2; }
__host__ __device__ __forceinline__ int perm32(int rho) { const int n = rho >> 4, i = rho & 15; return 8 * (i >> 2) + 4 * n + (i & 3); }

struct Unit { int pm, pn; };
struct Gemm { const bf16_t* A; const bf16_t* Bt; int M, N, K; };

struct StaticOrder {
    int nM, nN, nwg, G, c;
    __host__ __device__ void init(int M, int N, int G_, int c_) { nM = M / BM; nN = N / BM; nwg = nM * nN; G = G_; c = c_; }
    __host__ __device__ bool next(int i, Unit& u) const {
        const long L = (long)i * G + c; if (L >= nwg) return false;
        int wgid = (int)L; { const int q = nwg / NXCD, r = nwg % NXCD, xcd = wgid % NXCD, off = wgid / NXCD; wgid = (xcd < r ? xcd * (q + 1) : r * (q + 1) + (xcd - r) * q) + off; }
        const int nig = WGM * nN, gid = wgid / nig, fm = gid * WGM, gsz = (nM - fm) < WGM ? (nM - fm) : WGM;
        u.pm = fm + ((wgid % nig) % gsz); u.pn = (wgid % nig) / gsz; return true;
    }
    __device__ __forceinline__ void a_ready(const Unit&) const {}
    __device__ __forceinline__ void done(const Unit&) const {}
};

__device__ __forceinline__ unsigned cvt_pk_bf16(float lo, float hi) { unsigned r; asm volatile("v_cvt_pk_bf16_f32 %0, %1, %2" : "=v"(r) : "v"(lo), "v"(hi)); return r; }
typedef float f32x2 __attribute__((ext_vector_type(2)));
template <class Epi, class Sched, bool ALIGN_EPI = false, bool SP2 = false>
__device__ __forceinline__ void gemm_phase(PG8_LAS unsigned char* lds, const Gemm g, const Sched& S, const Epi& E) {
    int tid = threadIdx.x; asm volatile("" : "+v"(tid));
    const int wid = __builtin_amdgcn_readfirstlane(tid >> 6), lane = tid & 63, wr = wid >> 2, wc = wid & 3, fr = lane & 15, fq = lane >> 4;
    const int K = g.K, nt = K / BK;
    unsigned voffA[2], voffB[2];
#pragma unroll
    for (int i = 0; i < 2; ++i) { int R, C; stage_rc(tid * 16 + i * 8192, R, C); const int Rb = Epi::PERM ? ((R & ~31) + perm32(R & 31)) : R;
        voffA[i] = (unsigned)(R * K + C) * 2u; voffB[i] = (unsigned)(Rb * K + C) * 2u; }
    const size_t kstep = (size_t)(BK * 2);
    const size_t hstep = (size_t)HALF * K * 2;
    const size_t tstep = 2 * hstep;
    const unsigned ldsw = (unsigned)wid * 1024u;
    const int aoff = lds_byte(wr * 64 + fr, fq * 8), boff = lds_byte(wc * 32 + fr, fq * 8);
#define PG8_SA(b, h) (((b) * 2 + (h)) * HTB)
#define PG8_SB(b, h) ((4 + (b) * 2 + (h)) * HTB)
#define PG8_STAGE(bufoff, gbase, voff) do { _Pragma("unroll") for (int _i = 0; _i < 2; ++_i) \
        __builtin_amdgcn_global_load_lds((const unsigned*)((const char*)(gbase) + (voff)[_i]), (PG8_LAS unsigned*)(lds + (bufoff) + ldsw + _i * 8192), 16, 0, 0); } while (0)
#define PG8_LDA(dst, b, h) do { _Pragma("unroll") for (int m = 0; m < 4; ++m) _Pragma("unroll") for (int k = 0; k < 2; ++k) dst[m][k] = *(const PG8_LAS bf16x8*)(lds + PG8_SA(b, h) + aoff + m * 2048 + k * 1024); } while (0)
#define PG8_LDB(dst, b, h) do { _Pragma("unroll") for (int n = 0; n < 2; ++n) _Pragma("unroll") for (int k = 0; k < 2; ++k) dst[n][k] = *(const PG8_LAS bf16x8*)(lds + PG8_SB(b, h) + boff + n * 2048 + k * 1024); } while (0)
#define PG8_MMA(ai, bj, At, Bt) do { __builtin_amdgcn_s_setprio(1); _Pragma("unroll") for (int m = 0; m < 4; ++m) _Pragma("unroll") for (int n = 0; n < 2; ++n) _Pragma("unroll") for (int k = 0; k < 2; ++k) \
        acc[ai][bj][m][n] = __builtin_amdgcn_mfma_f32_16x16x32_bf16(Bt[n][k], At[m][k], acc[ai][bj][m][n], 0, 0, 0); __builtin_amdgcn_s_setprio(0); } while (0)
#define PG8_WAIT_V(n) asm volatile("s_waitcnt vmcnt(" #n ")" ::: "memory")
#define PG8_WAIT_L(n) asm volatile("s_waitcnt lgkmcnt(" #n ")" ::: "memory")
#define PG8_BAR __builtin_amdgcn_s_barrier()
#define PG8_SCHED __builtin_amdgcn_sched_barrier(0)
    Unit cur, nxt; int ui = 0;
    if (!S.next(0, cur)) return;
    f32x4 acc[2][2][4][2];
#pragma unroll
    for (int a = 0; a < 2; ++a)
#pragma unroll
        for (int b = 0; b < 2; ++b)
#pragma unroll
            for (int m = 0; m < 4; ++m)
#pragma unroll
                for (int n = 0; n < 2; ++n) acc[a][b][m][n] = (f32x4){0.f, 0.f, 0.f, 0.f};
    bf16x8 At[4][2], B0[2][2], B1[2][2];
    const char* cA = (const char*)g.A + (size_t)cur.pm * tstep; const char* cB = (const char*)g.Bt + (size_t)cur.pn * tstep;
    S.a_ready(cur);
    if constexpr (SP2) {
        PG8_STAGE(PG8_SB(0, 0), cB, voffB); PG8_STAGE(PG8_SB(0, 1), cB + hstep, voffB); PG8_STAGE(PG8_SA(0, 0), cA, voffA); PG8_STAGE(PG8_SA(0, 1), cA + hstep, voffA);
        if (wr == 1) PG8_BAR;
        PG8_WAIT_V(2); PG8_BAR;
        PG8_STAGE(PG8_SB(1, 0), cB + kstep, voffB); PG8_STAGE(PG8_SA(1, 0), cA + kstep, voffA); PG8_STAGE(PG8_SB(1, 1), cB + hstep + kstep, voffB);
        PG8_WAIT_V(6); PG8_BAR;
    } else {
        PG8_STAGE(PG8_SB(0, 0), cB, voffB); PG8_STAGE(PG8_SA(0, 0), cA, voffA); PG8_STAGE(PG8_SB(0, 1), cB + hstep, voffB); PG8_STAGE(PG8_SA(0, 1), cA + hstep, voffA);
        if (wr == 1) PG8_BAR;
        PG8_WAIT_V(4); PG8_BAR;
        PG8_STAGE(PG8_SB(1, 0), cB + kstep, voffB); PG8_STAGE(PG8_SA(1, 0), cA + kstep, voffA); PG8_STAGE(PG8_SB(1, 1), cB + hstep + kstep, voffB);
        PG8_WAIT_V(6); PG8_BAR;
    }
    for (;;) {
        const bool has_next = S.next(ui + 1, nxt);
        const char* nA = has_next ? (const char*)g.A + (size_t)nxt.pm * tstep : cA; const char* nB = has_next ? (const char*)g.Bt + (size_t)nxt.pn * tstep : cB;
        for (int t = 0; t < nt; t += 2) {
            const bool last = (t == nt - 2);
            const char* a1 = cA + (size_t)(t + 1) * kstep;
            const char* a2 = last ? nA : cA + (size_t)(t + 2) * kstep; const char* b2 = last ? nB : cB + (size_t)(t + 2) * kstep;
            const char* a3 = a2 + kstep; const char* b3 = b2 + kstep;
            if (last && has_next) S.a_ready(nxt);
            if constexpr (SP2) {
            PG8_LDB(B0, 0, 0); PG8_LDB(B1, 0, 1); PG8_SCHED; PG8_LDA(At, 0, 0); PG8_STAGE(PG8_SA(1, 1), a1 + hstep, voffA);
            PG8_WAIT_V(8); PG8_WAIT_L(0); PG8_BAR; PG8_MMA(0, 0, At, B0); PG8_MMA(0, 1, At, B1); PG8_BAR; PG8_SCHED;
            PG8_LDA(At, 0, 1); PG8_STAGE(PG8_SB(0, 0), b2, voffB); PG8_STAGE(PG8_SB(0, 1), b2 + hstep, voffB); PG8_STAGE(PG8_SA(0, 0), a2, voffA);
            PG8_WAIT_V(8); PG8_WAIT_L(0); PG8_BAR; PG8_MMA(1, 0, At, B0); PG8_MMA(1, 1, At, B1); PG8_BAR; PG8_SCHED;
            PG8_LDB(B0, 1, 0); PG8_LDB(B1, 1, 1); PG8_SCHED; PG8_LDA(At, 1, 0); PG8_STAGE(PG8_SA(0, 1), a2 + hstep, voffA);
            PG8_WAIT_V(8); PG8_WAIT_L(0); PG8_BAR; PG8_MMA(0, 0, At, B0); PG8_MMA(0, 1, At, B1); PG8_BAR; PG8_SCHED;
            PG8_LDA(At, 1, 1); PG8_STAGE(PG8_SB(1, 0), b3, voffB); PG8_STAGE(PG8_SB(1, 1), b3 + hstep, voffB); PG8_STAGE(PG8_SA(1, 0), a3, voffA);
            PG8_WAIT_V(8); PG8_WAIT_L(0); PG8_BAR; PG8_MMA(1, 0, At, B0); PG8_MMA(1, 1, At, B1); PG8_BAR; PG8_SCHED;
            } else {
            PG8_LDB(B0, 0, 0); PG8_SCHED; PG8_LDA(At, 0, 0); PG8_STAGE(PG8_SA(1, 1), a1 + hstep, voffA);
            PG8_WAIT_L(8); PG8_BAR; PG8_WAIT_L(0); PG8_MMA(0, 0, At, B0); PG8_BAR; PG8_SCHED;
            PG8_LDB(B1, 0, 1); PG8_STAGE(PG8_SB(0, 0), b2, voffB);
            PG8_BAR; PG8_WAIT_L(0); PG8_MMA(0, 1, At, B1); PG8_BAR;
            PG8_LDA(At, 0, 1); PG8_STAGE(PG8_SA(0, 0), a2, voffA);
            PG8_BAR; PG8_WAIT_L(0); PG8_MMA(1, 0, At, B0); PG8_BAR; PG8_SCHED;
            PG8_STAGE(PG8_SB(0, 1), b2 + hstep, voffB);
            PG8_WAIT_V(6); PG8_BAR; PG8_MMA(1, 1, At, B1); PG8_BAR;
            PG8_LDB(B0, 1, 0); PG8_SCHED; PG8_LDA(At, 1, 0); PG8_STAGE(PG8_SA(0, 1), a2 + hstep, voffA);
            PG8_WAIT_L(8); PG8_BAR; PG8_WAIT_L(0); PG8_MMA(0, 0, At, B0); PG8_BAR; PG8_SCHED;
            PG8_LDB(B1, 1, 1); PG8_STAGE(PG8_SB(1, 0), b3, voffB);
            PG8_BAR; PG8_WAIT_L(0); PG8_MMA(0, 1, At, B1); PG8_BAR;
            PG8_LDA(At, 1, 1); PG8_STAGE(PG8_SA(1, 0), a3, voffA);
            PG8_BAR; PG8_WAIT_L(0); PG8_MMA(1, 0, At, B0); PG8_BAR; PG8_SCHED;
            PG8_STAGE(PG8_SB(1, 1), b3 + hstep, voffB);
            PG8_WAIT_V(6); PG8_BAR; PG8_MMA(1, 1, At, B1); PG8_BAR;
            }
        }
        if constexpr (ALIGN_EPI) { if (wr == 0) PG8_BAR; }
        if constexpr (!Epi::AFTER_DRAIN) { E(acc, cur, wr, wc, fr, fq); S.done(cur); }
        if (!has_next) break;
#pragma unroll
        for (int a = 0; a < 2; ++a)
#pragma unroll
            for (int b = 0; b < 2; ++b)
#pragma unroll
                for (int m = 0; m < 4; ++m)
#pragma unroll
                    for (int n = 0; n < 2; ++n) acc[a][b][m][n] = (f32x4){0.f, 0.f, 0.f, 0.f};
        cur = nxt; cA = nA; cB = nB; ++ui;
        if constexpr (ALIGN_EPI) { if (wr == 1) PG8_BAR; }
    }
    PG8_WAIT_V(0);
    if constexpr (!ALIGN_EPI) { if (wr == 0) PG8_BAR; }
    PG8_BAR;
    if constexpr (Epi::AFTER_DRAIN) { E.fused(acc, cur, wr, wc, fr, fq, lds, wid, lane); S.done(cur); }
#undef PG8_SA
#undef PG8_SB
#undef PG8_STAGE
#undef PG8_LDA
#undef PG8_LDB
#undef PG8_MMA
#undef PG8_WAIT_V
#undef PG8_WAIT_L
#undef PG8_BAR
#undef PG8_SCHED
}
}


namespace {

constexpr int D = 2048, BATCH = 32, SEQ = 256, DEPTH = 4, DB = 2, DS = 1024, PAST = 512;
constexpr int NCTX = BATCH * SEQ, NLAT = DB * DS, T = NCTX + NLAT, TKV = T + DB * PAST;
constexpr int DIN = 3904, DINP = 4096;
constexpr int RING_OFF = 0, MISC_OFF = 131072, LDS_TOTAL = 147456;
typedef unsigned short bf16_t;
constexpr int O_CQ = 0, O_CKV = 512, O_KPE = 768, O_NAQ = 832, O_NAK = 1344, O_NAV = 1856, O_GB = 2368, O_GC = 2880, O_U = 3392;
constexpr float EPS = 1e-6f;
constexpr int NTHREADS = 512, NWAVES = NTHREADS / 64;

struct Params {
    const float *x_prompt, *x_sample, *cache_ckv, *cache_kpe, *cache_nak, *cache_nav, *c, *c_ctx;
    const float *ada_w, *ada_b, *norm_mix_g, *norm_ffn_g, *w_in, *q_norm_g, *w_uq, *kv_norm_g, *w_ukv;
    const float *q_head_g, *k_head_g, *naq_g, *nak_g, *rel_bias, *conv_w, *w_out, *peer_wq, *sub_keys, *peer_u, *peer_v;
    float* out;
    float *o_ckv, *o_kpe, *o_nak, *o_nav;
    unsigned* bar;
    float *ada, *hn, *z, *cqn, *ckv, *qm, *kvr, *km, *qna, *kna, *mix, *qp, *sc, *gate;
    int* eidx;
    unsigned short *wt_in, *wt_uq, *wt_ukv, *wt_out, *wt_q;
    unsigned short *hn_b, *cqn_b, *ckv_b, *mix_b;
    unsigned short *q_b, *k_b, *qna_b, *kna_b, *cnak_b;
    unsigned short *vt_mla_ctx, *vt_mla_lat, *vt_na_ctx, *vt_na_lat, *vt_na_cache;
};

typedef const __attribute__((address_space(4))) Params CParams;

DEVI int tidx() { int t = threadIdx.x; asm volatile("" : "+v"(t)); return t; }
DEVI float wave_sum(float v) {
#pragma unroll
    for (int o = 32; o > 0; o >>= 1) v += __shfl_xor(v, o);
    return v;
}
DEVI float wave_max(float v) {
#pragma unroll
    for (int o = 32; o > 0; o >>= 1) v = fmaxf(v, __shfl_xor(v, o));
    return v;
}
DEVI void wave_argmax(float& v, int& idx) {
#pragma unroll
    for (int o = 32; o > 0; o >>= 1) {
        float ov = __shfl_xor(v, o); int oi = __shfl_xor(idx, o);
        if (ov > v || (ov == v && oi < idx)) { v = ov; idx = oi; }
    }
}
typedef float f32x2_t __attribute__((ext_vector_type(2))); typedef __bf16 bf16x2_t __attribute__((ext_vector_type(2)));
DEVI unsigned cvtpk(float lo, float hi) { f32x2_t v = {lo, hi}; bf16x2_t b = __builtin_convertvector(v, bf16x2_t); return __builtin_bit_cast(unsigned, b); }
DEVI bf16_t f2bf(float v) { return (bf16_t)(cvtpk(v, 0.f) & 0xffffu); }
DEVI int cond_of(int t) { return t < NCTX ? 2 : (t - NCTX) / DS; }
DEVI const float* xrow(CParams& p, int layer, int t) {
    if (layer == 0) return t < NCTX ? p.x_prompt + (size_t)t * D : p.x_sample + (size_t)(t - NCTX) * D;
    return p.out + (size_t)t * D;
}

DEVI void phase_ada(CParams& p, int bid, int nb, float* lds) {
    float* sv = lds;
    float* red = lds + 3 * D;
    const int tid = tidx(), lane = tid & 63, w = tid >> 6;
    for (int i = tid; i < 3 * D; i += NTHREADS) {
        int j = i / D, k = i % D;
        float v = j < 2 ? p.c[j * D + k] : p.c_ctx[k];
        sv[i] = v / (1.f + __expf(-v));
    }
    __syncthreads();
    const int nitems = DEPTH * (6 * D / 64);
    for (int it = bid; it < nitems; it += nb) {
        const int l = it / (6 * D / 64), n = (it % (6 * D / 64)) * 64 + lane;
        const float* W = p.ada_w + (size_t)l * D * 6 * D + n;
        float a0 = 0.f, a1 = 0.f, a2 = 0.f;
        const int k0 = w * (D / NWAVES);
#pragma unroll 8
        for (int k = k0; k < k0 + D / NWAVES; ++k) {
            float wv = W[(size_t)k * 6 * D];
            a0 += sv[k] * wv; a1 += sv[D + k] * wv; a2 += sv[2 * D + k] * wv;
        }
        red[(w * 3 + 0) * 64 + lane] = a0; red[(w * 3 + 1) * 64 + lane] = a1; red[(w * 3 + 2) * 64 + lane] = a2;
        __syncthreads();
        if (tid < 192) {
            int j = tid / 64, ln = tid % 64;
            float s = 0.f;
            for (int ww = 0; ww < NWAVES; ++ww) s += red[(ww * 3 + j) * 64 + ln];
            int nn = (it % (6 * D / 64)) * 64 + ln;
            p.ada[((size_t)l * 3 + j) * 6 * D + nn] = s + p.ada_b[(size_t)l * 6 * D + nn];
        }
        __syncthreads();
    }
}

DEVI void phase_modnorm(CParams& p, int layer, int which, int bid, int nb) {
    const int lane = tidx() & 63, w = tidx() >> 6;
    const float* g = (which == 0 ? p.norm_mix_g : p.norm_ffn_g) + (size_t)layer * D;
    for (int t = bid * NWAVES + w; t < T; t += nb * NWAVES) {
        const float* x = which == 0 ? xrow(p, layer, t) : p.out + (size_t)t * D;
        const float* ad = p.ada + ((size_t)layer * 3 + cond_of(t)) * 6 * D + (which == 0 ? 0 : 3 * D);
        float4 v[8]; float ss = 0.f;
#pragma unroll
        for (int i = 0; i < 8; ++i) { v[i] = *(const float4*)(x + i * 256 + lane * 4); ss += v[i].x * v[i].x + v[i].y * v[i].y + v[i].z * v[i].z + v[i].w * v[i].w; }
        ss = wave_sum(ss);
        const float r = rsqrtf(ss / D + EPS);
#pragma unroll
        for (int i = 0; i < 8; ++i) {
            const int c = i * 256 + lane * 4;
            float4 gg = *(const float4*)(g + c), sh = *(const float4*)(ad + c), sc = *(const float4*)(ad + D + c), o;
            o.x = v[i].x * r * gg.x * (1.f + sc.x) + sh.x; o.y = v[i].y * r * gg.y * (1.f + sc.y) + sh.y;
            o.z = v[i].z * r * gg.z * (1.f + sc.z) + sh.z; o.w = v[i].w * r * gg.w * (1.f + sc.w) + sh.w;
            *(float4*)(p.hn + (size_t)t * D + c) = o;
            *(uint2*)(p.hn_b + (size_t)t * D + c) = make_uint2(pg8::cvt_pk_bf16(o.x, o.y), pg8::cvt_pk_bf16(o.z, o.w));
        }
    }
}

template <bool BT, class Epi>
DEVI void gemm_tile(const float* A, int lda, const float* W, int ldw, int K, int m0, int n0, const Epi& epi, float* lds) {
    float (*As)[132] = (float (*)[132])lds;
    float (*Bs)[68] = (float (*)[68])(lds + 16 * 132);
    const int tid = tidx(), tx = tid & 15, ty = tid >> 4;
    float acc[4][4];
#pragma unroll
    for (int i = 0; i < 4; ++i)
#pragma unroll
        for (int j = 0; j < 4; ++j) acc[i][j] = 0.f;
    for (int k0 = 0; k0 < K; k0 += 16) {
        {
            const int row = tid >> 2, kq = tid & 3;
            float4 v = *(const float4*)(A + (size_t)(m0 + row) * lda + k0 + kq * 4);
            As[kq * 4 + 0][row] = v.x; As[kq * 4 + 1][row] = v.y; As[kq * 4 + 2][row] = v.z; As[kq * 4 + 3][row] = v.w;
        }
        if (tid < 256) {
            if (!BT) {
                const int k = tid >> 4, n4 = tid & 15;
                float4 v = *(const float4*)(W + (size_t)(k0 + k) * ldw + n0 + n4 * 4);
                *(float4*)&Bs[k][n4 * 4] = v;
            } else {
                const int n = tid >> 2, kq = tid & 3;
                float4 v = *(const float4*)(W + (size_t)(n0 + n) * ldw + k0 + kq * 4);
                Bs[kq * 4 + 0][n] = v.x; Bs[kq * 4 + 1][n] = v.y; Bs[kq * 4 + 2][n] = v.z; Bs[kq * 4 + 3][n] = v.w;
            }
        }
        __syncthreads();
#pragma unroll
        for (int k = 0; k < 16; ++k) {
            float4 a = *(const float4*)&As[k][ty * 4], b = *(const float4*)&Bs[k][tx * 4];
            const float av[4] = {a.x, a.y, a.z, a.w}, bv[4] = {b.x, b.y, b.z, b.w};
#pragma unroll
            for (int i = 0; i < 4; ++i)
#pragma unroll
                for (int j = 0; j < 4; ++j) acc[i][j] += av[i] * bv[j];
        }
        __syncthreads();
    }
#pragma unroll
    for (int i = 0; i < 4; ++i) epi(m0 + ty * 4 + i, n0 + tx * 4, make_float4(acc[i][0], acc[i][1], acc[i][2], acc[i][3]));
}
template <bool BT, class Epi>
DEVI void gemm_f32(const float* A, int lda, const float* W, int ldw, int M, int N, int K, const Epi& epi, int bid, int nb, float* lds) {
    const int nn = N / 64, nt = (M / 128) * nn;
    for (int tile = bid; tile < nt; tile += nb) gemm_tile<BT>(A, lda, W, ldw, K, (tile / nn) * 128, (tile % nn) * 64, epi, lds);
}
struct EpiStore { float* C; int ldc; DEVI void operator()(int r, int c, float4 v) const { *(float4*)(C + (size_t)r * ldc + c) = v; } };
struct EpiResid {
    CParams* p; int layer;
    DEVI void operator()(int r, int c, float4 v) const {
        const float* x = xrow(*p, layer, r) + c;
        const float* g1 = p->ada + ((size_t)layer * 3 + cond_of(r)) * 6 * D + 2 * D + c;
        float4 xv = *(const float4*)x, gv = *(const float4*)g1, o;
        o.x = xv.x + gv.x * v.x; o.y = xv.y + gv.y * v.y; o.z = xv.z + gv.z * v.z; o.w = xv.w + gv.w * v.w;
        *(float4*)(p->out + (size_t)r * D + c) = o;
    }
};


struct EpiF32 {
    static constexpr bool PERM = false, AFTER_DRAIN = false;
    float* C; int ldc, ncols;
    DEVI void operator()(const pg8::f32x4 (&acc)[2][2][4][2], const pg8::Unit& u, int wr, int wc, int fr, int fq) const {
        const int row0 = u.pm * 256 + wr * 64 + fr, col0 = u.pn * 256 + wc * 32 + 4 * fq;
#pragma unroll
        for (int ai = 0; ai < 2; ++ai)
#pragma unroll
            for (int m = 0; m < 4; ++m) { float* rowp = C + (size_t)(row0 + ai * 128 + m * 16) * ldc;
#pragma unroll
                for (int bj = 0; bj < 2; ++bj)
#pragma unroll
                    for (int n = 0; n < 2; ++n) { const int c = col0 + bj * 128 + n * 16; if (c < ncols) *(pg8::f32x4*)(rowp + c) = acc[ai][bj][m][n]; } }
    }
};
struct EpiResidMF {
    static constexpr bool PERM = false, AFTER_DRAIN = false;
    CParams* p; int layer;
    DEVI void operator()(const pg8::f32x4 (&acc)[2][2][4][2], const pg8::Unit& u, int wr, int wc, int fr, int fq) const {
        const int row0 = u.pm * 256 + wr * 64 + fr, col0 = u.pn * 256 + wc * 32 + 4 * fq;
#pragma unroll
        for (int ai = 0; ai < 2; ++ai)
#pragma unroll
            for (int m = 0; m < 4; ++m) {
                const int r = row0 + ai * 128 + m * 16;
                const float* x = xrow(*p, layer, r);
                const float* g1 = p->ada + ((size_t)layer * 3 + cond_of(r)) * 6 * D + 2 * D;
                float* o = p->out + (size_t)r * D;
#pragma unroll
                for (int bj = 0; bj < 2; ++bj)
#pragma unroll
                    for (int n = 0; n < 2; ++n) { const int c = col0 + bj * 128 + n * 16;
                        const pg8::f32x4 xv = *(const pg8::f32x4*)(x + c), gv = *(const pg8::f32x4*)(g1 + c);
                        *(pg8::f32x4*)(o + c) = xv + gv * acc[ai][bj][m][n]; } }
    }
};
template <class Epi>
DEVI void mfma_gemm(const bf16_t* A, const bf16_t* Bt, int M, int N, int K, const Epi& E, int bid, int nb, float* lds) {
    pg8::Gemm g{A, Bt, M, N, K};
    pg8::StaticOrder S; S.init(M, N, nb, bid);
    pg8::gemm_phase<Epi, pg8::StaticOrder, true, true>((PG8_LAS unsigned char*)lds + RING_OFF, g, S, E);
    __syncthreads();
}

DEVI void transpose_tile(const float* W, int ldw, bf16_t* Wt, int ldt, int k0, int n0, float* lds) {
    float (*tl)[65] = (float (*)[65])lds;
    const int tid = tidx();
#pragma unroll
    for (int rep = 0; rep < 2; ++rep) {
        const int k = (tid >> 4) + rep * 32, n4 = (tid & 15) * 4;
        const float4 v = *(const float4*)(W + (size_t)(k0 + k) * ldw + n0 + n4);
        tl[k][n4] = v.x; tl[k][n4 + 1] = v.y; tl[k][n4 + 2] = v.z; tl[k][n4 + 3] = v.w;
    }
    __syncthreads();
    {
        const int n = tid >> 3, k8 = (tid & 7) * 8;
        uint4 o;
        o.x = pg8::cvt_pk_bf16(tl[k8 + 0][n], tl[k8 + 1][n]); o.y = pg8::cvt_pk_bf16(tl[k8 + 2][n], tl[k8 + 3][n]);
        o.z = pg8::cvt_pk_bf16(tl[k8 + 4][n], tl[k8 + 5][n]); o.w = pg8::cvt_pk_bf16(tl[k8 + 6][n], tl[k8 + 7][n]);
        *(uint4*)(Wt + (size_t)(n0 + n) * ldt + k0 + k8) = o;
    }
    __syncthreads();
}
DEVI void phase_weights(CParams& p, int bid, int nb, float* lds) {
    constexpr int N_IN = 32 * 61, N_UQ = 8 * 24, N_UKV = 4 * 32, N_SQ = 32 * 32, PER = N_IN + N_UQ + N_UKV + 2 * N_SQ;
    for (int it = bid; it < DEPTH * PER; it += nb) {
        const int l = it / PER; int j = it % PER;
        if (j < N_IN) { transpose_tile(p.w_in + (size_t)l * D * DIN, DIN, p.wt_in + (size_t)l * DINP * D, D, (j / 61) * 64, (j % 61) * 64, lds); continue; }
        j -= N_IN;
        if (j < N_UQ) { transpose_tile(p.w_uq + (size_t)l * 512 * 1536, 1536, p.wt_uq + (size_t)l * 1536 * 512, 512, (j / 24) * 64, (j % 24) * 64, lds); continue; }
        j -= N_UQ;
        if (j < N_UKV) { transpose_tile(p.w_ukv + (size_t)l * 256 * 2048, 2048, p.wt_ukv + (size_t)l * 2048 * 256, 256, (j / 32) * 64, (j % 32) * 64, lds); continue; }
        j -= N_UKV;
        if (j < N_SQ) { transpose_tile(p.w_out + (size_t)l * D * D, D, p.wt_out + (size_t)l * D * D, D, (j / 32) * 64, (j % 32) * 64, lds); continue; }
        j -= N_SQ;
        transpose_tile(p.peer_wq + (size_t)l * D * D, D, p.wt_q + (size_t)l * D * D, D, (j / 32) * 64, (j % 32) * 64, lds);
    }
    const int nz = DEPTH * (DINP - DIN) * D / 8;
    for (int i = bid * NTHREADS + tidx(); i < nz; i += nb * NTHREADS) {
        const int per = (DINP - DIN) * D / 8, l = i / per, r = i % per;
        *(uint4*)(p.wt_in + ((size_t)l * DINP + DIN) * D + (size_t)r * 8) = make_uint4(0u, 0u, 0u, 0u);
    }
}

DEVI void phase_postz(CParams& p, int layer, int bid, int nb) {
    const int lane = tidx() & 63, w = tidx() >> 6;
    for (int r = bid * NWAVES + w; r < TKV; r += nb * NWAVES) {
        if (r >= T) {
            const int b = (r - T) / PAST, j = (r - T) % PAST;
            const float* src = p.cache_ckv + (((size_t)b * DEPTH + layer) * PAST + j) * 256;
            { float4 v = *(const float4*)(src + lane * 4); *(uint2*)(p.ckv_b + (size_t)r * 256 + lane * 4) = make_uint2(pg8::cvt_pk_bf16(v.x, v.y), pg8::cvt_pk_bf16(v.z, v.w)); }
            continue;
        }
        const float* z = p.z + (size_t)r * DIN;
        const bool ctx = r < NCTX;
        const int b = ctx ? r / SEQ : (r - NCTX) / DS, s = ctx ? r % SEQ : (r - NCTX) % DS;
        {
            float v[8], ss = 0.f;
#pragma unroll
            for (int i = 0; i < 8; ++i) { v[i] = z[O_CQ + i * 64 + lane]; ss += v[i] * v[i]; }
            ss = wave_sum(ss); const float rr = rsqrtf(ss / 512.f + EPS);
#pragma unroll
            for (int i = 0; i < 8; ++i) p.cqn_b[(size_t)r * 512 + i * 64 + lane] = f2bf(v[i] * rr * p.q_norm_g[layer * 512 + i * 64 + lane]);
        }
        {
            float v[4], ss = 0.f;
#pragma unroll
            for (int i = 0; i < 4; ++i) { v[i] = z[O_CKV + i * 64 + lane]; ss += v[i] * v[i]; }
            ss = wave_sum(ss); const float rr = rsqrtf(ss / 256.f + EPS);
#pragma unroll
            for (int i = 0; i < 4; ++i) {
                const float o = v[i] * rr * p.kv_norm_g[layer * 256 + i * 64 + lane];
                p.ckv_b[(size_t)r * 256 + i * 64 + lane] = f2bf(o);
                if (ctx) p.o_ckv[(((size_t)b * DEPTH + layer) * SEQ + s) * 256 + i * 64 + lane] = o;
            }
        }
        if (ctx) p.o_kpe[(((size_t)b * DEPTH + layer) * SEQ + s) * 64 + lane] = z[O_KPE + lane];
#pragma unroll
        for (int h = 0; h < 4; ++h) {
            float q0 = z[O_NAQ + h * 128 + lane], q1 = z[O_NAQ + h * 128 + 64 + lane];
            float ss = wave_sum(q0 * q0 + q1 * q1); float rr = rsqrtf(ss / 128.f + EPS);
            p.qna_b[(size_t)r * 512 + h * 128 + lane] = f2bf(q0 * rr * p.naq_g[layer * 128 + lane]);
            p.qna_b[(size_t)r * 512 + h * 128 + 64 + lane] = f2bf(q1 * rr * p.naq_g[layer * 128 + 64 + lane]);
            float k0 = z[O_NAK + h * 128 + lane], k1 = z[O_NAK + h * 128 + 64 + lane];
            ss = wave_sum(k0 * k0 + k1 * k1); rr = rsqrtf(ss / 128.f + EPS);
            k0 = k0 * rr * p.nak_g[layer * 128 + lane]; k1 = k1 * rr * p.nak_g[layer * 128 + 64 + lane];
            p.kna_b[(size_t)r * 512 + h * 128 + lane] = f2bf(k0); p.kna_b[(size_t)r * 512 + h * 128 + 64 + lane] = f2bf(k1);
            if (ctx) {
                const size_t o = ((((size_t)b * DEPTH + layer) * 4 + h) * SEQ + s) * 128;
                p.o_nak[o + lane] = k0; p.o_nak[o + 64 + lane] = k1;
                p.o_nav[o + lane] = z[O_NAV + h * 128 + lane]; p.o_nav[o + 64 + lane] = z[O_NAV + h * 128 + 64 + lane];
            }
        }
        {
            const int S = ctx ? SEQ : DS;
#pragma unroll
            for (int i = 0; i < 8; ++i) {
                const int ch = i * 64 + lane;
                const float* cw = p.conv_w + ((size_t)layer * 512 + ch) * 3;
                float acc = z[O_GC + ch] * z[O_U + ch] * cw[1];
                if (s > 0) acc += (z - DIN)[O_GC + ch] * (z - DIN)[O_U + ch] * cw[0];
                if (s < S - 1) acc += (z + DIN)[O_GC + ch] * (z + DIN)[O_U + ch] * cw[2];
                p.mix_b[(size_t)r * D + 1536 + ch] = f2bf(z[O_GB + ch] * acc);
            }
        }
    }
}

DEVI float rope_angle(int pos, int j) {
    const int row = pos / 64, col = pos % 64;
    const int f = j & 15;
    const float inv = powf(10000.f, -(float)f / 16.f);
    return (j < 16 ? (float)row : (float)col) * inv;
}

DEVI void transpose_v(const float* src, size_t sstride, bf16_t* dst, int ldv, float* lds) {
    float (*tl)[129] = (float (*)[129])lds;
    const int tid = tidx();
#pragma unroll
    for (int rep = 0; rep < 4; ++rep) {
        const int row = (tid >> 5) + 16 * rep, c4 = (tid & 31) * 4;
        const float4 v = *(const float4*)(src + (size_t)row * sstride + c4);
        tl[row][c4] = v.x; tl[row][c4 + 1] = v.y; tl[row][c4 + 2] = v.z; tl[row][c4 + 3] = v.w;
    }
    __syncthreads();
    {
        const int d = tid >> 2, k16 = (tid & 3) * 16;
        uint4 o0, o1;
        o0.x = cvtpk(tl[k16 + 0][d], tl[k16 + 1][d]); o0.y = cvtpk(tl[k16 + 2][d], tl[k16 + 3][d]); o0.z = cvtpk(tl[k16 + 4][d], tl[k16 + 5][d]); o0.w = cvtpk(tl[k16 + 6][d], tl[k16 + 7][d]);
        o1.x = cvtpk(tl[k16 + 8][d], tl[k16 + 9][d]); o1.y = cvtpk(tl[k16 + 10][d], tl[k16 + 11][d]); o1.z = cvtpk(tl[k16 + 12][d], tl[k16 + 13][d]); o1.w = cvtpk(tl[k16 + 14][d], tl[k16 + 15][d]);
        bf16_t* o = dst + (size_t)d * ldv + k16;
        *(uint4*)o = o0; *(uint4*)(o + 8) = o1;
    }
    __syncthreads();
}
DEVI void phase_headnorm(CParams& p, int layer, int bid, int nb, float* lds) {
    const int lane = tidx() & 63, w = tidx() >> 6;
    const int nq = T * 8, nk = TKV * 8;
    for (int it = bid * NWAVES + w; it < nq + nk; it += nb * NWAVES) {
        const bool isq = it < nq;
        const int r = isq ? it / 8 : (it - nq) / 8, h = it % 8;
        float v0, v1, v2; const float* g; bf16_t* dst; int pos = -1;
        if (isq) {
            const float* q = p.qm + (size_t)r * 1536 + h * 192;
            v0 = q[lane]; v1 = q[64 + lane]; v2 = q[128 + lane]; g = p.q_head_g + layer * 192; dst = p.q_b + (size_t)r * 1536 + h * 192;
            if (r >= NCTX) pos = (r - NCTX) % DS;
        } else {
            const float* kv = p.kvr + (size_t)r * 2048 + h * 256;
            v0 = kv[lane]; v1 = kv[64 + lane];
            if (r < T) v2 = p.z[(size_t)r * DIN + O_KPE + lane];
            else { const int b = (r - T) / PAST, j = (r - T) % PAST; v2 = p.cache_kpe[(((size_t)b * DEPTH + layer) * PAST + j) * 64 + lane]; }
            g = p.k_head_g + layer * 192; dst = p.k_b + (size_t)r * 1536 + h * 192;
            if (r >= NCTX && r < T) pos = (r - NCTX) % DS;
        }
        const float ss = wave_sum(v0 * v0 + v1 * v1 + v2 * v2);
        const float rr = rsqrtf(ss / 192.f + EPS);
        v0 *= rr * g[lane]; v1 *= rr * g[64 + lane]; v2 *= rr * g[128 + lane];
        if (pos >= 0) {
            const float other = __shfl_xor(v2, 32);
            const float ang = rope_angle(pos, lane & 31);
            const float cs = cosf(ang), sn = sinf(ang);
            v2 = lane < 32 ? v2 * cs - other * sn : other * sn + v2 * cs;
        }
        dst[lane] = f2bf(v0); dst[64 + lane] = f2bf(v1); dst[128 + lane] = f2bf(v2);
    }
    for (int i = bid * NTHREADS + tidx(); i < DB * 4 * PAST * 128 / 4; i += nb * NTHREADS) {
        const int e = i * 4, bh = e / (PAST * 128), rem = e % (PAST * 128), b = bh / 4, h = bh % 4;
        const float4 v = *(const float4*)(p.cache_nak + (((size_t)b * DEPTH + layer) * 4 + h) * PAST * 128 + rem);
        *(uint2*)(p.cnak_b + (size_t)e) = make_uint2(cvtpk(v.x, v.y), cvtpk(v.z, v.w));
    }
    constexpr int N_MLA = (TKV / 64) * 8, N_NA = (T / 64) * 4, N_NC = DB * 4 * (PAST / 64);
    for (int it = bid; it < N_MLA + N_NA + N_NC; it += nb) {
        if (it < N_MLA) {
            const int kt = it / 8, h = it % 8, r0 = kt * 64;
            const float* src = p.kvr + (size_t)r0 * 2048 + h * 256 + 128;
            bf16_t* dst; int ldv;
            if (r0 < NCTX) { const int b = r0 / SEQ; dst = p.vt_mla_ctx + ((size_t)(b * 8 + h) * 128) * SEQ + r0 % SEQ; ldv = SEQ; }
            else if (r0 < T) { const int b = (r0 - NCTX) / DS; dst = p.vt_mla_lat + ((size_t)(b * 8 + h) * 128) * (PAST + DS) + PAST + (r0 - NCTX) % DS; ldv = PAST + DS; }
            else { const int b = (r0 - T) / PAST; dst = p.vt_mla_lat + ((size_t)(b * 8 + h) * 128) * (PAST + DS) + (r0 - T) % PAST; ldv = PAST + DS; }
            transpose_v(src, 2048, dst, ldv, lds);
        } else if (it < N_MLA + N_NA) {
            const int j = it - N_MLA, kt = j / 4, h = j % 4, r0 = kt * 64;
            const float* src = p.z + (size_t)r0 * DIN + O_NAV + h * 128;
            bf16_t* dst; int ldv;
            if (r0 < NCTX) { const int b = r0 / SEQ; dst = p.vt_na_ctx + ((size_t)(b * 4 + h) * 128) * SEQ + r0 % SEQ; ldv = SEQ; }
            else { const int b = (r0 - NCTX) / DS; dst = p.vt_na_lat + ((size_t)(b * 4 + h) * 128) * DS + (r0 - NCTX) % DS; ldv = DS; }
            transpose_v(src, DIN, dst, ldv, lds);
        } else {
            const int j = it - N_MLA - N_NA, bh = j / (PAST / 64), jt = j % (PAST / 64), b = bh / 4, h = bh % 4;
            const float* src = p.cache_nav + ((((size_t)b * DEPTH + layer) * 4 + h) * PAST + jt * 64) * 128;
            transpose_v(src, 128, p.vt_na_cache + ((size_t)(b * 4 + h) * 128) * PAST + jt * 64, PAST, lds);
        }
    }
}

typedef short bf16x8_t __attribute__((ext_vector_type(8)));
typedef float f32x16_t __attribute__((ext_vector_type(16)));
#define MFMA32(a, b, c) __builtin_amdgcn_mfma_f32_32x32x16_bf16((a), (b), (c), 0, 0, 0)
DEVI int crow(int reg, int h) { return (reg & 3) + 8 * (reg >> 2) + 4 * h; }

struct AttnUnit {
    const bf16_t* q; int qstride;
    const bf16_t *k0, *vt0; int ks0, ldv0, nt0;
    const bf16_t *k1, *vt1; int ks1, ldv1, nt1;
    const bf16_t *kl, *vtl; int nloc;
    const float* bias; int qr, c0, rs;
    bf16_t* out;
    float scale;
};

template <int DQ>
DEVI void attn_unit(const AttnUnit& u) {
    const int lane = tidx() & 63, r = lane & 31, h = lane >> 5;
    bf16x8_t qf[DQ / 16];
    {
        const bf16_t* qrow = u.q + (size_t)r * u.qstride + 8 * h;
#pragma unroll
        for (int kk = 0; kk < DQ / 16; ++kk) qf[kk] = *(const bf16x8_t*)(qrow + kk * 16);
    }
    f32x16_t ot[4];
#pragma unroll
    for (int b = 0; b < 4; ++b)
#pragma unroll
        for (int i = 0; i < 16; ++i) ot[b][i] = 0.f;
    float m = -INFINITY, l = 0.f;
    const int ntiles = u.nt0 + u.nt1 + u.nloc;
    for (int t = 0; t < ntiles; ++t) {
        const bf16_t *kp, *vp; int ks, ldv, lrow = -1, lcol = 0;
        if (t < u.nt0) { kp = u.k0 + (size_t)t * 32 * u.ks0; ks = u.ks0; vp = u.vt0 + t * 32; ldv = u.ldv0; }
        else if (t < u.nt0 + u.nt1) { const int tt = t - u.nt0; kp = u.k1 + (size_t)tt * 32 * u.ks1; ks = u.ks1; vp = u.vt1 + tt * 32; ldv = u.ldv1; }
        else { const int tt = t - u.nt0 - u.nt1; lrow = u.rs + (tt >> 1); lcol = (tt & 1) * 32; kp = u.kl + (size_t)(lrow * 64 + lcol) * 512; ks = 512; vp = u.vtl + lrow * 64 + lcol; ldv = DS; }
        f32x16_t st;
#pragma unroll
        for (int i = 0; i < 16; ++i) st[i] = 0.f;
        {
            const bf16_t* krow = kp + (size_t)r * ks + 8 * h;
#pragma unroll
            for (int kk = 0; kk < DQ / 16; ++kk) { const bf16x8_t a = *(const bf16x8_t*)(krow + kk * 16); st = MFMA32(a, qf[kk], st); }
        }
        float sv[16], mx = -INFINITY;
        if (lrow >= 0) {
            const int qc = u.c0 + r, cs = min(max(qc - 8, 0), 48);
            const float* brow = u.bias + (lrow - u.qr + 7) * 31 + (15 - qc);
#pragma unroll
            for (int i = 0; i < 16; ++i) {
                const int kc = lcol + crow(i, h);
                const bool valid = kc >= cs && kc < cs + 16;
                const float bv = valid ? brow[kc] : 0.f;
                sv[i] = valid ? st[i] * u.scale + bv : -INFINITY; mx = fmaxf(mx, sv[i]);
            }
        } else {
#pragma unroll
            for (int i = 0; i < 16; ++i) { sv[i] = st[i] * u.scale; mx = fmaxf(mx, sv[i]); }
        }
        mx = fmaxf(mx, __shfl_xor(mx, 32));
        const float mnew = fmaxf(m, mx), alpha = __expf(m - mnew);
        m = mnew;
        float ls = 0.f;
#pragma unroll
        for (int i = 0; i < 16; ++i) { sv[i] = __expf(sv[i] - mnew); ls += sv[i]; }
        l = l * alpha + ls;
#pragma unroll
        for (int b = 0; b < 4; ++b)
#pragma unroll
            for (int i = 0; i < 16; ++i) ot[b][i] *= alpha;
#pragma unroll
        for (int s2 = 0; s2 < 2; ++s2) {
            uint4 pk; pk.x = cvtpk(sv[8 * s2 + 0], sv[8 * s2 + 1]); pk.y = cvtpk(sv[8 * s2 + 2], sv[8 * s2 + 3]); pk.z = cvtpk(sv[8 * s2 + 4], sv[8 * s2 + 5]); pk.w = cvtpk(sv[8 * s2 + 6], sv[8 * s2 + 7]);
            const bf16x8_t xs = __builtin_bit_cast(bf16x8_t, pk);
#pragma unroll
            for (int b = 0; b < 4; ++b) {
                const bf16_t* vrow = vp + (size_t)(32 * b + r) * ldv + 16 * s2 + 4 * h;
                const uint2 lo = *(const uint2*)vrow, hi = *(const uint2*)(vrow + 8);
                const bf16x8_t pa = __builtin_bit_cast(bf16x8_t, make_uint4(lo.x, lo.y, hi.x, hi.y));
                ot[b] = MFMA32(pa, xs, ot[b]);
            }
        }
    }
    l += __shfl_xor(l, 32);
    const float inv = 1.f / l;
    bf16_t* orow = u.out + (size_t)r * D;
#pragma unroll
    for (int b = 0; b < 4; ++b)
#pragma unroll
        for (int g = 0; g < 4; ++g)
            *(uint2*)(orow + 32 * b + 8 * g + 4 * h) = make_uint2(cvtpk(ot[b][4 * g] * inv, ot[b][4 * g + 1] * inv), cvtpk(ot[b][4 * g + 2] * inv, ot[b][4 * g + 3] * inv));
}

DEVI void attn_dispatch(CParams& p, int layer, int kind, int idx) {
    AttnUnit u;
    u.k1 = nullptr; u.vt1 = nullptr; u.ks1 = 0; u.ldv1 = 0; u.nt1 = 0; u.kl = nullptr; u.vtl = nullptr; u.nloc = 0; u.bias = nullptr; u.qr = 0; u.c0 = 0; u.rs = 0;
    if (kind == 0) {
        const int qt = idx % 32, h = (idx / 32) % 8, b = idx / 256, t0 = NCTX + b * DS + qt * 32;
        u.q = p.q_b + (size_t)t0 * 1536 + h * 192; u.qstride = 1536; u.scale = 0.07216878364870322f;
        u.k0 = p.k_b + (size_t)(T + b * PAST) * 1536 + h * 192; u.ks0 = 1536; u.vt0 = p.vt_mla_lat + ((size_t)(b * 8 + h) * 128) * (PAST + DS); u.ldv0 = PAST + DS; u.nt0 = PAST / 32;
        u.k1 = p.k_b + (size_t)(NCTX + b * DS) * 1536 + h * 192; u.ks1 = 1536; u.vt1 = u.vt0 + PAST; u.ldv1 = PAST + DS; u.nt1 = DS / 32;
        u.out = p.mix_b + (size_t)t0 * D + h * 128;
        attn_unit<192>(u);
    } else if (kind == 1) {
        const int qt = idx % 32, h = (idx / 32) % 4, b = idx / 128, t0 = NCTX + b * DS + qt * 32;
        u.q = p.qna_b + (size_t)t0 * 512 + h * 128; u.qstride = 512; u.scale = 0.08838834764831845f;
        u.k0 = p.cnak_b + ((size_t)(b * 4 + h) * PAST) * 128; u.ks0 = 128; u.vt0 = p.vt_na_cache + ((size_t)(b * 4 + h) * 128) * PAST; u.ldv0 = PAST; u.nt0 = PAST / 32;
        u.kl = p.kna_b + (size_t)(NCTX + b * DS) * 512 + h * 128; u.vtl = p.vt_na_lat + ((size_t)(b * 4 + h) * 128) * DS; u.nloc = 16;
        u.bias = p.rel_bias + ((size_t)layer * 4 + h) * 15 * 31; u.qr = qt >> 1; u.c0 = (qt & 1) * 32; u.rs = min(max(u.qr - 4, 0), 8);
        u.out = p.mix_b + (size_t)t0 * D + 1024 + h * 128;
        attn_unit<128>(u);
    } else if (kind == 2) {
        const int qt = idx % 8, h = (idx / 8) % 8, b = idx / 64, t0 = b * SEQ + qt * 32;
        u.q = p.q_b + (size_t)t0 * 1536 + h * 192; u.qstride = 1536; u.scale = 0.07216878364870322f;
        u.k0 = p.k_b + (size_t)(b * SEQ) * 1536 + h * 192; u.ks0 = 1536; u.vt0 = p.vt_mla_ctx + ((size_t)(b * 8 + h) * 128) * SEQ; u.ldv0 = SEQ; u.nt0 = SEQ / 32;
        u.out = p.mix_b + (size_t)t0 * D + h * 128;
        attn_unit<192>(u);
    } else {
        const int qt = idx % 8, h = (idx / 8) % 4, b = idx / 32, t0 = b * SEQ + qt * 32;
        u.q = p.qna_b + (size_t)t0 * 512 + h * 128; u.qstride = 512; u.scale = 0.08838834764831845f;
        u.k0 = p.kna_b + (size_t)(b * SEQ) * 512 + h * 128; u.ks0 = 512; u.vt0 = p.vt_na_ctx + ((size_t)(b * 4 + h) * 128) * SEQ; u.ldv0 = SEQ; u.nt0 = SEQ / 32;
        u.out = p.mix_b + (size_t)t0 * D + 1024 + h * 128;
        attn_unit<128>(u);
    }
}
DEVI void phase_attn(CParams& p, int layer, int bid, int nb) {
    const int w = __builtin_amdgcn_readfirstlane(tidx() >> 6);
    constexpr int N0 = DB * 8 * (DS / 32), N1 = DB * 4 * (DS / 32), N2 = BATCH * 8 * (SEQ / 32), N3 = BATCH * 4 * (SEQ / 32);
    if (w < 2) {
        for (int it = w * nb + bid; it < N0; it += 2 * nb) attn_dispatch(p, layer, 0, it);
    } else {
        for (int it = (w - 2) * nb + bid; it < N1 + N3 + N2; it += (NWAVES - 2) * nb) {
            if (it < N1) attn_dispatch(p, layer, 1, it);
            else if (it < N1 + N3) attn_dispatch(p, layer, 3, it - N1);
            else attn_dispatch(p, layer, 2, it - N1 - N3);
        }
    }
}

DEVI void phase_route(CParams& p, int bid, int nb) {
    const int lane = tidx() & 63, w = tidx() >> 6;
    for (int it = bid * NWAVES + w; it < T * 8; it += nb * NWAVES) {
        const int t = it / 8, h = it % 8;
        const float* sc = p.sc + (size_t)t * 2048 + h * 256;
        float keepS[2]; int keepI[2];
#pragma unroll
        for (int pp = 0; pp < 2; ++pp) {
            float x0 = sc[pp * 128 + lane], x1 = sc[pp * 128 + 64 + lane];
            float ks = 0.f; int ki = 0;
            for (int r = 0; r < 16; ++r) {
                float bv; int bi;
                if (x0 >= x1) { bv = x0; bi = lane; } else { bv = x1; bi = lane + 64; }
                wave_argmax(bv, bi);
                if (lane == r) { ks = bv; ki = bi; }
                if ((bi & 63) == lane) { if (bi < 64) x0 = -INFINITY; else x1 = -INFINITY; }
            }
            keepS[pp] = ks; keepI[pp] = ki;
        }
        const int a = lane >> 2, b0 = (lane & 3) * 4;
        const float s1a = __shfl(keepS[0], a);
        float c0 = s1a + __shfl(keepS[1], b0 + 0), c1 = s1a + __shfl(keepS[1], b0 + 1), c2 = s1a + __shfl(keepS[1], b0 + 2), c3 = s1a + __shfl(keepS[1], b0 + 3);
        float topS = 0.f; int topE = 0; float mx = 0.f;
        for (int r = 0; r < 16; ++r) {
            float bv = c0; int bi = lane * 4;
            if (c1 > bv) { bv = c1; bi = lane * 4 + 1; }
            if (c2 > bv) { bv = c2; bi = lane * 4 + 2; }
            if (c3 > bv) { bv = c3; bi = lane * 4 + 3; }
            wave_argmax(bv, bi);
            const int e = __shfl(keepI[0], bi >> 4) * 128 + __shfl(keepI[1], bi & 15);
            if (r == 0) mx = bv;
            if (lane == r) { topS = bv; topE = e; }
            if ((bi >> 2) == lane) { const int c = bi & 3; if (c == 0) c0 = -INFINITY; else if (c == 1) c1 = -INFINITY; else if (c == 2) c2 = -INFINITY; else c3 = -INFINITY; }
        }
        float e = lane < 16 ? __expf(topS - mx) : 0.f;
        const float sum = wave_sum(e);
        if (lane < 16) { p.gate[(size_t)t * 128 + h * 16 + lane] = e / sum; p.eidx[(size_t)t * 128 + h * 16 + lane] = topE; }
    }
}

DEVI void phase_experts(CParams& p, int layer, int bid, int nb, float* lds) {
    const int lane = tidx() & 63, w = tidx() >> 6;
    float* wgt = lds + w * 128;
    const float* U = p.peer_u + (size_t)layer * 16384 * D;
    const float* V = p.peer_v + (size_t)layer * 16384 * D;
    for (int t = bid * NWAVES + w; t < T; t += nb * NWAVES) {
        float4 x[8];
#pragma unroll
        for (int i = 0; i < 8; ++i) x[i] = *(const float4*)(p.hn + (size_t)t * D + i * 256 + lane * 4);
        for (int e = 0; e < 128; ++e) {
            const int idx = p.eidx[(size_t)t * 128 + e];
            const float* u = U + (size_t)idx * D;
            float d = 0.f;
#pragma unroll
            for (int i = 0; i < 8; ++i) { float4 uv = *(const float4*)(u + i * 256 + lane * 4); d += uv.x * x[i].x + uv.y * x[i].y + uv.z * x[i].z + uv.w * x[i].w; }
            d = wave_sum(d);
            const float a = 0.5f * d * (1.f + erff(d * 0.70710678118654752f));
            if (lane == 0) wgt[e] = a * p.gate[(size_t)t * 128 + e];
        }
        __builtin_amdgcn_wave_barrier();
        float4 o[8];
#pragma unroll
        for (int i = 0; i < 8; ++i) o[i] = make_float4(0.f, 0.f, 0.f, 0.f);
        for (int e = 0; e < 128; ++e) {
            const int idx = p.eidx[(size_t)t * 128 + e];
            const float* v = V + (size_t)idx * D;
            const float wg = wgt[e];
#pragma unroll
            for (int i = 0; i < 8; ++i) { float4 vv = *(const float4*)(v + i * 256 + lane * 4); o[i].x += wg * vv.x; o[i].y += wg * vv.y; o[i].z += wg * vv.z; o[i].w += wg * vv.w; }
        }
        const float* g2 = p.ada + ((size_t)layer * 3 + cond_of(t)) * 6 * D + 5 * D;
        float* xo = p.out + (size_t)t * D;
#pragma unroll
        for (int i = 0; i < 8; ++i) {
            const int c = i * 256 + lane * 4;
            float4 xv = *(const float4*)(xo + c), gv = *(const float4*)(g2 + c);
            xv.x += gv.x * o[i].x; xv.y += gv.y * o[i].y; xv.z += gv.z * o[i].z; xv.w += gv.w * o[i].w;
            *(float4*)(xo + c) = xv;
        }
    }
}

enum { PH_ADA = 0, PH_NORM1, PH_WIN, PH_POSTZ, PH_UQKV, PH_HEADNORM, PH_ATTN, PH_WOUT, PH_NORM2, PH_WQ, PH_SCORES, PH_ROUTE, PH_EXPERTS, PH_COUNT };

template <int PH>
DEVI void run_phase(CParams& p, int layer, int bid, int nb, float* lds) {
    if constexpr (PH == PH_ADA) { phase_ada(p, bid, nb, lds); phase_weights(p, bid, nb, lds); }
    if constexpr (PH == PH_NORM1) phase_modnorm(p, layer, 0, bid, nb);
    if constexpr (PH == PH_WIN) mfma_gemm(p.hn_b, p.wt_in + (size_t)layer * DINP * D, T, DINP, D, EpiF32{p.z, DIN, DIN}, bid, nb, lds);
    if constexpr (PH == PH_POSTZ) phase_postz(p, layer, bid, nb);
    if constexpr (PH == PH_UQKV) {
        mfma_gemm(p.cqn_b, p.wt_uq + (size_t)layer * 1536 * 512, T, 1536, 512, EpiF32{p.qm, 1536, 1536}, bid, nb, lds);
        mfma_gemm(p.ckv_b, p.wt_ukv + (size_t)layer * 2048 * 256, TKV, 2048, 256, EpiF32{p.kvr, 2048, 2048}, bid, nb, lds);
    }
    if constexpr (PH == PH_HEADNORM) phase_headnorm(p, layer, bid, nb, lds);
    if constexpr (PH == PH_ATTN) phase_attn(p, layer, bid, nb);
    if constexpr (PH == PH_WOUT) mfma_gemm(p.mix_b, p.wt_out + (size_t)layer * D * D, T, D, D, EpiResidMF{&p, layer}, bid, nb, lds);
    if constexpr (PH == PH_NORM2) phase_modnorm(p, layer, 1, bid, nb);
    if constexpr (PH == PH_WQ) mfma_gemm(p.hn_b, p.wt_q + (size_t)layer * D * D, T, D, D, EpiF32{p.qp, D, D}, bid, nb, lds);
    if constexpr (PH == PH_SCORES) {
        for (int hp = 0; hp < 16; ++hp)
            gemm_f32<true>(p.qp + hp * 128, D, p.sub_keys + ((size_t)layer * 16 + hp) * 128 * 128, 128, T, 128, 128, EpiStore{p.sc + hp * 128, D}, bid, nb, lds);
    }
    if constexpr (PH == PH_ROUTE) phase_route(p, bid, nb);
    if constexpr (PH == PH_EXPERTS) phase_experts(p, layer, bid, nb, lds);
}

#ifndef MK_ONE_LAUNCH
#define MK_ONE_LAUNCH 1
#endif
constexpr size_t LDS_BYTES = LDS_TOTAL;

#if MK_ONE_LAUNCH
#define PHASE(PH, l) do { CParams* q_ = pp; asm volatile("" : "+s"(q_)); run_phase<PH>(*q_, l, (int)blockIdx.x, (int)gridDim.x, lds); xcd_barrier(bar); } while (0)
__global__ void __launch_bounds__(NTHREADS, 2) k_fwd(Params p_unused) {
    CParams* pp = (CParams*)__builtin_amdgcn_kernarg_segment_ptr();
    extern __shared__ __attribute__((aligned(16))) unsigned char lds_raw[];
    float* lds = (float*)lds_raw;
    if (threadIdx.x == 0) *(uint4*)(lds_raw + MISC_OFF) = make_uint4(0u, 0u, 0u, 0u);
    __syncthreads();
    XcdBarrier bar = xcd_barrier_post(pp->bar, (volatile LAS unsigned*)(lds_raw + MISC_OFF));
    PHASE(PH_ADA, 0);
    for (int l = 0; l < DEPTH; ++l) {
        PHASE(PH_NORM1, l);
        PHASE(PH_WIN, l);
        PHASE(PH_POSTZ, l);
        PHASE(PH_UQKV, l);
        PHASE(PH_HEADNORM, l);
        PHASE(PH_ATTN, l);
        PHASE(PH_WOUT, l);
        PHASE(PH_NORM2, l);
        PHASE(PH_WQ, l);
        PHASE(PH_SCORES, l);
        PHASE(PH_ROUTE, l);
        PHASE(PH_EXPERTS, l);
    }
}
#else
template <int PH>
__global__ void __launch_bounds__(NTHREADS, 4) k_phase(Params p, int layer) {
    extern __shared__ float4 lds4[];
    CParams* pp = (CParams*)__builtin_amdgcn_kernarg_segment_ptr();
    run_phase<PH>(*pp, layer, blockIdx.x, gridDim.x, (float*)lds4);
}
template <int PH>
void launch_phase(const Params& p, int layer, hipStream_t stream) {
    hipLaunchKernelGGL(k_phase<PH>, dim3(1024), dim3(NTHREADS), LDS_BYTES, stream, p, layer);
}
#endif

}

extern "C" void kernel_launch(void* const* d_in, const int* in_sizes, int n_in, void* d_out, int out_size, void* d_ws, size_t ws_size, hipStream_t stream) {
    Params p{};
    const float* const* in = (const float* const*)d_in;
    p.x_prompt = in[0]; p.x_sample = in[1]; p.cache_ckv = in[2]; p.cache_kpe = in[3]; p.cache_nak = in[4]; p.cache_nav = in[5]; p.c = in[6]; p.c_ctx = in[7];
    p.ada_w = in[8]; p.ada_b = in[9]; p.norm_mix_g = in[10]; p.norm_ffn_g = in[11]; p.w_in = in[12]; p.q_norm_g = in[13]; p.w_uq = in[14]; p.kv_norm_g = in[15]; p.w_ukv = in[16];
    p.q_head_g = in[17]; p.k_head_g = in[18]; p.naq_g = in[19]; p.nak_g = in[20]; p.rel_bias = in[21]; p.conv_w = in[22]; p.w_out = in[23]; p.peer_wq = in[24]; p.sub_keys = in[25];
    p.peer_u = in[26]; p.peer_v = in[27];
    float* out = (float*)d_out;
    p.out = out;
    p.o_ckv = out + (size_t)T * D;
    p.o_kpe = p.o_ckv + (size_t)BATCH * DEPTH * SEQ * 256;
    p.o_nak = p.o_kpe + (size_t)BATCH * DEPTH * SEQ * 64;
    p.o_nav = p.o_nak + (size_t)BATCH * DEPTH * 4 * SEQ * 128;
    char* ws = (char*)d_ws; size_t off = 0;
    auto carve = [&](size_t bytes) { void* r = ws + off; off += (bytes + 255) & ~(size_t)255; return r; };
    p.bar = (unsigned*)carve(16384);
    p.ada = (float*)carve((size_t)DEPTH * 3 * 6 * D * 4);
    p.hn = (float*)carve((size_t)T * D * 4);
    p.z = (float*)carve((size_t)(T + 1) * DIN * 4);
    p.cqn = (float*)carve((size_t)T * 512 * 4);
    p.ckv = (float*)carve((size_t)TKV * 256 * 4);
    p.qm = (float*)carve((size_t)T * 1536 * 4);
    p.kvr = (float*)carve((size_t)TKV * 2048 * 4);
    p.km = (float*)carve((size_t)TKV * 1536 * 4);
    p.qna = (float*)carve((size_t)T * 512 * 4);
    p.kna = (float*)carve((size_t)T * 512 * 4);
    p.mix = (float*)carve((size_t)T * D * 4);
    p.qp = (float*)carve((size_t)T * D * 4);
    p.sc = (float*)carve((size_t)T * D * 4);
    p.gate = (float*)carve((size_t)T * 128 * 4);
    p.eidx = (int*)carve((size_t)T * 128 * 4);
    p.wt_in = (bf16_t*)carve((size_t)DEPTH * DINP * D * 2);
    p.wt_uq = (bf16_t*)carve((size_t)DEPTH * 1536 * 512 * 2);
    p.wt_ukv = (bf16_t*)carve((size_t)DEPTH * 2048 * 256 * 2);
    p.wt_out = (bf16_t*)carve((size_t)DEPTH * D * D * 2);
    p.wt_q = (bf16_t*)carve((size_t)DEPTH * D * D * 2);
    p.hn_b = (bf16_t*)carve((size_t)T * D * 2);
    p.cqn_b = (bf16_t*)carve((size_t)T * 512 * 2);
    p.ckv_b = (bf16_t*)carve((size_t)TKV * 256 * 2);
    p.mix_b = (bf16_t*)carve((size_t)T * D * 2);
    p.q_b = (bf16_t*)carve((size_t)T * 1536 * 2);
    p.k_b = (bf16_t*)carve((size_t)TKV * 1536 * 2);
    p.qna_b = (bf16_t*)carve((size_t)T * 512 * 2);
    p.kna_b = (bf16_t*)carve((size_t)T * 512 * 2);
    p.cnak_b = (bf16_t*)carve((size_t)DB * 4 * PAST * 128 * 2);
    p.vt_mla_ctx = (bf16_t*)carve((size_t)BATCH * 8 * 128 * SEQ * 2);
    p.vt_mla_lat = (bf16_t*)carve((size_t)DB * 8 * 128 * (PAST + DS) * 2);
    p.vt_na_ctx = (bf16_t*)carve((size_t)BATCH * 4 * 128 * SEQ * 2);
    p.vt_na_lat = (bf16_t*)carve((size_t)DB * 4 * 128 * DS * 2);
    p.vt_na_cache = (bf16_t*)carve((size_t)DB * 4 * 128 * PAST * 2);

#if MK_ONE_LAUNCH
    static int grid = 0;
    if (!grid) {
        int dev = 0, cus = 0, per_cu = 0;
        hipGetDevice(&dev);
        hipDeviceGetAttribute(&cus, hipDeviceAttributeMultiprocessorCount, dev);
        hipFuncSetAttribute((const void*)k_fwd, hipFuncAttributeMaxDynamicSharedMemorySize, (int)LDS_BYTES);
        hipOccupancyMaxActiveBlocksPerMultiprocessor(&per_cu, k_fwd, NTHREADS, LDS_BYTES);
        if (per_cu < 1) per_cu = 1;
        grid = cus * (per_cu < 1 ? per_cu : 1);
    }
    hipMemsetAsync(p.bar, 0, XCD_BAR_WORDS * sizeof(unsigned), stream);
    hipLaunchKernelGGL(k_fwd, dim3(grid), dim3(NTHREADS), LDS_BYTES, stream, p);
#else
    launch_phase<PH_ADA>(p, 0, stream);
    for (int l = 0; l < DEPTH; ++l) {
        launch_phase<PH_NORM1>(p, l, stream);
        launch_phase<PH_WIN>(p, l, stream);
        launch_phase<PH_POSTZ>(p, l, stream);
        launch_phase<PH_UQKV>(p, l, stream);
        launch_phase<PH_HEADNORM>(p, l, stream);
        launch_phase<PH_ATTN>(p, l, stream);
        launch_phase<PH_WOUT>(p, l, stream);
        launch_phase<PH_NORM2>(p, l, stream);
        launch_phase<PH_WQ>(p, l, stream);
        launch_phase<PH_SCORES>(p, l, stream);
        launch_phase<PH_ROUTE>(p, l, stream);
        launch_phase<PH_EXPERTS>(p, l, stream);
    }
#endif
}
```

```cpp
#include <hip/hip_runtime.h>
#include <stdint.h>

#define DEVI __device__ __forceinline__

#define XB_TMO      128
#define XB_XCNT(j)  (256  + 64 * (j))
#define XB_XSUB(j)  (1280 + 64 * (j))
#define XB_XGEN(j)  (2304 + 64 * (j))
#define XB_TOP      3328
#define XB_TOPGEN   3392
#define XCD_BAR_WORDS 3456
#define XB_SPIN_CAP (1u << 18)
#define LAS __attribute__((address_space(3)))

__device__ __forceinline__ unsigned xb_ld(unsigned* p)              { return __hip_atomic_load(p, __ATOMIC_RELAXED, __HIP_MEMORY_SCOPE_AGENT); }
__device__ __forceinline__ unsigned xb_add(unsigned* p, unsigned v) { return __hip_atomic_fetch_add(p, v, __ATOMIC_RELAXED, __HIP_MEMORY_SCOPE_AGENT); }
__device__ __forceinline__ unsigned xb_xcc_id() { return (unsigned)__builtin_amdgcn_s_getreg((3 << 11) | 20) & 0xFu; }
#define XB_SPIN(cond, bar) do { unsigned _sp = 0; while (cond) { __builtin_amdgcn_s_sleep(1); \
    if ((++_sp & 255u) == 0u) { if (xb_ld(&(bar)[XB_TMO])) break; if (_sp > XB_SPIN_CAP) { atomicAdd(&(bar)[XB_TMO], 1u); break; } } } } while (0)

struct XcdBarrier {
    unsigned* bar; unsigned x;
    volatile LAS unsigned* st;
};

__device__ __forceinline__ XcdBarrier xcd_barrier_post(unsigned* bar, volatile LAS unsigned* st) {
    XcdBarrier b; b.bar = bar; b.x = xb_xcc_id(); b.st = st;
    if (threadIdx.x == 0) (void)xb_add(&bar[XB_XCNT(b.x)], 1u);
    return b;
}
__device__ __forceinline__ void xcd_barrier_complete(unsigned* bar, unsigned x, unsigned& nloc, unsigned& nx) {
    const unsigned G = gridDim.x * gridDim.y * gridDim.z;
    unsigned sum, cnt, mine, sp = 0u;
    for (;;) {
        sum = 0u; cnt = 0u; mine = 0u;
#pragma unroll
        for (unsigned j = 0; j < 16; ++j) { const unsigned c = xb_ld(&bar[XB_XCNT(j)]); sum += c; cnt += (c > 0u) ? 1u : 0u; mine = (j == x) ? c : mine; }
        if (sum == G) break;
        __builtin_amdgcn_s_sleep(1);
        if ((++sp & 255u) == 0u) { if (xb_ld(&bar[XB_TMO])) break; if (sp > XB_SPIN_CAP) { atomicAdd(&bar[XB_TMO], 1u); break; } }
    }
    nloc = mine > 0u ? mine : 1u; nx = cnt > 0u ? cnt : 1u;
}

__device__ __forceinline__ void xcd_barrier(const XcdBarrier& b) {
    asm volatile("s_waitcnt vmcnt(0)" ::: "memory");
    __syncthreads();
    if (threadIdx.x == 0) {
        unsigned* bar = b.bar;
        __builtin_amdgcn_s_waitcnt(0);
        unsigned nloc = b.st[0], nx = b.st[1];
        if (nloc == 0u) { xcd_barrier_complete(bar, b.x, nloc, nx); b.st[0] = nloc; b.st[1] = nx; }
        const unsigned old = xb_add(&bar[XB_XSUB(b.x)], 1u);
        const unsigned gen = old / nloc;
        if (old + 1u == (gen + 1u) * nloc) {
            __builtin_amdgcn_fence(__ATOMIC_RELEASE, "agent");
            asm volatile("s_waitcnt vmcnt(0)" ::: "memory");
            const unsigned og = xb_add(&bar[XB_TOP], 1u);
            const unsigned tg = og / nx;
            if (og + 1u == (tg + 1u) * nx) xb_add(&bar[XB_TOPGEN], 1u);
            else XB_SPIN(xb_ld(&bar[XB_TOPGEN]) == tg, bar);
            __builtin_amdgcn_fence(__ATOMIC_ACQUIRE, "agent");
            xb_add(&bar[XB_XGEN(b.x)], 1u);
            asm volatile("s_waitcnt vmcnt(0)" ::: "memory");
        } else {
            XB_SPIN(xb_ld(&bar[XB_XGEN(b.x)]) == gen, bar);
            __builtin_amdgcn_fence(__ATOMIC_ACQUIRE, "agent");
            asm volatile("s_waitcnt vmcnt(0)" ::: "memory");
        }
    }
    __syncthreads();
}


namespace pg8 {
#define PG8_LAS __attribute__((address_space(3)))
typedef unsigned short bf16_t;
typedef short bf16x8 __attribute__((ext_vector_type(8)));
typedef float f32x4 __attribute__((ext_vector_type(4)));
typedef unsigned u32x4 __attribute__((ext_vector_type(4)));
constexpr int BM = 256, BK = 64, HALF = 128, HTB = HALF * BK * 2  , STAGE_BYTES = 8 * HTB, NXCD = 8, WGM = 8;

__host__ __device__ __forceinline__ int lds_byte(int r, int c) { const int st = (r >> 4) * 2 + (c >> 5), rr = r & 15, cc = c & 31, ob = rr * 64 + cc * 2; return st * 1024 + (ob ^ (((ob >> 9) & 1) << 5)); }
__host__ __device__ __forceinline__ void stage_rc(int b, int& R, int& C) { const int st = b / 1024, sb = b % 1024, swz = sb ^ (((sb >> 9) & 1) << 5); R = (st >> 1) * 16 + swz / 64; C = (st & 1) * 32 + (swz % 64) / 2; }
__host__ __device__ __forceinline__ int perm32(int rho) { const int n = rho >> 4, i = rho & 15; return 8 * (i >> 2) + 4 * n + (i & 3); }

struct Unit { int pm, pn; };
struct Gemm { const bf16_t* A; const bf16_t* Bt; int M, N, K; };

struct StaticOrder {
    int nM, nN, nwg, G, c;
    __host__ __device__ void init(int M, int N, int G_, int c_) { nM = M / BM; nN = N / BM; nwg = nM * nN; G = G_; c = c_; }
    __host__ __device__ bool next(int i, Unit& u) const {
        const long L = (long)i * G + c; if (L >= nwg) return false;
        int wgid = (int)L; { const int q = nwg / NXCD, r = nwg % NXCD, xcd = wgid % NXCD, off = wgid / NXCD; wgid = (xcd < r ? xcd * (q + 1) : r * (q + 1) + (xcd - r) * q) + off; }
        const int nig = WGM * nN, gid = wgid / nig, fm = gid * WGM, gsz = (nM - fm) < WGM ? (nM - fm) : WGM;
        u.pm = fm + ((wgid % nig) % gsz); u.pn = (wgid % nig) / gsz; return true;
    }
    __device__ __forceinline__ void a_ready(const Unit&) const {}
    __device__ __forceinline__ void done(const Unit&) const {}
};

__device__ __forceinline__ unsigned cvt_pk_bf16(float lo, float hi) { unsigned r; asm volatile("v_cvt_pk_bf16_f32 %0, %1, %2" : "=v"(r) : "v"(lo), "v"(hi)); return r; }
typedef float f32x2 __attribute__((ext_vector_type(2)));
template <class Epi, class Sched, bool ALIGN_EPI = false, bool SP2 = false>
__device__ __forceinline__ void gemm_phase(PG8_LAS unsigned char* lds, const Gemm g, const Sched& S, const Epi& E) {
    int tid = threadIdx.x; asm volatile("" : "+v"(tid));
    const int wid = __builtin_amdgcn_readfirstlane(tid >> 6), lane = tid & 63, wr = wid >> 2, wc = wid & 3, fr = lane & 15, fq = lane >> 4;
    const int K = g.K, nt = K / BK;
    unsigned voffA[2], voffB[2];
#pragma unroll
    for (int i = 0; i < 2; ++i) { int R, C; stage_rc(tid * 16 + i * 8192, R, C); const int Rb = Epi::PERM ? ((R & ~31) + perm32(R & 31)) : R;
        voffA[i] = (unsigned)(R * K + C) * 2u; voffB[i] = (unsigned)(Rb * K + C) * 2u; }
    const size_t kstep = (size_t)(BK * 2);
    const size_t hstep = (size_t)HALF * K * 2;
    const size_t tstep = 2 * hstep;
    const unsigned ldsw = (unsigned)wid * 1024u;
    const int aoff = lds_byte(wr * 64 + fr, fq * 8), boff = lds_byte(wc * 32 + fr, fq * 8);
#define PG8_SA(b, h) (((b) * 2 + (h)) * HTB)
#define PG8_SB(b, h) ((4 + (b) * 2 + (h)) * HTB)
#define PG8_STAGE(bufoff, gbase, voff) do { _Pragma("unroll") for (int _i = 0; _i < 2; ++_i) \
        __builtin_amdgcn_global_load_lds((const unsigned*)((const char*)(gbase) + (voff)[_i]), (PG8_LAS unsigned*)(lds + (bufoff) + ldsw + _i * 8192), 16, 0, 0); } while (0)
#define PG8_LDA(dst, b, h) do { _Pragma("unroll") for (int m = 0; m < 4; ++m) _Pragma("unroll") for (int k = 0; k < 2; ++k) dst[m][k] = *(const PG8_LAS bf16x8*)(lds + PG8_SA(b, h) + aoff + m * 2048 + k * 1024); } while (0)
#define PG8_LDB(dst, b, h) do { _Pragma("unroll") for (int n = 0; n < 2; ++n) _Pragma("unroll") for (int k = 0; k < 2; ++k) dst[n][k] = *(const PG8_LAS bf16x8*)(lds + PG8_SB(b, h) + boff + n * 2048 + k * 1024); } while (0)
#define PG8_MMA(ai, bj, At, Bt) do { __builtin_amdgcn_s_setprio(1); _Pragma("unroll") for (int m = 0; m < 4; ++m) _Pragma("unroll") for (int n = 0; n < 2; ++n) _Pragma("unroll") for (int k = 0; k < 2; ++k) \
        acc[ai][bj][m][n] = __builtin_amdgcn_mfma_f32_16x16x32_bf16(Bt[n][k], At[m][k], acc[ai][bj][m][n], 0, 0, 0); __builtin_amdgcn_s_setprio(0); } while (0)
#define PG8_WAIT_V(n) asm volatile("s_waitcnt vmcnt(" #n ")" ::: "memory")
#define PG8_WAIT_L(n) asm volatile("s_waitcnt lgkmcnt(" #n ")" ::: "memory")
#define PG8_BAR __builtin_amdgcn_s_barrier()
#define PG8_SCHED __builtin_amdgcn_sched_barrier(0)
    Unit cur, nxt; int ui = 0;
    if (!S.next(0, cur)) return;
    f32x4 acc[2][2][4][2];
#pragma unroll
    for (int a = 0; a < 2; ++a)
#pragma unroll
        for (int b = 0; b < 2; ++b)
#pragma unroll
            for (int m = 0; m < 4; ++m)
#pragma unroll
                for (int n = 0; n < 2; ++n) acc[a][b][m][n] = (f32x4){0.f, 0.f, 0.f, 0.f};
    bf16x8 At[4][2], B0[2][2], B1[2][2];
    const char* cA = (const char*)g.A + (size_t)cur.pm * tstep; const char* cB = (const char*)g.Bt + (size_t)cur.pn * tstep;
    S.a_ready(cur);
    if constexpr (SP2) {
        PG8_STAGE(PG8_SB(0, 0), cB, voffB); PG8_STAGE(PG8_SB(0, 1), cB + hstep, voffB); PG8_STAGE(PG8_SA(0, 0), cA, voffA); PG8_STAGE(PG8_SA(0, 1), cA + hstep, voffA);
        if (wr == 1) PG8_BAR;
        PG8_WAIT_V(2); PG8_BAR;
        PG8_STAGE(PG8_SB(1, 0), cB + kstep, voffB); PG8_STAGE(PG8_SA(1, 0), cA + kstep, voffA); PG8_STAGE(PG8_SB(1, 1), cB + hstep + kstep, voffB);
        PG8_WAIT_V(6); PG8_BAR;
    } else {
        PG8_STAGE(PG8_SB(0, 0), cB, voffB); PG8_STAGE(PG8_SA(0, 0), cA, voffA); PG8_STAGE(PG8_SB(0, 1), cB + hstep, voffB); PG8_STAGE(PG8_SA(0, 1), cA + hstep, voffA);
        if (wr == 1) PG8_BAR;
        PG8_WAIT_V(4); PG8_BAR;
        PG8_STAGE(PG8_SB(1, 0), cB + kstep, voffB); PG8_STAGE(PG8_SA(1, 0), cA + kstep, voffA); PG8_STAGE(PG8_SB(1, 1), cB + hstep + kstep, voffB);
        PG8_WAIT_V(6); PG8_BAR;
    }
    for (;;) {
        const bool has_next = S.next(ui + 1, nxt);
        const char* nA = has_next ? (const char*)g.A + (size_t)nxt.pm * tstep : cA; const char* nB = has_next ? (const char*)g.Bt + (size_t)nxt.pn * tstep : cB;
        for (int t = 0; t < nt; t += 2) {
            const bool last = (t == nt - 2);
            const char* a1 = cA + (size_t)(t + 1) * kstep;
            const char* a2 = last ? nA : cA + (size_t)(t + 2) * kstep; const char* b2 = last ? nB : cB + (size_t)(t + 2) * kstep;
            const char* a3 = a2 + kstep; const char* b3 = b2 + kstep;
            if (last && has_next) S.a_ready(nxt);
            if constexpr (SP2) {
            PG8_LDB(B0, 0, 0); PG8_LDB(B1, 0, 1); PG8_SCHED; PG8_LDA(At, 0, 0); PG8_STAGE(PG8_SA(1, 1), a1 + hstep, voffA);
            PG8_WAIT_V(8); PG8_WAIT_L(0); PG8_BAR; PG8_MMA(0, 0, At, B0); PG8_MMA(0, 1, At, B1); PG8_BAR; PG8_SCHED;
            PG8_LDA(At, 0, 1); PG8_STAGE(PG8_SB(0, 0), b2, voffB); PG8_STAGE(PG8_SB(0, 1), b2 + hstep, voffB); PG8_STAGE(PG8_SA(0, 0), a2, voffA);
            PG8_WAIT_V(8); PG8_WAIT_L(0); PG8_BAR; PG8_MMA(1, 0, At, B0); PG8_MMA(1, 1, At, B1); PG8_BAR; PG8_SCHED;
            PG8_LDB(B0, 1, 0); PG8_LDB(B1, 1, 1); PG8_SCHED; PG8_LDA(At, 1, 0); PG8_STAGE(PG8_SA(0, 1), a2 + hstep, voffA);
            PG8_WAIT_V(8); PG8_WAIT_L(0); PG8_BAR; PG8_MMA(0, 0, At, B0); PG8_MMA(0, 1, At, B1); PG8_BAR; PG8_SCHED;
            PG8_LDA(At, 1, 1); PG8_STAGE(PG8_SB(1, 0), b3, voffB); PG8_STAGE(PG8_SB(1, 1), b3 + hstep, voffB); PG8_STAGE(PG8_SA(1, 0), a3, voffA);
            PG8_WAIT_V(8); PG8_WAIT_L(0); PG8_BAR; PG8_MMA(1, 0, At, B0); PG8_MMA(1, 1, At, B1); PG8_BAR; PG8_SCHED;
            } else {
            PG8_LDB(B0, 0, 0); PG8_SCHED; PG8_LDA(At, 0, 0); PG8_STAGE(PG8_SA(1, 1), a1 + hstep, voffA);
            PG8_WAIT_L(8); PG8_BAR; PG8_WAIT_L(0); PG8_MMA(0, 0, At, B0); PG8_BAR; PG8_SCHED;
            PG8_LDB(B1, 0, 1); PG8_STAGE(PG8_SB(0, 0), b2, voffB);
            PG8_BAR; PG8_WAIT_L(0); PG8_MMA(0, 1, At, B1); PG8_BAR;
            PG8_LDA(At, 0, 1); PG8_STAGE(PG8_SA(0, 0), a2, voffA);
            PG8_BAR; PG8_WAIT_L(0); PG8_MMA(1, 0, At, B0); PG8_BAR; PG8_SCHED;
            PG8_STAGE(PG8_SB(0, 1), b2 + hstep, voffB);
            PG8_WAIT_V(6); PG8_BAR; PG8_MMA(1, 1, At, B1); PG8_BAR;
            PG8_LDB(B0, 1, 0); PG8_SCHED; PG8_LDA(At, 1, 0); PG8_STAGE(PG8_SA(0, 1), a2 + hstep, voffA);
            PG8_WAIT_L(8); PG8_BAR; PG8_WAIT_L(0); PG8_MMA(0, 0, At, B0); PG8_BAR; PG8_SCHED;
            PG8_LDB(B1, 1, 1); PG8_STAGE(PG8_SB(1, 0), b3, voffB);
            PG8_BAR; PG8_WAIT_L(0); PG8_MMA(0, 1, At, B1); PG8_BAR;
            PG8_LDA(At, 1, 1); PG8_STAGE(PG8_SA(1, 0), a3, voffA);
            PG8_BAR; PG8_WAIT_L(0); PG8_MMA(1, 0, At, B0); PG8_BAR; PG8_SCHED;
            PG8_STAGE(PG8_SB(1, 1), b3 + hstep, voffB);
            PG8_WAIT_V(6); PG8_BAR; PG8_MMA(1, 1, At, B1); PG8_BAR;
            }
        }
        if constexpr (ALIGN_EPI) { if (wr == 0) PG8_BAR; }
        if constexpr (!Epi::AFTER_DRAIN) { E(acc, cur, wr, wc, fr, fq); S.done(cur); }
        if (!has_next) break;
#pragma unroll
        for (int a = 0; a < 2; ++a)
#pragma unroll
            for (int b = 0; b < 2; ++b)
#pragma unroll
                for (int m = 0; m < 4; ++m)
#pragma unroll
                    for (int n = 0; n < 2; ++n) acc[a][b][m][n] = (f32x4){0.f, 0.f, 0.f, 0.f};
        cur = nxt; cA = nA; cB = nB; ++ui;
        if constexpr (ALIGN_EPI) { if (wr == 1) PG8_BAR; }
    }
    PG8_WAIT_V(0);
    if constexpr (!ALIGN_EPI) { if (wr == 0) PG8_BAR; }
    PG8_BAR;
    if constexpr (Epi::AFTER_DRAIN) { E.fused(acc, cur, wr, wc, fr, fq, lds, wid, lane); S.done(cur); }
#undef PG8_SA
#undef PG8_SB
#undef PG8_STAGE
#undef PG8_LDA
#undef PG8_LDB
#undef PG8_MMA
#undef PG8_WAIT_V
#undef PG8_WAIT_L
#undef PG8_BAR
#undef PG8_SCHED
}
}


namespace {

constexpr int D = 2048, BATCH = 32, SEQ = 256, DEPTH = 4, DB = 2, DS = 1024, PAST = 512;
constexpr int NCTX = BATCH * SEQ, NLAT = DB * DS, T = NCTX + NLAT, TKV = T + DB * PAST;
constexpr int DIN = 3904, DINP = 4096;
constexpr int RING_OFF = 0, MISC_OFF = 131072, LDS_TOTAL = 147456;
typedef unsigned short bf16_t;
constexpr int O_CQ = 0, O_CKV = 512, O_KPE = 768, O_NAQ = 832, O_NAK = 1344, O_NAV = 1856, O_GB = 2368, O_GC = 2880, O_U = 3392;
constexpr float EPS = 1e-6f;
constexpr int NTHREADS = 512, NWAVES = NTHREADS / 64;

struct Params {
    const float *x_prompt, *x_sample, *cache_ckv, *cache_kpe, *cache_nak, *cache_nav, *c, *c_ctx;
    const float *ada_w, *ada_b, *norm_mix_g, *norm_ffn_g, *w_in, *q_norm_g, *w_uq, *kv_norm_g, *w_ukv;
    const float *q_head_g, *k_head_g, *naq_g, *nak_g, *rel_bias, *conv_w, *w_out, *peer_wq, *sub_keys, *peer_u, *peer_v;
    float* out;
    float *o_ckv, *o_kpe, *o_nak, *o_nav;
    unsigned* bar;
    float *ada, *hn, *z, *cqn, *ckv, *qm, *kvr, *km, *qna, *kna, *mix, *qp, *sc, *gate;
    int* eidx;
    unsigned short *wt_in, *wt_uq, *wt_ukv, *wt_out, *wt_q;
    unsigned short *hn_b, *cqn_b, *ckv_b, *mix_b;
    unsigned short *pu_b, *pv_b;
    unsigned short *q_b, *k_b, *qna_b, *kna_b, *cnak_b;
    unsigned short *vt_mla_ctx, *vt_mla_lat, *vt_na_ctx, *vt_na_lat, *vt_na_cache;
};

typedef const __attribute__((address_space(4))) Params CParams;

DEVI int tidx() { int t = threadIdx.x; asm volatile("" : "+v"(t)); return t; }
DEVI float wave_sum(float v) {
#pragma unroll
    for (int o = 32; o > 0; o >>= 1) v += __shfl_xor(v, o);
    return v;
}
DEVI float wave_max(float v) {
#pragma unroll
    for (int o = 32; o > 0; o >>= 1) v = fmaxf(v, __shfl_xor(v, o));
    return v;
}
DEVI void wave_argmax(float& v, int& idx) {
#pragma unroll
    for (int o = 32; o > 0; o >>= 1) {
        float ov = __shfl_xor(v, o); int oi = __shfl_xor(idx, o);
        if (ov > v || (ov == v && oi < idx)) { v = ov; idx = oi; }
    }
}
typedef float f32x2_t __attribute__((ext_vector_type(2))); typedef __bf16 bf16x2_t __attribute__((ext_vector_type(2)));
DEVI unsigned cvtpk(float lo, float hi) { f32x2_t v = {lo, hi}; bf16x2_t b = __builtin_convertvector(v, bf16x2_t); return __builtin_bit_cast(unsigned, b); }
DEVI bf16_t f2bf(float v) { return (bf16_t)(cvtpk(v, 0.f) & 0xffffu); }
DEVI int cond_of(int t) { return t < NCTX ? 2 : (t - NCTX) / DS; }
DEVI const float* xrow(CParams& p, int layer, int t) {
    if (layer == 0) return t < NCTX ? p.x_prompt + (size_t)t * D : p.x_sample + (size_t)(t - NCTX) * D;
    return p.out + (size_t)t * D;
}

DEVI void phase_ada(CParams& p, int bid, int nb, float* lds) {
    float* sv = lds;
    float* red = lds + 3 * D;
    const int tid = tidx(), lane = tid & 63, w = tid >> 6;
    for (int i = tid; i < 3 * D; i += NTHREADS) {
        int j = i / D, k = i % D;
        float v = j < 2 ? p.c[j * D + k] : p.c_ctx[k];
        sv[i] = v / (1.f + __expf(-v));
    }
    __syncthreads();
    const int nitems = DEPTH * (6 * D / 64);
    for (int it = bid; it < nitems; it += nb) {
        const int l = it / (6 * D / 64), n = (it % (6 * D / 64)) * 64 + lane;
        const float* W = p.ada_w + (size_t)l * D * 6 * D + n;
        float a0 = 0.f, a1 = 0.f, a2 = 0.f;
        const int k0 = w * (D / NWAVES);
#pragma unroll 8
        for (int k = k0; k < k0 + D / NWAVES; ++k) {
            float wv = W[(size_t)k * 6 * D];
            a0 += sv[k] * wv; a1 += sv[D + k] * wv; a2 += sv[2 * D + k] * wv;
        }
        red[(w * 3 + 0) * 64 + lane] = a0; red[(w * 3 + 1) * 64 + lane] = a1; red[(w * 3 + 2) * 64 + lane] = a2;
        __syncthreads();
        if (tid < 192) {
            int j = tid / 64, ln = tid % 64;
            float s = 0.f;
            for (int ww = 0; ww < NWAVES; ++ww) s += red[(ww * 3 + j) * 64 + ln];
            int nn = (it % (6 * D / 64)) * 64 + ln;
            p.ada[((size_t)l * 3 + j) * 6 * D + nn] = s + p.ada_b[(size_t)l * 6 * D + nn];
        }
        __syncthreads();
    }
}

DEVI void phase_modnorm(CParams& p, int layer, int which, int bid, int nb) {
    const int lane = tidx() & 63, w = tidx() >> 6;
    const float* g = (which == 0 ? p.norm_mix_g : p.norm_ffn_g) + (size_t)layer * D;
    for (int t = bid * NWAVES + w; t < T; t += nb * NWAVES) {
        const float* x = which == 0 ? xrow(p, layer, t) : p.out + (size_t)t * D;
        const float* ad = p.ada + ((size_t)layer * 3 + cond_of(t)) * 6 * D + (which == 0 ? 0 : 3 * D);
        float4 v[8]; float ss = 0.f;
#pragma unroll
        for (int i = 0; i < 8; ++i) { v[i] = *(const float4*)(x + i * 256 + lane * 4); ss += v[i].x * v[i].x + v[i].y * v[i].y + v[i].z * v[i].z + v[i].w * v[i].w; }
        ss = wave_sum(ss);
        const float r = rsqrtf(ss / D + EPS);
#pragma unroll
        for (int i = 0; i < 8; ++i) {
            const int c = i * 256 + lane * 4;
            float4 gg = *(const float4*)(g + c), sh = *(const float4*)(ad + c), sc = *(const float4*)(ad + D + c), o;
            o.x = v[i].x * r * gg.x * (1.f + sc.x) + sh.x; o.y = v[i].y * r * gg.y * (1.f + sc.y) + sh.y;
            o.z = v[i].z * r * gg.z * (1.f + sc.z) + sh.z; o.w = v[i].w * r * gg.w * (1.f + sc.w) + sh.w;
            *(uint2*)(p.hn_b + (size_t)t * D + c) = make_uint2(pg8::cvt_pk_bf16(o.x, o.y), pg8::cvt_pk_bf16(o.z, o.w));
        }
    }
}

template <bool BT, class Epi>
DEVI void gemm_tile(const float* A, int lda, const float* W, int ldw, int K, int m0, int n0, const Epi& epi, float* lds) {
    float (*As)[132] = (float (*)[132])lds;
    float (*Bs)[68] = (float (*)[68])(lds + 16 * 132);
    const int tid = tidx(), tx = tid & 15, ty = tid >> 4;
    float acc[4][4];
#pragma unroll
    for (int i = 0; i < 4; ++i)
#pragma unroll
        for (int j = 0; j < 4; ++j) acc[i][j] = 0.f;
    for (int k0 = 0; k0 < K; k0 += 16) {
        {
            const int row = tid >> 2, kq = tid & 3;
            float4 v = *(const float4*)(A + (size_t)(m0 + row) * lda + k0 + kq * 4);
            As[kq * 4 + 0][row] = v.x; As[kq * 4 + 1][row] = v.y; As[kq * 4 + 2][row] = v.z; As[kq * 4 + 3][row] = v.w;
        }
        if (tid < 256) {
            if (!BT) {
                const int k = tid >> 4, n4 = tid & 15;
                float4 v = *(const float4*)(W + (size_t)(k0 + k) * ldw + n0 + n4 * 4);
                *(float4*)&Bs[k][n4 * 4] = v;
            } else {
                const int n = tid >> 2, kq = tid & 3;
                float4 v = *(const float4*)(W + (size_t)(n0 + n) * ldw + k0 + kq * 4);
                Bs[kq * 4 + 0][n] = v.x; Bs[kq * 4 + 1][n] = v.y; Bs[kq * 4 + 2][n] = v.z; Bs[kq * 4 + 3][n] = v.w;
            }
        }
        __syncthreads();
#pragma unroll
        for (int k = 0; k < 16; ++k) {
            float4 a = *(const float4*)&As[k][ty * 4], b = *(const float4*)&Bs[k][tx * 4];
            const float av[4] = {a.x, a.y, a.z, a.w}, bv[4] = {b.x, b.y, b.z, b.w};
#pragma unroll
            for (int i = 0; i < 4; ++i)
#pragma unroll
                for (int j = 0; j < 4; ++j) acc[i][j] += av[i] * bv[j];
        }
        __syncthreads();
    }
#pragma unroll
    for (int i = 0; i < 4; ++i) epi(m0 + ty * 4 + i, n0 + tx * 4, make_float4(acc[i][0], acc[i][1], acc[i][2], acc[i][3]));
}
template <bool BT, class Epi>
DEVI void gemm_f32(const float* A, int lda, const float* W, int ldw, int M, int N, int K, const Epi& epi, int bid, int nb, float* lds) {
    const int nn = N / 64, nt = (M / 128) * nn;
    for (int tile = bid; tile < nt; tile += nb) gemm_tile<BT>(A, lda, W, ldw, K, (tile / nn) * 128, (tile % nn) * 64, epi, lds);
}
struct EpiStore { float* C; int ldc; DEVI void operator()(int r, int c, float4 v) const { *(float4*)(C + (size_t)r * ldc + c) = v; } };
struct EpiResid {
    CParams* p; int layer;
    DEVI void operator()(int r, int c, float4 v) const {
        const float* x = xrow(*p, layer, r) + c;
        const float* g1 = p->ada + ((size_t)layer * 3 + cond_of(r)) * 6 * D + 2 * D + c;
        float4 xv = *(const float4*)x, gv = *(const float4*)g1, o;
        o.x = xv.x + gv.x * v.x; o.y = xv.y + gv.y * v.y; o.z = xv.z + gv.z * v.z; o.w = xv.w + gv.w * v.w;
        *(float4*)(p->out + (size_t)r * D + c) = o;
    }
};


struct EpiF32 {
    static constexpr bool PERM = false, AFTER_DRAIN = false;
    float* C; int ldc, ncols;
    DEVI void operator()(const pg8::f32x4 (&acc)[2][2][4][2], const pg8::Unit& u, int wr, int wc, int fr, int fq) const {
        const int row0 = u.pm * 256 + wr * 64 + fr, col0 = u.pn * 256 + wc * 32 + 4 * fq;
#pragma unroll
        for (int ai = 0; ai < 2; ++ai)
#pragma unroll
            for (int m = 0; m < 4; ++m) { float* rowp = C + (size_t)(row0 + ai * 128 + m * 16) * ldc;
#pragma unroll
                for (int bj = 0; bj < 2; ++bj)
#pragma unroll
                    for (int n = 0; n < 2; ++n) { const int c = col0 + bj * 128 + n * 16; if (c < ncols) *(pg8::f32x4*)(rowp + c) = acc[ai][bj][m][n]; } }
    }
};
struct EpiResidMF {
    static constexpr bool PERM = false, AFTER_DRAIN = false;
    CParams* p; int layer;
    DEVI void operator()(const pg8::f32x4 (&acc)[2][2][4][2], const pg8::Unit& u, int wr, int wc, int fr, int fq) const {
        const int row0 = u.pm * 256 + wr * 64 + fr, col0 = u.pn * 256 + wc * 32 + 4 * fq;
#pragma unroll
        for (int ai = 0; ai < 2; ++ai)
#pragma unroll
            for (int m = 0; m < 4; ++m) {
                const int r = row0 + ai * 128 + m * 16;
                const float* x = xrow(*p, layer, r);
                const float* g1 = p->ada + ((size_t)layer * 3 + cond_of(r)) * 6 * D + 2 * D;
                float* o = p->out + (size_t)r * D;
#pragma unroll
                for (int bj = 0; bj < 2; ++bj)
#pragma unroll
                    for (int n = 0; n < 2; ++n) { const int c = col0 + bj * 128 + n * 16;
                        const pg8::f32x4 xv = *(const pg8::f32x4*)(x + c), gv = *(const pg8::f32x4*)(g1 + c);
                        *(pg8::f32x4*)(o + c) = xv + gv * acc[ai][bj][m][n]; } }
    }
};
template <class Epi>
DEVI void mfma_gemm(const bf16_t* A, const bf16_t* Bt, int M, int N, int K, const Epi& E, int bid, int nb, float* lds) {
    pg8::Gemm g{A, Bt, M, N, K};
    pg8::StaticOrder S; S.init(M, N, nb, bid);
    pg8::gemm_phase<Epi, pg8::StaticOrder, true, true>((PG8_LAS unsigned char*)lds + RING_OFF, g, S, E);
    __syncthreads();
}

DEVI void transpose_tile(const float* W, int ldw, bf16_t* Wt, int ldt, int k0, int n0, float* lds) {
    float (*tl)[65] = (float (*)[65])lds;
    const int tid = tidx();
#pragma unroll
    for (int rep = 0; rep < 2; ++rep) {
        const int k = (tid >> 4) + rep * 32, n4 = (tid & 15) * 4;
        const float4 v = *(const float4*)(W + (size_t)(k0 + k) * ldw + n0 + n4);
        tl[k][n4] = v.x; tl[k][n4 + 1] = v.y; tl[k][n4 + 2] = v.z; tl[k][n4 + 3] = v.w;
    }
    __syncthreads();
    {
        const int n = tid >> 3, k8 = (tid & 7) * 8;
        uint4 o;
        o.x = pg8::cvt_pk_bf16(tl[k8 + 0][n], tl[k8 + 1][n]); o.y = pg8::cvt_pk_bf16(tl[k8 + 2][n], tl[k8 + 3][n]);
        o.z = pg8::cvt_pk_bf16(tl[k8 + 4][n], tl[k8 + 5][n]); o.w = pg8::cvt_pk_bf16(tl[k8 + 6][n], tl[k8 + 7][n]);
        *(uint4*)(Wt + (size_t)(n0 + n) * ldt + k0 + k8) = o;
    }
    __syncthreads();
}
DEVI void phase_weights(CParams& p, int bid, int nb, float* lds) {
    constexpr int N_IN = 32 * 61, N_UQ = 8 * 24, N_UKV = 4 * 32, N_SQ = 32 * 32, PER = N_IN + N_UQ + N_UKV + 2 * N_SQ;
    for (int it = bid; it < DEPTH * PER; it += nb) {
        const int l = it / PER; int j = it % PER;
        if (j < N_IN) { transpose_tile(p.w_in + (size_t)l * D * DIN, DIN, p.wt_in + (size_t)l * DINP * D, D, (j / 61) * 64, (j % 61) * 64, lds); continue; }
        j -= N_IN;
        if (j < N_UQ) { transpose_tile(p.w_uq + (size_t)l * 512 * 1536, 1536, p.wt_uq + (size_t)l * 1536 * 512, 512, (j / 24) * 64, (j % 24) * 64, lds); continue; }
        j -= N_UQ;
        if (j < N_UKV) { transpose_tile(p.w_ukv + (size_t)l * 256 * 2048, 2048, p.wt_ukv + (size_t)l * 2048 * 256, 256, (j / 32) * 64, (j % 32) * 64, lds); continue; }
        j -= N_UKV;
        if (j < N_SQ) { transpose_tile(p.w_out + (size_t)l * D * D, D, p.wt_out + (size_t)l * D * D, D, (j / 32) * 64, (j % 32) * 64, lds); continue; }
        j -= N_SQ;
        transpose_tile(p.peer_wq + (size_t)l * D * D, D, p.wt_q + (size_t)l * D * D, D, (j / 32) * 64, (j % 32) * 64, lds);
    }
    {
        const size_t n8 = (size_t)DEPTH * 16384 * D / 8;
        for (size_t i = (size_t)bid * NTHREADS + tidx(); i < n8; i += (size_t)nb * NTHREADS) {
            const float4 a0 = *(const float4*)(p.peer_u + i * 8), a1 = *(const float4*)(p.peer_u + i * 8 + 4);
            *(uint4*)(p.pu_b + i * 8) = make_uint4(cvtpk(a0.x, a0.y), cvtpk(a0.z, a0.w), cvtpk(a1.x, a1.y), cvtpk(a1.z, a1.w));
            const float4 b0 = *(const float4*)(p.peer_v + i * 8), b1 = *(const float4*)(p.peer_v + i * 8 + 4);
            *(uint4*)(p.pv_b + i * 8) = make_uint4(cvtpk(b0.x, b0.y), cvtpk(b0.z, b0.w), cvtpk(b1.x, b1.y), cvtpk(b1.z, b1.w));
        }
    }
    const int nz = DEPTH * (DINP - DIN) * D / 8;
    for (int i = bid * NTHREADS + tidx(); i < nz; i += nb * NTHREADS) {
        const int per = (DINP - DIN) * D / 8, l = i / per, r = i % per;
        *(uint4*)(p.wt_in + ((size_t)l * DINP + DIN) * D + (size_t)r * 8) = make_uint4(0u, 0u, 0u, 0u);
    }
}

DEVI void phase_postz(CParams& p, int layer, int bid, int nb) {
    const int lane = tidx() & 63, w = tidx() >> 6;
    for (int r = bid * NWAVES + w; r < TKV; r += nb * NWAVES) {
        if (r >= T) {
            const int b = (r - T) / PAST, j = (r - T) % PAST;
            const float* src = p.cache_ckv + (((size_t)b * DEPTH + layer) * PAST + j) * 256;
            { float4 v = *(const float4*)(src + lane * 4); *(uint2*)(p.ckv_b + (size_t)r * 256 + lane * 4) = make_uint2(pg8::cvt_pk_bf16(v.x, v.y), pg8::cvt_pk_bf16(v.z, v.w)); }
            continue;
        }
        const float* z = p.z + (size_t)r * DIN;
        const bool ctx = r < NCTX;
        const int b = ctx ? r / SEQ : (r - NCTX) / DS, s = ctx ? r % SEQ : (r - NCTX) % DS;
        {
            float v[8], ss = 0.f;
#pragma unroll
            for (int i = 0; i < 8; ++i) { v[i] = z[O_CQ + i * 64 + lane]; ss += v[i] * v[i]; }
            ss = wave_sum(ss); const float rr = rsqrtf(ss / 512.f + EPS);
#pragma unroll
            for (int i = 0; i < 8; ++i) p.cqn_b[(size_t)r * 512 + i * 64 + lane] = f2bf(v[i] * rr * p.q_norm_g[layer * 512 + i * 64 + lane]);
        }
        {
            float v[4], ss = 0.f;
#pragma unroll
            for (int i = 0; i < 4; ++i) { v[i] = z[O_CKV + i * 64 + lane]; ss += v[i] * v[i]; }
            ss = wave_sum(ss); const float rr = rsqrtf(ss / 256.f + EPS);
#pragma unroll
            for (int i = 0; i < 4; ++i) {
                const float o = v[i] * rr * p.kv_norm_g[layer * 256 + i * 64 + lane];
                p.ckv_b[(size_t)r * 256 + i * 64 + lane] = f2bf(o);
                if (ctx) p.o_ckv[(((size_t)b * DEPTH + layer) * SEQ + s) * 256 + i * 64 + lane] = o;
            }
        }
        if (ctx) p.o_kpe[(((size_t)b * DEPTH + layer) * SEQ + s) * 64 + lane] = z[O_KPE + lane];
#pragma unroll
        for (int h = 0; h < 4; ++h) {
            float q0 = z[O_NAQ + h * 128 + lane], q1 = z[O_NAQ + h * 128 + 64 + lane];
            float ss = wave_sum(q0 * q0 + q1 * q1); float rr = rsqrtf(ss / 128.f + EPS);
            p.qna_b[(size_t)r * 512 + h * 128 + lane] = f2bf(q0 * rr * p.naq_g[layer * 128 + lane]);
            p.qna_b[(size_t)r * 512 + h * 128 + 64 + lane] = f2bf(q1 * rr * p.naq_g[layer * 128 + 64 + lane]);
            float k0 = z[O_NAK + h * 128 + lane], k1 = z[O_NAK + h * 128 + 64 + lane];
            ss = wave_sum(k0 * k0 + k1 * k1); rr = rsqrtf(ss / 128.f + EPS);
            k0 = k0 * rr * p.nak_g[layer * 128 + lane]; k1 = k1 * rr * p.nak_g[layer * 128 + 64 + lane];
            p.kna_b[(size_t)r * 512 + h * 128 + lane] = f2bf(k0); p.kna_b[(size_t)r * 512 + h * 128 + 64 + lane] = f2bf(k1);
            if (ctx) {
                const size_t o = ((((size_t)b * DEPTH + layer) * 4 + h) * SEQ + s) * 128;
                p.o_nak[o + lane] = k0; p.o_nak[o + 64 + lane] = k1;
                p.o_nav[o + lane] = z[O_NAV + h * 128 + lane]; p.o_nav[o + 64 + lane] = z[O_NAV + h * 128 + 64 + lane];
            }
        }
        {
            const int S = ctx ? SEQ : DS;
#pragma unroll
            for (int i = 0; i < 8; ++i) {
                const int ch = i * 64 + lane;
                const float* cw = p.conv_w + ((size_t)layer * 512 + ch) * 3;
                float acc = z[O_GC + ch] * z[O_U + ch] * cw[1];
                if (s > 0) acc += (z - DIN)[O_GC + ch] * (z - DIN)[O_U + ch] * cw[0];
                if (s < S - 1) acc += (z + DIN)[O_GC + ch] * (z + DIN)[O_U + ch] * cw[2];
                p.mix_b[(size_t)r * D + 1536 + ch] = f2bf(z[O_GB + ch] * acc);
            }
        }
    }
}

DEVI float rope_angle(int pos, int j) {
    const int row = pos / 64, col = pos % 64;
    const int f = j & 15;
    const float inv = powf(10000.f, -(float)f / 16.f);
    return (j < 16 ? (float)row : (float)col) * inv;
}

DEVI void transpose_v(const float* src, size_t sstride, bf16_t* dst, int ldv, float* lds) {
    float (*tl)[129] = (float (*)[129])lds;
    const int tid = tidx();
#pragma unroll
    for (int rep = 0; rep < 4; ++rep) {
        const int row = (tid >> 5) + 16 * rep, c4 = (tid & 31) * 4;
        const float4 v = *(const float4*)(src + (size_t)row * sstride + c4);
        tl[row][c4] = v.x; tl[row][c4 + 1] = v.y; tl[row][c4 + 2] = v.z; tl[row][c4 + 3] = v.w;
    }
    __syncthreads();
    {
        const int d = tid >> 2, k16 = (tid & 3) * 16;
        uint4 o0, o1;
        o0.x = cvtpk(tl[k16 + 0][d], tl[k16 + 1][d]); o0.y = cvtpk(tl[k16 + 2][d], tl[k16 + 3][d]); o0.z = cvtpk(tl[k16 + 4][d], tl[k16 + 5][d]); o0.w = cvtpk(tl[k16 + 6][d], tl[k16 + 7][d]);
        o1.x = cvtpk(tl[k16 + 8][d], tl[k16 + 9][d]); o1.y = cvtpk(tl[k16 + 10][d], tl[k16 + 11][d]); o1.z = cvtpk(tl[k16 + 12][d], tl[k16 + 13][d]); o1.w = cvtpk(tl[k16 + 14][d], tl[k16 + 15][d]);
        bf16_t* o = dst + (size_t)d * ldv + k16;
        *(uint4*)o = o0; *(uint4*)(o + 8) = o1;
    }
    __syncthreads();
}
DEVI void phase_headnorm(CParams& p, int layer, int bid, int nb, float* lds) {
    const int lane = tidx() & 63, w = tidx() >> 6;
    const int nq = T * 8, nk = TKV * 8;
    for (int it = bid * NWAVES + w; it < nq + nk; it += nb * NWAVES) {
        const bool isq = it < nq;
        const int r = isq ? it / 8 : (it - nq) / 8, h = it % 8;
        float v0, v1, v2; const float* g; bf16_t* dst; int pos = -1;
        if (isq) {
            const float* q = p.qm + (size_t)r * 1536 + h * 192;
            v0 = q[lane]; v1 = q[64 + lane]; v2 = q[128 + lane]; g = p.q_head_g + layer * 192; dst = p.q_b + (size_t)r * 1536 + h * 192;
            if (r >= NCTX) pos = (r - NCTX) % DS;
        } else {
            const float* kv = p.kvr + (size_t)r * 2048 + h * 256;
            v0 = kv[lane]; v1 = kv[64 + lane];
            if (r < T) v2 = p.z[(size_t)r * DIN + O_KPE + lane];
            else { const int b = (r - T) / PAST, j = (r - T) % PAST; v2 = p.cache_kpe[(((size_t)b * DEPTH + layer) * PAST + j) * 64 + lane]; }
            g = p.k_head_g + layer * 192; dst = p.k_b + (size_t)r * 1536 + h * 192;
            if (r >= NCTX && r < T) pos = (r - NCTX) % DS;
        }
        const float ss = wave_sum(v0 * v0 + v1 * v1 + v2 * v2);
        const float rr = rsqrtf(ss / 192.f + EPS);
        v0 *= rr * g[lane]; v1 *= rr * g[64 + lane]; v2 *= rr * g[128 + lane];
        if (pos >= 0) {
            const float other = __shfl_xor(v2, 32);
            const float ang = rope_angle(pos, lane & 31);
            const float cs = cosf(ang), sn = sinf(ang);
            v2 = lane < 32 ? v2 * cs - other * sn : other * sn + v2 * cs;
        }
        dst[lane] = f2bf(v0); dst[64 + lane] = f2bf(v1); dst[128 + lane] = f2bf(v2);
    }
    for (int i = bid * NTHREADS + tidx(); i < DB * 4 * PAST * 128 / 4; i += nb * NTHREADS) {
        const int e = i * 4, bh = e / (PAST * 128), rem = e % (PAST * 128), b = bh / 4, h = bh % 4;
        const float4 v = *(const float4*)(p.cache_nak + (((size_t)b * DEPTH + layer) * 4 + h) * PAST * 128 + rem);
        *(uint2*)(p.cnak_b + (size_t)e) = make_uint2(cvtpk(v.x, v.y), cvtpk(v.z, v.w));
    }
    constexpr int N_MLA = (TKV / 64) * 8, N_NA = (T / 64) * 4, N_NC = DB * 4 * (PAST / 64);
    for (int it = bid; it < N_MLA + N_NA + N_NC; it += nb) {
        if (it < N_MLA) {
            const int kt = it / 8, h = it % 8, r0 = kt * 64;
            const float* src = p.kvr + (size_t)r0 * 2048 + h * 256 + 128;
            bf16_t* dst; int ldv;
            if (r0 < NCTX) { const int b = r0 / SEQ; dst = p.vt_mla_ctx + ((size_t)(b * 8 + h) * 128) * SEQ + r0 % SEQ; ldv = SEQ; }
            else if (r0 < T) { const int b = (r0 - NCTX) / DS; dst = p.vt_mla_lat + ((size_t)(b * 8 + h) * 128) * (PAST + DS) + PAST + (r0 - NCTX) % DS; ldv = PAST + DS; }
            else { const int b = (r0 - T) / PAST; dst = p.vt_mla_lat + ((size_t)(b * 8 + h) * 128) * (PAST + DS) + (r0 - T) % PAST; ldv = PAST + DS; }
            transpose_v(src, 2048, dst, ldv, lds);
        } else if (it < N_MLA + N_NA) {
            const int j = it - N_MLA, kt = j / 4, h = j % 4, r0 = kt * 64;
            const float* src = p.z + (size_t)r0 * DIN + O_NAV + h * 128;
            bf16_t* dst; int ldv;
            if (r0 < NCTX) { const int b = r0 / SEQ; dst = p.vt_na_ctx + ((size_t)(b * 4 + h) * 128) * SEQ + r0 % SEQ; ldv = SEQ; }
            else { const int b = (r0 - NCTX) / DS; dst = p.vt_na_lat + ((size_t)(b * 4 + h) * 128) * DS + (r0 - NCTX) % DS; ldv = DS; }
            transpose_v(src, DIN, dst, ldv, lds);
        } else {
            const int j = it - N_MLA - N_NA, bh = j / (PAST / 64), jt = j % (PAST / 64), b = bh / 4, h = bh % 4;
            const float* src = p.cache_nav + ((((size_t)b * DEPTH + layer) * 4 + h) * PAST + jt * 64) * 128;
            transpose_v(src, 128, p.vt_na_cache + ((size_t)(b * 4 + h) * 128) * PAST + jt * 64, PAST, lds);
        }
    }
}

typedef short bf16x8_t __attribute__((ext_vector_type(8)));
typedef float f32x16_t __attribute__((ext_vector_type(16)));
#define MFMA32(a, b, c) __builtin_amdgcn_mfma_f32_32x32x16_bf16((a), (b), (c), 0, 0, 0)
DEVI int crow(int reg, int h) { return (reg & 3) + 8 * (reg >> 2) + 4 * h; }

struct AttnUnit {
    const bf16_t* q; int qstride;
    const bf16_t *k0, *vt0; int ks0, ldv0, nt0;
    const bf16_t *k1, *vt1; int ks1, ldv1, nt1;
    const bf16_t *kl, *vtl; int nloc;
    const float* bias; int qr, c0, rs;
    bf16_t* out;
    float scale;
};

template <int DQ>
DEVI void attn_unit(const AttnUnit& u) {
    const int lane = tidx() & 63, r = lane & 31, h = lane >> 5;
    bf16x8_t qf[DQ / 16];
    {
        const bf16_t* qrow = u.q + (size_t)r * u.qstride + 8 * h;
#pragma unroll
        for (int kk = 0; kk < DQ / 16; ++kk) qf[kk] = *(const bf16x8_t*)(qrow + kk * 16);
    }
    f32x16_t ot[4];
#pragma unroll
    for (int b = 0; b < 4; ++b)
#pragma unroll
        for (int i = 0; i < 16; ++i) ot[b][i] = 0.f;
    float m = -INFINITY, l = 0.f;
    const int ntiles = u.nt0 + u.nt1 + u.nloc;
    for (int t = 0; t < ntiles; ++t) {
        const bf16_t *kp, *vp; int ks, ldv, lrow = -1, lcol = 0;
        if (t < u.nt0) { kp = u.k0 + (size_t)t * 32 * u.ks0; ks = u.ks0; vp = u.vt0 + t * 32; ldv = u.ldv0; }
        else if (t < u.nt0 + u.nt1) { const int tt = t - u.nt0; kp = u.k1 + (size_t)tt * 32 * u.ks1; ks = u.ks1; vp = u.vt1 + tt * 32; ldv = u.ldv1; }
        else { const int tt = t - u.nt0 - u.nt1; lrow = u.rs + (tt >> 1); lcol = (tt & 1) * 32; kp = u.kl + (size_t)(lrow * 64 + lcol) * 512; ks = 512; vp = u.vtl + lrow * 64 + lcol; ldv = DS; }
        f32x16_t st;
#pragma unroll
        for (int i = 0; i < 16; ++i) st[i] = 0.f;
        {
            const bf16_t* krow = kp + (size_t)r * ks + 8 * h;
#pragma unroll
            for (int kk = 0; kk < DQ / 16; ++kk) { const bf16x8_t a = *(const bf16x8_t*)(krow + kk * 16); st = MFMA32(a, qf[kk], st); }
        }
        float sv[16], mx = -INFINITY;
        if (lrow >= 0) {
            const int qc = u.c0 + r, cs = min(max(qc - 8, 0), 48);
            const float* brow = u.bias + (lrow - u.qr + 7) * 31 + (15 - qc);
#pragma unroll
            for (int i = 0; i < 16; ++i) {
                const int kc = lcol + crow(i, h);
                const bool valid = kc >= cs && kc < cs + 16;
                const float bv = valid ? brow[kc] : 0.f;
                sv[i] = valid ? st[i] * u.scale + bv : -INFINITY; mx = fmaxf(mx, sv[i]);
            }
        } else {
#pragma unroll
            for (int i = 0; i < 16; ++i) { sv[i] = st[i] * u.scale; mx = fmaxf(mx, sv[i]); }
        }
        mx = fmaxf(mx, __shfl_xor(mx, 32));
        const float mnew = fmaxf(m, mx), alpha = __expf(m - mnew);
        m = mnew;
        float ls = 0.f;
#pragma unroll
        for (int i = 0; i < 16; ++i) { sv[i] = __expf(sv[i] - mnew); ls += sv[i]; }
        l = l * alpha + ls;
#pragma unroll
        for (int b = 0; b < 4; ++b)
#pragma unroll
            for (int i = 0; i < 16; ++i) ot[b][i] *= alpha;
#pragma unroll
        for (int s2 = 0; s2 < 2; ++s2) {
            uint4 pk; pk.x = cvtpk(sv[8 * s2 + 0], sv[8 * s2 + 1]); pk.y = cvtpk(sv[8 * s2 + 2], sv[8 * s2 + 3]); pk.z = cvtpk(sv[8 * s2 + 4], sv[8 * s2 + 5]); pk.w = cvtpk(sv[8 * s2 + 6], sv[8 * s2 + 7]);
            const bf16x8_t xs = __builtin_bit_cast(bf16x8_t, pk);
#pragma unroll
            for (int b = 0; b < 4; ++b) {
                const bf16_t* vrow = vp + (size_t)(32 * b + r) * ldv + 16 * s2 + 4 * h;
                const uint2 lo = *(const uint2*)vrow, hi = *(const uint2*)(vrow + 8);
                const bf16x8_t pa = __builtin_bit_cast(bf16x8_t, make_uint4(lo.x, lo.y, hi.x, hi.y));
                ot[b] = MFMA32(pa, xs, ot[b]);
            }
        }
    }
    l += __shfl_xor(l, 32);
    const float inv = 1.f / l;
    bf16_t* orow = u.out + (size_t)r * D;
#pragma unroll
    for (int b = 0; b < 4; ++b)
#pragma unroll
        for (int g = 0; g < 4; ++g)
            *(uint2*)(orow + 32 * b + 8 * g + 4 * h) = make_uint2(cvtpk(ot[b][4 * g] * inv, ot[b][4 * g + 1] * inv), cvtpk(ot[b][4 * g + 2] * inv, ot[b][4 * g + 3] * inv));
}

DEVI void attn_dispatch(CParams& p, int layer, int kind, int idx) {
    AttnUnit u;
    u.k1 = nullptr; u.vt1 = nullptr; u.ks1 = 0; u.ldv1 = 0; u.nt1 = 0; u.kl = nullptr; u.vtl = nullptr; u.nloc = 0; u.bias = nullptr; u.qr = 0; u.c0 = 0; u.rs = 0;
    if (kind == 0) {
        const int qt = idx % 32, h = (idx / 32) % 8, b = idx / 256, t0 = NCTX + b * DS + qt * 32;
        u.q = p.q_b + (size_t)t0 * 1536 + h * 192; u.qstride = 1536; u.scale = 0.07216878364870322f;
        u.k0 = p.k_b + (size_t)(T + b * PAST) * 1536 + h * 192; u.ks0 = 1536; u.vt0 = p.vt_mla_lat + ((size_t)(b * 8 + h) * 128) * (PAST + DS); u.ldv0 = PAST + DS; u.nt0 = PAST / 32;
        u.k1 = p.k_b + (size_t)(NCTX + b * DS) * 1536 + h * 192; u.ks1 = 1536; u.vt1 = u.vt0 + PAST; u.ldv1 = PAST + DS; u.nt1 = DS / 32;
        u.out = p.mix_b + (size_t)t0 * D + h * 128;
        attn_unit<192>(u);
    } else if (kind == 1) {
        const int qt = idx % 32, h = (idx / 32) % 4, b = idx / 128, t0 = NCTX + b * DS + qt * 32;
        u.q = p.qna_b + (size_t)t0 * 512 + h * 128; u.qstride = 512; u.scale = 0.08838834764831845f;
        u.k0 = p.cnak_b + ((size_t)(b * 4 + h) * PAST) * 128; u.ks0 = 128; u.vt0 = p.vt_na_cache + ((size_t)(b * 4 + h) * 128) * PAST; u.ldv0 = PAST; u.nt0 = PAST / 32;
        u.kl = p.kna_b + (size_t)(NCTX + b * DS) * 512 + h * 128; u.vtl = p.vt_na_lat + ((size_t)(b * 4 + h) * 128) * DS; u.nloc = 16;
        u.bias = p.rel_bias + ((size_t)layer * 4 + h) * 15 * 31; u.qr = qt >> 1; u.c0 = (qt & 1) * 32; u.rs = min(max(u.qr - 4, 0), 8);
        u.out = p.mix_b + (size_t)t0 * D + 1024 + h * 128;
        attn_unit<128>(u);
    } else if (kind == 2) {
        const int qt = idx % 8, h = (idx / 8) % 8, b = idx / 64, t0 = b * SEQ + qt * 32;
        u.q = p.q_b + (size_t)t0 * 1536 + h * 192; u.qstride = 1536; u.scale = 0.07216878364870322f;
        u.k0 = p.k_b + (size_t)(b * SEQ) * 1536 + h * 192; u.ks0 = 1536; u.vt0 = p.vt_mla_ctx + ((size_t)(b * 8 + h) * 128) * SEQ; u.ldv0 = SEQ; u.nt0 = SEQ / 32;
        u.out = p.mix_b + (size_t)t0 * D + h * 128;
        attn_unit<192>(u);
    } else {
        const int qt = idx % 8, h = (idx / 8) % 4, b = idx / 32, t0 = b * SEQ + qt * 32;
        u.q = p.qna_b + (size_t)t0 * 512 + h * 128; u.qstride = 512; u.scale = 0.08838834764831845f;
        u.k0 = p.kna_b + (size_t)(b * SEQ) * 512 + h * 128; u.ks0 = 512; u.vt0 = p.vt_na_ctx + ((size_t)(b * 4 + h) * 128) * SEQ; u.ldv0 = SEQ; u.nt0 = SEQ / 32;
        u.out = p.mix_b + (size_t)t0 * D + 1024 + h * 128;
        attn_unit<128>(u);
    }
}
DEVI void phase_attn(CParams& p, int layer, int bid, int nb) {
    const int w = __builtin_amdgcn_readfirstlane(tidx() >> 6);
    constexpr int N0 = DB * 8 * (DS / 32), N1 = DB * 4 * (DS / 32), N2 = BATCH * 8 * (SEQ / 32), N3 = BATCH * 4 * (SEQ / 32);
    if (w < 2) {
        for (int it = w * nb + bid; it < N0; it += 2 * nb) attn_dispatch(p, layer, 0, it);
    } else {
        for (int it = (w - 2) * nb + bid; it < N1 + N3 + N2; it += (NWAVES - 2) * nb) {
            if (it < N1) attn_dispatch(p, layer, 1, it);
            else if (it < N1 + N3) attn_dispatch(p, layer, 3, it - N1);
            else attn_dispatch(p, layer, 2, it - N1 - N3);
        }
    }
}

DEVI void phase_route(CParams& p, int bid, int nb) {
    const int lane = tidx() & 63, w = tidx() >> 6;
    for (int it = bid * NWAVES + w; it < T * 8; it += nb * NWAVES) {
        const int t = it / 8, h = it % 8;
        const float* sc = p.sc + (size_t)t * 2048 + h * 256;
        float keepS[2]; int keepI[2];
#pragma unroll
        for (int pp = 0; pp < 2; ++pp) {
            float x0 = sc[pp * 128 + lane], x1 = sc[pp * 128 + 64 + lane];
            float ks = 0.f; int ki = 0;
            for (int r = 0; r < 16; ++r) {
                float bv; int bi;
                if (x0 >= x1) { bv = x0; bi = lane; } else { bv = x1; bi = lane + 64; }
                wave_argmax(bv, bi);
                if (lane == r) { ks = bv; ki = bi; }
                if ((bi & 63) == lane) { if (bi < 64) x0 = -INFINITY; else x1 = -INFINITY; }
            }
            keepS[pp] = ks; keepI[pp] = ki;
        }
        const int a = lane >> 2, b0 = (lane & 3) * 4;
        const float s1a = __shfl(keepS[0], a);
        float c0 = s1a + __shfl(keepS[1], b0 + 0), c1 = s1a + __shfl(keepS[1], b0 + 1), c2 = s1a + __shfl(keepS[1], b0 + 2), c3 = s1a + __shfl(keepS[1], b0 + 3);
        float topS = 0.f; int topE = 0; float mx = 0.f;
        for (int r = 0; r < 16; ++r) {
            float bv = c0; int bi = lane * 4;
            if (c1 > bv) { bv = c1; bi = lane * 4 + 1; }
            if (c2 > bv) { bv = c2; bi = lane * 4 + 2; }
            if (c3 > bv) { bv = c3; bi = lane * 4 + 3; }
            wave_argmax(bv, bi);
            const int e = __shfl(keepI[0], bi >> 4) * 128 + __shfl(keepI[1], bi & 15);
            if (r == 0) mx = bv;
            if (lane == r) { topS = bv; topE = e; }
            if ((bi >> 2) == lane) { const int c = bi & 3; if (c == 0) c0 = -INFINITY; else if (c == 1) c1 = -INFINITY; else if (c == 2) c2 = -INFINITY; else c3 = -INFINITY; }
        }
        float e = lane < 16 ? __expf(topS - mx) : 0.f;
        const float sum = wave_sum(e);
        if (lane < 16) { p.gate[(size_t)t * 128 + h * 16 + lane] = e / sum; p.eidx[(size_t)t * 128 + h * 16 + lane] = topE; }
    }
}

typedef __bf16 bf16x2v __attribute__((ext_vector_type(2)));
DEVI float dot2(unsigned a, unsigned b, float c) { return __builtin_amdgcn_fdot2_f32_bf16(__builtin_bit_cast(bf16x2v, a), __builtin_bit_cast(bf16x2v, b), c, false); }
DEVI float bflo(unsigned v) { return __uint_as_float(v << 16); }
DEVI float bfhi(unsigned v) { return __uint_as_float(v & 0xffff0000u); }
DEVI void phase_experts(CParams& p, int layer, int bid, int nb, float* lds) {
    const int lane = tidx() & 63, w = tidx() >> 6;
    float* wgt = lds + w * 128;
    const bf16_t* U = p.pu_b + (size_t)layer * 16384 * D;
    const bf16_t* V = p.pv_b + (size_t)layer * 16384 * D;
    for (int t = bid * NWAVES + w; t < T; t += nb * NWAVES) {
        uint4 x[4];
#pragma unroll
        for (int j = 0; j < 4; ++j) x[j] = *(const uint4*)(p.hn_b + (size_t)t * D + j * 512 + lane * 8);
        const int* eix = p.eidx + (size_t)t * 128;
        const float* gat = p.gate + (size_t)t * 128;
        for (int c = 0; c < 16; ++c) {
            uint4 u[8][4];
#pragma unroll
            for (int e = 0; e < 8; ++e) {
                const int idx = __builtin_amdgcn_readfirstlane(eix[c * 8 + e]);
                const bf16_t* ur = U + (size_t)idx * D + lane * 8;
#pragma unroll
                for (int j = 0; j < 4; ++j) u[e][j] = *(const uint4*)(ur + j * 512);
            }
            float d[8];
#pragma unroll
            for (int e = 0; e < 8; ++e) {
                float a = 0.f;
#pragma unroll
                for (int j = 0; j < 4; ++j) { a = dot2(u[e][j].x, x[j].x, a); a = dot2(u[e][j].y, x[j].y, a); a = dot2(u[e][j].z, x[j].z, a); a = dot2(u[e][j].w, x[j].w, a); }
                d[e] = a;
            }
            const bool b5 = lane & 32, b4 = lane & 16, b3 = lane & 8;
            float r4[4];
#pragma unroll
            for (int i = 0; i < 4; ++i) { const float mine = b5 ? d[4 + i] : d[i], theirs = b5 ? d[i] : d[4 + i]; r4[i] = mine + __shfl_xor(theirs, 32); }
            float r2[2];
#pragma unroll
            for (int i = 0; i < 2; ++i) { const float mine = b4 ? r4[2 + i] : r4[i], theirs = b4 ? r4[i] : r4[2 + i]; r2[i] = mine + __shfl_xor(theirs, 16); }
            float r1;
            { const float mine = b3 ? r2[1] : r2[0], theirs = b3 ? r2[0] : r2[1]; r1 = mine + __shfl_xor(theirs, 8); }
            r1 += __shfl_xor(r1, 4); r1 += __shfl_xor(r1, 2); r1 += __shfl_xor(r1, 1);
            const int e = (lane >> 3) & 7;
            const float a = 0.5f * r1 * (1.f + erff(r1 * 0.70710678118654752f));
            if ((lane & 7) == 0) wgt[c * 8 + e] = a * gat[c * 8 + e];
        }
        __builtin_amdgcn_wave_barrier();
        float o[4][8];
#pragma unroll
        for (int j = 0; j < 4; ++j)
#pragma unroll
            for (int i = 0; i < 8; ++i) o[j][i] = 0.f;
        for (int c = 0; c < 16; ++c) {
            uint4 v[8][4];
#pragma unroll
            for (int e = 0; e < 8; ++e) {
                const int idx = __builtin_amdgcn_readfirstlane(eix[c * 8 + e]);
                const bf16_t* vr = V + (size_t)idx * D + lane * 8;
#pragma unroll
                for (int j = 0; j < 4; ++j) v[e][j] = *(const uint4*)(vr + j * 512);
            }
#pragma unroll
            for (int e = 0; e < 8; ++e) {
                const float wg = wgt[c * 8 + e];
#pragma unroll
                for (int j = 0; j < 4; ++j) {
                    o[j][0] += wg * bflo(v[e][j].x); o[j][1] += wg * bfhi(v[e][j].x); o[j][2] += wg * bflo(v[e][j].y); o[j][3] += wg * bfhi(v[e][j].y);
                    o[j][4] += wg * bflo(v[e][j].z); o[j][5] += wg * bfhi(v[e][j].z); o[j][6] += wg * bflo(v[e][j].w); o[j][7] += wg * bfhi(v[e][j].w);
                }
            }
        }
        __builtin_amdgcn_wave_barrier();
        const int cond = cond_of(t);
        const float* g2 = p.ada + ((size_t)layer * 3 + cond) * 6 * D + 5 * D;
        float* xo = p.out + (size_t)t * D;
        float ss = 0.f;
#pragma unroll
        for (int j = 0; j < 4; ++j) {
            const int cb = j * 512 + lane * 8;
#pragma unroll
            for (int q = 0; q < 2; ++q) {
                float4 xv = *(const float4*)(xo + cb + q * 4); const float4 gv = *(const float4*)(g2 + cb + q * 4);
                xv.x += gv.x * o[j][q * 4 + 0]; xv.y += gv.y * o[j][q * 4 + 1]; xv.z += gv.z * o[j][q * 4 + 2]; xv.w += gv.w * o[j][q * 4 + 3];
                *(float4*)(xo + cb + q * 4) = xv;
                o[j][q * 4 + 0] = xv.x; o[j][q * 4 + 1] = xv.y; o[j][q * 4 + 2] = xv.z; o[j][q * 4 + 3] = xv.w;
                ss += xv.x * xv.x + xv.y * xv.y + xv.z * xv.z + xv.w * xv.w;
            }
        }
        if (layer + 1 < DEPTH) {
            ss = wave_sum(ss);
            const float rr = rsqrtf(ss / D + EPS);
            const float* g = p.norm_mix_g + (size_t)(layer + 1) * D;
            const float* ad = p.ada + ((size_t)(layer + 1) * 3 + cond) * 6 * D;
#pragma unroll
            for (int j = 0; j < 4; ++j) {
                const int cb = j * 512 + lane * 8;
                float hv[8];
#pragma unroll
                for (int q = 0; q < 2; ++q) {
                    const float4 gg = *(const float4*)(g + cb + q * 4), sh = *(const float4*)(ad + cb + q * 4), sc = *(const float4*)(ad + D + cb + q * 4);
                    hv[q * 4 + 0] = o[j][q * 4 + 0] * rr * gg.x * (1.f + sc.x) + sh.x; hv[q * 4 + 1] = o[j][q * 4 + 1] * rr * gg.y * (1.f + sc.y) + sh.y;
                    hv[q * 4 + 2] = o[j][q * 4 + 2] * rr * gg.z * (1.f + sc.z) + sh.z; hv[q * 4 + 3] = o[j][q * 4 + 3] * rr * gg.w * (1.f + sc.w) + sh.w;
                }
                *(uint4*)(p.hn_b + (size_t)t * D + cb) = make_uint4(cvtpk(hv[0], hv[1]), cvtpk(hv[2], hv[3]), cvtpk(hv[4], hv[5]), cvtpk(hv[6], hv[7]));
            }
        }
    }
}

enum { PH_ADA = 0, PH_NORM1, PH_WIN, PH_POSTZ, PH_UQKV, PH_HEADNORM, PH_ATTN, PH_WOUT, PH_NORM2, PH_WQ, PH_SCORES, PH_ROUTE, PH_EXPERTS, PH_COUNT };

template <int PH>
DEVI void run_phase(CParams& p, int layer, int bid, int nb, float* lds) {
    if constexpr (PH == PH_ADA) { phase_ada(p, bid, nb, lds); phase_weights(p, bid, nb, lds); }
    if constexpr (PH == PH_NORM1) phase_modnorm(p, layer, 0, bid, nb);
    if constexpr (PH == PH_WIN) mfma_gemm(p.hn_b, p.wt_in + (size_t)layer * DINP * D, T, DINP, D, EpiF32{p.z, DIN, DIN}, bid, nb, lds);
    if constexpr (PH == PH_POSTZ) phase_postz(p, layer, bid, nb);
    if constexpr (PH == PH_UQKV) {
        mfma_gemm(p.cqn_b, p.wt_uq + (size_t)layer * 1536 * 512, T, 1536, 512, EpiF32{p.qm, 1536, 1536}, bid, nb, lds);
        mfma_gemm(p.ckv_b, p.wt_ukv + (size_t)layer * 2048 * 256, TKV, 2048, 256, EpiF32{p.kvr, 2048, 2048}, bid, nb, lds);
    }
    if constexpr (PH == PH_HEADNORM) phase_headnorm(p, layer, bid, nb, lds);
    if constexpr (PH == PH_ATTN) phase_attn(p, layer, bid, nb);
    if constexpr (PH == PH_WOUT) mfma_gemm(p.mix_b, p.wt_out + (size_t)layer * D * D, T, D, D, EpiResidMF{&p, layer}, bid, nb, lds);
    if constexpr (PH == PH_NORM2) phase_modnorm(p, layer, 1, bid, nb);
    if constexpr (PH == PH_WQ) mfma_gemm(p.hn_b, p.wt_q + (size_t)layer * D * D, T, D, D, EpiF32{p.qp, D, D}, bid, nb, lds);
    if constexpr (PH == PH_SCORES) {
        for (int hp = 0; hp < 16; ++hp)
            gemm_f32<true>(p.qp + hp * 128, D, p.sub_keys + ((size_t)layer * 16 + hp) * 128 * 128, 128, T, 128, 128, EpiStore{p.sc + hp * 128, D}, bid, nb, lds);
    }
    if constexpr (PH == PH_ROUTE) phase_route(p, bid, nb);
    if constexpr (PH == PH_EXPERTS) phase_experts(p, layer, bid, nb, lds);
}

#ifndef MK_ONE_LAUNCH
#define MK_ONE_LAUNCH 1
#endif
constexpr size_t LDS_BYTES = LDS_TOTAL;

#if MK_ONE_LAUNCH
#define PHASE(PH, l) do { CParams* q_ = pp; asm volatile("" : "+s"(q_)); run_phase<PH>(*q_, l, (int)blockIdx.x, (int)gridDim.x, lds); \
    XcdBarrier b_; b_.bar = q_->bar; b_.x = xb_xcc_id(); b_.st = (volatile LAS unsigned*)(lds_raw + MISC_OFF); xcd_barrier(b_); } while (0)
__global__ void __launch_bounds__(NTHREADS, 2) k_fwd(Params p_unused) {
    CParams* pp = (CParams*)__builtin_amdgcn_kernarg_segment_ptr();
    extern __shared__ __attribute__((aligned(16))) unsigned char lds_raw[];
    float* lds = (float*)lds_raw;
    if (threadIdx.x == 0) *(uint4*)(lds_raw + MISC_OFF) = make_uint4(0u, 0u, 0u, 0u);
    __syncthreads();
    (void)xcd_barrier_post(pp->bar, (volatile LAS unsigned*)(lds_raw + MISC_OFF));
    PHASE(PH_ADA, 0);
    for (int l = 0; l < DEPTH; ++l) {
        if (l == 0) PHASE(PH_NORM1, l);
        PHASE(PH_WIN, l);
        PHASE(PH_POSTZ, l);
        PHASE(PH_UQKV, l);
        PHASE(PH_HEADNORM, l);
        PHASE(PH_ATTN, l);
        PHASE(PH_WOUT, l);
        PHASE(PH_NORM2, l);
        PHASE(PH_WQ, l);
        PHASE(PH_SCORES, l);
        PHASE(PH_ROUTE, l);
        PHASE(PH_EXPERTS, l);
    }
}
#else
template <int PH>
__global__ void __launch_bounds__(NTHREADS, 4) k_phase(Params p, int layer) {
    extern __shared__ float4 lds4[];
    CParams* pp = (CParams*)__builtin_amdgcn_kernarg_segment_ptr();
    run_phase<PH>(*pp, layer, blockIdx.x, gridDim.x, (float*)lds4);
}
template <int PH>
void launch_phase(const Params& p, int layer, hipStream_t stream) {
    hipLaunchKernelGGL(k_phase<PH>, dim3(1024), dim3(NTHREADS), LDS_BYTES, stream, p, layer);
}
#endif

}

extern "C" void kernel_launch(void* const* d_in, const int* in_sizes, int n_in, void* d_out, int out_size, void* d_ws, size_t ws_size, hipStream_t stream) {
    Params p{};
    const float* const* in = (const float* const*)d_in;
    p.x_prompt = in[0]; p.x_sample = in[1]; p.cache_ckv = in[2]; p.cache_kpe = in[3]; p.cache_nak = in[4]; p.cache_nav = in[5]; p.c = in[6]; p.c_ctx = in[7];
    p.ada_w = in[8]; p.ada_b = in[9]; p.norm_mix_g = in[10]; p.norm_ffn_g = in[11]; p.w_in = in[12]; p.q_norm_g = in[13]; p.w_uq = in[14]; p.kv_norm_g = in[15]; p.w_ukv = in[16];
    p.q_head_g = in[17]; p.k_head_g = in[18]; p.naq_g = in[19]; p.nak_g = in[20]; p.rel_bias = in[21]; p.conv_w = in[22]; p.w_out = in[23]; p.peer_wq = in[24]; p.sub_keys = in[25];
    p.peer_u = in[26]; p.peer_v = in[27];
    float* out = (float*)d_out;
    p.out = out;
    p.o_ckv = out + (size_t)T * D;
    p.o_kpe = p.o_ckv + (size_t)BATCH * DEPTH * SEQ * 256;
    p.o_nak = p.o_kpe + (size_t)BATCH * DEPTH * SEQ * 64;
    p.o_nav = p.o_nak + (size_t)BATCH * DEPTH * 4 * SEQ * 128;
    char* ws = (char*)d_ws; size_t off = 0;
    auto carve = [&](size_t bytes) { void* r = ws + off; off += (bytes + 255) & ~(size_t)255; return r; };
    p.bar = (unsigned*)carve(16384);
    p.ada = (float*)carve((size_t)DEPTH * 3 * 6 * D * 4);
    p.hn = (float*)carve((size_t)T * D * 4);
    p.z = (float*)carve((size_t)(T + 1) * DIN * 4);
    p.cqn = (float*)carve((size_t)T * 512 * 4);
    p.ckv = (float*)carve((size_t)TKV * 256 * 4);
    p.qm = (float*)carve((size_t)T * 1536 * 4);
    p.kvr = (float*)carve((size_t)TKV * 2048 * 4);
    p.km = (float*)carve((size_t)TKV * 1536 * 4);
    p.qna = (float*)carve((size_t)T * 512 * 4);
    p.kna = (float*)carve((size_t)T * 512 * 4);
    p.mix = (float*)carve((size_t)T * D * 4);
    p.qp = (float*)carve((size_t)T * D * 4);
    p.sc = (float*)carve((size_t)T * D * 4);
    p.gate = (float*)carve((size_t)T * 128 * 4);
    p.eidx = (int*)carve((size_t)T * 128 * 4);
    p.wt_in = (bf16_t*)carve((size_t)DEPTH * DINP * D * 2);
    p.wt_uq = (bf16_t*)carve((size_t)DEPTH * 1536 * 512 * 2);
    p.wt_ukv = (bf16_t*)carve((size_t)DEPTH * 2048 * 256 * 2);
    p.wt_out = (bf16_t*)carve((size_t)DEPTH * D * D * 2);
    p.wt_q = (bf16_t*)carve((size_t)DEPTH * D * D * 2);
    p.hn_b = (bf16_t*)carve((size_t)T * D * 2);
    p.cqn_b = (bf16_t*)carve((size_t)T * 512 * 2);
    p.ckv_b = (bf16_t*)carve((size_t)TKV * 256 * 2);
    p.mix_b = (bf16_t*)carve((size_t)T * D * 2);
    p.q_b = (bf16_t*)carve((size_t)T * 1536 * 2);
    p.pu_b = (bf16_t*)carve((size_t)DEPTH * 16384 * D * 2);
    p.pv_b = (bf16_t*)carve((size_t)DEPTH * 16384 * D * 2);
    p.k_b = (bf16_t*)carve((size_t)TKV * 1536 * 2);
    p.qna_b = (bf16_t*)carve((size_t)T * 512 * 2);
    p.kna_b = (bf16_t*)carve((size_t)T * 512 * 2);
    p.cnak_b = (bf16_t*)carve((size_t)DB * 4 * PAST * 128 * 2);
    p.vt_mla_ctx = (bf16_t*)carve((size_t)BATCH * 8 * 128 * SEQ * 2);
    p.vt_mla_lat = (bf16_t*)carve((size_t)DB * 8 * 128 * (PAST + DS) * 2);
    p.vt_na_ctx = (bf16_t*)carve((size_t)BATCH * 4 * 128 * SEQ * 2);
    p.vt_na_lat = (bf16_t*)carve((size_t)DB * 4 * 128 * DS * 2);
    p.vt_na_cache = (bf16_t*)carve((size_t)DB * 4 * 128 * PAST * 2);

#if MK_ONE_LAUNCH
    static int grid = 0;
    if (!grid) {
        int dev = 0, cus = 0, per_cu = 0;
        hipGetDevice(&dev);
        hipDeviceGetAttribute(&cus, hipDeviceAttributeMultiprocessorCount, dev);
        hipFuncSetAttribute((const void*)k_fwd, hipFuncAttributeMaxDynamicSharedMemorySize, (int)LDS_BYTES);
        hipOccupancyMaxActiveBlocksPerMultiprocessor(&per_cu, k_fwd, NTHREADS, LDS_BYTES);
        if (per_cu < 1) per_cu = 1;
        grid = cus * (per_cu < 1 ? per_cu : 1);
    }
    hipMemsetAsync(p.bar, 0, XCD_BAR_WORDS * sizeof(unsigned), stream);
    hipLaunchKernelGGL(k_fwd, dim3(grid), dim3(NTHREADS), LDS_BYTES, stream, p);
#else
    launch_phase<PH_ADA>(p, 0, stream);
    for (int l = 0; l < DEPTH; ++l) {
        if (l == 0) launch_phase<PH_NORM1>(p, l, stream);
        launch_phase<PH_WIN>(p, l, stream);
        launch_phase<PH_POSTZ>(p, l, stream);
        launch_phase<PH_UQKV>(p, l, stream);
        launch_phase<PH_HEADNORM>(p, l, stream);
        launch_phase<PH_ATTN>(p, l, stream);
        launch_phase<PH_WOUT>(p, l, stream);
        launch_phase<PH_NORM2>(p, l, stream);
        launch_phase<PH_WQ>(p, l, stream);
        launch_phase<PH_SCORES>(p, l, stream);
        launch_phase<PH_ROUTE>(p, l, stream);
        launch_phase<PH_EXPERTS>(p, l, stream);
    }
#endif
}
```

```cpp
#include <hip/hip_runtime.h>
#include <stdint.h>

#define DEVI __device__ __forceinline__

#define XB_TMO      128
#define XB_XCNT(j)  (256  + 64 * (j))
#define XB_XSUB(j)  (1280 + 64 * (j))
#define XB_XGEN(j)  (2304 + 64 * (j))
#define XB_TOP      3328
#define XB_TOPGEN   3392
#define XCD_BAR_WORDS 3456
#define XB_SPIN_CAP (1u << 18)
#define LAS __attribute__((address_space(3)))

__device__ __forceinline__ unsigned xb_ld(unsigned* p)              { return __hip_atomic_load(p, __ATOMIC_RELAXED, __HIP_MEMORY_SCOPE_AGENT); }
__device__ __forceinline__ unsigned xb_add(unsigned* p, unsigned v) { return __hip_atomic_fetch_add(p, v, __ATOMIC_RELAXED, __HIP_MEMORY_SCOPE_AGENT); }
__device__ __forceinline__ unsigned xb_xcc_id() { return (unsigned)__builtin_amdgcn_s_getreg((3 << 11) | 20) & 0xFu; }
#define XB_SPIN(cond, bar) do { unsigned _sp = 0; while (cond) { __builtin_amdgcn_s_sleep(1); \
    if ((++_sp & 255u) == 0u) { if (xb_ld(&(bar)[XB_TMO])) break; if (_sp > XB_SPIN_CAP) { atomicAdd(&(bar)[XB_TMO], 1u); break; } } } } while (0)

struct XcdBarrier {
    unsigned* bar; unsigned x;
    volatile LAS unsigned* st;
};

__device__ __forceinline__ XcdBarrier xcd_barrier_post(unsigned* bar, volatile LAS unsigned* st) {
    XcdBarrier b; b.bar = bar; b.x = xb_xcc_id(); b.st = st;
    if (threadIdx.x == 0) (void)xb_add(&bar[XB_XCNT(b.x)], 1u);
    return b;
}
__device__ __forceinline__ void xcd_barrier_complete(unsigned* bar, unsigned x, unsigned& nloc, unsigned& nx) {
    const unsigned G = gridDim.x * gridDim.y * gridDim.z;
    unsigned sum, cnt, mine, sp = 0u;
    for (;;) {
        sum = 0u; cnt = 0u; mine = 0u;
#pragma unroll
        for (unsigned j = 0; j < 16; ++j) { const unsigned c = xb_ld(&bar[XB_XCNT(j)]); sum += c; cnt += (c > 0u) ? 1u : 0u; mine = (j == x) ? c : mine; }
        if (sum == G) break;
        __builtin_amdgcn_s_sleep(1);
        if ((++sp & 255u) == 0u) { if (xb_ld(&bar[XB_TMO])) break; if (sp > XB_SPIN_CAP) { atomicAdd(&bar[XB_TMO], 1u); break; } }
    }
    nloc = mine > 0u ? mine : 1u; nx = cnt > 0u ? cnt : 1u;
}

__device__ __forceinline__ void xcd_barrier(const XcdBarrier& b) {
    asm volatile("s_waitcnt vmcnt(0)" ::: "memory");
    __syncthreads();
    if (threadIdx.x == 0) {
        unsigned* bar = b.bar;
        __builtin_amdgcn_s_waitcnt(0);
        unsigned nloc = b.st[0], nx = b.st[1];
        if (nloc == 0u) { xcd_barrier_complete(bar, b.x, nloc, nx); b.st[0] = nloc; b.st[1] = nx; }
        const unsigned old = xb_add(&bar[XB_XSUB(b.x)], 1u);
        const unsigned gen = old / nloc;
        if (old + 1u == (gen + 1u) * nloc) {
            __builtin_amdgcn_fence(__ATOMIC_RELEASE, "agent");
            asm volatile("s_waitcnt vmcnt(0)" ::: "memory");
            const unsigned og = xb_add(&bar[XB_TOP], 1u);
            const unsigned tg = og / nx;
            if (og + 1u == (tg + 1u) * nx) xb_add(&bar[XB_TOPGEN], 1u);
            else XB_SPIN(xb_ld(&bar[XB_TOPGEN]) == tg, bar);
            __builtin_amdgcn_fence(__ATOMIC_ACQUIRE, "agent");
            xb_add(&bar[XB_XGEN(b.x)], 1u);
            asm volatile("s_waitcnt vmcnt(0)" ::: "memory");
        } else {
            XB_SPIN(xb_ld(&bar[XB_XGEN(b.x)]) == gen, bar);
            __builtin_amdgcn_fence(__ATOMIC_ACQUIRE, "agent");
            asm volatile("s_waitcnt vmcnt(0)" ::: "memory");
        }
    }
    __syncthreads();
}


namespace pg8 {
#define PG8_LAS __attribute__((address_space(3)))
typedef unsigned short bf16_t;
typedef short bf16x8 __attribute__((ext_vector_type(8)));
typedef float f32x4 __attribute__((ext_vector_type(4)));
typedef unsigned u32x4 __attribute__((ext_vector_type(4)));
constexpr int BM = 256, BK = 64, HALF = 128, HTB = HALF * BK * 2  , STAGE_BYTES = 8 * HTB, NXCD = 8, WGM = 8;

__host__ __device__ __forceinline__ int lds_byte(int r, int c) { const int st = (r >> 4) * 2 + (c >> 5), rr = r & 15, cc = c & 31, ob = rr * 64 + cc * 2; return st * 1024 + (ob ^ (((ob >> 9) & 1) << 5)); }
__host__ __device__ __forceinline__ void stage_rc(int b, int& R, int& C) { const int st = b / 1024, sb = b % 1024, swz = sb ^ (((sb >> 9) & 1) << 5); R = (st >> 1) * 16 + swz / 64; C = (st & 1) * 32 + (swz % 64) / 2; }
__host__ __device__ __forceinline__ int perm32(int rho) { const int n = rho >> 4, i = rho & 15; return 8 * (i >> 2) + 4 * n + (i & 3); }

struct Unit { int pm, pn; };
struct Gemm { const bf16_t* A; const bf16_t* Bt; int M, N, K; };

struct StaticOrder {
    int nM, nN, nwg, G, c;
    __host__ __device__ void init(int M, int N, int G_, int c_) { nM = M / BM; nN = N / BM; nwg = nM * nN; G = G_; c = c_; }
    __host__ __device__ bool next(int i, Unit& u) const {
        const long L = (long)i * G + c; if (L >= nwg) return false;
        int wgid = (int)L; { const int q = nwg / NXCD, r = nwg % NXCD, xcd = wgid % NXCD, off = wgid / NXCD; wgid = (xcd < r ? xcd * (q + 1) : r * (q + 1) + (xcd - r) * q) + off; }
        const int nig = WGM * nN, gid = wgid / nig, fm = gid * WGM, gsz = (nM - fm) < WGM ? (nM - fm) : WGM;
        u.pm = fm + ((wgid % nig) % gsz); u.pn = (wgid % nig) / gsz; return true;
    }
    __device__ __forceinline__ void a_ready(const Unit&) const {}
    __device__ __forceinline__ void done(const Unit&) const {}
};

__device__ __forceinline__ unsigned cvt_pk_bf16(float lo, float hi) { unsigned r; asm volatile("v_cvt_pk_bf16_f32 %0, %1, %2" : "=v"(r) : "v"(lo), "v"(hi)); return r; }
typedef float f32x2 __attribute__((ext_vector_type(2)));
template <class Epi, class Sched, bool ALIGN_EPI = false, bool SP2 = false>
__device__ __forceinline__ void gemm_phase(PG8_LAS unsigned char* lds, const Gemm g, const Sched& S, const Epi& E) {
    int tid = threadIdx.x; asm volatile("" : "+v"(tid));
    const int wid = __builtin_amdgcn_readfirstlane(tid >> 6), lane = tid & 63, wr = wid >> 2, wc = wid & 3, fr = lane & 15, fq = lane >> 4;
    const int K = g.K, nt = K / BK;
    unsigned voffA[2], voffB[2];
#pragma unroll
    for (int i = 0; i < 2; ++i) { int R, C; stage_rc(tid * 16 + i * 8192, R, C); const int Rb = Epi::PERM ? ((R & ~31) + perm32(R & 31)) : R;
        voffA[i] = (unsigned)(R * K + C) * 2u; voffB[i] = (unsigned)(Rb * K + C) * 2u; }
    const size_t kstep = (size_t)(BK * 2);
    const size_t hstep = (size_t)HALF * K * 2;
    const size_t tstep = 2 * hstep;
    const unsigned ldsw = (unsigned)wid * 1024u;
    const int aoff = lds_byte(wr * 64 + fr, fq * 8), boff = lds_byte(wc * 32 + fr, fq * 8);
#define PG8_SA(b, h) (((b) * 2 + (h)) * HTB)
#define PG8_SB(b, h) ((4 + (b) * 2 + (h)) * HTB)
#define PG8_STAGE(bufoff, gbase, voff) do { _Pragma("unroll") for (int _i = 0; _i < 2; ++_i) \
        __builtin_amdgcn_global_load_lds((const unsigned*)((const char*)(gbase) + (voff)[_i]), (PG8_LAS unsigned*)(lds + (bufoff) + ldsw + _i * 8192), 16, 0, 0); } while (0)
#define PG8_LDA(dst, b, h) do { _Pragma("unroll") for (int m = 0; m < 4; ++m) _Pragma("unroll") for (int k = 0; k < 2; ++k) dst[m][k] = *(const PG8_LAS bf16x8*)(lds + PG8_SA(b, h) + aoff + m * 2048 + k * 1024); } while (0)
#define PG8_LDB(dst, b, h) do { _Pragma("unroll") for (int n = 0; n < 2; ++n) _Pragma("unroll") for (int k = 0; k < 2; ++k) dst[n][k] = *(const PG8_LAS bf16x8*)(lds + PG8_SB(b, h) + boff + n * 2048 + k * 1024); } while (0)
#define PG8_MMA(ai, bj, At, Bt) do { __builtin_amdgcn_s_setprio(1); _Pragma("unroll") for (int m = 0; m < 4; ++m) _Pragma("unroll") for (int n = 0; n < 2; ++n) _Pragma("unroll") for (int k = 0; k < 2; ++k) \
        acc[ai][bj][m][n] = __builtin_amdgcn_mfma_f32_16x16x32_bf16(Bt[n][k], At[m][k], acc[ai][bj][m][n], 0, 0, 0); __builtin_amdgcn_s_setprio(0); } while (0)
#define PG8_WAIT_V(n) asm volatile("s_waitcnt vmcnt(" #n ")" ::: "memory")
#define PG8_WAIT_L(n) asm volatile("s_waitcnt lgkmcnt(" #n ")" ::: "memory")
#define PG8_BAR __builtin_amdgcn_s_barrier()
#define PG8_SCHED __builtin_amdgcn_sched_barrier(0)
    Unit cur, nxt; int ui = 0;
    if (!S.next(0, cur)) return;
    f32x4 acc[2][2][4][2];
#pragma unroll
    for (int a = 0; a < 2; ++a)
#pragma unroll
        for (int b = 0; b < 2; ++b)
#pragma unroll
            for (int m = 0; m < 4; ++m)
#pragma unroll
                for (int n = 0; n < 2; ++n) acc[a][b][m][n] = (f32x4){0.f, 0.f, 0.f, 0.f};
    bf16x8 At[4][2], B0[2][2], B1[2][2];
    const char* cA = (const char*)g.A + (size_t)cur.pm * tstep; const char* cB = (const char*)g.Bt + (size_t)cur.pn * tstep;
    S.a_ready(cur);
    if constexpr (SP2) {
        PG8_STAGE(PG8_SB(0, 0), cB, voffB); PG8_STAGE(PG8_SB(0, 1), cB + hstep, voffB); PG8_STAGE(PG8_SA(0, 0), cA, voffA); PG8_STAGE(PG8_SA(0, 1), cA + hstep, voffA);
        if (wr == 1) PG8_BAR;
        PG8_WAIT_V(2); PG8_BAR;
        PG8_STAGE(PG8_SB(1, 0), cB + kstep, voffB); PG8_STAGE(PG8_SA(1, 0), cA + kstep, voffA); PG8_STAGE(PG8_SB(1, 1), cB + hstep + kstep, voffB);
        PG8_WAIT_V(6); PG8_BAR;
    } else {
        PG8_STAGE(PG8_SB(0, 0), cB, voffB); PG8_STAGE(PG8_SA(0, 0), cA, voffA); PG8_STAGE(PG8_SB(0, 1), cB + hstep, voffB); PG8_STAGE(PG8_SA(0, 1), cA + hstep, voffA);
        if (wr == 1) PG8_BAR;
        PG8_WAIT_V(4); PG8_BAR;
        PG8_STAGE(PG8_SB(1, 0), cB + kstep, voffB); PG8_STAGE(PG8_SA(1, 0), cA + kstep, voffA); PG8_STAGE(PG8_SB(1, 1), cB + hstep + kstep, voffB);
        PG8_WAIT_V(6); PG8_BAR;
    }
    for (;;) {
        const bool has_next = S.next(ui + 1, nxt);
        const char* nA = has_next ? (const char*)g.A + (size_t)nxt.pm * tstep : cA; const char* nB = has_next ? (const char*)g.Bt + (size_t)nxt.pn * tstep : cB;
        for (int t = 0; t < nt; t += 2) {
            const bool last = (t == nt - 2);
            const char* a1 = cA + (size_t)(t + 1) * kstep;
            const char* a2 = last ? nA : cA + (size_t)(t + 2) * kstep; const char* b2 = last ? nB : cB + (size_t)(t + 2) * kstep;
            const char* a3 = a2 + kstep; const char* b3 = b2 + kstep;
            if (last && has_next) S.a_ready(nxt);
            if constexpr (SP2) {
            PG8_LDB(B0, 0, 0); PG8_LDB(B1, 0, 1); PG8_SCHED; PG8_LDA(At, 0, 0); PG8_STAGE(PG8_SA(1, 1), a1 + hstep, voffA);
            PG8_WAIT_V(8); PG8_WAIT_L(0); PG8_BAR; PG8_MMA(0, 0, At, B0); PG8_MMA(0, 1, At, B1); PG8_BAR; PG8_SCHED;
            PG8_LDA(At, 0, 1); PG8_STAGE(PG8_SB(0, 0), b2, voffB); PG8_STAGE(PG8_SB(0, 1), b2 + hstep, voffB); PG8_STAGE(PG8_SA(0, 0), a2, voffA);
            PG8_WAIT_V(8); PG8_WAIT_L(0); PG8_BAR; PG8_MMA(1, 0, At, B0); PG8_MMA(1, 1, At, B1); PG8_BAR; PG8_SCHED;
            PG8_LDB(B0, 1, 0); PG8_LDB(B1, 1, 1); PG8_SCHED; PG8_LDA(At, 1, 0); PG8_STAGE(PG8_SA(0, 1), a2 + hstep, voffA);
            PG8_WAIT_V(8); PG8_WAIT_L(0); PG8_BAR; PG8_MMA(0, 0, At, B0); PG8_MMA(0, 1, At, B1); PG8_BAR; PG8_SCHED;
            PG8_LDA(At, 1, 1); PG8_STAGE(PG8_SB(1, 0), b3, voffB); PG8_STAGE(PG8_SB(1, 1), b3 + hstep, voffB); PG8_STAGE(PG8_SA(1, 0), a3, voffA);
            PG8_WAIT_V(8); PG8_WAIT_L(0); PG8_BAR; PG8_MMA(1, 0, At, B0); PG8_MMA(1, 1, At, B1); PG8_BAR; PG8_SCHED;
            } else {
            PG8_LDB(B0, 0, 0); PG8_SCHED; PG8_LDA(At, 0, 0); PG8_STAGE(PG8_SA(1, 1), a1 + hstep, voffA);
            PG8_WAIT_L(8); PG8_BAR; PG8_WAIT_L(0); PG8_MMA(0, 0, At, B0); PG8_BAR; PG8_SCHED;
            PG8_LDB(B1, 0, 1); PG8_STAGE(PG8_SB(0, 0), b2, voffB);
            PG8_BAR; PG8_WAIT_L(0); PG8_MMA(0, 1, At, B1); PG8_BAR;
            PG8_LDA(At, 0, 1); PG8_STAGE(PG8_SA(0, 0), a2, voffA);
            PG8_BAR; PG8_WAIT_L(0); PG8_MMA(1, 0, At, B0); PG8_BAR; PG8_SCHED;
            PG8_STAGE(PG8_SB(0, 1), b2 + hstep, voffB);
            PG8_WAIT_V(6); PG8_BAR; PG8_MMA(1, 1, At, B1); PG8_BAR;
            PG8_LDB(B0, 1, 0); PG8_SCHED; PG8_LDA(At, 1, 0); PG8_STAGE(PG8_SA(0, 1), a2 + hstep, voffA);
            PG8_WAIT_L(8); PG8_BAR; PG8_WAIT_L(0); PG8_MMA(0, 0, At, B0); PG8_BAR; PG8_SCHED;
            PG8_LDB(B1, 1, 1); PG8_STAGE(PG8_SB(1, 0), b3, voffB);
            PG8_BAR; PG8_WAIT_L(0); PG8_MMA(0, 1, At, B1); PG8_BAR;
            PG8_LDA(At, 1, 1); PG8_STAGE(PG8_SA(1, 0), a3, voffA);
            PG8_BAR; PG8_WAIT_L(0); PG8_MMA(1, 0, At, B0); PG8_BAR; PG8_SCHED;
            PG8_STAGE(PG8_SB(1, 1), b3 + hstep, voffB);
            PG8_WAIT_V(6); PG8_BAR; PG8_MMA(1, 1, At, B1); PG8_BAR;
            }
        }
        if constexpr (ALIGN_EPI) { if (wr == 0) PG8_BAR; }
        if constexpr (!Epi::AFTER_DRAIN) { E(acc, cur, wr, wc, fr, fq); S.done(cur); }
        if (!has_next) break;
#pragma unroll
        for (int a = 0; a < 2; ++a)
#pragma unroll
            for (int b = 0; b < 2; ++b)
#pragma unroll
                for (int m = 0; m < 4; ++m)
#pragma unroll
                    for (int n = 0; n < 2; ++n) acc[a][b][m][n] = (f32x4){0.f, 0.f, 0.f, 0.f};
        cur = nxt; cA = nA; cB = nB; ++ui;
        if constexpr (ALIGN_EPI) { if (wr == 1) PG8_BAR; }
    }
    PG8_WAIT_V(0);
    if constexpr (!ALIGN_EPI) { if (wr == 0) PG8_BAR; }
    PG8_BAR;
    if constexpr (Epi::AFTER_DRAIN) { E.fused(acc, cur, wr, wc, fr, fq, lds, wid, lane); S.done(cur); }
#undef PG8_SA
#undef PG8_SB
#undef PG8_STAGE
#undef PG8_LDA
#undef PG8_LDB
#undef PG8_MMA
#undef PG8_WAIT_V
#undef PG8_WAIT_L
#undef PG8_BAR
#undef PG8_SCHED
}
}


namespace {

constexpr int D = 2048, BATCH = 32, SEQ = 256, DEPTH = 4, DB = 2, DS = 1024, PAST = 512;
constexpr int NCTX = BATCH * SEQ, NLAT = DB * DS, T = NCTX + NLAT, TKV = T + DB * PAST;
constexpr int DIN = 3904, DINP = 4096;
constexpr int RING_OFF = 0, MISC_OFF = 131072, LDS_TOTAL = 147456;
typedef unsigned short bf16_t;
constexpr int O_CQ = 0, O_CKV = 512, O_KPE = 768, O_NAQ = 832, O_NAK = 1344, O_NAV = 1856, O_GB = 2368, O_GC = 2880, O_U = 3392;
constexpr float EPS = 1e-6f;
constexpr int NTHREADS = 512, NWAVES = NTHREADS / 64;

struct Params {
    const float *x_prompt, *x_sample, *cache_ckv, *cache_kpe, *cache_nak, *cache_nav, *c, *c_ctx;
    const float *ada_w, *ada_b, *norm_mix_g, *norm_ffn_g, *w_in, *q_norm_g, *w_uq, *kv_norm_g, *w_ukv;
    const float *q_head_g, *k_head_g, *naq_g, *nak_g, *rel_bias, *conv_w, *w_out, *peer_wq, *sub_keys, *peer_u, *peer_v;
    float* out;
    float *o_ckv, *o_kpe, *o_nak, *o_nav;
    unsigned* bar;
    float *ada, *hn, *z, *cqn, *ckv, *qm, *kvr, *km, *qna, *kna, *mix, *qp, *sc, *gate;
    int* eidx;
    unsigned short *wt_in, *wt_uq, *wt_ukv, *wt_out, *wt_q;
    unsigned short *hn_b, *cqn_b, *ckv_b, *mix_b;
    unsigned short *qp_b, *sk_b;
    unsigned short *pu_b, *pv_b;
    unsigned short *q_b, *k_b, *qna_b, *kna_b, *cnak_b;
    unsigned short *vt_mla_ctx, *vt_mla_lat, *vt_na_ctx, *vt_na_lat, *vt_na_cache;
};

typedef const __attribute__((address_space(4))) Params CParams;

DEVI int tidx() { int t = threadIdx.x; asm volatile("" : "+v"(t)); return t; }
DEVI float wave_sum(float v) {
#pragma unroll
    for (int o = 32; o > 0; o >>= 1) v += __shfl_xor(v, o);
    return v;
}
DEVI float wave_max(float v) {
#pragma unroll
    for (int o = 32; o > 0; o >>= 1) v = fmaxf(v, __shfl_xor(v, o));
    return v;
}
DEVI void wave_argmax(float& v, int& idx) {
#pragma unroll
    for (int o = 32; o > 0; o >>= 1) {
        float ov = __shfl_xor(v, o); int oi = __shfl_xor(idx, o);
        if (ov > v || (ov == v && oi < idx)) { v = ov; idx = oi; }
    }
}
typedef float f32x2_t __attribute__((ext_vector_type(2))); typedef __bf16 bf16x2_t __attribute__((ext_vector_type(2)));
DEVI unsigned cvtpk(float lo, float hi) { f32x2_t v = {lo, hi}; bf16x2_t b = __builtin_convertvector(v, bf16x2_t); return __builtin_bit_cast(unsigned, b); }
DEVI bf16_t f2bf(float v) { return (bf16_t)(cvtpk(v, 0.f) & 0xffffu); }
DEVI int cond_of(int t) { return t < NCTX ? 2 : (t - NCTX) / DS; }
DEVI const float* xrow(CParams& p, int layer, int t) {
    if (layer == 0) return t < NCTX ? p.x_prompt + (size_t)t * D : p.x_sample + (size_t)(t - NCTX) * D;
    return p.out + (size_t)t * D;
}

DEVI void phase_ada(CParams& p, int bid, int nb, float* lds) {
    float* sv = lds;
    float* red = lds + 3 * D;
    const int tid = tidx(), lane = tid & 63, w = tid >> 6;
    for (int i = tid; i < 3 * D; i += NTHREADS) {
        int j = i / D, k = i % D;
        float v = j < 2 ? p.c[j * D + k] : p.c_ctx[k];
        sv[i] = v / (1.f + __expf(-v));
    }
    __syncthreads();
    const int nitems = DEPTH * (6 * D / 64);
    for (int it = bid; it < nitems; it += nb) {
        const int l = it / (6 * D / 64), n = (it % (6 * D / 64)) * 64 + lane;
        const float* W = p.ada_w + (size_t)l * D * 6 * D + n;
        float a0 = 0.f, a1 = 0.f, a2 = 0.f;
        const int k0 = w * (D / NWAVES);
#pragma unroll 8
        for (int k = k0; k < k0 + D / NWAVES; ++k) {
            float wv = W[(size_t)k * 6 * D];
            a0 += sv[k] * wv; a1 += sv[D + k] * wv; a2 += sv[2 * D + k] * wv;
        }
        red[(w * 3 + 0) * 64 + lane] = a0; red[(w * 3 + 1) * 64 + lane] = a1; red[(w * 3 + 2) * 64 + lane] = a2;
        __syncthreads();
        if (tid < 192) {
            int j = tid / 64, ln = tid % 64;
            float s = 0.f;
            for (int ww = 0; ww < NWAVES; ++ww) s += red[(ww * 3 + j) * 64 + ln];
            int nn = (it % (6 * D / 64)) * 64 + ln;
            p.ada[((size_t)l * 3 + j) * 6 * D + nn] = s + p.ada_b[(size_t)l * 6 * D + nn];
        }
        __syncthreads();
    }
}

DEVI void phase_modnorm(CParams& p, int layer, int which, int bid, int nb) {
    const int lane = tidx() & 63, w = tidx() >> 6;
    const float* g = (which == 0 ? p.norm_mix_g : p.norm_ffn_g) + (size_t)layer * D;
    for (int t = bid * NWAVES + w; t < T; t += nb * NWAVES) {
        const float* x = which == 0 ? xrow(p, layer, t) : p.out + (size_t)t * D;
        const float* ad = p.ada + ((size_t)layer * 3 + cond_of(t)) * 6 * D + (which == 0 ? 0 : 3 * D);
        float4 v[8]; float ss = 0.f;
#pragma unroll
        for (int i = 0; i < 8; ++i) { v[i] = *(const float4*)(x + i * 256 + lane * 4); ss += v[i].x * v[i].x + v[i].y * v[i].y + v[i].z * v[i].z + v[i].w * v[i].w; }
        ss = wave_sum(ss);
        const float r = rsqrtf(ss / D + EPS);
#pragma unroll
        for (int i = 0; i < 8; ++i) {
            const int c = i * 256 + lane * 4;
            float4 gg = *(const float4*)(g + c), sh = *(const float4*)(ad + c), sc = *(const float4*)(ad + D + c), o;
            o.x = v[i].x * r * gg.x * (1.f + sc.x) + sh.x; o.y = v[i].y * r * gg.y * (1.f + sc.y) + sh.y;
            o.z = v[i].z * r * gg.z * (1.f + sc.z) + sh.z; o.w = v[i].w * r * gg.w * (1.f + sc.w) + sh.w;
            *(uint2*)(p.hn_b + (size_t)t * D + c) = make_uint2(pg8::cvt_pk_bf16(o.x, o.y), pg8::cvt_pk_bf16(o.z, o.w));
        }
    }
}

template <bool BT, class Epi>
DEVI void gemm_tile(const float* A, int lda, const float* W, int ldw, int K, int m0, int n0, const Epi& epi, float* lds) {
    float (*As)[132] = (float (*)[132])lds;
    float (*Bs)[68] = (float (*)[68])(lds + 16 * 132);
    const int tid = tidx(), tx = tid & 15, ty = tid >> 4;
    float acc[4][4];
#pragma unroll
    for (int i = 0; i < 4; ++i)
#pragma unroll
        for (int j = 0; j < 4; ++j) acc[i][j] = 0.f;
    for (int k0 = 0; k0 < K; k0 += 16) {
        {
            const int row = tid >> 2, kq = tid & 3;
            float4 v = *(const float4*)(A + (size_t)(m0 + row) * lda + k0 + kq * 4);
            As[kq * 4 + 0][row] = v.x; As[kq * 4 + 1][row] = v.y; As[kq * 4 + 2][row] = v.z; As[kq * 4 + 3][row] = v.w;
        }
        if (tid < 256) {
            if (!BT) {
                const int k = tid >> 4, n4 = tid & 15;
                float4 v = *(const float4*)(W + (size_t)(k0 + k) * ldw + n0 + n4 * 4);
                *(float4*)&Bs[k][n4 * 4] = v;
            } else {
                const int n = tid >> 2, kq = tid & 3;
                float4 v = *(const float4*)(W + (size_t)(n0 + n) * ldw + k0 + kq * 4);
                Bs[kq * 4 + 0][n] = v.x; Bs[kq * 4 + 1][n] = v.y; Bs[kq * 4 + 2][n] = v.z; Bs[kq * 4 + 3][n] = v.w;
            }
        }
        __syncthreads();
#pragma unroll
        for (int k = 0; k < 16; ++k) {
            float4 a = *(const float4*)&As[k][ty * 4], b = *(const float4*)&Bs[k][tx * 4];
            const float av[4] = {a.x, a.y, a.z, a.w}, bv[4] = {b.x, b.y, b.z, b.w};
#pragma unroll
            for (int i = 0; i < 4; ++i)
#pragma unroll
                for (int j = 0; j < 4; ++j) acc[i][j] += av[i] * bv[j];
        }
        __syncthreads();
    }
#pragma unroll
    for (int i = 0; i < 4; ++i) epi(m0 + ty * 4 + i, n0 + tx * 4, make_float4(acc[i][0], acc[i][1], acc[i][2], acc[i][3]));
}
template <bool BT, class Epi>
DEVI void gemm_f32(const float* A, int lda, const float* W, int ldw, int M, int N, int K, const Epi& epi, int bid, int nb, float* lds) {
    const int nn = N / 64, nt = (M / 128) * nn;
    for (int tile = bid; tile < nt; tile += nb) gemm_tile<BT>(A, lda, W, ldw, K, (tile / nn) * 128, (tile % nn) * 64, epi, lds);
}
struct EpiStore { float* C; int ldc; DEVI void operator()(int r, int c, float4 v) const { *(float4*)(C + (size_t)r * ldc + c) = v; } };
struct EpiResid {
    CParams* p; int layer;
    DEVI void operator()(int r, int c, float4 v) const {
        const float* x = xrow(*p, layer, r) + c;
        const float* g1 = p->ada + ((size_t)layer * 3 + cond_of(r)) * 6 * D + 2 * D + c;
        float4 xv = *(const float4*)x, gv = *(const float4*)g1, o;
        o.x = xv.x + gv.x * v.x; o.y = xv.y + gv.y * v.y; o.z = xv.z + gv.z * v.z; o.w = xv.w + gv.w * v.w;
        *(float4*)(p->out + (size_t)r * D + c) = o;
    }
};


struct EpiF32 {
    static constexpr bool PERM = false, AFTER_DRAIN = false;
    float* C; int ldc, ncols;
    DEVI void operator()(const pg8::f32x4 (&acc)[2][2][4][2], const pg8::Unit& u, int wr, int wc, int fr, int fq) const {
        const int row0 = u.pm * 256 + wr * 64 + fr, col0 = u.pn * 256 + wc * 32 + 4 * fq;
#pragma unroll
        for (int ai = 0; ai < 2; ++ai)
#pragma unroll
            for (int m = 0; m < 4; ++m) { float* rowp = C + (size_t)(row0 + ai * 128 + m * 16) * ldc;
#pragma unroll
                for (int bj = 0; bj < 2; ++bj)
#pragma unroll
                    for (int n = 0; n < 2; ++n) { const int c = col0 + bj * 128 + n * 16; if (c < ncols) *(pg8::f32x4*)(rowp + c) = acc[ai][bj][m][n]; } }
    }
};
struct EpiResidMF {
    static constexpr bool PERM = false, AFTER_DRAIN = false;
    CParams* p; int layer;
    DEVI void operator()(const pg8::f32x4 (&acc)[2][2][4][2], const pg8::Unit& u, int wr, int wc, int fr, int fq) const {
        const int row0 = u.pm * 256 + wr * 64 + fr, col0 = u.pn * 256 + wc * 32 + 4 * fq;
#pragma unroll
        for (int ai = 0; ai < 2; ++ai)
#pragma unroll
            for (int m = 0; m < 4; ++m) {
                const int r = row0 + ai * 128 + m * 16;
                const float* x = xrow(*p, layer, r);
                const float* g1 = p->ada + ((size_t)layer * 3 + cond_of(r)) * 6 * D + 2 * D;
                float* o = p->out + (size_t)r * D;
#pragma unroll
                for (int bj = 0; bj < 2; ++bj)
#pragma unroll
                    for (int n = 0; n < 2; ++n) { const int c = col0 + bj * 128 + n * 16;
                        const pg8::f32x4 xv = *(const pg8::f32x4*)(x + c), gv = *(const pg8::f32x4*)(g1 + c);
                        *(pg8::f32x4*)(o + c) = xv + gv * acc[ai][bj][m][n]; } }
    }
};
struct EpiBf16Store {
    static constexpr bool PERM = true, AFTER_DRAIN = false;
    bf16_t* O; int ldc;
    DEVI void operator()(const pg8::f32x4 (&acc)[2][2][4][2], const pg8::Unit& u, int wr, int wc, int fr, int fq) const {
        const int row0 = u.pm * 256 + wr * 64 + fr, col0 = u.pn * 256 + wc * 32 + 8 * fq;
#pragma unroll
        for (int ai = 0; ai < 2; ++ai)
#pragma unroll
            for (int m = 0; m < 4; ++m) { bf16_t* rowp = O + (size_t)(row0 + ai * 128 + m * 16) * ldc + col0;
#pragma unroll
                for (int bj = 0; bj < 2; ++bj) { const pg8::f32x4 v0 = acc[ai][bj][m][0], v1 = acc[ai][bj][m][1];
                    *(uint4*)(rowp + bj * 128) = make_uint4(cvtpk(v0[0], v0[1]), cvtpk(v0[2], v0[3]), cvtpk(v1[0], v1[1]), cvtpk(v1[2], v1[3])); } }
    }
};
template <class Epi>
DEVI void mfma_gemm(const bf16_t* A, const bf16_t* Bt, int M, int N, int K, const Epi& E, int bid, int nb, float* lds) {
    pg8::Gemm g{A, Bt, M, N, K};
    pg8::StaticOrder S; S.init(M, N, nb, bid);
    pg8::gemm_phase<Epi, pg8::StaticOrder, true, true>((PG8_LAS unsigned char*)lds + RING_OFF, g, S, E);
    __syncthreads();
}

DEVI void transpose_tile(const float* W, int ldw, bf16_t* Wt, int ldt, int k0, int n0, float* lds) {
    float (*tl)[65] = (float (*)[65])lds;
    const int tid = tidx();
#pragma unroll
    for (int rep = 0; rep < 2; ++rep) {
        const int k = (tid >> 4) + rep * 32, n4 = (tid & 15) * 4;
        const float4 v = *(const float4*)(W + (size_t)(k0 + k) * ldw + n0 + n4);
        tl[k][n4] = v.x; tl[k][n4 + 1] = v.y; tl[k][n4 + 2] = v.z; tl[k][n4 + 3] = v.w;
    }
    __syncthreads();
    {
        const int n = tid >> 3, k8 = (tid & 7) * 8;
        uint4 o;
        o.x = pg8::cvt_pk_bf16(tl[k8 + 0][n], tl[k8 + 1][n]); o.y = pg8::cvt_pk_bf16(tl[k8 + 2][n], tl[k8 + 3][n]);
        o.z = pg8::cvt_pk_bf16(tl[k8 + 4][n], tl[k8 + 5][n]); o.w = pg8::cvt_pk_bf16(tl[k8 + 6][n], tl[k8 + 7][n]);
        *(uint4*)(Wt + (size_t)(n0 + n) * ldt + k0 + k8) = o;
    }
    __syncthreads();
}
DEVI void phase_weights(CParams& p, int bid, int nb, float* lds) {
    constexpr int N_IN = 32 * 61, N_UQ = 8 * 24, N_UKV = 4 * 32, N_SQ = 32 * 32, PER = N_IN + N_UQ + N_UKV + 2 * N_SQ;
    for (int it = bid; it < DEPTH * PER; it += nb) {
        const int l = it / PER; int j = it % PER;
        if (j < N_IN) { transpose_tile(p.w_in + (size_t)l * D * DIN, DIN, p.wt_in + (size_t)l * DINP * D, D, (j / 61) * 64, (j % 61) * 64, lds); continue; }
        j -= N_IN;
        if (j < N_UQ) { transpose_tile(p.w_uq + (size_t)l * 512 * 1536, 1536, p.wt_uq + (size_t)l * 1536 * 512, 512, (j / 24) * 64, (j % 24) * 64, lds); continue; }
        j -= N_UQ;
        if (j < N_UKV) { transpose_tile(p.w_ukv + (size_t)l * 256 * 2048, 2048, p.wt_ukv + (size_t)l * 2048 * 256, 256, (j / 32) * 64, (j % 32) * 64, lds); continue; }
        j -= N_UKV;
        if (j < N_SQ) { transpose_tile(p.w_out + (size_t)l * D * D, D, p.wt_out + (size_t)l * D * D, D, (j / 32) * 64, (j % 32) * 64, lds); continue; }
        j -= N_SQ;
        transpose_tile(p.peer_wq + (size_t)l * D * D, D, p.wt_q + (size_t)l * D * D, D, (j / 32) * 64, (j % 32) * 64, lds);
    }
    for (int i = bid * NTHREADS + tidx(); i < DEPTH * 8 * 2 * 128 * 128 / 4; i += nb * NTHREADS) {
        const float4 v = *(const float4*)(p.sub_keys + (size_t)i * 4);
        *(uint2*)(p.sk_b + (size_t)i * 4) = make_uint2(cvtpk(v.x, v.y), cvtpk(v.z, v.w));
    }
    {
        const size_t n8 = (size_t)DEPTH * 16384 * D / 8;
        for (size_t i = (size_t)bid * NTHREADS + tidx(); i < n8; i += (size_t)nb * NTHREADS) {
            const float4 a0 = *(const float4*)(p.peer_u + i * 8), a1 = *(const float4*)(p.peer_u + i * 8 + 4);
            *(uint4*)(p.pu_b + i * 8) = make_uint4(cvtpk(a0.x, a0.y), cvtpk(a0.z, a0.w), cvtpk(a1.x, a1.y), cvtpk(a1.z, a1.w));
            const float4 b0 = *(const float4*)(p.peer_v + i * 8), b1 = *(const float4*)(p.peer_v + i * 8 + 4);
            *(uint4*)(p.pv_b + i * 8) = make_uint4(cvtpk(b0.x, b0.y), cvtpk(b0.z, b0.w), cvtpk(b1.x, b1.y), cvtpk(b1.z, b1.w));
        }
    }
    const int nz = DEPTH * (DINP - DIN) * D / 8;
    for (int i = bid * NTHREADS + tidx(); i < nz; i += nb * NTHREADS) {
        const int per = (DINP - DIN) * D / 8, l = i / per, r = i % per;
        *(uint4*)(p.wt_in + ((size_t)l * DINP + DIN) * D + (size_t)r * 8) = make_uint4(0u, 0u, 0u, 0u);
    }
}

DEVI void phase_postz(CParams& p, int layer, int bid, int nb) {
    const int lane = tidx() & 63, w = tidx() >> 6;
    for (int r = bid * NWAVES + w; r < TKV; r += nb * NWAVES) {
        if (r >= T) {
            const int b = (r - T) / PAST, j = (r - T) % PAST;
            const float* src = p.cache_ckv + (((size_t)b * DEPTH + layer) * PAST + j) * 256;
            { float4 v = *(const float4*)(src + lane * 4); *(uint2*)(p.ckv_b + (size_t)r * 256 + lane * 4) = make_uint2(pg8::cvt_pk_bf16(v.x, v.y), pg8::cvt_pk_bf16(v.z, v.w)); }
            continue;
        }
        const float* z = p.z + (size_t)r * DIN;
        const bool ctx = r < NCTX;
        const int b = ctx ? r / SEQ : (r - NCTX) / DS, s = ctx ? r % SEQ : (r - NCTX) % DS;
        {
            float v[8], ss = 0.f;
#pragma unroll
            for (int i = 0; i < 8; ++i) { v[i] = z[O_CQ + i * 64 + lane]; ss += v[i] * v[i]; }
            ss = wave_sum(ss); const float rr = rsqrtf(ss / 512.f + EPS);
#pragma unroll
            for (int i = 0; i < 8; ++i) p.cqn_b[(size_t)r * 512 + i * 64 + lane] = f2bf(v[i] * rr * p.q_norm_g[layer * 512 + i * 64 + lane]);
        }
        {
            float v[4], ss = 0.f;
#pragma unroll
            for (int i = 0; i < 4; ++i) { v[i] = z[O_CKV + i * 64 + lane]; ss += v[i] * v[i]; }
            ss = wave_sum(ss); const float rr = rsqrtf(ss / 256.f + EPS);
#pragma unroll
            for (int i = 0; i < 4; ++i) {
                const float o = v[i] * rr * p.kv_norm_g[layer * 256 + i * 64 + lane];
                p.ckv_b[(size_t)r * 256 + i * 64 + lane] = f2bf(o);
                if (ctx) p.o_ckv[(((size_t)b * DEPTH + layer) * SEQ + s) * 256 + i * 64 + lane] = o;
            }
        }
        if (ctx) p.o_kpe[(((size_t)b * DEPTH + layer) * SEQ + s) * 64 + lane] = z[O_KPE + lane];
#pragma unroll
        for (int h = 0; h < 4; ++h) {
            float q0 = z[O_NAQ + h * 128 + lane], q1 = z[O_NAQ + h * 128 + 64 + lane];
            float ss = wave_sum(q0 * q0 + q1 * q1); float rr = rsqrtf(ss / 128.f + EPS);
            p.qna_b[(size_t)r * 512 + h * 128 + lane] = f2bf(q0 * rr * p.naq_g[layer * 128 + lane]);
            p.qna_b[(size_t)r * 512 + h * 128 + 64 + lane] = f2bf(q1 * rr * p.naq_g[layer * 128 + 64 + lane]);
            float k0 = z[O_NAK + h * 128 + lane], k1 = z[O_NAK + h * 128 + 64 + lane];
            ss = wave_sum(k0 * k0 + k1 * k1); rr = rsqrtf(ss / 128.f + EPS);
            k0 = k0 * rr * p.nak_g[layer * 128 + lane]; k1 = k1 * rr * p.nak_g[layer * 128 + 64 + lane];
            p.kna_b[(size_t)r * 512 + h * 128 + lane] = f2bf(k0); p.kna_b[(size_t)r * 512 + h * 128 + 64 + lane] = f2bf(k1);
            if (ctx) {
                const size_t o = ((((size_t)b * DEPTH + layer) * 4 + h) * SEQ + s) * 128;
                p.o_nak[o + lane] = k0; p.o_nak[o + 64 + lane] = k1;
                p.o_nav[o + lane] = z[O_NAV + h * 128 + lane]; p.o_nav[o + 64 + lane] = z[O_NAV + h * 128 + 64 + lane];
            }
        }
        {
            const int S = ctx ? SEQ : DS;
#pragma unroll
            for (int i = 0; i < 8; ++i) {
                const int ch = i * 64 + lane;
                const float* cw = p.conv_w + ((size_t)layer * 512 + ch) * 3;
                float acc = z[O_GC + ch] * z[O_U + ch] * cw[1];
                if (s > 0) acc += (z - DIN)[O_GC + ch] * (z - DIN)[O_U + ch] * cw[0];
                if (s < S - 1) acc += (z + DIN)[O_GC + ch] * (z + DIN)[O_U + ch] * cw[2];
                p.mix_b[(size_t)r * D + 1536 + ch] = f2bf(z[O_GB + ch] * acc);
            }
        }
    }
}

DEVI float rope_angle(int pos, int j) {
    const int row = pos / 64, col = pos % 64;
    const int f = j & 15;
    const float inv = powf(10000.f, -(float)f / 16.f);
    return (j < 16 ? (float)row : (float)col) * inv;
}

DEVI void transpose_v(const float* src, size_t sstride, bf16_t* dst, int ldv, float* lds) {
    float (*tl)[129] = (float (*)[129])lds;
    const int tid = tidx();
#pragma unroll
    for (int rep = 0; rep < 4; ++rep) {
        const int row = (tid >> 5) + 16 * rep, c4 = (tid & 31) * 4;
        const float4 v = *(const float4*)(src + (size_t)row * sstride + c4);
        tl[row][c4] = v.x; tl[row][c4 + 1] = v.y; tl[row][c4 + 2] = v.z; tl[row][c4 + 3] = v.w;
    }
    __syncthreads();
    {
        const int d = tid >> 2, k16 = (tid & 3) * 16;
        uint4 o0, o1;
        o0.x = cvtpk(tl[k16 + 0][d], tl[k16 + 1][d]); o0.y = cvtpk(tl[k16 + 2][d], tl[k16 + 3][d]); o0.z = cvtpk(tl[k16 + 4][d], tl[k16 + 5][d]); o0.w = cvtpk(tl[k16 + 6][d], tl[k16 + 7][d]);
        o1.x = cvtpk(tl[k16 + 8][d], tl[k16 + 9][d]); o1.y = cvtpk(tl[k16 + 10][d], tl[k16 + 11][d]); o1.z = cvtpk(tl[k16 + 12][d], tl[k16 + 13][d]); o1.w = cvtpk(tl[k16 + 14][d], tl[k16 + 15][d]);
        bf16_t* o = dst + (size_t)d * ldv + k16;
        *(uint4*)o = o0; *(uint4*)(o + 8) = o1;
    }
    __syncthreads();
}
DEVI void phase_headnorm(CParams& p, int layer, int bid, int nb, float* lds) {
    const int lane = tidx() & 63, w = tidx() >> 6;
    const int nq = T * 8, nk = TKV * 8;
    for (int it = bid * NWAVES + w; it < nq + nk; it += nb * NWAVES) {
        const bool isq = it < nq;
        const int r = isq ? it / 8 : (it - nq) / 8, h = it % 8;
        float v0, v1, v2; const float* g; bf16_t* dst; int pos = -1;
        if (isq) {
            const float* q = p.qm + (size_t)r * 1536 + h * 192;
            v0 = q[lane]; v1 = q[64 + lane]; v2 = q[128 + lane]; g = p.q_head_g + layer * 192; dst = p.q_b + (size_t)r * 1536 + h * 192;
            if (r >= NCTX) pos = (r - NCTX) % DS;
        } else {
            const float* kv = p.kvr + (size_t)r * 2048 + h * 256;
            v0 = kv[lane]; v1 = kv[64 + lane];
            if (r < T) v2 = p.z[(size_t)r * DIN + O_KPE + lane];
            else { const int b = (r - T) / PAST, j = (r - T) % PAST; v2 = p.cache_kpe[(((size_t)b * DEPTH + layer) * PAST + j) * 64 + lane]; }
            g = p.k_head_g + layer * 192; dst = p.k_b + (size_t)r * 1536 + h * 192;
            if (r >= NCTX && r < T) pos = (r - NCTX) % DS;
        }
        const float ss = wave_sum(v0 * v0 + v1 * v1 + v2 * v2);
        const float rr = rsqrtf(ss / 192.f + EPS);
        v0 *= rr * g[lane]; v1 *= rr * g[64 + lane]; v2 *= rr * g[128 + lane];
        if (pos >= 0) {
            const float other = __shfl_xor(v2, 32);
            const float ang = rope_angle(pos, lane & 31);
            const float cs = cosf(ang), sn = sinf(ang);
            v2 = lane < 32 ? v2 * cs - other * sn : other * sn + v2 * cs;
        }
        dst[lane] = f2bf(v0); dst[64 + lane] = f2bf(v1); dst[128 + lane] = f2bf(v2);
    }
    for (int i = bid * NTHREADS + tidx(); i < DB * 4 * PAST * 128 / 4; i += nb * NTHREADS) {
        const int e = i * 4, bh = e / (PAST * 128), rem = e % (PAST * 128), b = bh / 4, h = bh % 4;
        const float4 v = *(const float4*)(p.cache_nak + (((size_t)b * DEPTH + layer) * 4 + h) * PAST * 128 + rem);
        *(uint2*)(p.cnak_b + (size_t)e) = make_uint2(cvtpk(v.x, v.y), cvtpk(v.z, v.w));
    }
    constexpr int N_MLA = (TKV / 64) * 8, N_NA = (T / 64) * 4, N_NC = DB * 4 * (PAST / 64);
    for (int it = bid; it < N_MLA + N_NA + N_NC; it += nb) {
        if (it < N_MLA) {
            const int kt = it / 8, h = it % 8, r0 = kt * 64;
            const float* src = p.kvr + (size_t)r0 * 2048 + h * 256 + 128;
            bf16_t* dst; int ldv;
            if (r0 < NCTX) { const int b = r0 / SEQ; dst = p.vt_mla_ctx + ((size_t)(b * 8 + h) * 128) * SEQ + r0 % SEQ; ldv = SEQ; }
            else if (r0 < T) { const int b = (r0 - NCTX) / DS; dst = p.vt_mla_lat + ((size_t)(b * 8 + h) * 128) * (PAST + DS) + PAST + (r0 - NCTX) % DS; ldv = PAST + DS; }
            else { const int b = (r0 - T) / PAST; dst = p.vt_mla_lat + ((size_t)(b * 8 + h) * 128) * (PAST + DS) + (r0 - T) % PAST; ldv = PAST + DS; }
            transpose_v(src, 2048, dst, ldv, lds);
        } else if (it < N_MLA + N_NA) {
            const int j = it - N_MLA, kt = j / 4, h = j % 4, r0 = kt * 64;
            const float* src = p.z + (size_t)r0 * DIN + O_NAV + h * 128;
            bf16_t* dst; int ldv;
            if (r0 < NCTX) { const int b = r0 / SEQ; dst = p.vt_na_ctx + ((size_t)(b * 4 + h) * 128) * SEQ + r0 % SEQ; ldv = SEQ; }
            else { const int b = (r0 - NCTX) / DS; dst = p.vt_na_lat + ((size_t)(b * 4 + h) * 128) * DS + (r0 - NCTX) % DS; ldv = DS; }
            transpose_v(src, DIN, dst, ldv, lds);
        } else {
            const int j = it - N_MLA - N_NA, bh = j / (PAST / 64), jt = j % (PAST / 64), b = bh / 4, h = bh % 4;
            const float* src = p.cache_nav + ((((size_t)b * DEPTH + layer) * 4 + h) * PAST + jt * 64) * 128;
            transpose_v(src, 128, p.vt_na_cache + ((size_t)(b * 4 + h) * 128) * PAST + jt * 64, PAST, lds);
        }
    }
}

typedef short bf16x8_t __attribute__((ext_vector_type(8)));
typedef float f32x16_t __attribute__((ext_vector_type(16)));
#define MFMA32(a, b, c) __builtin_amdgcn_mfma_f32_32x32x16_bf16((a), (b), (c), 0, 0, 0)
DEVI int crow(int reg, int h) { return (reg & 3) + 8 * (reg >> 2) + 4 * h; }

struct AttnUnit {
    const bf16_t* q; int qstride;
    const bf16_t *k0, *vt0; int ks0, ldv0, nt0;
    const bf16_t *k1, *vt1; int ks1, ldv1, nt1;
    const bf16_t *kl, *vtl; int nloc;
    const float* bias; int qr, c0, rs;
    bf16_t* out;
    float scale;
};

template <int DQ>
DEVI void attn_unit(const AttnUnit& u) {
    const int lane = tidx() & 63, r = lane & 31, h = lane >> 5;
    bf16x8_t qf[DQ / 16];
    {
        const bf16_t* qrow = u.q + (size_t)r * u.qstride + 8 * h;
#pragma unroll
        for (int kk = 0; kk < DQ / 16; ++kk) qf[kk] = *(const bf16x8_t*)(qrow + kk * 16);
    }
    f32x16_t ot[4];
#pragma unroll
    for (int b = 0; b < 4; ++b)
#pragma unroll
        for (int i = 0; i < 16; ++i) ot[b][i] = 0.f;
    float m = -INFINITY, l = 0.f;
    const int ntiles = u.nt0 + u.nt1 + u.nloc;
    for (int t = 0; t < ntiles; ++t) {
        const bf16_t *kp, *vp; int ks, ldv, lrow = -1, lcol = 0;
        if (t < u.nt0) { kp = u.k0 + (size_t)t * 32 * u.ks0; ks = u.ks0; vp = u.vt0 + t * 32; ldv = u.ldv0; }
        else if (t < u.nt0 + u.nt1) { const int tt = t - u.nt0; kp = u.k1 + (size_t)tt * 32 * u.ks1; ks = u.ks1; vp = u.vt1 + tt * 32; ldv = u.ldv1; }
        else { const int tt = t - u.nt0 - u.nt1; lrow = u.rs + (tt >> 1); lcol = (tt & 1) * 32; kp = u.kl + (size_t)(lrow * 64 + lcol) * 512; ks = 512; vp = u.vtl + lrow * 64 + lcol; ldv = DS; }
        f32x16_t st;
#pragma unroll
        for (int i = 0; i < 16; ++i) st[i] = 0.f;
        {
            const bf16_t* krow = kp + (size_t)r * ks + 8 * h;
#pragma unroll
            for (int kk = 0; kk < DQ / 16; ++kk) { const bf16x8_t a = *(const bf16x8_t*)(krow + kk * 16); st = MFMA32(a, qf[kk], st); }
        }
        float sv[16], mx = -INFINITY;
        if (lrow >= 0) {
            const int qc = u.c0 + r, cs = min(max(qc - 8, 0), 48);
            const float* brow = u.bias + (lrow - u.qr + 7) * 31 + (15 - qc);
#pragma unroll
            for (int i = 0; i < 16; ++i) {
                const int kc = lcol + crow(i, h);
                const bool valid = kc >= cs && kc < cs + 16;
                const float bv = valid ? brow[kc] : 0.f;
                sv[i] = valid ? st[i] * u.scale + bv : -INFINITY; mx = fmaxf(mx, sv[i]);
            }
        } else {
#pragma unroll
            for (int i = 0; i < 16; ++i) { sv[i] = st[i] * u.scale; mx = fmaxf(mx, sv[i]); }
        }
        mx = fmaxf(mx, __shfl_xor(mx, 32));
        const float mnew = fmaxf(m, mx), alpha = __expf(m - mnew);
        m = mnew;
        float ls = 0.f;
#pragma unroll
        for (int i = 0; i < 16; ++i) { sv[i] = __expf(sv[i] - mnew); ls += sv[i]; }
        l = l * alpha + ls;
#pragma unroll
        for (int b = 0; b < 4; ++b)
#pragma unroll
            for (int i = 0; i < 16; ++i) ot[b][i] *= alpha;
#pragma unroll
        for (int s2 = 0; s2 < 2; ++s2) {
            uint4 pk; pk.x = cvtpk(sv[8 * s2 + 0], sv[8 * s2 + 1]); pk.y = cvtpk(sv[8 * s2 + 2], sv[8 * s2 + 3]); pk.z = cvtpk(sv[8 * s2 + 4], sv[8 * s2 + 5]); pk.w = cvtpk(sv[8 * s2 + 6], sv[8 * s2 + 7]);
            const bf16x8_t xs = __builtin_bit_cast(bf16x8_t, pk);
#pragma unroll
            for (int b = 0; b < 4; ++b) {
                const bf16_t* vrow = vp + (size_t)(32 * b + r) * ldv + 16 * s2 + 4 * h;
                const uint2 lo = *(const uint2*)vrow, hi = *(const uint2*)(vrow + 8);
                const bf16x8_t pa = __builtin_bit_cast(bf16x8_t, make_uint4(lo.x, lo.y, hi.x, hi.y));
                ot[b] = MFMA32(pa, xs, ot[b]);
            }
        }
    }
    l += __shfl_xor(l, 32);
    const float inv = 1.f / l;
    bf16_t* orow = u.out + (size_t)r * D;
#pragma unroll
    for (int b = 0; b < 4; ++b)
#pragma unroll
        for (int g = 0; g < 4; ++g)
            *(uint2*)(orow + 32 * b + 8 * g + 4 * h) = make_uint2(cvtpk(ot[b][4 * g] * inv, ot[b][4 * g + 1] * inv), cvtpk(ot[b][4 * g + 2] * inv, ot[b][4 * g + 3] * inv));
}

DEVI void attn_dispatch(CParams& p, int layer, int kind, int idx) {
    AttnUnit u;
    u.k1 = nullptr; u.vt1 = nullptr; u.ks1 = 0; u.ldv1 = 0; u.nt1 = 0; u.kl = nullptr; u.vtl = nullptr; u.nloc = 0; u.bias = nullptr; u.qr = 0; u.c0 = 0; u.rs = 0;
    if (kind == 0) {
        const int qt = idx % 32, h = (idx / 32) % 8, b = idx / 256, t0 = NCTX + b * DS + qt * 32;
        u.q = p.q_b + (size_t)t0 * 1536 + h * 192; u.qstride = 1536; u.scale = 0.07216878364870322f;
        u.k0 = p.k_b + (size_t)(T + b * PAST) * 1536 + h * 192; u.ks0 = 1536; u.vt0 = p.vt_mla_lat + ((size_t)(b * 8 + h) * 128) * (PAST + DS); u.ldv0 = PAST + DS; u.nt0 = PAST / 32;
        u.k1 = p.k_b + (size_t)(NCTX + b * DS) * 1536 + h * 192; u.ks1 = 1536; u.vt1 = u.vt0 + PAST; u.ldv1 = PAST + DS; u.nt1 = DS / 32;
        u.out = p.mix_b + (size_t)t0 * D + h * 128;
        attn_unit<192>(u);
    } else if (kind == 1) {
        const int qt = idx % 32, h = (idx / 32) % 4, b = idx / 128, t0 = NCTX + b * DS + qt * 32;
        u.q = p.qna_b + (size_t)t0 * 512 + h * 128; u.qstride = 512; u.scale = 0.08838834764831845f;
        u.k0 = p.cnak_b + ((size_t)(b * 4 + h) * PAST) * 128; u.ks0 = 128; u.vt0 = p.vt_na_cache + ((size_t)(b * 4 + h) * 128) * PAST; u.ldv0 = PAST; u.nt0 = PAST / 32;
        u.kl = p.kna_b + (size_t)(NCTX + b * DS) * 512 + h * 128; u.vtl = p.vt_na_lat + ((size_t)(b * 4 + h) * 128) * DS; u.nloc = 16;
        u.bias = p.rel_bias + ((size_t)layer * 4 + h) * 15 * 31; u.qr = qt >> 1; u.c0 = (qt & 1) * 32; u.rs = min(max(u.qr - 4, 0), 8);
        u.out = p.mix_b + (size_t)t0 * D + 1024 + h * 128;
        attn_unit<128>(u);
    } else if (kind == 2) {
        const int qt = idx % 8, h = (idx / 8) % 8, b = idx / 64, t0 = b * SEQ + qt * 32;
        u.q = p.q_b + (size_t)t0 * 1536 + h * 192; u.qstride = 1536; u.scale = 0.07216878364870322f;
        u.k0 = p.k_b + (size_t)(b * SEQ) * 1536 + h * 192; u.ks0 = 1536; u.vt0 = p.vt_mla_ctx + ((size_t)(b * 8 + h) * 128) * SEQ; u.ldv0 = SEQ; u.nt0 = SEQ / 32;
        u.out = p.mix_b + (size_t)t0 * D + h * 128;
        attn_unit<192>(u);
    } else {
        const int qt = idx % 8, h = (idx / 8) % 4, b = idx / 32, t0 = b * SEQ + qt * 32;
        u.q = p.qna_b + (size_t)t0 * 512 + h * 128; u.qstride = 512; u.scale = 0.08838834764831845f;
        u.k0 = p.kna_b + (size_t)(b * SEQ) * 512 + h * 128; u.ks0 = 512; u.vt0 = p.vt_na_ctx + ((size_t)(b * 4 + h) * 128) * SEQ; u.ldv0 = SEQ; u.nt0 = SEQ / 32;
        u.out = p.mix_b + (size_t)t0 * D + 1024 + h * 128;
        attn_unit<128>(u);
    }
}
DEVI void phase_attn(CParams& p, int layer, int bid, int nb) {
    const int w = __builtin_amdgcn_readfirstlane(tidx() >> 6);
    constexpr int N0 = DB * 8 * (DS / 32), N1 = DB * 4 * (DS / 32), N2 = BATCH * 8 * (SEQ / 32), N3 = BATCH * 4 * (SEQ / 32);
    if (w < 2) {
        for (int it = w * nb + bid; it < N0; it += 2 * nb) attn_dispatch(p, layer, 0, it);
    } else {
        for (int it = (w - 2) * nb + bid; it < N1 + N3 + N2; it += (NWAVES - 2) * nb) {
            if (it < N1) attn_dispatch(p, layer, 1, it);
            else if (it < N1 + N3) attn_dispatch(p, layer, 3, it - N1);
            else attn_dispatch(p, layer, 2, it - N1 - N3);
        }
    }
}

template <int N, int K, int J>
DEVI void bitonic_stage(float (&v)[N]) {
#pragma unroll
    for (int i = 0; i < N; ++i) {
        const int l = i ^ J;
        if (l > i) { const bool desc = ((i & K) == 0); const float a = v[i], b = v[l], mx = fmaxf(a, b), mn = fminf(a, b); v[i] = desc ? mx : mn; v[l] = desc ? mn : mx; }
    }
}
template <int N, int K, int J> DEVI void bitonic_j(float (&v)[N]) { bitonic_stage<N, K, J>(v); if constexpr (J > 1) bitonic_j<N, K, J / 2>(v); }
template <int N, int K> DEVI void bitonic_k(float (&v)[N]) { bitonic_j<N, K, K / 2>(v); if constexpr (K < N) bitonic_k<N, K * 2>(v); }
template <int N> DEVI void bitonic_sort_desc(float (&v)[N]) { bitonic_k<N, 2>(v); }
DEVI void merge_top16(float (&a)[16], const float (&b)[16]) {
#pragma unroll
    for (int i = 0; i < 16; ++i) a[i] = fmaxf(a[i], b[15 - i]);
    bitonic_j<16, 16, 8>(a);
}
constexpr int cand_ab(int idx) { int n = 0; for (int a = 0; a < 16; ++a) for (int b = 0; b < 16; ++b) if ((a + 1) * (b + 1) <= 16) { if (n == idx) return a * 16 + b; ++n; } return -1; }
template <int CH, int I>
DEVI void cand_fill(float (&c)[16], const float (&s1)[16], const float (&s2)[16]) {
    constexpr int ab = cand_ab(CH * 16 + I);
    if constexpr (ab >= 0) c[I] = __uint_as_float((__float_as_uint(s1[ab >> 4] + s2[ab & 15]) & ~255u) | (unsigned)ab); else c[I] = -INFINITY;
    if constexpr (I + 1 < 16) cand_fill<CH, I + 1>(c, s1, s2);
}
DEVI float packkey(float v, unsigned id, unsigned mask) { return __uint_as_float((__float_as_uint(v) & ~mask) | id); }

DEVI void phase_route(CParams& p, int layer, int bid, int nb, float* lds) {
    const int lane = tidx() & 63, w = __builtin_amdgcn_readfirstlane(tidx() >> 6), r = lane & 31, h = lane >> 5;
    unsigned char* ix = (unsigned char*)lds + w * 2048;
    for (int it = bid * NWAVES + w; it < (T / 32) * 8; it += nb * NWAVES) {
        const int tt = it >> 3, hh = it & 7, t0 = tt * 32;
        float s12[2][16];
#pragma unroll
        for (int pp = 0; pp < 2; ++pp) {
            bf16x8_t qf[8];
            const bf16_t* qrow = p.qp_b + (size_t)(t0 + r) * D + hh * 256 + pp * 128 + 8 * h;
#pragma unroll
            for (int kk = 0; kk < 8; ++kk) qf[kk] = *(const bf16x8_t*)(qrow + kk * 16);
            const bf16_t* sk = p.sk_b + (((size_t)layer * 8 + hh) * 2 + pp) * 128 * 128 + (size_t)r * 128 + 8 * h;
            float top[16];
#pragma unroll
            for (int i = 0; i < 16; ++i) top[i] = -INFINITY;
#pragma unroll 1
            for (int blk = 0; blk < 4; ++blk) {
                const bf16_t* skb = sk + (size_t)blk * 32 * 128;
                asm volatile("" : "+v"(skb));
                f32x16_t acc;
#pragma unroll
                for (int i = 0; i < 16; ++i) acc[i] = 0.f;
#pragma unroll
                for (int kk = 0; kk < 8; ++kk) { const bf16x8_t a = *(const bf16x8_t*)(skb + kk * 16); acc = MFMA32(a, qf[kk], acc); }
                float c[16];
#pragma unroll
                for (int i = 0; i < 16; ++i) c[i] = packkey(acc[i], (unsigned)(32 * blk + crow(i, h)), 127u);
                bitonic_sort_desc<16>(c);
                merge_top16(top, c);
            }
            float o[16];
#pragma unroll
            for (int i = 0; i < 16; ++i) o[i] = __shfl_xor(top[i], 32);
            merge_top16(top, o);
#pragma unroll
            for (int i = 0; i < 16; ++i) { s12[pp][i] = top[i]; ix[(pp * 16 + i) * 64 + lane] = (unsigned char)(__float_as_uint(top[i]) & 127u); }
        }
        float best[16];
        {
            float c[16];
            cand_fill<0, 0>(best, s12[0], s12[1]); bitonic_sort_desc<16>(best);
            cand_fill<1, 0>(c, s12[0], s12[1]); bitonic_sort_desc<16>(c); merge_top16(best, c);
            cand_fill<2, 0>(c, s12[0], s12[1]); bitonic_sort_desc<16>(c); merge_top16(best, c);
            cand_fill<3, 0>(c, s12[0], s12[1]); bitonic_sort_desc<16>(c); merge_top16(best, c);
        }
        __builtin_amdgcn_wave_barrier();
        float g[16], sum = 0.f; int ex[16];
        const float mx = __uint_as_float(__float_as_uint(best[0]) & ~255u);
#pragma unroll
        for (int k = 0; k < 16; ++k) {
            const unsigned bits = __float_as_uint(best[k]), id = bits & 255u;
            g[k] = __expf(__uint_as_float(bits & ~255u) - mx); sum += g[k];
            ex[k] = (int)ix[(id >> 4) * 64 + lane] * 128 + (int)ix[(16 + (id & 15)) * 64 + lane];
        }
        const float inv = 1.f / sum;
        if (h == 0) {
            int* eo = p.eidx + (size_t)(t0 + r) * 128 + hh * 16; float* go = p.gate + (size_t)(t0 + r) * 128 + hh * 16;
#pragma unroll
            for (int k = 0; k < 16; k += 4) { *(int4*)(eo + k) = make_int4(ex[k], ex[k + 1], ex[k + 2], ex[k + 3]); *(float4*)(go + k) = make_float4(g[k] * inv, g[k + 1] * inv, g[k + 2] * inv, g[k + 3] * inv); }
        }
        __builtin_amdgcn_wave_barrier();
    }
}

typedef __bf16 bf16x2v __attribute__((ext_vector_type(2)));
DEVI float dot2(unsigned a, unsigned b, float c) { return __builtin_amdgcn_fdot2_f32_bf16(__builtin_bit_cast(bf16x2v, a), __builtin_bit_cast(bf16x2v, b), c, false); }
DEVI float bflo(unsigned v) { return __uint_as_float(v << 16); }
DEVI float bfhi(unsigned v) { return __uint_as_float(v & 0xffff0000u); }
DEVI void phase_experts(CParams& p, int layer, int bid, int nb, float* lds) {
    const int lane = tidx() & 63, w = tidx() >> 6;
    float* wgt = lds + w * 128;
    const bf16_t* U = p.pu_b + (size_t)layer * 16384 * D;
    const bf16_t* V = p.pv_b + (size_t)layer * 16384 * D;
    for (int t = bid * NWAVES + w; t < T; t += nb * NWAVES) {
        uint4 x[4];
#pragma unroll
        for (int j = 0; j < 4; ++j) x[j] = *(const uint4*)(p.hn_b + (size_t)t * D + j * 512 + lane * 8);
        const int* eix = p.eidx + (size_t)t * 128;
        const float* gat = p.gate + (size_t)t * 128;
        for (int c = 0; c < 16; ++c) {
            uint4 u[8][4];
#pragma unroll
            for (int e = 0; e < 8; ++e) {
                const int idx = __builtin_amdgcn_readfirstlane(eix[c * 8 + e]);
                const bf16_t* ur = U + (size_t)idx * D + lane * 8;
#pragma unroll
                for (int j = 0; j < 4; ++j) u[e][j] = *(const uint4*)(ur + j * 512);
            }
            float d[8];
#pragma unroll
            for (int e = 0; e < 8; ++e) {
                float a = 0.f;
#pragma unroll
                for (int j = 0; j < 4; ++j) { a = dot2(u[e][j].x, x[j].x, a); a = dot2(u[e][j].y, x[j].y, a); a = dot2(u[e][j].z, x[j].z, a); a = dot2(u[e][j].w, x[j].w, a); }
                d[e] = a;
            }
            const bool b5 = lane & 32, b4 = lane & 16, b3 = lane & 8;
            float r4[4];
#pragma unroll
            for (int i = 0; i < 4; ++i) { const float mine = b5 ? d[4 + i] : d[i], theirs = b5 ? d[i] : d[4 + i]; r4[i] = mine + __shfl_xor(theirs, 32); }
            float r2[2];
#pragma unroll
            for (int i = 0; i < 2; ++i) { const float mine = b4 ? r4[2 + i] : r4[i], theirs = b4 ? r4[i] : r4[2 + i]; r2[i] = mine + __shfl_xor(theirs, 16); }
            float r1;
            { const float mine = b3 ? r2[1] : r2[0], theirs = b3 ? r2[0] : r2[1]; r1 = mine + __shfl_xor(theirs, 8); }
            r1 += __shfl_xor(r1, 4); r1 += __shfl_xor(r1, 2); r1 += __shfl_xor(r1, 1);
            const int e = (lane >> 3) & 7;
            const float a = 0.5f * r1 * (1.f + erff(r1 * 0.70710678118654752f));
            if ((lane & 7) == 0) wgt[c * 8 + e] = a * gat[c * 8 + e];
        }
        __builtin_amdgcn_wave_barrier();
        float o[4][8];
#pragma unroll
        for (int j = 0; j < 4; ++j)
#pragma unroll
            for (int i = 0; i < 8; ++i) o[j][i] = 0.f;
        for (int c = 0; c < 16; ++c) {
            uint4 v[8][4];
#pragma unroll
            for (int e = 0; e < 8; ++e) {
                const int idx = __builtin_amdgcn_readfirstlane(eix[c * 8 + e]);
                const bf16_t* vr = V + (size_t)idx * D + lane * 8;
#pragma unroll
                for (int j = 0; j < 4; ++j) v[e][j] = *(const uint4*)(vr + j * 512);
            }
#pragma unroll
            for (int e = 0; e < 8; ++e) {
                const float wg = wgt[c * 8 + e];
#pragma unroll
                for (int j = 0; j < 4; ++j) {
                    o[j][0] += wg * bflo(v[e][j].x); o[j][1] += wg * bfhi(v[e][j].x); o[j][2] += wg * bflo(v[e][j].y); o[j][3] += wg * bfhi(v[e][j].y);
                    o[j][4] += wg * bflo(v[e][j].z); o[j][5] += wg * bfhi(v[e][j].z); o[j][6] += wg * bflo(v[e][j].w); o[j][7] += wg * bfhi(v[e][j].w);
                }
            }
        }
        __builtin_amdgcn_wave_barrier();
        const int cond = cond_of(t);
        const float* g2 = p.ada + ((size_t)layer * 3 + cond) * 6 * D + 5 * D;
        float* xo = p.out + (size_t)t * D;
        float ss = 0.f;
#pragma unroll
        for (int j = 0; j < 4; ++j) {
            const int cb = j * 512 + lane * 8;
#pragma unroll
            for (int q = 0; q < 2; ++q) {
                float4 xv = *(const float4*)(xo + cb + q * 4); const float4 gv = *(const float4*)(g2 + cb + q * 4);
                xv.x += gv.x * o[j][q * 4 + 0]; xv.y += gv.y * o[j][q * 4 + 1]; xv.z += gv.z * o[j][q * 4 + 2]; xv.w += gv.w * o[j][q * 4 + 3];
                *(float4*)(xo + cb + q * 4) = xv;
                o[j][q * 4 + 0] = xv.x; o[j][q * 4 + 1] = xv.y; o[j][q * 4 + 2] = xv.z; o[j][q * 4 + 3] = xv.w;
                ss += xv.x * xv.x + xv.y * xv.y + xv.z * xv.z + xv.w * xv.w;
            }
        }
        if (layer + 1 < DEPTH) {
            ss = wave_sum(ss);
            const float rr = rsqrtf(ss / D + EPS);
            const float* g = p.norm_mix_g + (size_t)(layer + 1) * D;
            const float* ad = p.ada + ((size_t)(layer + 1) * 3 + cond) * 6 * D;
#pragma unroll
            for (int j = 0; j < 4; ++j) {
                const int cb = j * 512 + lane * 8;
                float hv[8];
#pragma unroll
                for (int q = 0; q < 2; ++q) {
                    const float4 gg = *(const float4*)(g + cb + q * 4), sh = *(const float4*)(ad + cb + q * 4), sc = *(const float4*)(ad + D + cb + q * 4);
                    hv[q * 4 + 0] = o[j][q * 4 + 0] * rr * gg.x * (1.f + sc.x) + sh.x; hv[q * 4 + 1] = o[j][q * 4 + 1] * rr * gg.y * (1.f + sc.y) + sh.y;
                    hv[q * 4 + 2] = o[j][q * 4 + 2] * rr * gg.z * (1.f + sc.z) + sh.z; hv[q * 4 + 3] = o[j][q * 4 + 3] * rr * gg.w * (1.f + sc.w) + sh.w;
                }
                *(uint4*)(p.hn_b + (size_t)t * D + cb) = make_uint4(cvtpk(hv[0], hv[1]), cvtpk(hv[2], hv[3]), cvtpk(hv[4], hv[5]), cvtpk(hv[6], hv[7]));
            }
        }
    }
}

enum { PH_ADA = 0, PH_NORM1, PH_WIN, PH_POSTZ, PH_UQKV, PH_HEADNORM, PH_ATTN, PH_WOUT, PH_NORM2, PH_WQ, PH_SCORES, PH_ROUTE, PH_EXPERTS, PH_COUNT };

template <int PH>
DEVI void run_phase(CParams& p, int layer, int bid, int nb, float* lds) {
    if constexpr (PH == PH_ADA) { phase_ada(p, bid, nb, lds); phase_weights(p, bid, nb, lds); }
    if constexpr (PH == PH_NORM1) phase_modnorm(p, layer, 0, bid, nb);
    if constexpr (PH == PH_WIN) mfma_gemm(p.hn_b, p.wt_in + (size_t)layer * DINP * D, T, DINP, D, EpiF32{p.z, DIN, DIN}, bid, nb, lds);
    if constexpr (PH == PH_POSTZ) phase_postz(p, layer, bid, nb);
    if constexpr (PH == PH_UQKV) {
        mfma_gemm(p.cqn_b, p.wt_uq + (size_t)layer * 1536 * 512, T, 1536, 512, EpiF32{p.qm, 1536, 1536}, bid, nb, lds);
        mfma_gemm(p.ckv_b, p.wt_ukv + (size_t)layer * 2048 * 256, TKV, 2048, 256, EpiF32{p.kvr, 2048, 2048}, bid, nb, lds);
    }
    if constexpr (PH == PH_HEADNORM) phase_headnorm(p, layer, bid, nb, lds);
    if constexpr (PH == PH_ATTN) phase_attn(p, layer, bid, nb);
    if constexpr (PH == PH_WOUT) mfma_gemm(p.mix_b, p.wt_out + (size_t)layer * D * D, T, D, D, EpiResidMF{&p, layer}, bid, nb, lds);
    if constexpr (PH == PH_NORM2) phase_modnorm(p, layer, 1, bid, nb);
    if constexpr (PH == PH_WQ) mfma_gemm(p.hn_b, p.wt_q + (size_t)layer * D * D, T, D, D, EpiBf16Store{p.qp_b, D}, bid, nb, lds);
    if constexpr (PH == PH_ROUTE) phase_route(p, layer, bid, nb, lds);
    if constexpr (PH == PH_EXPERTS) phase_experts(p, layer, bid, nb, lds);
}

#ifndef MK_ONE_LAUNCH
#define MK_ONE_LAUNCH 1
#endif
constexpr size_t LDS_BYTES = LDS_TOTAL;

#if MK_ONE_LAUNCH
#define PHASE(PH, l) do { CParams* q_ = pp; asm volatile("" : "+s"(q_)); run_phase<PH>(*q_, l, (int)blockIdx.x, (int)gridDim.x, lds); \
    XcdBarrier b_; b_.bar = q_->bar; b_.x = xb_xcc_id(); b_.st = (volatile LAS unsigned*)(lds_raw + MISC_OFF); xcd_barrier(b_); } while (0)
__global__ void __launch_bounds__(NTHREADS, 2) k_fwd(Params p_unused) {
    CParams* pp = (CParams*)__builtin_amdgcn_kernarg_segment_ptr();
    extern __shared__ __attribute__((aligned(16))) unsigned char lds_raw[];
    float* lds = (float*)lds_raw;
    if (threadIdx.x == 0) *(uint4*)(lds_raw + MISC_OFF) = make_uint4(0u, 0u, 0u, 0u);
    __syncthreads();
    (void)xcd_barrier_post(pp->bar, (volatile LAS unsigned*)(lds_raw + MISC_OFF));
    PHASE(PH_ADA, 0);
    for (int l = 0; l < DEPTH; ++l) {
        if (l == 0) PHASE(PH_NORM1, l);
        PHASE(PH_WIN, l);
        PHASE(PH_POSTZ, l);
        PHASE(PH_UQKV, l);
        PHASE(PH_HEADNORM, l);
        PHASE(PH_ATTN, l);
        PHASE(PH_WOUT, l);
        PHASE(PH_NORM2, l);
        PHASE(PH_WQ, l);
        PHASE(PH_ROUTE, l);
        PHASE(PH_EXPERTS, l);
    }
}
#else
template <int PH>
__global__ void __launch_bounds__(NTHREADS, 4) k_phase(Params p, int layer) {
    extern __shared__ float4 lds4[];
    CParams* pp = (CParams*)__builtin_amdgcn_kernarg_segment_ptr();
    run_phase<PH>(*pp, layer, blockIdx.x, gridDim.x, (float*)lds4);
}
template <int PH>
void launch_phase(const Params& p, int layer, hipStream_t stream) {
    hipLaunchKernelGGL(k_phase<PH>, dim3(1024), dim3(NTHREADS), LDS_BYTES, stream, p, layer);
}
#endif

}

extern "C" void kernel_launch(void* const* d_in, const int* in_sizes, int n_in, void* d_out, int out_size, void* d_ws, size_t ws_size, hipStream_t stream) {
    Params p{};
    const float* const* in = (const float* const*)d_in;
    p.x_prompt = in[0]; p.x_sample = in[1]; p.cache_ckv = in[2]; p.cache_kpe = in[3]; p.cache_nak = in[4]; p.cache_nav = in[5]; p.c = in[6]; p.c_ctx = in[7];
    p.ada_w = in[8]; p.ada_b = in[9]; p.norm_mix_g = in[10]; p.norm_ffn_g = in[11]; p.w_in = in[12]; p.q_norm_g = in[13]; p.w_uq = in[14]; p.kv_norm_g = in[15]; p.w_ukv = in[16];
    p.q_head_g = in[17]; p.k_head_g = in[18]; p.naq_g = in[19]; p.nak_g = in[20]; p.rel_bias = in[21]; p.conv_w = in[22]; p.w_out = in[23]; p.peer_wq = in[24]; p.sub_keys = in[25];
    p.peer_u = in[26]; p.peer_v = in[27];
    float* out = (float*)d_out;
    p.out = out;
    p.o_ckv = out + (size_t)T * D;
    p.o_kpe = p.o_ckv + (size_t)BATCH * DEPTH * SEQ * 256;
    p.o_nak = p.o_kpe + (size_t)BATCH * DEPTH * SEQ * 64;
    p.o_nav = p.o_nak + (size_t)BATCH * DEPTH * 4 * SEQ * 128;
    char* ws = (char*)d_ws; size_t off = 0;
    auto carve = [&](size_t bytes) { void* r = ws + off; off += (bytes + 255) & ~(size_t)255; return r; };
    p.bar = (unsigned*)carve(16384);
    p.ada = (float*)carve((size_t)DEPTH * 3 * 6 * D * 4);
    p.hn = (float*)carve((size_t)T * D * 4);
    p.z = (float*)carve((size_t)(T + 1) * DIN * 4);
    p.cqn = (float*)carve((size_t)T * 512 * 4);
    p.ckv = (float*)carve((size_t)TKV * 256 * 4);
    p.qm = (float*)carve((size_t)T * 1536 * 4);
    p.kvr = (float*)carve((size_t)TKV * 2048 * 4);
    p.km = (float*)carve((size_t)TKV * 1536 * 4);
    p.qna = (float*)carve((size_t)T * 512 * 4);
    p.kna = (float*)carve((size_t)T * 512 * 4);
    p.mix = (float*)carve((size_t)T * D * 4);
    p.qp = (float*)carve((size_t)T * D * 4);
    p.sc = (float*)carve((size_t)T * D * 4);
    p.gate = (float*)carve((size_t)T * 128 * 4);
    p.eidx = (int*)carve((size_t)T * 128 * 4);
    p.wt_in = (bf16_t*)carve((size_t)DEPTH * DINP * D * 2);
    p.wt_uq = (bf16_t*)carve((size_t)DEPTH * 1536 * 512 * 2);
    p.wt_ukv = (bf16_t*)carve((size_t)DEPTH * 2048 * 256 * 2);
    p.wt_out = (bf16_t*)carve((size_t)DEPTH * D * D * 2);
    p.wt_q = (bf16_t*)carve((size_t)DEPTH * D * D * 2);
    p.hn_b = (bf16_t*)carve((size_t)T * D * 2);
    p.cqn_b = (bf16_t*)carve((size_t)T * 512 * 2);
    p.ckv_b = (bf16_t*)carve((size_t)TKV * 256 * 2);
    p.mix_b = (bf16_t*)carve((size_t)T * D * 2);
    p.q_b = (bf16_t*)carve((size_t)T * 1536 * 2);
    p.qp_b = (bf16_t*)carve((size_t)T * D * 2);
    p.sk_b = (bf16_t*)carve((size_t)DEPTH * 8 * 2 * 128 * 128 * 2);
    p.pu_b = (bf16_t*)carve((size_t)DEPTH * 16384 * D * 2);
    p.pv_b = (bf16_t*)carve((size_t)DEPTH * 16384 * D * 2);
    p.k_b = (bf16_t*)carve((size_t)TKV * 1536 * 2);
    p.qna_b = (bf16_t*)carve((size_t)T * 512 * 2);
    p.kna_b = (bf16_t*)carve((size_t)T * 512 * 2);
    p.cnak_b = (bf16_t*)carve((size_t)DB * 4 * PAST * 128 * 2);
    p.vt_mla_ctx = (bf16_t*)carve((size_t)BATCH * 8 * 128 * SEQ * 2);
    p.vt_mla_lat = (bf16_t*)carve((size_t)DB * 8 * 128 * (PAST + DS) * 2);
    p.vt_na_ctx = (bf16_t*)carve((size_t)BATCH * 4 * 128 * SEQ * 2);
    p.vt_na_lat = (bf16_t*)carve((size_t)DB * 4 * 128 * DS * 2);
    p.vt_na_cache = (bf16_t*)carve((size_t)DB * 4 * 128 * PAST * 2);

#if MK_ONE_LAUNCH
    static int grid = 0;
    if (!grid) {
        int dev = 0, cus = 0, per_cu = 0;
        hipGetDevice(&dev);
        hipDeviceGetAttribute(&cus, hipDeviceAttributeMultiprocessorCount, dev);
        hipFuncSetAttribute((const void*)k_fwd, hipFuncAttributeMaxDynamicSharedMemorySize, (int)LDS_BYTES);
        hipOccupancyMaxActiveBlocksPerMultiprocessor(&per_cu, k_fwd, NTHREADS, LDS_BYTES);
        if (per_cu < 1) per_cu = 1;
        grid = cus * (per_cu < 1 ? per_cu : 1);
    }
    hipMemsetAsync(p.bar, 0, XCD_BAR_WORDS * sizeof(unsigned), stream);
    hipLaunchKernelGGL(k_fwd, dim3(grid), dim3(NTHREADS), LDS_BYTES, stream, p);
#else
    launch_phase<PH_ADA>(p, 0, stream);
    for (int l = 0; l < DEPTH; ++l) {
        if (l == 0) launch_phase<PH_NORM1>(p, l, stream);
        launch_phase<PH_WIN>(p, l, stream);
        launch_phase<PH_POSTZ>(p, l, stream);
        launch_phase<PH_UQKV>(p, l, stream);
        launch_phase<PH_HEADNORM>(p, l, stream);
        launch_phase<PH_ATTN>(p, l, stream);
        launch_phase<PH_WOUT>(p, l, stream);
        launch_phase<PH_NORM2>(p, l, stream);
        launch_phase<PH_WQ>(p, l, stream);
        launch_phase<PH_ROUTE>(p, l, stream);
        launch_phase<PH_EXPERTS>(p, l, stream);
    }
#endif
}
```

```cpp
#include <hip/hip_runtime.h>
#include <stdint.h>

#define DEVI __device__ __forceinline__

#define XB_TMO      128
#define XB_XCNT(j)  (256  + 64 * (j))
#define XB_XSUB(j)  (1280 + 64 * (j))
#define XB_XGEN(j)  (2304 + 64 * (j))
#define XB_TOP      3328
#define XB_TOPGEN   3392
#define XCD_BAR_WORDS 3456
#define XB_SPIN_CAP (1u << 18)
#define LAS __attribute__((address_space(3)))

__device__ __forceinline__ unsigned xb_ld(unsigned* p)              { return __hip_atomic_load(p, __ATOMIC_RELAXED, __HIP_MEMORY_SCOPE_AGENT); }
__device__ __forceinline__ unsigned xb_add(unsigned* p, unsigned v) { return __hip_atomic_fetch_add(p, v, __ATOMIC_RELAXED, __HIP_MEMORY_SCOPE_AGENT); }
__device__ __forceinline__ unsigned xb_xcc_id() { return (unsigned)__builtin_amdgcn_s_getreg((3 << 11) | 20) & 0xFu; }
#define XB_SPIN(cond, bar) do { unsigned _sp = 0; while (cond) { __builtin_amdgcn_s_sleep(1); \
    if ((++_sp & 255u) == 0u) { if (xb_ld(&(bar)[XB_TMO])) break; if (_sp > XB_SPIN_CAP) { atomicAdd(&(bar)[XB_TMO], 1u); break; } } } } while (0)

struct XcdBarrier {
    unsigned* bar; unsigned x;
    volatile LAS unsigned* st;
};

__device__ __forceinline__ XcdBarrier xcd_barrier_post(unsigned* bar, volatile LAS unsigned* st) {
    XcdBarrier b; b.bar = bar; b.x = xb_xcc_id(); b.st = st;
    if (threadIdx.x == 0) (void)xb_add(&bar[XB_XCNT(b.x)], 1u);
    return b;
}
__device__ __forceinline__ void xcd_barrier_complete(unsigned* bar, unsigned x, unsigned& nloc, unsigned& nx) {
    const unsigned G = gridDim.x * gridDim.y * gridDim.z;
    unsigned sum, cnt, mine, sp = 0u;
    for (;;) {
        sum = 0u; cnt = 0u; mine = 0u;
#pragma unroll
        for (unsigned j = 0; j < 16; ++j) { const unsigned c = xb_ld(&bar[XB_XCNT(j)]); sum += c; cnt += (c > 0u) ? 1u : 0u; mine = (j == x) ? c : mine; }
        if (sum == G) break;
        __builtin_amdgcn_s_sleep(1);
        if ((++sp & 255u) == 0u) { if (xb_ld(&bar[XB_TMO])) break; if (sp > XB_SPIN_CAP) { atomicAdd(&bar[XB_TMO], 1u); break; } }
    }
    nloc = mine > 0u ? mine : 1u; nx = cnt > 0u ? cnt : 1u;
}

__device__ __forceinline__ void xcd_barrier(const XcdBarrier& b) {
    asm volatile("s_waitcnt vmcnt(0)" ::: "memory");
    __syncthreads();
    if (threadIdx.x == 0) {
        unsigned* bar = b.bar;
        __builtin_amdgcn_s_waitcnt(0);
        unsigned nloc = b.st[0], nx = b.st[1];
        if (nloc == 0u) { xcd_barrier_complete(bar, b.x, nloc, nx); b.st[0] = nloc; b.st[1] = nx; }
        const unsigned old = xb_add(&bar[XB_XSUB(b.x)], 1u);
        const unsigned gen = old / nloc;
        if (old + 1u == (gen + 1u) * nloc) {
            __builtin_amdgcn_fence(__ATOMIC_RELEASE, "agent");
            asm volatile("s_waitcnt vmcnt(0)" ::: "memory");
            const unsigned og = xb_add(&bar[XB_TOP], 1u);
            const unsigned tg = og / nx;
            if (og + 1u == (tg + 1u) * nx) xb_add(&bar[XB_TOPGEN], 1u);
            else XB_SPIN(xb_ld(&bar[XB_TOPGEN]) == tg, bar);
            __builtin_amdgcn_fence(__ATOMIC_ACQUIRE, "agent");
            xb_add(&bar[XB_XGEN(b.x)], 1u);
            asm volatile("s_waitcnt vmcnt(0)" ::: "memory");
        } else {
            XB_SPIN(xb_ld(&bar[XB_XGEN(b.x)]) == gen, bar);
            __builtin_amdgcn_fence(__ATOMIC_ACQUIRE, "agent");
            asm volatile("s_waitcnt vmcnt(0)" ::: "memory");
        }
    }
    __syncthreads();
}


namespace pg8 {
#define PG8_LAS __attribute__((address_space(3)))
typedef unsigned short bf16_t;
typedef short bf16x8 __attribute__((ext_vector_type(8)));
typedef float f32x4 __attribute__((ext_vector_type(4)));
typedef unsigned u32x4 __attribute__((ext_vector_type(4)));
constexpr int BM = 256, BK = 64, HALF = 128, HTB = HALF * BK * 2  , STAGE_BYTES = 8 * HTB, NXCD = 8, WGM = 8;

__host__ __device__ __forceinline__ int lds_byte(int r, int c) { const int st = (r >> 4) * 2 + (c >> 5), rr = r & 15, cc = c & 31, ob = rr * 64 + cc * 2; return st * 1024 + (ob ^ (((ob >> 9) & 1) << 5)); }
__host__ __device__ __forceinline__ void stage_rc(int b, int& R, int& C) { const int st = b / 1024, sb = b % 1024, swz = sb ^ (((sb >> 9) & 1) << 5); R = (st >> 1) * 16 + swz / 64; C = (st & 1) * 32 + (swz % 64) / 2; }
__host__ __device__ __forceinline__ int perm32(int rho) { const int n = rho >> 4, i = rho & 15; return 8 * (i >> 2) + 4 * n + (i & 3); }

struct Unit { int pm, pn; };
struct Gemm { const bf16_t* A; const bf16_t* Bt; int M, N, K; };

struct StaticOrder {
    int nM, nN, nwg, G, c;
    __host__ __device__ void init(int M, int N, int G_, int c_) { nM = M / BM; nN = N / BM; nwg = nM * nN; G = G_; c = c_; }
    __host__ __device__ bool next(int i, Unit& u) const {
        const long L = (long)i * G + c; if (L >= nwg) return false;
        int wgid = (int)L; { const int q = nwg / NXCD, r = nwg % NXCD, xcd = wgid % NXCD, off = wgid / NXCD; wgid = (xcd < r ? xcd * (q + 1) : r * (q + 1) + (xcd - r) * q) + off; }
        const int nig = WGM * nN, gid = wgid / nig, fm = gid * WGM, gsz = (nM - fm) < WGM ? (nM - fm) : WGM;
        u.pm = fm + ((wgid % nig) % gsz); u.pn = (wgid % nig) / gsz; return true;
    }
    __device__ __forceinline__ void a_ready(const Unit&) const {}
    __device__ __forceinline__ void done(const Unit&) const {}
};

__device__ __forceinline__ unsigned cvt_pk_bf16(float lo, float hi) { unsigned r; asm volatile("v_cvt_pk_bf16_f32 %0, %1, %2" : "=v"(r) : "v"(lo), "v"(hi)); return r; }
typedef float f32x2 __attribute__((ext_vector_type(2)));
template <class Epi, class Sched, bool ALIGN_EPI = false, bool SP2 = false>
__device__ __forceinline__ void gemm_phase(PG8_LAS unsigned char* lds, const Gemm g, const Sched& S, const Epi& E) {
    int tid = threadIdx.x; asm volatile("" : "+v"(tid));
    const int wid = __builtin_amdgcn_readfirstlane(tid >> 6), lane = tid & 63, wr = wid >> 2, wc = wid & 3, fr = lane & 15, fq = lane >> 4;
    const int K = g.K, nt = K / BK;
    unsigned voffA[2], voffB[2];
#pragma unroll
    for (int i = 0; i < 2; ++i) { int R, C; stage_rc(tid * 16 + i * 8192, R, C); const int Rb = Epi::PERM ? ((R & ~31) + perm32(R & 31)) : R;
        voffA[i] = (unsigned)(R * K + C) * 2u; voffB[i] = (unsigned)(Rb * K + C) * 2u; }
    const size_t kstep = (size_t)(BK * 2);
    const size_t hstep = (size_t)HALF * K * 2;
    const size_t tstep = 2 * hstep;
    const unsigned ldsw = (unsigned)wid * 1024u;
    const int aoff = lds_byte(wr * 64 + fr, fq * 8), boff = lds_byte(wc * 32 + fr, fq * 8);
#define PG8_SA(b, h) (((b) * 2 + (h)) * HTB)
#define PG8_SB(b, h) ((4 + (b) * 2 + (h)) * HTB)
#define PG8_STAGE(bufoff, gbase, voff) do { _Pragma("unroll") for (int _i = 0; _i < 2; ++_i) \
        __builtin_amdgcn_global_load_lds((const unsigned*)((const char*)(gbase) + (voff)[_i]), (PG8_LAS unsigned*)(lds + (bufoff) + ldsw + _i * 8192), 16, 0, 0); } while (0)
#define PG8_LDA(dst, b, h) do { _Pragma("unroll") for (int m = 0; m < 4; ++m) _Pragma("unroll") for (int k = 0; k < 2; ++k) dst[m][k] = *(const PG8_LAS bf16x8*)(lds + PG8_SA(b, h) + aoff + m * 2048 + k * 1024); } while (0)
#define PG8_LDB(dst, b, h) do { _Pragma("unroll") for (int n = 0; n < 2; ++n) _Pragma("unroll") for (int k = 0; k < 2; ++k) dst[n][k] = *(const PG8_LAS bf16x8*)(lds + PG8_SB(b, h) + boff + n * 2048 + k * 1024); } while (0)
#define PG8_MMA(ai, bj, At, Bt) do { __builtin_amdgcn_s_setprio(1); _Pragma("unroll") for (int m = 0; m < 4; ++m) _Pragma("unroll") for (int n = 0; n < 2; ++n) _Pragma("unroll") for (int k = 0; k < 2; ++k) \
        acc[ai][bj][m][n] = __builtin_amdgcn_mfma_f32_16x16x32_bf16(Bt[n][k], At[m][k], acc[ai][bj][m][n], 0, 0, 0); __builtin_amdgcn_s_setprio(0); } while (0)
#define PG8_WAIT_V(n) asm volatile("s_waitcnt vmcnt(" #n ")" ::: "memory")
#define PG8_WAIT_L(n) asm volatile("s_waitcnt lgkmcnt(" #n ")" ::: "memory")
#define PG8_BAR __builtin_amdgcn_s_barrier()
#define PG8_SCHED __builtin_amdgcn_sched_barrier(0)
    Unit cur, nxt; int ui = 0;
    if (!S.next(0, cur)) return;
    f32x4 acc[2][2][4][2];
#pragma unroll
    for (int a = 0; a < 2; ++a)
#pragma unroll
        for (int b = 0; b < 2; ++b)
#pragma unroll
            for (int m = 0; m < 4; ++m)
#pragma unroll
                for (int n = 0; n < 2; ++n) acc[a][b][m][n] = (f32x4){0.f, 0.f, 0.f, 0.f};
    bf16x8 At[4][2], B0[2][2], B1[2][2];
    const char* cA = (const char*)g.A + (size_t)cur.pm * tstep; const char* cB = (const char*)g.Bt + (size_t)cur.pn * tstep;
    S.a_ready(cur);
    if constexpr (SP2) {
        PG8_STAGE(PG8_SB(0, 0), cB, voffB); PG8_STAGE(PG8_SB(0, 1), cB + hstep, voffB); PG8_STAGE(PG8_SA(0, 0), cA, voffA); PG8_STAGE(PG8_SA(0, 1), cA + hstep, voffA);
        if (wr == 1) PG8_BAR;
        PG8_WAIT_V(2); PG8_BAR;
        PG8_STAGE(PG8_SB(1, 0), cB + kstep, voffB); PG8_STAGE(PG8_SA(1, 0), cA + kstep, voffA); PG8_STAGE(PG8_SB(1, 1), cB + hstep + kstep, voffB);
        PG8_WAIT_V(6); PG8_BAR;
    } else {
        PG8_STAGE(PG8_SB(0, 0), cB, voffB); PG8_STAGE(PG8_SA(0, 0), cA, voffA); PG8_STAGE(PG8_SB(0, 1), cB + hstep, voffB); PG8_STAGE(PG8_SA(0, 1), cA + hstep, voffA);
        if (wr == 1) PG8_BAR;
        PG8_WAIT_V(4); PG8_BAR;
        PG8_STAGE(PG8_SB(1, 0), cB + kstep, voffB); PG8_STAGE(PG8_SA(1, 0), cA + kstep, voffA); PG8_STAGE(PG8_SB(1, 1), cB + hstep + kstep, voffB);
        PG8_WAIT_V(6); PG8_BAR;
    }
    for (;;) {
        const bool has_next = S.next(ui + 1, nxt);
        const char* nA = has_next ? (const char*)g.A + (size_t)nxt.pm * tstep : cA; const char* nB = has_next ? (const char*)g.Bt + (size_t)nxt.pn * tstep : cB;
        for (int t = 0; t < nt; t += 2) {
            const bool last = (t == nt - 2);
            const char* a1 = cA + (size_t)(t + 1) * kstep;
            const char* a2 = last ? nA : cA + (size_t)(t + 2) * kstep; const char* b2 = last ? nB : cB + (size_t)(t + 2) * kstep;
            const char* a3 = a2 + kstep; const char* b3 = b2 + kstep;
            if (last && has_next) S.a_ready(nxt);
            if constexpr (SP2) {
            PG8_LDB(B0, 0, 0); PG8_LDB(B1, 0, 1); PG8_SCHED; PG8_LDA(At, 0, 0); PG8_STAGE(PG8_SA(1, 1), a1 + hstep, voffA);
            PG8_WAIT_V(8); PG8_WAIT_L(0); PG8_BAR; PG8_MMA(0, 0, At, B0); PG8_MMA(0, 1, At, B1); PG8_BAR; PG8_SCHED;
            PG8_LDA(At, 0, 1); PG8_STAGE(PG8_SB(0, 0), b2, voffB); PG8_STAGE(PG8_SB(0, 1), b2 + hstep, voffB); PG8_STAGE(PG8_SA(0, 0), a2, voffA);
            PG8_WAIT_V(8); PG8_WAIT_L(0); PG8_BAR; PG8_MMA(1, 0, At, B0); PG8_MMA(1, 1, At, B1); PG8_BAR; PG8_SCHED;
            PG8_LDB(B0, 1, 0); PG8_LDB(B1, 1, 1); PG8_SCHED; PG8_LDA(At, 1, 0); PG8_STAGE(PG8_SA(0, 1), a2 + hstep, voffA);
            PG8_WAIT_V(8); PG8_WAIT_L(0); PG8_BAR; PG8_MMA(0, 0, At, B0); PG8_MMA(0, 1, At, B1); PG8_BAR; PG8_SCHED;
            PG8_LDA(At, 1, 1); PG8_STAGE(PG8_SB(1, 0), b3, voffB); PG8_STAGE(PG8_SB(1, 1), b3 + hstep, voffB); PG8_STAGE(PG8_SA(1, 0), a3, voffA);
            PG8_WAIT_V(8); PG8_WAIT_L(0); PG8_BAR; PG8_MMA(1, 0, At, B0); PG8_MMA(1, 1, At, B1); PG8_BAR; PG8_SCHED;
            } else {
            PG8_LDB(B0, 0, 0); PG8_SCHED; PG8_LDA(At, 0, 0); PG8_STAGE(PG8_SA(1, 1), a1 + hstep, voffA);
            PG8_WAIT_L(8); PG8_BAR; PG8_WAIT_L(0); PG8_MMA(0, 0, At, B0); PG8_BAR; PG8_SCHED;
            PG8_LDB(B1, 0, 1); PG8_STAGE(PG8_SB(0, 0), b2, voffB);
            PG8_BAR; PG8_WAIT_L(0); PG8_MMA(0, 1, At, B1); PG8_BAR;
            PG8_LDA(At, 0, 1); PG8_STAGE(PG8_SA(0, 0), a2, voffA);
            PG8_BAR; PG8_WAIT_L(0); PG8_MMA(1, 0, At, B0); PG8_BAR; PG8_SCHED;
            PG8_STAGE(PG8_SB(0, 1), b2 + hstep, voffB);
            PG8_WAIT_V(6); PG8_BAR; PG8_MMA(1, 1, At, B1); PG8_BAR;
            PG8_LDB(B0, 1, 0); PG8_SCHED; PG8_LDA(At, 1, 0); PG8_STAGE(PG8_SA(0, 1), a2 + hstep, voffA);
            PG8_WAIT_L(8); PG8_BAR; PG8_WAIT_L(0); PG8_MMA(0, 0, At, B0); PG8_BAR; PG8_SCHED;
            PG8_LDB(B1, 1, 1); PG8_STAGE(PG8_SB(1, 0), b3, voffB);
            PG8_BAR; PG8_WAIT_L(0); PG8_MMA(0, 1, At, B1); PG8_BAR;
            PG8_LDA(At, 1, 1); PG8_STAGE(PG8_SA(1, 0), a3, voffA);
            PG8_BAR; PG8_WAIT_L(0); PG8_MMA(1, 0, At, B0); PG8_BAR; PG8_SCHED;
            PG8_STAGE(PG8_SB(1, 1), b3 + hstep, voffB);
            PG8_WAIT_V(6); PG8_BAR; PG8_MMA(1, 1, At, B1); PG8_BAR;
            }
        }
        if constexpr (ALIGN_EPI) { if (wr == 0) PG8_BAR; }
        if constexpr (!Epi::AFTER_DRAIN) { E(acc, cur, wr, wc, fr, fq); S.done(cur); }
        if (!has_next) break;
#pragma unroll
        for (int a = 0; a < 2; ++a)
#pragma unroll
            for (int b = 0; b < 2; ++b)
#pragma unroll
                for (int m = 0; m < 4; ++m)
#pragma unroll
                    for (int n = 0; n < 2; ++n) acc[a][b][m][n] = (f32x4){0.f, 0.f, 0.f, 0.f};
        cur = nxt; cA = nA; cB = nB; ++ui;
        if constexpr (ALIGN_EPI) { if (wr == 1) PG8_BAR; }
    }
    PG8_WAIT_V(0);
    if constexpr (!ALIGN_EPI) { if (wr == 0) PG8_BAR; }
    PG8_BAR;
    if constexpr (Epi::AFTER_DRAIN) { E.fused(acc, cur, wr, wc, fr, fq, lds, wid, lane); S.done(cur); }
#undef PG8_SA
#undef PG8_SB
#undef PG8_STAGE
#undef PG8_LDA
#undef PG8_LDB
#undef PG8_MMA
#undef PG8_WAIT_V
#undef PG8_WAIT_L
#undef PG8_BAR
#undef PG8_SCHED
}
}


namespace {

constexpr int D = 2048, BATCH = 32, SEQ = 256, DEPTH = 4, DB = 2, DS = 1024, PAST = 512;
constexpr int NCTX = BATCH * SEQ, NLAT = DB * DS, T = NCTX + NLAT, TKV = T + DB * PAST;
constexpr int DIN = 3904, DINP = 4096;
constexpr int RING_OFF = 0, MISC_OFF = 131072, LDS_TOTAL = 147456;
typedef unsigned short bf16_t;
constexpr int O_CQ = 0, O_CKV = 512, O_KPE = 768, O_NAQ = 832, O_NAK = 1344, O_NAV = 1856, O_GB = 2368, O_GC = 2880, O_U = 3392;
constexpr float EPS = 1e-6f;
constexpr int NTHREADS = 512, NWAVES = NTHREADS / 64;

struct Params {
    const float *x_prompt, *x_sample, *cache_ckv, *cache_kpe, *cache_nak, *cache_nav, *c, *c_ctx;
    const float *ada_w, *ada_b, *norm_mix_g, *norm_ffn_g, *w_in, *q_norm_g, *w_uq, *kv_norm_g, *w_ukv;
    const float *q_head_g, *k_head_g, *naq_g, *nak_g, *rel_bias, *conv_w, *w_out, *peer_wq, *sub_keys, *peer_u, *peer_v;
    float* out;
    float *o_ckv, *o_kpe, *o_nak, *o_nav;
    unsigned* bar;
    float *ada, *hn, *z, *cqn, *ckv, *qm, *kvr, *km, *qna, *kna, *mix, *qp, *sc, *gate;
    int* eidx;
    unsigned short *wt_in, *wt_uq, *wt_ukv, *wt_out, *wt_q;
    unsigned short *hn_b, *cqn_b, *ckv_b, *mix_b;
    unsigned short *qp_b, *sk_b;
    unsigned char *pu8, *pv8; float *su8, *sv8;
    unsigned short *q_b, *k_b, *qna_b, *kna_b, *cnak_b;
    unsigned short *vt_mla_ctx, *vt_mla_lat, *vt_na_ctx, *vt_na_lat, *vt_na_cache;
};

typedef const __attribute__((address_space(4))) Params CParams;

DEVI int tidx() { int t = threadIdx.x; asm volatile("" : "+v"(t)); return t; }
DEVI float wave_sum(float v) {
#pragma unroll
    for (int o = 32; o > 0; o >>= 1) v += __shfl_xor(v, o);
    return v;
}
DEVI float wave_max(float v) {
#pragma unroll
    for (int o = 32; o > 0; o >>= 1) v = fmaxf(v, __shfl_xor(v, o));
    return v;
}
DEVI void wave_argmax(float& v, int& idx) {
#pragma unroll
    for (int o = 32; o > 0; o >>= 1) {
        float ov = __shfl_xor(v, o); int oi = __shfl_xor(idx, o);
        if (ov > v || (ov == v && oi < idx)) { v = ov; idx = oi; }
    }
}
typedef float f32x2_t __attribute__((ext_vector_type(2))); typedef __bf16 bf16x2_t __attribute__((ext_vector_type(2)));
DEVI unsigned cvtpk(float lo, float hi) { f32x2_t v = {lo, hi}; bf16x2_t b = __builtin_convertvector(v, bf16x2_t); return __builtin_bit_cast(unsigned, b); }
DEVI bf16_t f2bf(float v) { return (bf16_t)(cvtpk(v, 0.f) & 0xffffu); }
DEVI int cond_of(int t) { return t < NCTX ? 2 : (t - NCTX) / DS; }
DEVI const float* xrow(CParams& p, int layer, int t) {
    if (layer == 0) return t < NCTX ? p.x_prompt + (size_t)t * D : p.x_sample + (size_t)(t - NCTX) * D;
    return p.out + (size_t)t * D;
}

DEVI void phase_ada(CParams& p, int bid, int nb, float* lds) {
    float* sv = lds;
    float* red = lds + 3 * D;
    const int tid = tidx(), lane = tid & 63, w = tid >> 6;
    for (int i = tid; i < 3 * D; i += NTHREADS) {
        int j = i / D, k = i % D;
        float v = j < 2 ? p.c[j * D + k] : p.c_ctx[k];
        sv[i] = v / (1.f + __expf(-v));
    }
    __syncthreads();
    const int nitems = DEPTH * (6 * D / 64);
    for (int it = bid; it < nitems; it += nb) {
        const int l = it / (6 * D / 64), n = (it % (6 * D / 64)) * 64 + lane;
        const float* W = p.ada_w + (size_t)l * D * 6 * D + n;
        float a0 = 0.f, a1 = 0.f, a2 = 0.f;
        const int k0 = w * (D / NWAVES);
#pragma unroll 8
        for (int k = k0; k < k0 + D / NWAVES; ++k) {
            float wv = W[(size_t)k * 6 * D];
            a0 += sv[k] * wv; a1 += sv[D + k] * wv; a2 += sv[2 * D + k] * wv;
        }
        red[(w * 3 + 0) * 64 + lane] = a0; red[(w * 3 + 1) * 64 + lane] = a1; red[(w * 3 + 2) * 64 + lane] = a2;
        __syncthreads();
        if (tid < 192) {
            int j = tid / 64, ln = tid % 64;
            float s = 0.f;
            for (int ww = 0; ww < NWAVES; ++ww) s += red[(ww * 3 + j) * 64 + ln];
            int nn = (it % (6 * D / 64)) * 64 + ln;
            p.ada[((size_t)l * 3 + j) * 6 * D + nn] = s + p.ada_b[(size_t)l * 6 * D + nn];
        }
        __syncthreads();
    }
}

DEVI void phase_modnorm(CParams& p, int layer, int which, int bid, int nb) {
    const int lane = tidx() & 63, w = tidx() >> 6;
    const float* g = (which == 0 ? p.norm_mix_g : p.norm_ffn_g) + (size_t)layer * D;
    for (int t = bid * NWAVES + w; t < T; t += nb * NWAVES) {
        const float* x = which == 0 ? xrow(p, layer, t) : p.out + (size_t)t * D;
        const float* ad = p.ada + ((size_t)layer * 3 + cond_of(t)) * 6 * D + (which == 0 ? 0 : 3 * D);
        float4 v[8]; float ss = 0.f;
#pragma unroll
        for (int i = 0; i < 8; ++i) { v[i] = *(const float4*)(x + i * 256 + lane * 4); ss += v[i].x * v[i].x + v[i].y * v[i].y + v[i].z * v[i].z + v[i].w * v[i].w; }
        ss = wave_sum(ss);
        const float r = rsqrtf(ss / D + EPS);
#pragma unroll
        for (int i = 0; i < 8; ++i) {
            const int c = i * 256 + lane * 4;
            float4 gg = *(const float4*)(g + c), sh = *(const float4*)(ad + c), sc = *(const float4*)(ad + D + c), o;
            o.x = v[i].x * r * gg.x * (1.f + sc.x) + sh.x; o.y = v[i].y * r * gg.y * (1.f + sc.y) + sh.y;
            o.z = v[i].z * r * gg.z * (1.f + sc.z) + sh.z; o.w = v[i].w * r * gg.w * (1.f + sc.w) + sh.w;
            *(uint2*)(p.hn_b + (size_t)t * D + c) = make_uint2(pg8::cvt_pk_bf16(o.x, o.y), pg8::cvt_pk_bf16(o.z, o.w));
        }
    }
}

template <bool BT, class Epi>
DEVI void gemm_tile(const float* A, int lda, const float* W, int ldw, int K, int m0, int n0, const Epi& epi, float* lds) {
    float (*As)[132] = (float (*)[132])lds;
    float (*Bs)[68] = (float (*)[68])(lds + 16 * 132);
    const int tid = tidx(), tx = tid & 15, ty = tid >> 4;
    float acc[4][4];
#pragma unroll
    for (int i = 0; i < 4; ++i)
#pragma unroll
        for (int j = 0; j < 4; ++j) acc[i][j] = 0.f;
    for (int k0 = 0; k0 < K; k0 += 16) {
        {
            const int row = tid >> 2, kq = tid & 3;
            float4 v = *(const float4*)(A + (size_t)(m0 + row) * lda + k0 + kq * 4);
            As[kq * 4 + 0][row] = v.x; As[kq * 4 + 1][row] = v.y; As[kq * 4 + 2][row] = v.z; As[kq * 4 + 3][row] = v.w;
        }
        if (tid < 256) {
            if (!BT) {
                const int k = tid >> 4, n4 = tid & 15;
                float4 v = *(const float4*)(W + (size_t)(k0 + k) * ldw + n0 + n4 * 4);
                *(float4*)&Bs[k][n4 * 4] = v;
            } else {
                const int n = tid >> 2, kq = tid & 3;
                float4 v = *(const float4*)(W + (size_t)(n0 + n) * ldw + k0 + kq * 4);
                Bs[kq * 4 + 0][n] = v.x; Bs[kq * 4 + 1][n] = v.y; Bs[kq * 4 + 2][n] = v.z; Bs[kq * 4 + 3][n] = v.w;
            }
        }
        __syncthreads();
#pragma unroll
        for (int k = 0; k < 16; ++k) {
            float4 a = *(const float4*)&As[k][ty * 4], b = *(const float4*)&Bs[k][tx * 4];
            const float av[4] = {a.x, a.y, a.z, a.w}, bv[4] = {b.x, b.y, b.z, b.w};
#pragma unroll
            for (int i = 0; i < 4; ++i)
#pragma unroll
                for (int j = 0; j < 4; ++j) acc[i][j] += av[i] * bv[j];
        }
        __syncthreads();
    }
#pragma unroll
    for (int i = 0; i < 4; ++i) epi(m0 + ty * 4 + i, n0 + tx * 4, make_float4(acc[i][0], acc[i][1], acc[i][2], acc[i][3]));
}
template <bool BT, class Epi>
DEVI void gemm_f32(const float* A, int lda, const float* W, int ldw, int M, int N, int K, const Epi& epi, int bid, int nb, float* lds) {
    const int nn = N / 64, nt = (M / 128) * nn;
    for (int tile = bid; tile < nt; tile += nb) gemm_tile<BT>(A, lda, W, ldw, K, (tile / nn) * 128, (tile % nn) * 64, epi, lds);
}
struct EpiStore { float* C; int ldc; DEVI void operator()(int r, int c, float4 v) const { *(float4*)(C + (size_t)r * ldc + c) = v; } };
struct EpiResid {
    CParams* p; int layer;
    DEVI void operator()(int r, int c, float4 v) const {
        const float* x = xrow(*p, layer, r) + c;
        const float* g1 = p->ada + ((size_t)layer * 3 + cond_of(r)) * 6 * D + 2 * D + c;
        float4 xv = *(const float4*)x, gv = *(const float4*)g1, o;
        o.x = xv.x + gv.x * v.x; o.y = xv.y + gv.y * v.y; o.z = xv.z + gv.z * v.z; o.w = xv.w + gv.w * v.w;
        *(float4*)(p->out + (size_t)r * D + c) = o;
    }
};


struct EpiF32 {
    static constexpr bool PERM = false, AFTER_DRAIN = false;
    float* C; int ldc, ncols;
    DEVI void operator()(const pg8::f32x4 (&acc)[2][2][4][2], const pg8::Unit& u, int wr, int wc, int fr, int fq) const {
        const int row0 = u.pm * 256 + wr * 64 + fr, col0 = u.pn * 256 + wc * 32 + 4 * fq;
#pragma unroll
        for (int ai = 0; ai < 2; ++ai)
#pragma unroll
            for (int m = 0; m < 4; ++m) { float* rowp = C + (size_t)(row0 + ai * 128 + m * 16) * ldc;
#pragma unroll
                for (int bj = 0; bj < 2; ++bj)
#pragma unroll
                    for (int n = 0; n < 2; ++n) { const int c = col0 + bj * 128 + n * 16; if (c < ncols) *(pg8::f32x4*)(rowp + c) = acc[ai][bj][m][n]; } }
    }
};
struct EpiResidMF {
    static constexpr bool PERM = false, AFTER_DRAIN = false;
    CParams* p; int layer;
    DEVI void operator()(const pg8::f32x4 (&acc)[2][2][4][2], const pg8::Unit& u, int wr, int wc, int fr, int fq) const {
        const int row0 = u.pm * 256 + wr * 64 + fr, col0 = u.pn * 256 + wc * 32 + 4 * fq;
#pragma unroll
        for (int ai = 0; ai < 2; ++ai)
#pragma unroll
            for (int m = 0; m < 4; ++m) {
                const int r = row0 + ai * 128 + m * 16;
                const float* x = xrow(*p, layer, r);
                const float* g1 = p->ada + ((size_t)layer * 3 + cond_of(r)) * 6 * D + 2 * D;
                float* o = p->out + (size_t)r * D;
#pragma unroll
                for (int bj = 0; bj < 2; ++bj)
#pragma unroll
                    for (int n = 0; n < 2; ++n) { const int c = col0 + bj * 128 + n * 16;
                        const pg8::f32x4 xv = *(const pg8::f32x4*)(x + c), gv = *(const pg8::f32x4*)(g1 + c);
                        *(pg8::f32x4*)(o + c) = xv + gv * acc[ai][bj][m][n]; } }
    }
};
struct EpiBf16Store {
    static constexpr bool PERM = true, AFTER_DRAIN = false;
    bf16_t* O; int ldc;
    DEVI void operator()(const pg8::f32x4 (&acc)[2][2][4][2], const pg8::Unit& u, int wr, int wc, int fr, int fq) const {
        const int row0 = u.pm * 256 + wr * 64 + fr, col0 = u.pn * 256 + wc * 32 + 8 * fq;
#pragma unroll
        for (int ai = 0; ai < 2; ++ai)
#pragma unroll
            for (int m = 0; m < 4; ++m) { bf16_t* rowp = O + (size_t)(row0 + ai * 128 + m * 16) * ldc + col0;
#pragma unroll
                for (int bj = 0; bj < 2; ++bj) { const pg8::f32x4 v0 = acc[ai][bj][m][0], v1 = acc[ai][bj][m][1];
                    *(uint4*)(rowp + bj * 128) = make_uint4(cvtpk(v0[0], v0[1]), cvtpk(v0[2], v0[3]), cvtpk(v1[0], v1[1]), cvtpk(v1[2], v1[3])); } }
    }
};
template <class Epi>
DEVI void mfma_gemm(const bf16_t* A, const bf16_t* Bt, int M, int N, int K, const Epi& E, int bid, int nb, float* lds) {
    pg8::Gemm g{A, Bt, M, N, K};
    pg8::StaticOrder S; S.init(M, N, nb, bid);
    pg8::gemm_phase<Epi, pg8::StaticOrder, true, true>((PG8_LAS unsigned char*)lds + RING_OFF, g, S, E);
    __syncthreads();
}

DEVI void transpose_tile(const float* W, int ldw, bf16_t* Wt, int ldt, int k0, int n0, float* lds) {
    float (*tl)[65] = (float (*)[65])lds;
    const int tid = tidx();
#pragma unroll
    for (int rep = 0; rep < 2; ++rep) {
        const int k = (tid >> 4) + rep * 32, n4 = (tid & 15) * 4;
        const float4 v = *(const float4*)(W + (size_t)(k0 + k) * ldw + n0 + n4);
        tl[k][n4] = v.x; tl[k][n4 + 1] = v.y; tl[k][n4 + 2] = v.z; tl[k][n4 + 3] = v.w;
    }
    __syncthreads();
    {
        const int n = tid >> 3, k8 = (tid & 7) * 8;
        uint4 o;
        o.x = pg8::cvt_pk_bf16(tl[k8 + 0][n], tl[k8 + 1][n]); o.y = pg8::cvt_pk_bf16(tl[k8 + 2][n], tl[k8 + 3][n]);
        o.z = pg8::cvt_pk_bf16(tl[k8 + 4][n], tl[k8 + 5][n]); o.w = pg8::cvt_pk_bf16(tl[k8 + 6][n], tl[k8 + 7][n]);
        *(uint4*)(Wt + (size_t)(n0 + n) * ldt + k0 + k8) = o;
    }
    __syncthreads();
}
DEVI void phase_weights(CParams& p, int bid, int nb, float* lds) {
    constexpr int N_IN = 32 * 61, N_UQ = 8 * 24, N_UKV = 4 * 32, N_SQ = 32 * 32, PER = N_IN + N_UQ + N_UKV + 2 * N_SQ;
    for (int it = bid; it < DEPTH * PER; it += nb) {
        const int l = it / PER; int j = it % PER;
        if (j < N_IN) { transpose_tile(p.w_in + (size_t)l * D * DIN, DIN, p.wt_in + (size_t)l * DINP * D, D, (j / 61) * 64, (j % 61) * 64, lds); continue; }
        j -= N_IN;
        if (j < N_UQ) { transpose_tile(p.w_uq + (size_t)l * 512 * 1536, 1536, p.wt_uq + (size_t)l * 1536 * 512, 512, (j / 24) * 64, (j % 24) * 64, lds); continue; }
        j -= N_UQ;
        if (j < N_UKV) { transpose_tile(p.w_ukv + (size_t)l * 256 * 2048, 2048, p.wt_ukv + (size_t)l * 2048 * 256, 256, (j / 32) * 64, (j % 32) * 64, lds); continue; }
        j -= N_UKV;
        if (j < N_SQ) { transpose_tile(p.w_out + (size_t)l * D * D, D, p.wt_out + (size_t)l * D * D, D, (j / 32) * 64, (j % 32) * 64, lds); continue; }
        j -= N_SQ;
        transpose_tile(p.peer_wq + (size_t)l * D * D, D, p.wt_q + (size_t)l * D * D, D, (j / 32) * 64, (j % 32) * 64, lds);
    }
    for (int i = bid * NTHREADS + tidx(); i < DEPTH * 8 * 2 * 128 * 128 / 4; i += nb * NTHREADS) {
        const float4 v = *(const float4*)(p.sub_keys + (size_t)i * 4);
        *(uint2*)(p.sk_b + (size_t)i * 4) = make_uint2(cvtpk(v.x, v.y), cvtpk(v.z, v.w));
    }
    {
        const int lane = tidx() & 63, w = tidx() >> 6;
        for (int row = bid * NWAVES + w; row < 2 * DEPTH * 16384; row += nb * NWAVES) {
            const bool isv = row >= DEPTH * 16384; const int rr = isv ? row - DEPTH * 16384 : row;
            const float* src = (isv ? p.peer_v : p.peer_u) + (size_t)rr * D;
            float4 v[8]; float mx = 0.f;
#pragma unroll
            for (int i = 0; i < 8; ++i) { v[i] = *(const float4*)(src + i * 256 + lane * 4); mx = fmaxf(mx, fmaxf(fmaxf(fabsf(v[i].x), fabsf(v[i].y)), fmaxf(fabsf(v[i].z), fabsf(v[i].w)))); }
            mx = wave_max(mx);
            const float scale = mx > 0.f ? mx * (1.f / 440.f) : 1.f, inv = 1.f / scale;
            unsigned char* dst = (isv ? p.pv8 : p.pu8) + (size_t)rr * D;
#pragma unroll
            for (int i = 0; i < 8; ++i) {
                int pk = 0;
                pk = __builtin_amdgcn_cvt_pk_fp8_f32(v[i].x * inv, v[i].y * inv, pk, false);
                pk = __builtin_amdgcn_cvt_pk_fp8_f32(v[i].z * inv, v[i].w * inv, pk, true);
                *(int*)(dst + i * 256 + lane * 4) = pk;
            }
            if (lane == 0) (isv ? p.sv8 : p.su8)[rr] = scale;
        }
    }
    const int nz = DEPTH * (DINP - DIN) * D / 8;
    for (int i = bid * NTHREADS + tidx(); i < nz; i += nb * NTHREADS) {
        const int per = (DINP - DIN) * D / 8, l = i / per, r = i % per;
        *(uint4*)(p.wt_in + ((size_t)l * DINP + DIN) * D + (size_t)r * 8) = make_uint4(0u, 0u, 0u, 0u);
    }
}

DEVI void phase_postz(CParams& p, int layer, int bid, int nb) {
    const int lane = tidx() & 63, w = tidx() >> 6;
    for (int r = bid * NWAVES + w; r < TKV; r += nb * NWAVES) {
        if (r >= T) {
            const int b = (r - T) / PAST, j = (r - T) % PAST;
            const float* src = p.cache_ckv + (((size_t)b * DEPTH + layer) * PAST + j) * 256;
            { float4 v = *(const float4*)(src + lane * 4); *(uint2*)(p.ckv_b + (size_t)r * 256 + lane * 4) = make_uint2(pg8::cvt_pk_bf16(v.x, v.y), pg8::cvt_pk_bf16(v.z, v.w)); }
            continue;
        }
        const float* z = p.z + (size_t)r * DIN;
        const bool ctx = r < NCTX;
        const int b = ctx ? r / SEQ : (r - NCTX) / DS, s = ctx ? r % SEQ : (r - NCTX) % DS;
        {
            float v[8], ss = 0.f;
#pragma unroll
            for (int i = 0; i < 8; ++i) { v[i] = z[O_CQ + i * 64 + lane]; ss += v[i] * v[i]; }
            ss = wave_sum(ss); const float rr = rsqrtf(ss / 512.f + EPS);
#pragma unroll
            for (int i = 0; i < 8; ++i) p.cqn_b[(size_t)r * 512 + i * 64 + lane] = f2bf(v[i] * rr * p.q_norm_g[layer * 512 + i * 64 + lane]);
        }
        {
            float v[4], ss = 0.f;
#pragma unroll
            for (int i = 0; i < 4; ++i) { v[i] = z[O_CKV + i * 64 + lane]; ss += v[i] * v[i]; }
            ss = wave_sum(ss); const float rr = rsqrtf(ss / 256.f + EPS);
#pragma unroll
            for (int i = 0; i < 4; ++i) {
                const float o = v[i] * rr * p.kv_norm_g[layer * 256 + i * 64 + lane];
                p.ckv_b[(size_t)r * 256 + i * 64 + lane] = f2bf(o);
                if (ctx) p.o_ckv[(((size_t)b * DEPTH + layer) * SEQ + s) * 256 + i * 64 + lane] = o;
            }
        }
        if (ctx) p.o_kpe[(((size_t)b * DEPTH + layer) * SEQ + s) * 64 + lane] = z[O_KPE + lane];
#pragma unroll
        for (int h = 0; h < 4; ++h) {
            float q0 = z[O_NAQ + h * 128 + lane], q1 = z[O_NAQ + h * 128 + 64 + lane];
            float ss = wave_sum(q0 * q0 + q1 * q1); float rr = rsqrtf(ss / 128.f + EPS);
            p.qna_b[(size_t)r * 512 + h * 128 + lane] = f2bf(q0 * rr * p.naq_g[layer * 128 + lane]);
            p.qna_b[(size_t)r * 512 + h * 128 + 64 + lane] = f2bf(q1 * rr * p.naq_g[layer * 128 + 64 + lane]);
            float k0 = z[O_NAK + h * 128 + lane], k1 = z[O_NAK + h * 128 + 64 + lane];
            ss = wave_sum(k0 * k0 + k1 * k1); rr = rsqrtf(ss / 128.f + EPS);
            k0 = k0 * rr * p.nak_g[layer * 128 + lane]; k1 = k1 * rr * p.nak_g[layer * 128 + 64 + lane];
            p.kna_b[(size_t)r * 512 + h * 128 + lane] = f2bf(k0); p.kna_b[(size_t)r * 512 + h * 128 + 64 + lane] = f2bf(k1);
            if (ctx) {
                const size_t o = ((((size_t)b * DEPTH + layer) * 4 + h) * SEQ + s) * 128;
                p.o_nak[o + lane] = k0; p.o_nak[o + 64 + lane] = k1;
                p.o_nav[o + lane] = z[O_NAV + h * 128 + lane]; p.o_nav[o + 64 + lane] = z[O_NAV + h * 128 + 64 + lane];
            }
        }
        {
            const int S = ctx ? SEQ : DS;
#pragma unroll
            for (int i = 0; i < 8; ++i) {
                const int ch = i * 64 + lane;
                const float* cw = p.conv_w + ((size_t)layer * 512 + ch) * 3;
                float acc = z[O_GC + ch] * z[O_U + ch] * cw[1];
                if (s > 0) acc += (z - DIN)[O_GC + ch] * (z - DIN)[O_U + ch] * cw[0];
                if (s < S - 1) acc += (z + DIN)[O_GC + ch] * (z + DIN)[O_U + ch] * cw[2];
                p.mix_b[(size_t)r * D + 1536 + ch] = f2bf(z[O_GB + ch] * acc);
            }
        }
    }
}

DEVI float rope_angle(int pos, int j) {
    const int row = pos / 64, col = pos % 64;
    const int f = j & 15;
    const float inv = powf(10000.f, -(float)f / 16.f);
    return (j < 16 ? (float)row : (float)col) * inv;
}

DEVI void transpose_v(const float* src, size_t sstride, bf16_t* dst, int ldv, float* lds) {
    float (*tl)[129] = (float (*)[129])lds;
    const int tid = tidx();
#pragma unroll
    for (int rep = 0; rep < 4; ++rep) {
        const int row = (tid >> 5) + 16 * rep, c4 = (tid & 31) * 4;
        const float4 v = *(const float4*)(src + (size_t)row * sstride + c4);
        tl[row][c4] = v.x; tl[row][c4 + 1] = v.y; tl[row][c4 + 2] = v.z; tl[row][c4 + 3] = v.w;
    }
    __syncthreads();
    {
        const int d = tid >> 2, k16 = (tid & 3) * 16;
        uint4 o0, o1;
        o0.x = cvtpk(tl[k16 + 0][d], tl[k16 + 1][d]); o0.y = cvtpk(tl[k16 + 2][d], tl[k16 + 3][d]); o0.z = cvtpk(tl[k16 + 4][d], tl[k16 + 5][d]); o0.w = cvtpk(tl[k16 + 6][d], tl[k16 + 7][d]);
        o1.x = cvtpk(tl[k16 + 8][d], tl[k16 + 9][d]); o1.y = cvtpk(tl[k16 + 10][d], tl[k16 + 11][d]); o1.z = cvtpk(tl[k16 + 12][d], tl[k16 + 13][d]); o1.w = cvtpk(tl[k16 + 14][d], tl[k16 + 15][d]);
        bf16_t* o = dst + (size_t)d * ldv + k16;
        *(uint4*)o = o0; *(uint4*)(o + 8) = o1;
    }
    __syncthreads();
}
DEVI void phase_headnorm(CParams& p, int layer, int bid, int nb, float* lds) {
    const int lane = tidx() & 63, w = tidx() >> 6;
    const int nq = T * 8, nk = TKV * 8;
    for (int it = bid * NWAVES + w; it < nq + nk; it += nb * NWAVES) {
        const bool isq = it < nq;
        const int r = isq ? it / 8 : (it - nq) / 8, h = it % 8;
        float v0, v1, v2; const float* g; bf16_t* dst; int pos = -1;
        if (isq) {
            const float* q = p.qm + (size_t)r * 1536 + h * 192;
            v0 = q[lane]; v1 = q[64 + lane]; v2 = q[128 + lane]; g = p.q_head_g + layer * 192; dst = p.q_b + (size_t)r * 1536 + h * 192;
            if (r >= NCTX) pos = (r - NCTX) % DS;
        } else {
            const float* kv = p.kvr + (size_t)r * 2048 + h * 256;
            v0 = kv[lane]; v1 = kv[64 + lane];
            if (r < T) v2 = p.z[(size_t)r * DIN + O_KPE + lane];
            else { const int b = (r - T) / PAST, j = (r - T) % PAST; v2 = p.cache_kpe[(((size_t)b * DEPTH + layer) * PAST + j) * 64 + lane]; }
            g = p.k_head_g + layer * 192; dst = p.k_b + (size_t)r * 1536 + h * 192;
            if (r >= NCTX && r < T) pos = (r - NCTX) % DS;
        }
        const float ss = wave_sum(v0 * v0 + v1 * v1 + v2 * v2);
        const float rr = rsqrtf(ss / 192.f + EPS);
        v0 *= rr * g[lane]; v1 *= rr * g[64 + lane]; v2 *= rr * g[128 + lane];
        if (pos >= 0) {
            const float other = __shfl_xor(v2, 32);
            const float ang = rope_angle(pos, lane & 31);
            const float cs = cosf(ang), sn = sinf(ang);
            v2 = lane < 32 ? v2 * cs - other * sn : other * sn + v2 * cs;
        }
        dst[lane] = f2bf(v0); dst[64 + lane] = f2bf(v1); dst[128 + lane] = f2bf(v2);
    }
    for (int i = bid * NTHREADS + tidx(); i < DB * 4 * PAST * 128 / 4; i += nb * NTHREADS) {
        const int e = i * 4, bh = e / (PAST * 128), rem = e % (PAST * 128), b = bh / 4, h = bh % 4;
        const float4 v = *(const float4*)(p.cache_nak + (((size_t)b * DEPTH + layer) * 4 + h) * PAST * 128 + rem);
        *(uint2*)(p.cnak_b + (size_t)e) = make_uint2(cvtpk(v.x, v.y), cvtpk(v.z, v.w));
    }
    constexpr int N_MLA = (TKV / 64) * 8, N_NA = (T / 64) * 4, N_NC = DB * 4 * (PAST / 64);
    for (int it = bid; it < N_MLA + N_NA + N_NC; it += nb) {
        if (it < N_MLA) {
            const int kt = it / 8, h = it % 8, r0 = kt * 64;
            const float* src = p.kvr + (size_t)r0 * 2048 + h * 256 + 128;
            bf16_t* dst; int ldv;
            if (r0 < NCTX) { const int b = r0 / SEQ; dst = p.vt_mla_ctx + ((size_t)(b * 8 + h) * 128) * SEQ + r0 % SEQ; ldv = SEQ; }
            else if (r0 < T) { const int b = (r0 - NCTX) / DS; dst = p.vt_mla_lat + ((size_t)(b * 8 + h) * 128) * (PAST + DS) + PAST + (r0 - NCTX) % DS; ldv = PAST + DS; }
            else { const int b = (r0 - T) / PAST; dst = p.vt_mla_lat + ((size_t)(b * 8 + h) * 128) * (PAST + DS) + (r0 - T) % PAST; ldv = PAST + DS; }
            transpose_v(src, 2048, dst, ldv, lds);
        } else if (it < N_MLA + N_NA) {
            const int j = it - N_MLA, kt = j / 4, h = j % 4, r0 = kt * 64;
            const float* src = p.z + (size_t)r0 * DIN + O_NAV + h * 128;
            bf16_t* dst; int ldv;
            if (r0 < NCTX) { const int b = r0 / SEQ; dst = p.vt_na_ctx + ((size_t)(b * 4 + h) * 128) * SEQ + r0 % SEQ; ldv = SEQ; }
            else { const int b = (r0 - NCTX) / DS; dst = p.vt_na_lat + ((size_t)(b * 4 + h) * 128) * DS + (r0 - NCTX) % DS; ldv = DS; }
            transpose_v(src, DIN, dst, ldv, lds);
        } else {
            const int j = it - N_MLA - N_NA, bh = j / (PAST / 64), jt = j % (PAST / 64), b = bh / 4, h = bh % 4;
            const float* src = p.cache_nav + ((((size_t)b * DEPTH + layer) * 4 + h) * PAST + jt * 64) * 128;
            transpose_v(src, 128, p.vt_na_cache + ((size_t)(b * 4 + h) * 128) * PAST + jt * 64, PAST, lds);
        }
    }
}

typedef short bf16x8_t __attribute__((ext_vector_type(8)));
typedef float f32x16_t __attribute__((ext_vector_type(16)));
#define MFMA32(a, b, c) __builtin_amdgcn_mfma_f32_32x32x16_bf16((a), (b), (c), 0, 0, 0)
DEVI int crow(int reg, int h) { return (reg & 3) + 8 * (reg >> 2) + 4 * h; }

struct AttnUnit {
    const bf16_t* q; int qstride;
    const bf16_t *k0, *vt0; int ks0, ldv0, nt0;
    const bf16_t *k1, *vt1; int ks1, ldv1, nt1;
    const bf16_t *kl, *vtl; int nloc;
    const float* bias; int qr, c0, rs;
    bf16_t* out;
    float scale;
};

template <int DQ>
DEVI void attn_unit(const AttnUnit& u) {
    const int lane = tidx() & 63, r = lane & 31, h = lane >> 5;
    bf16x8_t qf[DQ / 16];
    {
        const bf16_t* qrow = u.q + (size_t)r * u.qstride + 8 * h;
#pragma unroll
        for (int kk = 0; kk < DQ / 16; ++kk) qf[kk] = *(const bf16x8_t*)(qrow + kk * 16);
    }
    f32x16_t ot[4];
#pragma unroll
    for (int b = 0; b < 4; ++b)
#pragma unroll
        for (int i = 0; i < 16; ++i) ot[b][i] = 0.f;
    float m = -INFINITY, l = 0.f;
    const int ntiles = u.nt0 + u.nt1 + u.nloc;
    for (int t = 0; t < ntiles; ++t) {
        const bf16_t *kp, *vp; int ks, ldv, lrow = -1, lcol = 0;
        if (t < u.nt0) { kp = u.k0 + (size_t)t * 32 * u.ks0; ks = u.ks0; vp = u.vt0 + t * 32; ldv = u.ldv0; }
        else if (t < u.nt0 + u.nt1) { const int tt = t - u.nt0; kp = u.k1 + (size_t)tt * 32 * u.ks1; ks = u.ks1; vp = u.vt1 + tt * 32; ldv = u.ldv1; }
        else { const int tt = t - u.nt0 - u.nt1; lrow = u.rs + (tt >> 1); lcol = (tt & 1) * 32; kp = u.kl + (size_t)(lrow * 64 + lcol) * 512; ks = 512; vp = u.vtl + lrow * 64 + lcol; ldv = DS; }
        f32x16_t st;
#pragma unroll
        for (int i = 0; i < 16; ++i) st[i] = 0.f;
        {
            const bf16_t* krow = kp + (size_t)r * ks + 8 * h;
#pragma unroll
            for (int kk = 0; kk < DQ / 16; ++kk) { const bf16x8_t a = *(const bf16x8_t*)(krow + kk * 16); st = MFMA32(a, qf[kk], st); }
        }
        float sv[16], mx = -INFINITY;
        if (lrow >= 0) {
            const int qc = u.c0 + r, cs = min(max(qc - 8, 0), 48);
            const float* brow = u.bias + (lrow - u.qr + 7) * 31 + (15 - qc);
#pragma unroll
            for (int i = 0; i < 16; ++i) {
                const int kc = lcol + crow(i, h);
                const bool valid = kc >= cs && kc < cs + 16;
                const float bv = valid ? brow[kc] : 0.f;
                sv[i] = valid ? st[i] * u.scale + bv : -INFINITY; mx = fmaxf(mx, sv[i]);
            }
        } else {
#pragma unroll
            for (int i = 0; i < 16; ++i) { sv[i] = st[i] * u.scale; mx = fmaxf(mx, sv[i]); }
        }
        mx = fmaxf(mx, __shfl_xor(mx, 32));
        const float mnew = fmaxf(m, mx), alpha = __expf(m - mnew);
        m = mnew;
        float ls = 0.f;
#pragma unroll
        for (int i = 0; i < 16; ++i) { sv[i] = __expf(sv[i] - mnew); ls += sv[i]; }
        l = l * alpha + ls;
#pragma unroll
        for (int b = 0; b < 4; ++b)
#pragma unroll
            for (int i = 0; i < 16; ++i) ot[b][i] *= alpha;
#pragma unroll
        for (int s2 = 0; s2 < 2; ++s2) {
            uint4 pk; pk.x = cvtpk(sv[8 * s2 + 0], sv[8 * s2 + 1]); pk.y = cvtpk(sv[8 * s2 + 2], sv[8 * s2 + 3]); pk.z = cvtpk(sv[8 * s2 + 4], sv[8 * s2 + 5]); pk.w = cvtpk(sv[8 * s2 + 6], sv[8 * s2 + 7]);
            const bf16x8_t xs = __builtin_bit_cast(bf16x8_t, pk);
#pragma unroll
            for (int b = 0; b < 4; ++b) {
                const bf16_t* vrow = vp + (size_t)(32 * b + r) * ldv + 16 * s2 + 4 * h;
                const uint2 lo = *(const uint2*)vrow, hi = *(const uint2*)(vrow + 8);
                const bf16x8_t pa = __builtin_bit_cast(bf16x8_t, make_uint4(lo.x, lo.y, hi.x, hi.y));
                ot[b] = MFMA32(pa, xs, ot[b]);
            }
        }
    }
    l += __shfl_xor(l, 32);
    const float inv = 1.f / l;
    bf16_t* orow = u.out + (size_t)r * D;
#pragma unroll
    for (int b = 0; b < 4; ++b)
#pragma unroll
        for (int g = 0; g < 4; ++g)
            *(uint2*)(orow + 32 * b + 8 * g + 4 * h) = make_uint2(cvtpk(ot[b][4 * g] * inv, ot[b][4 * g + 1] * inv), cvtpk(ot[b][4 * g + 2] * inv, ot[b][4 * g + 3] * inv));
}

DEVI void attn_dispatch(CParams& p, int layer, int kind, int idx) {
    AttnUnit u;
    u.k1 = nullptr; u.vt1 = nullptr; u.ks1 = 0; u.ldv1 = 0; u.nt1 = 0; u.kl = nullptr; u.vtl = nullptr; u.nloc = 0; u.bias = nullptr; u.qr = 0; u.c0 = 0; u.rs = 0;
    if (kind == 0) {
        const int qt = idx % 32, h = (idx / 32) % 8, b = idx / 256, t0 = NCTX + b * DS + qt * 32;
        u.q = p.q_b + (size_t)t0 * 1536 + h * 192; u.qstride = 1536; u.scale = 0.07216878364870322f;
        u.k0 = p.k_b + (size_t)(T + b * PAST) * 1536 + h * 192; u.ks0 = 1536; u.vt0 = p.vt_mla_lat + ((size_t)(b * 8 + h) * 128) * (PAST + DS); u.ldv0 = PAST + DS; u.nt0 = PAST / 32;
        u.k1 = p.k_b + (size_t)(NCTX + b * DS) * 1536 + h * 192; u.ks1 = 1536; u.vt1 = u.vt0 + PAST; u.ldv1 = PAST + DS; u.nt1 = DS / 32;
        u.out = p.mix_b + (size_t)t0 * D + h * 128;
        attn_unit<192>(u);
    } else if (kind == 1) {
        const int qt = idx % 32, h = (idx / 32) % 4, b = idx / 128, t0 = NCTX + b * DS + qt * 32;
        u.q = p.qna_b + (size_t)t0 * 512 + h * 128; u.qstride = 512; u.scale = 0.08838834764831845f;
        u.k0 = p.cnak_b + ((size_t)(b * 4 + h) * PAST) * 128; u.ks0 = 128; u.vt0 = p.vt_na_cache + ((size_t)(b * 4 + h) * 128) * PAST; u.ldv0 = PAST; u.nt0 = PAST / 32;
        u.kl = p.kna_b + (size_t)(NCTX + b * DS) * 512 + h * 128; u.vtl = p.vt_na_lat + ((size_t)(b * 4 + h) * 128) * DS; u.nloc = 16;
        u.bias = p.rel_bias + ((size_t)layer * 4 + h) * 15 * 31; u.qr = qt >> 1; u.c0 = (qt & 1) * 32; u.rs = min(max(u.qr - 4, 0), 8);
        u.out = p.mix_b + (size_t)t0 * D + 1024 + h * 128;
        attn_unit<128>(u);
    } else if (kind == 2) {
        const int qt = idx % 8, h = (idx / 8) % 8, b = idx / 64, t0 = b * SEQ + qt * 32;
        u.q = p.q_b + (size_t)t0 * 1536 + h * 192; u.qstride = 1536; u.scale = 0.07216878364870322f;
        u.k0 = p.k_b + (size_t)(b * SEQ) * 1536 + h * 192; u.ks0 = 1536; u.vt0 = p.vt_mla_ctx + ((size_t)(b * 8 + h) * 128) * SEQ; u.ldv0 = SEQ; u.nt0 = SEQ / 32;
        u.out = p.mix_b + (size_t)t0 * D + h * 128;
        attn_unit<192>(u);
    } else {
        const int qt = idx % 8, h = (idx / 8) % 4, b = idx / 32, t0 = b * SEQ + qt * 32;
        u.q = p.qna_b + (size_t)t0 * 512 + h * 128; u.qstride = 512; u.scale = 0.08838834764831845f;
        u.k0 = p.kna_b + (size_t)(b * SEQ) * 512 + h * 128; u.ks0 = 512; u.vt0 = p.vt_na_ctx + ((size_t)(b * 4 + h) * 128) * SEQ; u.ldv0 = SEQ; u.nt0 = SEQ / 32;
        u.out = p.mix_b + (size_t)t0 * D + 1024 + h * 128;
        attn_unit<128>(u);
    }
}
DEVI void phase_attn(CParams& p, int layer, int bid, int nb) {
    const int w = __builtin_amdgcn_readfirstlane(tidx() >> 6);
    constexpr int N0 = DB * 8 * (DS / 32), N1 = DB * 4 * (DS / 32), N2 = BATCH * 8 * (SEQ / 32), N3 = BATCH * 4 * (SEQ / 32);
    if (w < 2) {
        for (int it = w * nb + bid; it < N0; it += 2 * nb) attn_dispatch(p, layer, 0, it);
    } else {
        for (int it = (w - 2) * nb + bid; it < N1 + N3 + N2; it += (NWAVES - 2) * nb) {
            if (it < N1) attn_dispatch(p, layer, 1, it);
            else if (it < N1 + N3) attn_dispatch(p, layer, 3, it - N1);
            else attn_dispatch(p, layer, 2, it - N1 - N3);
        }
    }
}

template <int N, int K, int J>
DEVI void bitonic_stage(float (&v)[N]) {
#pragma unroll
    for (int i = 0; i < N; ++i) {
        const int l = i ^ J;
        if (l > i) { const bool desc = ((i & K) == 0); const float a = v[i], b = v[l], mx = fmaxf(a, b), mn = fminf(a, b); v[i] = desc ? mx : mn; v[l] = desc ? mn : mx; }
    }
}
template <int N, int K, int J> DEVI void bitonic_j(float (&v)[N]) { bitonic_stage<N, K, J>(v); if constexpr (J > 1) bitonic_j<N, K, J / 2>(v); }
template <int N, int K> DEVI void bitonic_k(float (&v)[N]) { bitonic_j<N, K, K / 2>(v); if constexpr (K < N) bitonic_k<N, K * 2>(v); }
template <int N> DEVI void bitonic_sort_desc(float (&v)[N]) { bitonic_k<N, 2>(v); }
DEVI void merge_top16(float (&a)[16], const float (&b)[16]) {
#pragma unroll
    for (int i = 0; i < 16; ++i) a[i] = fmaxf(a[i], b[15 - i]);
    bitonic_j<16, 16, 8>(a);
}
constexpr int cand_ab(int idx) { int n = 0; for (int a = 0; a < 16; ++a) for (int b = 0; b < 16; ++b) if ((a + 1) * (b + 1) <= 16) { if (n == idx) return a * 16 + b; ++n; } return -1; }
template <int CH, int I>
DEVI void cand_fill(float (&c)[16], const float (&s1)[16], const float (&s2)[16]) {
    constexpr int ab = cand_ab(CH * 16 + I);
    if constexpr (ab >= 0) c[I] = __uint_as_float((__float_as_uint(s1[ab >> 4] + s2[ab & 15]) & ~255u) | (unsigned)ab); else c[I] = -INFINITY;
    if constexpr (I + 1 < 16) cand_fill<CH, I + 1>(c, s1, s2);
}
DEVI float packkey(float v, unsigned id, unsigned mask) { return __uint_as_float((__float_as_uint(v) & ~mask) | id); }

DEVI void phase_route(CParams& p, int layer, int bid, int nb, float* lds) {
    const int lane = tidx() & 63, w = __builtin_amdgcn_readfirstlane(tidx() >> 6), r = lane & 31, h = lane >> 5;
    unsigned char* ix = (unsigned char*)lds + w * 2048;
    for (int it = bid * NWAVES + w; it < (T / 32) * 8; it += nb * NWAVES) {
        const int tt = it >> 3, hh = it & 7, t0 = tt * 32;
        float s12[2][16];
#pragma unroll
        for (int pp = 0; pp < 2; ++pp) {
            bf16x8_t qf[8];
            const bf16_t* qrow = p.qp_b + (size_t)(t0 + r) * D + hh * 256 + pp * 128 + 8 * h;
#pragma unroll
            for (int kk = 0; kk < 8; ++kk) qf[kk] = *(const bf16x8_t*)(qrow + kk * 16);
            const bf16_t* sk = p.sk_b + (((size_t)layer * 8 + hh) * 2 + pp) * 128 * 128 + (size_t)r * 128 + 8 * h;
            float top[16];
#pragma unroll
            for (int i = 0; i < 16; ++i) top[i] = -INFINITY;
#pragma unroll 1
            for (int blk = 0; blk < 4; ++blk) {
                const bf16_t* skb = sk + (size_t)blk * 32 * 128;
                asm volatile("" : "+v"(skb));
                f32x16_t acc;
#pragma unroll
                for (int i = 0; i < 16; ++i) acc[i] = 0.f;
#pragma unroll
                for (int kk = 0; kk < 8; ++kk) { const bf16x8_t a = *(const bf16x8_t*)(skb + kk * 16); acc = MFMA32(a, qf[kk], acc); }
                float c[16];
#pragma unroll
                for (int i = 0; i < 16; ++i) c[i] = packkey(acc[i], (unsigned)(32 * blk + crow(i, h)), 127u);
                bitonic_sort_desc<16>(c);
                merge_top16(top, c);
            }
            float o[16];
#pragma unroll
            for (int i = 0; i < 16; ++i) o[i] = __shfl_xor(top[i], 32);
            merge_top16(top, o);
#pragma unroll
            for (int i = 0; i < 16; ++i) { s12[pp][i] = top[i]; ix[(pp * 16 + i) * 64 + lane] = (unsigned char)(__float_as_uint(top[i]) & 127u); }
        }
        float best[16];
        {
            float c[16];
            cand_fill<0, 0>(best, s12[0], s12[1]); bitonic_sort_desc<16>(best);
            cand_fill<1, 0>(c, s12[0], s12[1]); bitonic_sort_desc<16>(c); merge_top16(best, c);
            cand_fill<2, 0>(c, s12[0], s12[1]); bitonic_sort_desc<16>(c); merge_top16(best, c);
            cand_fill<3, 0>(c, s12[0], s12[1]); bitonic_sort_desc<16>(c); merge_top16(best, c);
        }
        __builtin_amdgcn_wave_barrier();
        float g[16], sum = 0.f; int ex[16];
        const float mx = __uint_as_float(__float_as_uint(best[0]) & ~255u);
#pragma unroll
        for (int k = 0; k < 16; ++k) {
            const unsigned bits = __float_as_uint(best[k]), id = bits & 255u;
            g[k] = __expf(__uint_as_float(bits & ~255u) - mx); sum += g[k];
            ex[k] = (int)ix[(id >> 4) * 64 + lane] * 128 + (int)ix[(16 + (id & 15)) * 64 + lane];
        }
        const float inv = 1.f / sum;
        if (h == 0) {
            int* eo = p.eidx + (size_t)(t0 + r) * 128 + hh * 16; float* go = p.gate + (size_t)(t0 + r) * 128 + hh * 16;
#pragma unroll
            for (int k = 0; k < 16; k += 4) { *(int4*)(eo + k) = make_int4(ex[k], ex[k + 1], ex[k + 2], ex[k + 3]); *(float4*)(go + k) = make_float4(g[k] * inv, g[k + 1] * inv, g[k + 2] * inv, g[k + 3] * inv); }
        }
        __builtin_amdgcn_wave_barrier();
    }
}

typedef float f32x2v __attribute__((ext_vector_type(2)));
DEVI void phase_experts(CParams& p, int layer, int bid, int nb, float* lds) {
    const int lane = tidx() & 63, w = tidx() >> 6;
    float* wgt = lds + w * 128;
    const unsigned char* U = p.pu8 + (size_t)layer * 16384 * D;
    const unsigned char* V = p.pv8 + (size_t)layer * 16384 * D;
    const float* SU = p.su8 + (size_t)layer * 16384;
    const float* SV = p.sv8 + (size_t)layer * 16384;
    for (int t = bid * NWAVES + w; t < T; t += nb * NWAVES) {
        f32x2v x[2][8];
#pragma unroll
        for (int j = 0; j < 2; ++j) {
            const uint4 a = *(const uint4*)(p.hn_b + (size_t)t * D + j * 1024 + lane * 16), b = *(const uint4*)(p.hn_b + (size_t)t * D + j * 1024 + lane * 16 + 8);
            x[j][0] = (f32x2v){__uint_as_float(a.x << 16), __uint_as_float(a.x & 0xffff0000u)}; x[j][1] = (f32x2v){__uint_as_float(a.y << 16), __uint_as_float(a.y & 0xffff0000u)};
            x[j][2] = (f32x2v){__uint_as_float(a.z << 16), __uint_as_float(a.z & 0xffff0000u)}; x[j][3] = (f32x2v){__uint_as_float(a.w << 16), __uint_as_float(a.w & 0xffff0000u)};
            x[j][4] = (f32x2v){__uint_as_float(b.x << 16), __uint_as_float(b.x & 0xffff0000u)}; x[j][5] = (f32x2v){__uint_as_float(b.y << 16), __uint_as_float(b.y & 0xffff0000u)};
            x[j][6] = (f32x2v){__uint_as_float(b.z << 16), __uint_as_float(b.z & 0xffff0000u)}; x[j][7] = (f32x2v){__uint_as_float(b.w << 16), __uint_as_float(b.w & 0xffff0000u)};
        }
        const int* eix = p.eidx + (size_t)t * 128;
        const float* gat = p.gate + (size_t)t * 128;
        for (int c = 0; c < 16; ++c) {
            uint4 u[8][2];
#pragma unroll
            for (int e = 0; e < 8; ++e) {
                const int idx = __builtin_amdgcn_readfirstlane(eix[c * 8 + e]);
                const unsigned char* ur = U + (size_t)idx * D + lane * 16;
                u[e][0] = *(const uint4*)ur; u[e][1] = *(const uint4*)(ur + 1024);
            }
            float d[8];
#pragma unroll
            for (int e = 0; e < 8; ++e) {
                f32x2v a = {0.f, 0.f};
#pragma unroll
                for (int j = 0; j < 2; ++j) {
                    const unsigned q[4] = {u[e][j].x, u[e][j].y, u[e][j].z, u[e][j].w};
#pragma unroll
                    for (int k = 0; k < 4; ++k) {
                        a = __builtin_elementwise_fma(__builtin_amdgcn_cvt_pk_f32_fp8((int)q[k], false), x[j][2 * k], a);
                        a = __builtin_elementwise_fma(__builtin_amdgcn_cvt_pk_f32_fp8((int)q[k], true), x[j][2 * k + 1], a);
                    }
                }
                d[e] = a.x + a.y;
            }
            const bool b5 = lane & 32, b4 = lane & 16, b3 = lane & 8;
            float r4[4];
#pragma unroll
            for (int i = 0; i < 4; ++i) { const float mine = b5 ? d[4 + i] : d[i], theirs = b5 ? d[i] : d[4 + i]; r4[i] = mine + __shfl_xor(theirs, 32); }
            float r2[2];
#pragma unroll
            for (int i = 0; i < 2; ++i) { const float mine = b4 ? r4[2 + i] : r4[i], theirs = b4 ? r4[i] : r4[2 + i]; r2[i] = mine + __shfl_xor(theirs, 16); }
            float r1;
            { const float mine = b3 ? r2[1] : r2[0], theirs = b3 ? r2[0] : r2[1]; r1 = mine + __shfl_xor(theirs, 8); }
            r1 += __shfl_xor(r1, 4); r1 += __shfl_xor(r1, 2); r1 += __shfl_xor(r1, 1);
            const int e = (lane >> 3) & 7;
            const int myidx = eix[c * 8 + e];
            r1 *= SU[myidx];
            const float a = 0.5f * r1 * (1.f + erff(r1 * 0.70710678118654752f));
            if ((lane & 7) == 0) wgt[c * 8 + e] = a * gat[c * 8 + e] * SV[myidx];
        }
        __builtin_amdgcn_wave_barrier();
        f32x2v o[2][8];
#pragma unroll
        for (int j = 0; j < 2; ++j)
#pragma unroll
            for (int i = 0; i < 8; ++i) o[j][i] = (f32x2v){0.f, 0.f};
        for (int c = 0; c < 16; ++c) {
            uint4 v[8][2];
#pragma unroll
            for (int e = 0; e < 8; ++e) {
                const int idx = __builtin_amdgcn_readfirstlane(eix[c * 8 + e]);
                const unsigned char* vr = V + (size_t)idx * D + lane * 16;
                v[e][0] = *(const uint4*)vr; v[e][1] = *(const uint4*)(vr + 1024);
            }
#pragma unroll
            for (int e = 0; e < 8; ++e) {
                const float wg1 = wgt[c * 8 + e];
                const f32x2v wg = {wg1, wg1};
#pragma unroll
                for (int j = 0; j < 2; ++j) {
                    const unsigned q[4] = {v[e][j].x, v[e][j].y, v[e][j].z, v[e][j].w};
#pragma unroll
                    for (int k = 0; k < 4; ++k) {
                        o[j][2 * k] = __builtin_elementwise_fma(__builtin_amdgcn_cvt_pk_f32_fp8((int)q[k], false), wg, o[j][2 * k]);
                        o[j][2 * k + 1] = __builtin_elementwise_fma(__builtin_amdgcn_cvt_pk_f32_fp8((int)q[k], true), wg, o[j][2 * k + 1]);
                    }
                }
            }
        }
        __builtin_amdgcn_wave_barrier();
        const int cond = cond_of(t);
        const float* g2 = p.ada + ((size_t)layer * 3 + cond) * 6 * D + 5 * D;
        float* xo = p.out + (size_t)t * D;
        float ss = 0.f;
#pragma unroll
        for (int j = 0; j < 2; ++j) {
            const int cb = j * 1024 + lane * 16;
#pragma unroll
            for (int q = 0; q < 4; ++q) {
                float4 xv = *(const float4*)(xo + cb + q * 4); const float4 gv = *(const float4*)(g2 + cb + q * 4);
                xv.x += gv.x * o[j][2 * q].x; xv.y += gv.y * o[j][2 * q].y; xv.z += gv.z * o[j][2 * q + 1].x; xv.w += gv.w * o[j][2 * q + 1].y;
                *(float4*)(xo + cb + q * 4) = xv;
                o[j][2 * q] = (f32x2v){xv.x, xv.y}; o[j][2 * q + 1] = (f32x2v){xv.z, xv.w};
                ss += xv.x * xv.x + xv.y * xv.y + xv.z * xv.z + xv.w * xv.w;
            }
        }
        if (layer + 1 < DEPTH) {
            ss = wave_sum(ss);
            const float rr = rsqrtf(ss / D + EPS);
            const float* g = p.norm_mix_g + (size_t)(layer + 1) * D;
            const float* ad = p.ada + ((size_t)(layer + 1) * 3 + cond) * 6 * D;
#pragma unroll
            for (int j = 0; j < 2; ++j) {
                const int cb = j * 1024 + lane * 16;
                unsigned hv[8];
#pragma unroll
                for (int q = 0; q < 4; ++q) {
                    const float4 gg = *(const float4*)(g + cb + q * 4), sh = *(const float4*)(ad + cb + q * 4), sc = *(const float4*)(ad + D + cb + q * 4);
                    hv[2 * q] = cvtpk(o[j][2 * q].x * rr * gg.x * (1.f + sc.x) + sh.x, o[j][2 * q].y * rr * gg.y * (1.f + sc.y) + sh.y);
                    hv[2 * q + 1] = cvtpk(o[j][2 * q + 1].x * rr * gg.z * (1.f + sc.z) + sh.z, o[j][2 * q + 1].y * rr * gg.w * (1.f + sc.w) + sh.w);
                }
                *(uint4*)(p.hn_b + (size_t)t * D + cb) = make_uint4(hv[0], hv[1], hv[2], hv[3]);
                *(uint4*)(p.hn_b + (size_t)t * D + cb + 8) = make_uint4(hv[4], hv[5], hv[6], hv[7]);
            }
        }
    }
}

enum { PH_ADA = 0, PH_NORM1, PH_WIN, PH_POSTZ, PH_UQKV, PH_HEADNORM, PH_ATTN, PH_WOUT, PH_NORM2, PH_WQ, PH_SCORES, PH_ROUTE, PH_EXPERTS, PH_COUNT };

template <int PH>
DEVI void run_phase(CParams& p, int layer, int bid, int nb, float* lds) {
    if constexpr (PH == PH_ADA) { phase_ada(p, bid, nb, lds); phase_weights(p, bid, nb, lds); }
    if constexpr (PH == PH_NORM1) phase_modnorm(p, layer, 0, bid, nb);
    if constexpr (PH == PH_WIN) mfma_gemm(p.hn_b, p.wt_in + (size_t)layer * DINP * D, T, DINP, D, EpiF32{p.z, DIN, DIN}, bid, nb, lds);
    if constexpr (PH == PH_POSTZ) phase_postz(p, layer, bid, nb);
    if constexpr (PH == PH_UQKV) {
        mfma_gemm(p.cqn_b, p.wt_uq + (size_t)layer * 1536 * 512, T, 1536, 512, EpiF32{p.qm, 1536, 1536}, bid, nb, lds);
        mfma_gemm(p.ckv_b, p.wt_ukv + (size_t)layer * 2048 * 256, TKV, 2048, 256, EpiF32{p.kvr, 2048, 2048}, bid, nb, lds);
    }
    if constexpr (PH == PH_HEADNORM) phase_headnorm(p, layer, bid, nb, lds);
    if constexpr (PH == PH_ATTN) phase_attn(p, layer, bid, nb);
    if constexpr (PH == PH_WOUT) mfma_gemm(p.mix_b, p.wt_out + (size_t)layer * D * D, T, D, D, EpiResidMF{&p, layer}, bid, nb, lds);
    if constexpr (PH == PH_NORM2) phase_modnorm(p, layer, 1, bid, nb);
    if constexpr (PH == PH_WQ) mfma_gemm(p.hn_b, p.wt_q + (size_t)layer * D * D, T, D, D, EpiBf16Store{p.qp_b, D}, bid, nb, lds);
    if constexpr (PH == PH_ROUTE) phase_route(p, layer, bid, nb, lds);
    if constexpr (PH == PH_EXPERTS) phase_experts(p, layer, bid, nb, lds);
}

#ifndef MK_ONE_LAUNCH
#define MK_ONE_LAUNCH 1
#endif
constexpr size_t LDS_BYTES = LDS_TOTAL;

#if MK_ONE_LAUNCH
#define PHASE(PH, l) do { CParams* q_ = pp; asm volatile("" : "+s"(q_)); run_phase<PH>(*q_, l, (int)blockIdx.x, (int)gridDim.x, lds); \
    XcdBarrier b_; b_.bar = q_->bar; b_.x = xb_xcc_id(); b_.st = (volatile LAS unsigned*)(lds_raw + MISC_OFF); xcd_barrier(b_); } while (0)
__global__ void __launch_bounds__(NTHREADS, 2) k_fwd(Params p_unused) {
    CParams* pp = (CParams*)__builtin_amdgcn_kernarg_segment_ptr();
    extern __shared__ __attribute__((aligned(16))) unsigned char lds_raw[];
    float* lds = (float*)lds_raw;
    if (threadIdx.x == 0) *(uint4*)(lds_raw + MISC_OFF) = make_uint4(0u, 0u, 0u, 0u);
    __syncthreads();
    (void)xcd_barrier_post(pp->bar, (volatile LAS unsigned*)(lds_raw + MISC_OFF));
    PHASE(PH_ADA, 0);
    for (int l = 0; l < DEPTH; ++l) {
        if (l == 0) PHASE(PH_NORM1, l);
        PHASE(PH_WIN, l);
        PHASE(PH_POSTZ, l);
        PHASE(PH_UQKV, l);
        PHASE(PH_HEADNORM, l);
        PHASE(PH_ATTN, l);
        PHASE(PH_WOUT, l);
        PHASE(PH_NORM2, l);
        PHASE(PH_WQ, l);
        PHASE(PH_ROUTE, l);
        PHASE(PH_EXPERTS, l);
    }
}
#else
template <int PH>
__global__ void __launch_bounds__(NTHREADS, 4) k_phase(Params p, int layer) {
    extern __shared__ float4 lds4[];
    CParams* pp = (CParams*)__builtin_amdgcn_kernarg_segment_ptr();
    run_phase<PH>(*pp, layer, blockIdx.x, gridDim.x, (float*)lds4);
}
template <int PH>
void launch_phase(const Params& p, int layer, hipStream_t stream) {
    hipLaunchKernelGGL(k_phase<PH>, dim3(1024), dim3(NTHREADS), LDS_BYTES, stream, p, layer);
}
#endif

}

extern "C" void kernel_launch(void* const* d_in, const int* in_sizes, int n_in, void* d_out, int out_size, void* d_ws, size_t ws_size, hipStream_t stream) {
    Params p{};
    const float* const* in = (const float* const*)d_in;
    p.x_prompt = in[0]; p.x_sample = in[1]; p.cache_ckv = in[2]; p.cache_kpe = in[3]; p.cache_nak = in[4]; p.cache_nav = in[5]; p.c = in[6]; p.c_ctx = in[7];
    p.ada_w = in[8]; p.ada_b = in[9]; p.norm_mix_g = in[10]; p.norm_ffn_g = in[11]; p.w_in = in[12]; p.q_norm_g = in[13]; p.w_uq = in[14]; p.kv_norm_g = in[15]; p.w_ukv = in[16];
    p.q_head_g = in[17]; p.k_head_g = in[18]; p.naq_g = in[19]; p.nak_g = in[20]; p.rel_bias = in[21]; p.conv_w = in[22]; p.w_out = in[23]; p.peer_wq = in[24]; p.sub_keys = in[25];
    p.peer_u = in[26]; p.peer_v = in[27];
    float* out = (float*)d_out;
    p.out = out;
    p.o_ckv = out + (size_t)T * D;
    p.o_kpe = p.o_ckv + (size_t)BATCH * DEPTH * SEQ * 256;
    p.o_nak = p.o_kpe + (size_t)BATCH * DEPTH * SEQ * 64;
    p.o_nav = p.o_nak + (size_t)BATCH * DEPTH * 4 * SEQ * 128;
    char* ws = (char*)d_ws; size_t off = 0;
    auto carve = [&](size_t bytes) { void* r = ws + off; off += (bytes + 255) & ~(size_t)255; return r; };
    p.bar = (unsigned*)carve(16384);
    p.ada = (float*)carve((size_t)DEPTH * 3 * 6 * D * 4);
    p.hn = (float*)carve((size_t)T * D * 4);
    p.z = (float*)carve((size_t)(T + 1) * DIN * 4);
    p.cqn = (float*)carve((size_t)T * 512 * 4);
    p.ckv = (float*)carve((size_t)TKV * 256 * 4);
    p.qm = (float*)carve((size_t)T * 1536 * 4);
    p.kvr = (float*)carve((size_t)TKV * 2048 * 4);
    p.km = (float*)carve((size_t)TKV * 1536 * 4);
    p.qna = (float*)carve((size_t)T * 512 * 4);
    p.kna = (float*)carve((size_t)T * 512 * 4);
    p.mix = (float*)carve((size_t)T * D * 4);
    p.qp = (float*)carve((size_t)T * D * 4);
    p.sc = (float*)carve((size_t)T * D * 4);
    p.gate = (float*)carve((size_t)T * 128 * 4);
    p.eidx = (int*)carve((size_t)T * 128 * 4);
    p.wt_in = (bf16_t*)carve((size_t)DEPTH * DINP * D * 2);
    p.wt_uq = (bf16_t*)carve((size_t)DEPTH * 1536 * 512 * 2);
    p.wt_ukv = (bf16_t*)carve((size_t)DEPTH * 2048 * 256 * 2);
    p.wt_out = (bf16_t*)carve((size_t)DEPTH * D * D * 2);
    p.wt_q = (bf16_t*)carve((size_t)DEPTH * D * D * 2);
    p.hn_b = (bf16_t*)carve((size_t)T * D * 2);
    p.cqn_b = (bf16_t*)carve((size_t)T * 512 * 2);
    p.ckv_b = (bf16_t*)carve((size_t)TKV * 256 * 2);
    p.mix_b = (bf16_t*)carve((size_t)T * D * 2);
    p.q_b = (bf16_t*)carve((size_t)T * 1536 * 2);
    p.qp_b = (bf16_t*)carve((size_t)T * D * 2);
    p.sk_b = (bf16_t*)carve((size_t)DEPTH * 8 * 2 * 128 * 128 * 2);
    p.pu8 = (unsigned char*)carve((size_t)DEPTH * 16384 * D);
    p.pv8 = (unsigned char*)carve((size_t)DEPTH * 16384 * D);
    p.su8 = (float*)carve((size_t)DEPTH * 16384 * 4);
    p.sv8 = (float*)carve((size_t)DEPTH * 16384 * 4);
    p.k_b = (bf16_t*)carve((size_t)TKV * 1536 * 2);
    p.qna_b = (bf16_t*)carve((size_t)T * 512 * 2);
    p.kna_b = (bf16_t*)carve((size_t)T * 512 * 2);
    p.cnak_b = (bf16_t*)carve((size_t)DB * 4 * PAST * 128 * 2);
    p.vt_mla_ctx = (bf16_t*)carve((size_t)BATCH * 8 * 128 * SEQ * 2);
    p.vt_mla_lat = (bf16_t*)carve((size_t)DB * 8 * 128 * (PAST + DS) * 2);
    p.vt_na_ctx = (bf16_t*)carve((size_t)BATCH * 4 * 128 * SEQ * 2);
    p.vt_na_lat = (bf16_t*)carve((size_t)DB * 4 * 128 * DS * 2);
    p.vt_na_cache = (bf16_t*)carve((size_t)DB * 4 * 128 * PAST * 2);

#if MK_ONE_LAUNCH
    static int grid = 0;
    if (!grid) {
        int dev = 0, cus = 0, per_cu = 0;
        hipGetDevice(&dev);
        hipDeviceGetAttribute(&cus, hipDeviceAttributeMultiprocessorCount, dev);
        hipFuncSetAttribute((const void*)k_fwd, hipFuncAttributeMaxDynamicSharedMemorySize, (int)LDS_BYTES);
        hipOccupancyMaxActiveBlocksPerMultiprocessor(&per_cu, k_fwd, NTHREADS, LDS_BYTES);
        if (per_cu < 1) per_cu = 1;
        grid = cus * (per_cu < 1 ? per_cu : 1);
    }
    hipMemsetAsync(p.bar, 0, XCD_BAR_WORDS * sizeof(unsigned), stream);
    hipLaunchKernelGGL(k_fwd, dim3(grid), dim3(NTHREADS), LDS_BYTES, stream, p);
#else
    launch_phase<PH_ADA>(p, 0, stream);
    for (int l = 0; l < DEPTH; ++l) {
        if (l == 0) launch_phase<PH_NORM1>(p, l, stream);
        launch_phase<PH_WIN>(p, l, stream);
        launch_phase<PH_POSTZ>(p, l, stream);
        launch_phase<PH_UQKV>(p, l, stream);
        launch_phase<PH_HEADNORM>(p, l, stream);
        launch_phase<PH_ATTN>(p, l, stream);
        launch_phase<PH_WOUT>(p, l, stream);
        launch_phase<PH_NORM2>(p, l, stream);
        launch_phase<PH_WQ>(p, l, stream);
        launch_phase<PH_ROUTE>(p, l, stream);
        launch_phase<PH_EXPERTS>(p, l, stream);
    }
#endif
}
```

```cpp
#include <hip/hip_runtime.h>
#include <stdint.h>

#define DEVI __device__ __forceinline__

#define XB_TMO      128
#define XB_XCNT(j)  (256  + 64 * (j))
#define XB_XSUB(j)  (1280 + 64 * (j))
#define XB_XGEN(j)  (2304 + 64 * (j))
#define XB_TOP      3328
#define XB_TOPGEN   3392
#define XCD_BAR_WORDS 3456
#define XB_SPIN_CAP (1u << 18)
#define LAS __attribute__((address_space(3)))

__device__ __forceinline__ unsigned xb_ld(unsigned* p)              { return __hip_atomic_load(p, __ATOMIC_RELAXED, __HIP_MEMORY_SCOPE_AGENT); }
__device__ __forceinline__ unsigned xb_add(unsigned* p, unsigned v) { return __hip_atomic_fetch_add(p, v, __ATOMIC_RELAXED, __HIP_MEMORY_SCOPE_AGENT); }
__device__ __forceinline__ unsigned xb_xcc_id() { return (unsigned)__builtin_amdgcn_s_getreg((3 << 11) | 20) & 0xFu; }
#define XB_SPIN(cond, bar) do { unsigned _sp = 0; while (cond) { __builtin_amdgcn_s_sleep(1); \
    if ((++_sp & 255u) == 0u) { if (xb_ld(&(bar)[XB_TMO])) break; if (_sp > XB_SPIN_CAP) { atomicAdd(&(bar)[XB_TMO], 1u); break; } } } } while (0)

struct XcdBarrier {
    unsigned* bar; unsigned x;
    volatile LAS unsigned* st;
};

__device__ __forceinline__ XcdBarrier xcd_barrier_post(unsigned* bar, volatile LAS unsigned* st) {
    XcdBarrier b; b.bar = bar; b.x = xb_xcc_id(); b.st = st;
    if (threadIdx.x == 0) (void)xb_add(&bar[XB_XCNT(b.x)], 1u);
    return b;
}
__device__ __forceinline__ void xcd_barrier_complete(unsigned* bar, unsigned x, unsigned& nloc, unsigned& nx) {
    const unsigned G = gridDim.x * gridDim.y * gridDim.z;
    unsigned sum, cnt, mine, sp = 0u;
    for (;;) {
        sum = 0u; cnt = 0u; mine = 0u;
#pragma unroll
        for (unsigned j = 0; j < 16; ++j) { const unsigned c = xb_ld(&bar[XB_XCNT(j)]); sum += c; cnt += (c > 0u) ? 1u : 0u; mine = (j == x) ? c : mine; }
        if (sum == G) break;
        __builtin_amdgcn_s_sleep(1);
        if ((++sp & 255u) == 0u) { if (xb_ld(&bar[XB_TMO])) break; if (sp > XB_SPIN_CAP) { atomicAdd(&bar[XB_TMO], 1u); break; } }
    }
    nloc = mine > 0u ? mine : 1u; nx = cnt > 0u ? cnt : 1u;
}

__device__ __forceinline__ void xcd_barrier(const XcdBarrier& b) {
    asm volatile("s_waitcnt vmcnt(0)" ::: "memory");
    __syncthreads();
    if (threadIdx.x == 0) {
        unsigned* bar = b.bar;
        __builtin_amdgcn_s_waitcnt(0);
        unsigned nloc = b.st[0], nx = b.st[1];
        if (nloc == 0u) { xcd_barrier_complete(bar, b.x, nloc, nx); b.st[0] = nloc; b.st[1] = nx; }
        const unsigned old = xb_add(&bar[XB_XSUB(b.x)], 1u);
        const unsigned gen = old / nloc;
        if (old + 1u == (gen + 1u) * nloc) {
            __builtin_amdgcn_fence(__ATOMIC_RELEASE, "agent");
            asm volatile("s_waitcnt vmcnt(0)" ::: "memory");
            const unsigned og = xb_add(&bar[XB_TOP], 1u);
            const unsigned tg = og / nx;
            if (og + 1u == (tg + 1u) * nx) xb_add(&bar[XB_TOPGEN], 1u);
            else XB_SPIN(xb_ld(&bar[XB_TOPGEN]) == tg, bar);
            __builtin_amdgcn_fence(__ATOMIC_ACQUIRE, "agent");
            xb_add(&bar[XB_XGEN(b.x)], 1u);
            asm volatile("s_waitcnt vmcnt(0)" ::: "memory");
        } else {
            XB_SPIN(xb_ld(&bar[XB_XGEN(b.x)]) == gen, bar);
            __builtin_amdgcn_fence(__ATOMIC_ACQUIRE, "agent");
            asm volatile("s_waitcnt vmcnt(0)" ::: "memory");
        }
    }
    __syncthreads();
}


namespace pg8 {
#define PG8_LAS __attribute__((address_space(3)))
typedef unsigned short bf16_t;
typedef short bf16x8 __attribute__((ext_vector_type(8)));
typedef float f32x4 __attribute__((ext_vector_type(4)));
typedef unsigned u32x4 __attribute__((ext_vector_type(4)));
constexpr int BM = 256, BK = 64, HALF = 128, HTB = HALF * BK * 2  , STAGE_BYTES = 8 * HTB, NXCD = 8, WGM = 8;

__host__ __device__ __forceinline__ int lds_byte(int r, int c) { const int st = (r >> 4) * 2 + (c >> 5), rr = r & 15, cc = c & 31, ob = rr * 64 + cc * 2; return st * 1024 + (ob ^ (((ob >> 9) & 1) << 5)); }
__host__ __device__ __forceinline__ void stage_rc(int b, int& R, int& C) { const int st = b / 1024, sb = b % 1024, swz = sb ^ (((sb >> 9) & 1) << 5); R = (st >> 1) * 16 + swz / 64; C = (st & 1) * 32 + (swz % 64) / 2; }
__host__ __device__ __forceinline__ int perm32(int rho) { const int n = rho >> 4, i = rho & 15; return 8 * (i >> 2) + 4 * n + (i & 3); }

struct Unit { int pm, pn; };
struct Gemm { const bf16_t* A; const bf16_t* Bt; int M, N, K; };

struct StaticOrder {
    int nM, nN, nwg, G, c;
    __host__ __device__ void init(int M, int N, int G_, int c_) { nM = M / BM; nN = N / BM; nwg = nM * nN; G = G_; c = c_; }
    __host__ __device__ bool next(int i, Unit& u) const {
        const long L = (long)i * G + c; if (L >= nwg) return false;
        int wgid = (int)L; { const int q = nwg / NXCD, r = nwg % NXCD, xcd = wgid % NXCD, off = wgid / NXCD; wgid = (xcd < r ? xcd * (q + 1) : r * (q + 1) + (xcd - r) * q) + off; }
        const int nig = WGM * nN, gid = wgid / nig, fm = gid * WGM, gsz = (nM - fm) < WGM ? (nM - fm) : WGM;
        u.pm = fm + ((wgid % nig) % gsz); u.pn = (wgid % nig) / gsz; return true;
    }
    __device__ __forceinline__ void a_ready(const Unit&) const {}
    __device__ __forceinline__ void done(const Unit&) const {}
};

__device__ __forceinline__ unsigned cvt_pk_bf16(float lo, float hi) { unsigned r; asm volatile("v_cvt_pk_bf16_f32 %0, %1, %2" : "=v"(r) : "v"(lo), "v"(hi)); return r; }
typedef float f32x2 __attribute__((ext_vector_type(2)));
template <class Epi, class Sched, bool ALIGN_EPI = false, bool SP2 = false>
__device__ __forceinline__ void gemm_phase(PG8_LAS unsigned char* lds, const Gemm g, const Sched& S, const Epi& E) {
    int tid = threadIdx.x; asm volatile("" : "+v"(tid));
    const int wid = __builtin_amdgcn_readfirstlane(tid >> 6), lane = tid & 63, wr = wid >> 2, wc = wid & 3, fr = lane & 15, fq = lane >> 4;
    const int K = g.K, nt = K / BK;
    unsigned voffA[2], voffB[2];
#pragma unroll
    for (int i = 0; i < 2; ++i) { int R, C; stage_rc(tid * 16 + i * 8192, R, C); const int Rb = Epi::PERM ? ((R & ~31) + perm32(R & 31)) : R;
        voffA[i] = (unsigned)(R * K + C) * 2u; voffB[i] = (unsigned)(Rb * K + C) * 2u; }
    const size_t kstep = (size_t)(BK * 2);
    const size_t hstep = (size_t)HALF * K * 2;
    const size_t tstep = 2 * hstep;
    const unsigned ldsw = (unsigned)wid * 1024u;
    const int aoff = lds_byte(wr * 64 + fr, fq * 8), boff = lds_byte(wc * 32 + fr, fq * 8);
#define PG8_SA(b, h) (((b) * 2 + (h)) * HTB)
#define PG8_SB(b, h) ((4 + (b) * 2 + (h)) * HTB)
#define PG8_STAGE(bufoff, gbase, voff) do { _Pragma("unroll") for (int _i = 0; _i < 2; ++_i) \
        __builtin_amdgcn_global_load_lds((const unsigned*)((const char*)(gbase) + (voff)[_i]), (PG8_LAS unsigned*)(lds + (bufoff) + ldsw + _i * 8192), 16, 0, 0); } while (0)
#define PG8_LDA(dst, b, h) do { _Pragma("unroll") for (int m = 0; m < 4; ++m) _Pragma("unroll") for (int k = 0; k < 2; ++k) dst[m][k] = *(const PG8_LAS bf16x8*)(lds + PG8_SA(b, h) + aoff + m * 2048 + k * 1024); } while (0)
#define PG8_LDB(dst, b, h) do { _Pragma("unroll") for (int n = 0; n < 2; ++n) _Pragma("unroll") for (int k = 0; k < 2; ++k) dst[n][k] = *(const PG8_LAS bf16x8*)(lds + PG8_SB(b, h) + boff + n * 2048 + k * 1024); } while (0)
#define PG8_MMA(ai, bj, At, Bt) do { __builtin_amdgcn_s_setprio(1); _Pragma("unroll") for (int m = 0; m < 4; ++m) _Pragma("unroll") for (int n = 0; n < 2; ++n) _Pragma("unroll") for (int k = 0; k < 2; ++k) \
        acc[ai][bj][m][n] = __builtin_amdgcn_mfma_f32_16x16x32_bf16(Bt[n][k], At[m][k], acc[ai][bj][m][n], 0, 0, 0); __builtin_amdgcn_s_setprio(0); } while (0)
#define PG8_WAIT_V(n) asm volatile("s_waitcnt vmcnt(" #n ")" ::: "memory")
#define PG8_WAIT_L(n) asm volatile("s_waitcnt lgkmcnt(" #n ")" ::: "memory")
#define PG8_BAR __builtin_amdgcn_s_barrier()
#define PG8_SCHED __builtin_amdgcn_sched_barrier(0)
    Unit cur, nxt; int ui = 0;
    if (!S.next(0, cur)) return;
    f32x4 acc[2][2][4][2];
#pragma unroll
    for (int a = 0; a < 2; ++a)
#pragma unroll
        for (int b = 0; b < 2; ++b)
#pragma unroll
            for (int m = 0; m < 4; ++m)
#pragma unroll
                for (int n = 0; n < 2; ++n) acc[a][b][m][n] = (f32x4){0.f, 0.f, 0.f, 0.f};
    bf16x8 At[4][2], B0[2][2], B1[2][2];
    const char* cA = (const char*)g.A + (size_t)cur.pm * tstep; const char* cB = (const char*)g.Bt + (size_t)cur.pn * tstep;
    S.a_ready(cur);
    if constexpr (SP2) {
        PG8_STAGE(PG8_SB(0, 0), cB, voffB); PG8_STAGE(PG8_SB(0, 1), cB + hstep, voffB); PG8_STAGE(PG8_SA(0, 0), cA, voffA); PG8_STAGE(PG8_SA(0, 1), cA + hstep, voffA);
        if (wr == 1) PG8_BAR;
        PG8_WAIT_V(2); PG8_BAR;
        PG8_STAGE(PG8_SB(1, 0), cB + kstep, voffB); PG8_STAGE(PG8_SA(1, 0), cA + kstep, voffA); PG8_STAGE(PG8_SB(1, 1), cB + hstep + kstep, voffB);
        PG8_WAIT_V(6); PG8_BAR;
    } else {
        PG8_STAGE(PG8_SB(0, 0), cB, voffB); PG8_STAGE(PG8_SA(0, 0), cA, voffA); PG8_STAGE(PG8_SB(0, 1), cB + hstep, voffB); PG8_STAGE(PG8_SA(0, 1), cA + hstep, voffA);
        if (wr == 1) PG8_BAR;
        PG8_WAIT_V(4); PG8_BAR;
        PG8_STAGE(PG8_SB(1, 0), cB + kstep, voffB); PG8_STAGE(PG8_SA(1, 0), cA + kstep, voffA); PG8_STAGE(PG8_SB(1, 1), cB + hstep + kstep, voffB);
        PG8_WAIT_V(6); PG8_BAR;
    }
    for (;;) {
        const bool has_next = S.next(ui + 1, nxt);
        const char* nA = has_next ? (const char*)g.A + (size_t)nxt.pm * tstep : cA; const char* nB = has_next ? (const char*)g.Bt + (size_t)nxt.pn * tstep : cB;
        for (int t = 0; t < nt; t += 2) {
            const bool last = (t == nt - 2);
            const char* a1 = cA + (size_t)(t + 1) * kstep;
            const char* a2 = last ? nA : cA + (size_t)(t + 2) * kstep; const char* b2 = last ? nB : cB + (size_t)(t + 2) * kstep;
            const char* a3 = a2 + kstep; const char* b3 = b2 + kstep;
            if (last && has_next) S.a_ready(nxt);
            if constexpr (SP2) {
            PG8_LDB(B0, 0, 0); PG8_LDB(B1, 0, 1); PG8_SCHED; PG8_LDA(At, 0, 0); PG8_STAGE(PG8_SA(1, 1), a1 + hstep, voffA);
            PG8_WAIT_V(8); PG8_WAIT_L(0); PG8_BAR; PG8_MMA(0, 0, At, B0); PG8_MMA(0, 1, At, B1); PG8_BAR; PG8_SCHED;
            PG8_LDA(At, 0, 1); PG8_STAGE(PG8_SB(0, 0), b2, voffB); PG8_STAGE(PG8_SB(0, 1), b2 + hstep, voffB); PG8_STAGE(PG8_SA(0, 0), a2, voffA);
            PG8_WAIT_V(8); PG8_WAIT_L(0); PG8_BAR; PG8_MMA(1, 0, At, B0); PG8_MMA(1, 1, At, B1); PG8_BAR; PG8_SCHED;
            PG8_LDB(B0, 1, 0); PG8_LDB(B1, 1, 1); PG8_SCHED; PG8_LDA(At, 1, 0); PG8_STAGE(PG8_SA(0, 1), a2 + hstep, voffA);
            PG8_WAIT_V(8); PG8_WAIT_L(0); PG8_BAR; PG8_MMA(0, 0, At, B0); PG8_MMA(0, 1, At, B1); PG8_BAR; PG8_SCHED;
            PG8_LDA(At, 1, 1); PG8_STAGE(PG8_SB(1, 0), b3, voffB); PG8_STAGE(PG8_SB(1, 1), b3 + hstep, voffB); PG8_STAGE(PG8_SA(1, 0), a3, voffA);
            PG8_WAIT_V(8); PG8_WAIT_L(0); PG8_BAR; PG8_MMA(1, 0, At, B0); PG8_MMA(1, 1, At, B1); PG8_BAR; PG8_SCHED;
            } else {
            PG8_LDB(B0, 0, 0); PG8_SCHED; PG8_LDA(At, 0, 0); PG8_STAGE(PG8_SA(1, 1), a1 + hstep, voffA);
            PG8_WAIT_L(8); PG8_BAR; PG8_WAIT_L(0); PG8_MMA(0, 0, At, B0); PG8_BAR; PG8_SCHED;
            PG8_LDB(B1, 0, 1); PG8_STAGE(PG8_SB(0, 0), b2, voffB);
            PG8_BAR; PG8_WAIT_L(0); PG8_MMA(0, 1, At, B1); PG8_BAR;
            PG8_LDA(At, 0, 1); PG8_STAGE(PG8_SA(0, 0), a2, voffA);
            PG8_BAR; PG8_WAIT_L(0); PG8_MMA(1, 0, At, B0); PG8_BAR; PG8_SCHED;
            PG8_STAGE(PG8_SB(0, 1), b2 + hstep, voffB);
            PG8_WAIT_V(6); PG8_BAR; PG8_MMA(1, 1, At, B1); PG8_BAR;
            PG8_LDB(B0, 1, 0); PG8_SCHED; PG8_LDA(At, 1, 0); PG8_STAGE(PG8_SA(0, 1), a2 + hstep, voffA);
            PG8_WAIT_L(8); PG8_BAR; PG8_WAIT_L(0); PG8_MMA(0, 0, At, B0); PG8_BAR; PG8_SCHED;
            PG8_LDB(B1, 1, 1); PG8_STAGE(PG8_SB(1, 0), b3, voffB);
            PG8_BAR; PG8_WAIT_L(0); PG8_MMA(0, 1, At, B1); PG8_BAR;
            PG8_LDA(At, 1, 1); PG8_STAGE(PG8_SA(1, 0), a3, voffA);
            PG8_BAR; PG8_WAIT_L(0); PG8_MMA(1, 0, At, B0); PG8_BAR; PG8_SCHED;
            PG8_STAGE(PG8_SB(1, 1), b3 + hstep, voffB);
            PG8_WAIT_V(6); PG8_BAR; PG8_MMA(1, 1, At, B1); PG8_BAR;
            }
        }
        if constexpr (ALIGN_EPI) { if (wr == 0) PG8_BAR; }
        if constexpr (!Epi::AFTER_DRAIN) { E(acc, cur, wr, wc, fr, fq); S.done(cur); }
        if (!has_next) break;
#pragma unroll
        for (int a = 0; a < 2; ++a)
#pragma unroll
            for (int b = 0; b < 2; ++b)
#pragma unroll
                for (int m = 0; m < 4; ++m)
#pragma unroll
                    for (int n = 0; n < 2; ++n) acc[a][b][m][n] = (f32x4){0.f, 0.f, 0.f, 0.f};
        cur = nxt; cA = nA; cB = nB; ++ui;
        if constexpr (ALIGN_EPI) { if (wr == 1) PG8_BAR; }
    }
    PG8_WAIT_V(0);
    if constexpr (!ALIGN_EPI) { if (wr == 0) PG8_BAR; }
    PG8_BAR;
    if constexpr (Epi::AFTER_DRAIN) { E.fused(acc, cur, wr, wc, fr, fq, lds, wid, lane); S.done(cur); }
#undef PG8_SA
#undef PG8_SB
#undef PG8_STAGE
#undef PG8_LDA
#undef PG8_LDB
#undef PG8_MMA
#undef PG8_WAIT_V
#undef PG8_WAIT_L
#undef PG8_BAR
#undef PG8_SCHED
}
}


namespace {

constexpr int D = 2048, BATCH = 32, SEQ = 256, DEPTH = 4, DB = 2, DS = 1024, PAST = 512;
constexpr int NCTX = BATCH * SEQ, NLAT = DB * DS, T = NCTX + NLAT, TKV = T + DB * PAST;
constexpr int DIN = 3904, DINP = 4096;
constexpr int RING_OFF = 0, MISC_OFF = 131072, LDS_TOTAL = 147456;
typedef unsigned short bf16_t;
constexpr int O_CQ = 0, O_CKV = 512, O_KPE = 768, O_NAQ = 832, O_NAK = 1344, O_NAV = 1856, O_GB = 2368, O_GC = 2880, O_U = 3392;
constexpr float EPS = 1e-6f;
constexpr int NTHREADS = 512, NWAVES = NTHREADS / 64;

struct Params {
    const float *x_prompt, *x_sample, *cache_ckv, *cache_kpe, *cache_nak, *cache_nav, *c, *c_ctx;
    const float *ada_w, *ada_b, *norm_mix_g, *norm_ffn_g, *w_in, *q_norm_g, *w_uq, *kv_norm_g, *w_ukv;
    const float *q_head_g, *k_head_g, *naq_g, *nak_g, *rel_bias, *conv_w, *w_out, *peer_wq, *sub_keys, *peer_u, *peer_v;
    float* out;
    float *o_ckv, *o_kpe, *o_nak, *o_nav;
    unsigned* bar;
    float *ada, *hn, *z, *cqn, *ckv, *qm, *kvr, *km, *qna, *kna, *mix, *qp, *sc, *gate;
    int* eidx;
    unsigned short *wt_in, *wt_uq, *wt_ukv, *wt_out, *wt_q;
    unsigned short *hn_b, *cqn_b, *ckv_b, *mix_b;
    unsigned short *qp_b, *sk_b;
    unsigned char *pu8, *pv8; float *su8, *sv8;
    unsigned short *q_b, *k_b, *qna_b, *kna_b, *cnak_b;
    unsigned short *vt_mla_ctx, *vt_mla_lat, *vt_na_ctx, *vt_na_lat, *vt_na_cache;
};

typedef const __attribute__((address_space(4))) Params CParams;

DEVI int tidx() { int t = threadIdx.x; asm volatile("" : "+v"(t)); return t; }
DEVI float wave_sum(float v) {
#pragma unroll
    for (int o = 32; o > 0; o >>= 1) v += __shfl_xor(v, o);
    return v;
}
DEVI float wave_max(float v) {
#pragma unroll
    for (int o = 32; o > 0; o >>= 1) v = fmaxf(v, __shfl_xor(v, o));
    return v;
}
DEVI void wave_argmax(float& v, int& idx) {
#pragma unroll
    for (int o = 32; o > 0; o >>= 1) {
        float ov = __shfl_xor(v, o); int oi = __shfl_xor(idx, o);
        if (ov > v || (ov == v && oi < idx)) { v = ov; idx = oi; }
    }
}
typedef float f32x2_t __attribute__((ext_vector_type(2))); typedef __bf16 bf16x2_t __attribute__((ext_vector_type(2)));
DEVI unsigned cvtpk(float lo, float hi) { f32x2_t v = {lo, hi}; bf16x2_t b = __builtin_convertvector(v, bf16x2_t); return __builtin_bit_cast(unsigned, b); }
DEVI bf16_t f2bf(float v) { return (bf16_t)(cvtpk(v, 0.f) & 0xffffu); }
DEVI int cond_of(int t) { return t < NCTX ? 2 : (t - NCTX) / DS; }
DEVI const float* xrow(CParams& p, int layer, int t) {
    if (layer == 0) return t < NCTX ? p.x_prompt + (size_t)t * D : p.x_sample + (size_t)(t - NCTX) * D;
    return p.out + (size_t)t * D;
}

DEVI void phase_ada(CParams& p, int bid, int nb, float* lds) {
    float* sv = lds;
    float* red = lds + 3 * D;
    const int tid = tidx(), lane = tid & 63, w = tid >> 6;
    for (int i = tid; i < 3 * D; i += NTHREADS) {
        int j = i / D, k = i % D;
        float v = j < 2 ? p.c[j * D + k] : p.c_ctx[k];
        sv[i] = v / (1.f + __expf(-v));
    }
    __syncthreads();
    const int nitems = DEPTH * (6 * D / 64);
    for (int it = bid; it < nitems; it += nb) {
        const int l = it / (6 * D / 64), n = (it % (6 * D / 64)) * 64 + lane;
        const float* W = p.ada_w + (size_t)l * D * 6 * D + n;
        float a0 = 0.f, a1 = 0.f, a2 = 0.f;
        const int k0 = w * (D / NWAVES);
#pragma unroll 8
        for (int k = k0; k < k0 + D / NWAVES; ++k) {
            float wv = W[(size_t)k * 6 * D];
            a0 += sv[k] * wv; a1 += sv[D + k] * wv; a2 += sv[2 * D + k] * wv;
        }
        red[(w * 3 + 0) * 64 + lane] = a0; red[(w * 3 + 1) * 64 + lane] = a1; red[(w * 3 + 2) * 64 + lane] = a2;
        __syncthreads();
        if (tid < 192) {
            int j = tid / 64, ln = tid % 64;
            float s = 0.f;
            for (int ww = 0; ww < NWAVES; ++ww) s += red[(ww * 3 + j) * 64 + ln];
            int nn = (it % (6 * D / 64)) * 64 + ln;
            p.ada[((size_t)l * 3 + j) * 6 * D + nn] = s + p.ada_b[(size_t)l * 6 * D + nn];
        }
        __syncthreads();
    }
}

DEVI void phase_modnorm(CParams& p, int layer, int which, int bid, int nb) {
    const int lane = tidx() & 63, w = tidx() >> 6;
    const float* g = (which == 0 ? p.norm_mix_g : p.norm_ffn_g) + (size_t)layer * D;
    for (int t = bid * NWAVES + w; t < T; t += nb * NWAVES) {
        const float* x = which == 0 ? xrow(p, layer, t) : p.out + (size_t)t * D;
        const float* ad = p.ada + ((size_t)layer * 3 + cond_of(t)) * 6 * D + (which == 0 ? 0 : 3 * D);
        float4 v[8]; float ss = 0.f;
#pragma unroll
        for (int i = 0; i < 8; ++i) { v[i] = *(const float4*)(x + i * 256 + lane * 4); ss += v[i].x * v[i].x + v[i].y * v[i].y + v[i].z * v[i].z + v[i].w * v[i].w; }
        ss = wave_sum(ss);
        const float r = rsqrtf(ss / D + EPS);
#pragma unroll
        for (int i = 0; i < 8; ++i) {
            const int c = i * 256 + lane * 4;
            float4 gg = *(const float4*)(g + c), sh = *(const float4*)(ad + c), sc = *(const float4*)(ad + D + c), o;
            o.x = v[i].x * r * gg.x * (1.f + sc.x) + sh.x; o.y = v[i].y * r * gg.y * (1.f + sc.y) + sh.y;
            o.z = v[i].z * r * gg.z * (1.f + sc.z) + sh.z; o.w = v[i].w * r * gg.w * (1.f + sc.w) + sh.w;
            *(uint2*)(p.hn_b + (size_t)t * D + c) = make_uint2(pg8::cvt_pk_bf16(o.x, o.y), pg8::cvt_pk_bf16(o.z, o.w));
        }
    }
}

template <bool BT, class Epi>
DEVI void gemm_tile(const float* A, int lda, const float* W, int ldw, int K, int m0, int n0, const Epi& epi, float* lds) {
    float (*As)[132] = (float (*)[132])lds;
    float (*Bs)[68] = (float (*)[68])(lds + 16 * 132);
    const int tid = tidx(), tx = tid & 15, ty = tid >> 4;
    float acc[4][4];
#pragma unroll
    for (int i = 0; i < 4; ++i)
#pragma unroll
        for (int j = 0; j < 4; ++j) acc[i][j] = 0.f;
    for (int k0 = 0; k0 < K; k0 += 16) {
        {
            const int row = tid >> 2, kq = tid & 3;
            float4 v = *(const float4*)(A + (size_t)(m0 + row) * lda + k0 + kq * 4);
            As[kq * 4 + 0][row] = v.x; As[kq * 4 + 1][row] = v.y; As[kq * 4 + 2][row] = v.z; As[kq * 4 + 3][row] = v.w;
        }
        if (tid < 256) {
            if (!BT) {
                const int k = tid >> 4, n4 = tid & 15;
                float4 v = *(const float4*)(W + (size_t)(k0 + k) * ldw + n0 + n4 * 4);
                *(float4*)&Bs[k][n4 * 4] = v;
            } else {
                const int n = tid >> 2, kq = tid & 3;
                float4 v = *(const float4*)(W + (size_t)(n0 + n) * ldw + k0 + kq * 4);
                Bs[kq * 4 + 0][n] = v.x; Bs[kq * 4 + 1][n] = v.y; Bs[kq * 4 + 2][n] = v.z; Bs[kq * 4 + 3][n] = v.w;
            }
        }
        __syncthreads();
#pragma unroll
        for (int k = 0; k < 16; ++k) {
            float4 a = *(const float4*)&As[k][ty * 4], b = *(const float4*)&Bs[k][tx * 4];
            const float av[4] = {a.x, a.y, a.z, a.w}, bv[4] = {b.x, b.y, b.z, b.w};
#pragma unroll
            for (int i = 0; i < 4; ++i)
#pragma unroll
                for (int j = 0; j < 4; ++j) acc[i][j] += av[i] * bv[j];
        }
        __syncthreads();
    }
#pragma unroll
    for (int i = 0; i < 4; ++i) epi(m0 + ty * 4 + i, n0 + tx * 4, make_float4(acc[i][0], acc[i][1], acc[i][2], acc[i][3]));
}
template <bool BT, class Epi>
DEVI void gemm_f32(const float* A, int lda, const float* W, int ldw, int M, int N, int K, const Epi& epi, int bid, int nb, float* lds) {
    const int nn = N / 64, nt = (M / 128) * nn;
    for (int tile = bid; tile < nt; tile += nb) gemm_tile<BT>(A, lda, W, ldw, K, (tile / nn) * 128, (tile % nn) * 64, epi, lds);
}
struct EpiStore { float* C; int ldc; DEVI void operator()(int r, int c, float4 v) const { *(float4*)(C + (size_t)r * ldc + c) = v; } };
struct EpiResid {
    CParams* p; int layer;
    DEVI void operator()(int r, int c, float4 v) const {
        const float* x = xrow(*p, layer, r) + c;
        const float* g1 = p->ada + ((size_t)layer * 3 + cond_of(r)) * 6 * D + 2 * D + c;
        float4 xv = *(const float4*)x, gv = *(const float4*)g1, o;
        o.x = xv.x + gv.x * v.x; o.y = xv.y + gv.y * v.y; o.z = xv.z + gv.z * v.z; o.w = xv.w + gv.w * v.w;
        *(float4*)(p->out + (size_t)r * D + c) = o;
    }
};


struct EpiF32 {
    static constexpr bool PERM = false, AFTER_DRAIN = false;
    float* C; int ldc, ncols;
    DEVI void operator()(const pg8::f32x4 (&acc)[2][2][4][2], const pg8::Unit& u, int wr, int wc, int fr, int fq) const {
        const int row0 = u.pm * 256 + wr * 64 + fr, col0 = u.pn * 256 + wc * 32 + 4 * fq;
#pragma unroll
        for (int ai = 0; ai < 2; ++ai)
#pragma unroll
            for (int m = 0; m < 4; ++m) { float* rowp = C + (size_t)(row0 + ai * 128 + m * 16) * ldc;
#pragma unroll
                for (int bj = 0; bj < 2; ++bj)
#pragma unroll
                    for (int n = 0; n < 2; ++n) { const int c = col0 + bj * 128 + n * 16; if (c < ncols) *(pg8::f32x4*)(rowp + c) = acc[ai][bj][m][n]; } }
    }
};
struct EpiResidMF {
    static constexpr bool PERM = false, AFTER_DRAIN = false;
    CParams* p; int layer;
    DEVI void operator()(const pg8::f32x4 (&acc)[2][2][4][2], const pg8::Unit& u, int wr, int wc, int fr, int fq) const {
        const int row0 = u.pm * 256 + wr * 64 + fr, col0 = u.pn * 256 + wc * 32 + 4 * fq;
#pragma unroll
        for (int ai = 0; ai < 2; ++ai)
#pragma unroll
            for (int m = 0; m < 4; ++m) {
                const int r = row0 + ai * 128 + m * 16;
                const float* x = xrow(*p, layer, r);
                const float* g1 = p->ada + ((size_t)layer * 3 + cond_of(r)) * 6 * D + 2 * D;
                float* o = p->out + (size_t)r * D;
#pragma unroll
                for (int bj = 0; bj < 2; ++bj)
#pragma unroll
                    for (int n = 0; n < 2; ++n) { const int c = col0 + bj * 128 + n * 16;
                        const pg8::f32x4 xv = *(const pg8::f32x4*)(x + c), gv = *(const pg8::f32x4*)(g1 + c);
                        *(pg8::f32x4*)(o + c) = xv + gv * acc[ai][bj][m][n]; } }
    }
};
struct EpiBf16Store {
    static constexpr bool PERM = true, AFTER_DRAIN = false;
    bf16_t* O; int ldc;
    DEVI void operator()(const pg8::f32x4 (&acc)[2][2][4][2], const pg8::Unit& u, int wr, int wc, int fr, int fq) const {
        const int row0 = u.pm * 256 + wr * 64 + fr, col0 = u.pn * 256 + wc * 32 + 8 * fq;
#pragma unroll
        for (int ai = 0; ai < 2; ++ai)
#pragma unroll
            for (int m = 0; m < 4; ++m) { bf16_t* rowp = O + (size_t)(row0 + ai * 128 + m * 16) * ldc + col0;
#pragma unroll
                for (int bj = 0; bj < 2; ++bj) { const pg8::f32x4 v0 = acc[ai][bj][m][0], v1 = acc[ai][bj][m][1];
                    *(uint4*)(rowp + bj * 128) = make_uint4(cvtpk(v0[0], v0[1]), cvtpk(v0[2], v0[3]), cvtpk(v1[0], v1[1]), cvtpk(v1[2], v1[3])); } }
    }
};
template <class Epi>
DEVI void mfma_gemm(const bf16_t* A, const bf16_t* Bt, int M, int N, int K, const Epi& E, int bid, int nb, float* lds) {
    pg8::Gemm g{A, Bt, M, N, K};
    pg8::StaticOrder S; S.init(M, N, nb, bid);
    pg8::gemm_phase<Epi, pg8::StaticOrder, true, true>((PG8_LAS unsigned char*)lds + RING_OFF, g, S, E);
    __syncthreads();
}

DEVI void transpose_tile(const float* W, int ldw, bf16_t* Wt, int ldt, int k0, int n0, float* lds) {
    float (*tl)[65] = (float (*)[65])lds;
    const int tid = tidx();
#pragma unroll
    for (int rep = 0; rep < 2; ++rep) {
        const int k = (tid >> 4) + rep * 32, n4 = (tid & 15) * 4;
        const float4 v = *(const float4*)(W + (size_t)(k0 + k) * ldw + n0 + n4);
        tl[k][n4] = v.x; tl[k][n4 + 1] = v.y; tl[k][n4 + 2] = v.z; tl[k][n4 + 3] = v.w;
    }
    __syncthreads();
    {
        const int n = tid >> 3, k8 = (tid & 7) * 8;
        uint4 o;
        o.x = pg8::cvt_pk_bf16(tl[k8 + 0][n], tl[k8 + 1][n]); o.y = pg8::cvt_pk_bf16(tl[k8 + 2][n], tl[k8 + 3][n]);
        o.z = pg8::cvt_pk_bf16(tl[k8 + 4][n], tl[k8 + 5][n]); o.w = pg8::cvt_pk_bf16(tl[k8 + 6][n], tl[k8 + 7][n]);
        *(uint4*)(Wt + (size_t)(n0 + n) * ldt + k0 + k8) = o;
    }
    __syncthreads();
}
DEVI void phase_weights(CParams& p, int bid, int nb, float* lds) {
    constexpr int N_IN = 32 * 61, N_UQ = 8 * 24, N_UKV = 4 * 32, N_SQ = 32 * 32, PER = N_IN + N_UQ + N_UKV + 2 * N_SQ;
    for (int it = bid; it < DEPTH * PER; it += nb) {
        const int l = it / PER; int j = it % PER;
        if (j < N_IN) { transpose_tile(p.w_in + (size_t)l * D * DIN, DIN, p.wt_in + (size_t)l * DINP * D, D, (j / 61) * 64, (j % 61) * 64, lds); continue; }
        j -= N_IN;
        if (j < N_UQ) { transpose_tile(p.w_uq + (size_t)l * 512 * 1536, 1536, p.wt_uq + (size_t)l * 1536 * 512, 512, (j / 24) * 64, (j % 24) * 64, lds); continue; }
        j -= N_UQ;
        if (j < N_UKV) { transpose_tile(p.w_ukv + (size_t)l * 256 * 2048, 2048, p.wt_ukv + (size_t)l * 2048 * 256, 256, (j / 32) * 64, (j % 32) * 64, lds); continue; }
        j -= N_UKV;
        if (j < N_SQ) { transpose_tile(p.w_out + (size_t)l * D * D, D, p.wt_out + (size_t)l * D * D, D, (j / 32) * 64, (j % 32) * 64, lds); continue; }
        j -= N_SQ;
        transpose_tile(p.peer_wq + (size_t)l * D * D, D, p.wt_q + (size_t)l * D * D, D, (j / 32) * 64, (j % 32) * 64, lds);
    }
    for (int i = bid * NTHREADS + tidx(); i < DEPTH * 8 * 2 * 128 * 128 / 4; i += nb * NTHREADS) {
        const float4 v = *(const float4*)(p.sub_keys + (size_t)i * 4);
        *(uint2*)(p.sk_b + (size_t)i * 4) = make_uint2(cvtpk(v.x, v.y), cvtpk(v.z, v.w));
    }
    {
        const int lane = tidx() & 63, w = tidx() >> 6;
        for (int row = bid * NWAVES + w; row < 2 * DEPTH * 16384; row += nb * NWAVES) {
            const bool isv = row >= DEPTH * 16384; const int rr = isv ? row - DEPTH * 16384 : row;
            const float* src = (isv ? p.peer_v : p.peer_u) + (size_t)rr * D;
            float4 v[8]; float mx = 0.f;
#pragma unroll
            for (int i = 0; i < 8; ++i) { v[i] = *(const float4*)(src + i * 256 + lane * 4); mx = fmaxf(mx, fmaxf(fmaxf(fabsf(v[i].x), fabsf(v[i].y)), fmaxf(fabsf(v[i].z), fabsf(v[i].w)))); }
            mx = wave_max(mx);
            const float scale = mx > 0.f ? mx * (1.f / 440.f) : 1.f, inv = 1.f / scale;
            unsigned char* dst = (isv ? p.pv8 : p.pu8) + (size_t)rr * D;
#pragma unroll
            for (int i = 0; i < 8; ++i) {
                int pk = 0;
                pk = __builtin_amdgcn_cvt_pk_fp8_f32(v[i].x * inv, v[i].y * inv, pk, false);
                pk = __builtin_amdgcn_cvt_pk_fp8_f32(v[i].z * inv, v[i].w * inv, pk, true);
                *(int*)(dst + i * 256 + lane * 4) = pk;
            }
            if (lane == 0) (isv ? p.sv8 : p.su8)[rr] = scale;
        }
    }
    const int nz = DEPTH * (DINP - DIN) * D / 8;
    for (int i = bid * NTHREADS + tidx(); i < nz; i += nb * NTHREADS) {
        const int per = (DINP - DIN) * D / 8, l = i / per, r = i % per;
        *(uint4*)(p.wt_in + ((size_t)l * DINP + DIN) * D + (size_t)r * 8) = make_uint4(0u, 0u, 0u, 0u);
    }
}

DEVI void phase_postz(CParams& p, int layer, int bid, int nb) {
    const int lane = tidx() & 63, w = tidx() >> 6;
    for (int r = bid * NWAVES + w; r < TKV; r += nb * NWAVES) {
        if (r >= T) {
            const int b = (r - T) / PAST, j = (r - T) % PAST;
            const float* src = p.cache_ckv + (((size_t)b * DEPTH + layer) * PAST + j) * 256;
            { float4 v = *(const float4*)(src + lane * 4); *(uint2*)(p.ckv_b + (size_t)r * 256 + lane * 4) = make_uint2(pg8::cvt_pk_bf16(v.x, v.y), pg8::cvt_pk_bf16(v.z, v.w)); }
            continue;
        }
        const float* z = p.z + (size_t)r * DIN;
        const bool ctx = r < NCTX;
        const int b = ctx ? r / SEQ : (r - NCTX) / DS, s = ctx ? r % SEQ : (r - NCTX) % DS;
        {
            float v[8], ss = 0.f;
#pragma unroll
            for (int i = 0; i < 8; ++i) { v[i] = z[O_CQ + i * 64 + lane]; ss += v[i] * v[i]; }
            ss = wave_sum(ss); const float rr = rsqrtf(ss / 512.f + EPS);
#pragma unroll
            for (int i = 0; i < 8; ++i) p.cqn_b[(size_t)r * 512 + i * 64 + lane] = f2bf(v[i] * rr * p.q_norm_g[layer * 512 + i * 64 + lane]);
        }
        {
            float v[4], ss = 0.f;
#pragma unroll
            for (int i = 0; i < 4; ++i) { v[i] = z[O_CKV + i * 64 + lane]; ss += v[i] * v[i]; }
            ss = wave_sum(ss); const float rr = rsqrtf(ss / 256.f + EPS);
#pragma unroll
            for (int i = 0; i < 4; ++i) {
                const float o = v[i] * rr * p.kv_norm_g[layer * 256 + i * 64 + lane];
                p.ckv_b[(size_t)r * 256 + i * 64 + lane] = f2bf(o);
                if (ctx) p.o_ckv[(((size_t)b * DEPTH + layer) * SEQ + s) * 256 + i * 64 + lane] = o;
            }
        }
        if (ctx) p.o_kpe[(((size_t)b * DEPTH + layer) * SEQ + s) * 64 + lane] = z[O_KPE + lane];
#pragma unroll
        for (int h = 0; h < 4; ++h) {
            float q0 = z[O_NAQ + h * 128 + lane], q1 = z[O_NAQ + h * 128 + 64 + lane];
            float ss = wave_sum(q0 * q0 + q1 * q1); float rr = rsqrtf(ss / 128.f + EPS);
            p.qna_b[(size_t)r * 512 + h * 128 + lane] = f2bf(q0 * rr * p.naq_g[layer * 128 + lane]);
            p.qna_b[(size_t)r * 512 + h * 128 + 64 + lane] = f2bf(q1 * rr * p.naq_g[layer * 128 + 64 + lane]);
            float k0 = z[O_NAK + h * 128 + lane], k1 = z[O_NAK + h * 128 + 64 + lane];
            ss = wave_sum(k0 * k0 + k1 * k1); rr = rsqrtf(ss / 128.f + EPS);
            k0 = k0 * rr * p.nak_g[layer * 128 + lane]; k1 = k1 * rr * p.nak_g[layer * 128 + 64 + lane];
            p.kna_b[(size_t)r * 512 + h * 128 + lane] = f2bf(k0); p.kna_b[(size_t)r * 512 + h * 128 + 64 + lane] = f2bf(k1);
            if (ctx) {
                const size_t o = ((((size_t)b * DEPTH + layer) * 4 + h) * SEQ + s) * 128;
                p.o_nak[o + lane] = k0; p.o_nak[o + 64 + lane] = k1;
                p.o_nav[o + lane] = z[O_NAV + h * 128 + lane]; p.o_nav[o + 64 + lane] = z[O_NAV + h * 128 + 64 + lane];
            }
        }
        {
            const int S = ctx ? SEQ : DS;
#pragma unroll
            for (int i = 0; i < 8; ++i) {
                const int ch = i * 64 + lane;
                const float* cw = p.conv_w + ((size_t)layer * 512 + ch) * 3;
                float acc = z[O_GC + ch] * z[O_U + ch] * cw[1];
                if (s > 0) acc += (z - DIN)[O_GC + ch] * (z - DIN)[O_U + ch] * cw[0];
                if (s < S - 1) acc += (z + DIN)[O_GC + ch] * (z + DIN)[O_U + ch] * cw[2];
                p.mix_b[(size_t)r * D + 1536 + ch] = f2bf(z[O_GB + ch] * acc);
            }
        }
    }
}

DEVI float rope_angle(int pos, int j) {
    const int row = pos / 64, col = pos % 64;
    const int f = j & 15;
    const float inv = powf(10000.f, -(float)f / 16.f);
    return (j < 16 ? (float)row : (float)col) * inv;
}

DEVI void transpose_v(const float* src, size_t sstride, bf16_t* dst, int ldv, float* lds) {
    float (*tl)[129] = (float (*)[129])lds;
    const int tid = tidx();
#pragma unroll
    for (int rep = 0; rep < 4; ++rep) {
        const int row = (tid >> 5) + 16 * rep, c4 = (tid & 31) * 4;
        const float4 v = *(const float4*)(src + (size_t)row * sstride + c4);
        tl[row][c4] = v.x; tl[row][c4 + 1] = v.y; tl[row][c4 + 2] = v.z; tl[row][c4 + 3] = v.w;
    }
    __syncthreads();
    {
        const int d = tid >> 2, k16 = (tid & 3) * 16;
        uint4 o0, o1;
        o0.x = cvtpk(tl[k16 + 0][d], tl[k16 + 1][d]); o0.y = cvtpk(tl[k16 + 2][d], tl[k16 + 3][d]); o0.z = cvtpk(tl[k16 + 4][d], tl[k16 + 5][d]); o0.w = cvtpk(tl[k16 + 6][d], tl[k16 + 7][d]);
        o1.x = cvtpk(tl[k16 + 8][d], tl[k16 + 9][d]); o1.y = cvtpk(tl[k16 + 10][d], tl[k16 + 11][d]); o1.z = cvtpk(tl[k16 + 12][d], tl[k16 + 13][d]); o1.w = cvtpk(tl[k16 + 14][d], tl[k16 + 15][d]);
        bf16_t* o = dst + (size_t)d * ldv + k16;
        *(uint4*)o = o0; *(uint4*)(o + 8) = o1;
    }
    __syncthreads();
}
DEVI void phase_headnorm(CParams& p, int layer, int bid, int nb, float* lds) {
    const int lane = tidx() & 63, w = tidx() >> 6;
    const int nq = T * 8, nk = TKV * 8;
    for (int it = bid * NWAVES + w; it < nq + nk; it += nb * NWAVES) {
        const bool isq = it < nq;
        const int r = isq ? it / 8 : (it - nq) / 8, h = it % 8;
        float v0, v1, v2; const float* g; bf16_t* dst; int pos = -1;
        if (isq) {
            const float* q = p.qm + (size_t)r * 1536 + h * 192;
            v0 = q[lane]; v1 = q[64 + lane]; v2 = q[128 + lane]; g = p.q_head_g + layer * 192; dst = p.q_b + (size_t)r * 1536 + h * 192;
            if (r >= NCTX) pos = (r - NCTX) % DS;
        } else {
            const float* kv = p.kvr + (size_t)r * 2048 + h * 256;
            v0 = kv[lane]; v1 = kv[64 + lane];
            if (r < T) v2 = p.z[(size_t)r * DIN + O_KPE + lane];
            else { const int b = (r - T) / PAST, j = (r - T) % PAST; v2 = p.cache_kpe[(((size_t)b * DEPTH + layer) * PAST + j) * 64 + lane]; }
            g = p.k_head_g + layer * 192; dst = p.k_b + (size_t)r * 1536 + h * 192;
            if (r >= NCTX && r < T) pos = (r - NCTX) % DS;
        }
        const float ss = wave_sum(v0 * v0 + v1 * v1 + v2 * v2);
        const float rr = rsqrtf(ss / 192.f + EPS);
        v0 *= rr * g[lane]; v1 *= rr * g[64 + lane]; v2 *= rr * g[128 + lane];
        if (pos >= 0) {
            const float other = __shfl_xor(v2, 32);
            const float ang = rope_angle(pos, lane & 31);
            const float cs = cosf(ang), sn = sinf(ang);
            v2 = lane < 32 ? v2 * cs - other * sn : other * sn + v2 * cs;
        }
        dst[lane] = f2bf(v0); dst[64 + lane] = f2bf(v1); dst[128 + lane] = f2bf(v2);
    }
    for (int i = bid * NTHREADS + tidx(); i < DB * 4 * PAST * 128 / 4; i += nb * NTHREADS) {
        const int e = i * 4, bh = e / (PAST * 128), rem = e % (PAST * 128), b = bh / 4, h = bh % 4;
        const float4 v = *(const float4*)(p.cache_nak + (((size_t)b * DEPTH + layer) * 4 + h) * PAST * 128 + rem);
        *(uint2*)(p.cnak_b + (size_t)e) = make_uint2(cvtpk(v.x, v.y), cvtpk(v.z, v.w));
    }
    constexpr int N_MLA = (TKV / 64) * 8, N_NA = (T / 64) * 4, N_NC = DB * 4 * (PAST / 64);
    for (int it = bid; it < N_MLA + N_NA + N_NC; it += nb) {
        if (it < N_MLA) {
            const int kt = it / 8, h = it % 8, r0 = kt * 64;
            const float* src = p.kvr + (size_t)r0 * 2048 + h * 256 + 128;
            bf16_t* dst; int ldv;
            if (r0 < NCTX) { const int b = r0 / SEQ; dst = p.vt_mla_ctx + ((size_t)(b * 8 + h) * 128) * SEQ + r0 % SEQ; ldv = SEQ; }
            else if (r0 < T) { const int b = (r0 - NCTX) / DS; dst = p.vt_mla_lat + ((size_t)(b * 8 + h) * 128) * (PAST + DS) + PAST + (r0 - NCTX) % DS; ldv = PAST + DS; }
            else { const int b = (r0 - T) / PAST; dst = p.vt_mla_lat + ((size_t)(b * 8 + h) * 128) * (PAST + DS) + (r0 - T) % PAST; ldv = PAST + DS; }
            transpose_v(src, 2048, dst, ldv, lds);
        } else if (it < N_MLA + N_NA) {
            const int j = it - N_MLA, kt = j / 4, h = j % 4, r0 = kt * 64;
            const float* src = p.z + (size_t)r0 * DIN + O_NAV + h * 128;
            bf16_t* dst; int ldv;
            if (r0 < NCTX) { const int b = r0 / SEQ; dst = p.vt_na_ctx + ((size_t)(b * 4 + h) * 128) * SEQ + r0 % SEQ; ldv = SEQ; }
            else { const int b = (r0 - NCTX) / DS; dst = p.vt_na_lat + ((size_t)(b * 4 + h) * 128) * DS + (r0 - NCTX) % DS; ldv = DS; }
            transpose_v(src, DIN, dst, ldv, lds);
        } else {
            const int j = it - N_MLA - N_NA, bh = j / (PAST / 64), jt = j % (PAST / 64), b = bh / 4, h = bh % 4;
            const float* src = p.cache_nav + ((((size_t)b * DEPTH + layer) * 4 + h) * PAST + jt * 64) * 128;
            transpose_v(src, 128, p.vt_na_cache + ((size_t)(b * 4 + h) * 128) * PAST + jt * 64, PAST, lds);
        }
    }
}

typedef short bf16x8_t __attribute__((ext_vector_type(8)));
typedef float f32x16_t __attribute__((ext_vector_type(16)));
#define MFMA32(a, b, c) __builtin_amdgcn_mfma_f32_32x32x16_bf16((a), (b), (c), 0, 0, 0)
DEVI int crow(int reg, int h) { return (reg & 3) + 8 * (reg >> 2) + 4 * h; }

struct AttnUnit {
    const bf16_t* q; int qstride;
    const bf16_t *k0, *vt0; int ks0, ldv0, nt0;
    const bf16_t *k1, *vt1; int ks1, ldv1, nt1;
    const bf16_t *kl, *vtl; int nloc;
    const float* bias; int qr, c0, rs;
    bf16_t* out;
    float scale;
};

template <int DQ>
DEVI void attn_unit(const AttnUnit& u) {
    const int lane = tidx() & 63, r = lane & 31, h = lane >> 5;
    bf16x8_t qf[DQ / 16];
    {
        const bf16_t* qrow = u.q + (size_t)r * u.qstride + 8 * h;
#pragma unroll
        for (int kk = 0; kk < DQ / 16; ++kk) qf[kk] = *(const bf16x8_t*)(qrow + kk * 16);
    }
    f32x16_t ot[4];
#pragma unroll
    for (int b = 0; b < 4; ++b)
#pragma unroll
        for (int i = 0; i < 16; ++i) ot[b][i] = 0.f;
    float m = -INFINITY, l = 0.f;
    const int ntiles = u.nt0 + u.nt1 + u.nloc;
    for (int t = 0; t < ntiles; ++t) {
        const bf16_t *kp, *vp; int ks, ldv, lrow = -1, lcol = 0;
        if (t < u.nt0) { kp = u.k0 + (size_t)t * 32 * u.ks0; ks = u.ks0; vp = u.vt0 + t * 32; ldv = u.ldv0; }
        else if (t < u.nt0 + u.nt1) { const int tt = t - u.nt0; kp = u.k1 + (size_t)tt * 32 * u.ks1; ks = u.ks1; vp = u.vt1 + tt * 32; ldv = u.ldv1; }
        else { const int tt = t - u.nt0 - u.nt1; lrow = u.rs + (tt >> 1); lcol = (tt & 1) * 32; kp = u.kl + (size_t)(lrow * 64 + lcol) * 512; ks = 512; vp = u.vtl + lrow * 64 + lcol; ldv = DS; }
        f32x16_t st;
#pragma unroll
        for (int i = 0; i < 16; ++i) st[i] = 0.f;
        {
            const bf16_t* krow = kp + (size_t)r * ks + 8 * h;
#pragma unroll
            for (int kk = 0; kk < DQ / 16; ++kk) { const bf16x8_t a = *(const bf16x8_t*)(krow + kk * 16); st = MFMA32(a, qf[kk], st); }
        }
        float sv[16], mx = -INFINITY;
        if (lrow >= 0) {
            const int qc = u.c0 + r, cs = min(max(qc - 8, 0), 48);
            const float* brow = u.bias + (lrow - u.qr + 7) * 31 + (15 - qc);
#pragma unroll
            for (int i = 0; i < 16; ++i) {
                const int kc = lcol + crow(i, h);
                const bool valid = kc >= cs && kc < cs + 16;
                const float bv = valid ? brow[kc] : 0.f;
                sv[i] = valid ? st[i] * u.scale + bv : -INFINITY; mx = fmaxf(mx, sv[i]);
            }
        } else {
#pragma unroll
            for (int i = 0; i < 16; ++i) { sv[i] = st[i] * u.scale; mx = fmaxf(mx, sv[i]); }
        }
        mx = fmaxf(mx, __shfl_xor(mx, 32));
        const float mnew = fmaxf(m, mx), alpha = __expf(m - mnew);
        m = mnew;
        float ls = 0.f;
#pragma unroll
        for (int i = 0; i < 16; ++i) { sv[i] = __expf(sv[i] - mnew); ls += sv[i]; }
        l = l * alpha + ls;
#pragma unroll
        for (int b = 0; b < 4; ++b)
#pragma unroll
            for (int i = 0; i < 16; ++i) ot[b][i] *= alpha;
#pragma unroll
        for (int s2 = 0; s2 < 2; ++s2) {
            uint4 pk; pk.x = cvtpk(sv[8 * s2 + 0], sv[8 * s2 + 1]); pk.y = cvtpk(sv[8 * s2 + 2], sv[8 * s2 + 3]); pk.z = cvtpk(sv[8 * s2 + 4], sv[8 * s2 + 5]); pk.w = cvtpk(sv[8 * s2 + 6], sv[8 * s2 + 7]);
            const bf16x8_t xs = __builtin_bit_cast(bf16x8_t, pk);
#pragma unroll
            for (int b = 0; b < 4; ++b) {
                const bf16_t* vrow = vp + (size_t)(32 * b + r) * ldv + 16 * s2 + 4 * h;
                const uint2 lo = *(const uint2*)vrow, hi = *(const uint2*)(vrow + 8);
                const bf16x8_t pa = __builtin_bit_cast(bf16x8_t, make_uint4(lo.x, lo.y, hi.x, hi.y));
                ot[b] = MFMA32(pa, xs, ot[b]);
            }
        }
    }
    l += __shfl_xor(l, 32);
    const float inv = 1.f / l;
    bf16_t* orow = u.out + (size_t)r * D;
#pragma unroll
    for (int b = 0; b < 4; ++b)
#pragma unroll
        for (int g = 0; g < 4; ++g)
            *(uint2*)(orow + 32 * b + 8 * g + 4 * h) = make_uint2(cvtpk(ot[b][4 * g] * inv, ot[b][4 * g + 1] * inv), cvtpk(ot[b][4 * g + 2] * inv, ot[b][4 * g + 3] * inv));
}

DEVI void attn_dispatch(CParams& p, int layer, int kind, int idx) {
    AttnUnit u;
    u.k1 = nullptr; u.vt1 = nullptr; u.ks1 = 0; u.ldv1 = 0; u.nt1 = 0; u.kl = nullptr; u.vtl = nullptr; u.nloc = 0; u.bias = nullptr; u.qr = 0; u.c0 = 0; u.rs = 0;
    if (kind == 0) {
        const int qt = idx % 32, h = (idx / 32) % 8, b = idx / 256, t0 = NCTX + b * DS + qt * 32;
        u.q = p.q_b + (size_t)t0 * 1536 + h * 192; u.qstride = 1536; u.scale = 0.07216878364870322f;
        u.k0 = p.k_b + (size_t)(T + b * PAST) * 1536 + h * 192; u.ks0 = 1536; u.vt0 = p.vt_mla_lat + ((size_t)(b * 8 + h) * 128) * (PAST + DS); u.ldv0 = PAST + DS; u.nt0 = PAST / 32;
        u.k1 = p.k_b + (size_t)(NCTX + b * DS) * 1536 + h * 192; u.ks1 = 1536; u.vt1 = u.vt0 + PAST; u.ldv1 = PAST + DS; u.nt1 = DS / 32;
        u.out = p.mix_b + (size_t)t0 * D + h * 128;
        attn_unit<192>(u);
    } else if (kind == 1) {
        const int qt = idx % 32, h = (idx / 32) % 4, b = idx / 128, t0 = NCTX + b * DS + qt * 32;
        u.q = p.qna_b + (size_t)t0 * 512 + h * 128; u.qstride = 512; u.scale = 0.08838834764831845f;
        u.k0 = p.cnak_b + ((size_t)(b * 4 + h) * PAST) * 128; u.ks0 = 128; u.vt0 = p.vt_na_cache + ((size_t)(b * 4 + h) * 128) * PAST; u.ldv0 = PAST; u.nt0 = PAST / 32;
        u.kl = p.kna_b + (size_t)(NCTX + b * DS) * 512 + h * 128; u.vtl = p.vt_na_lat + ((size_t)(b * 4 + h) * 128) * DS; u.nloc = 16;
        u.bias = p.rel_bias + ((size_t)layer * 4 + h) * 15 * 31; u.qr = qt >> 1; u.c0 = (qt & 1) * 32; u.rs = min(max(u.qr - 4, 0), 8);
        u.out = p.mix_b + (size_t)t0 * D + 1024 + h * 128;
        attn_unit<128>(u);
    } else if (kind == 2) {
        const int qt = idx % 8, h = (idx / 8) % 8, b = idx / 64, t0 = b * SEQ + qt * 32;
        u.q = p.q_b + (size_t)t0 * 1536 + h * 192; u.qstride = 1536; u.scale = 0.07216878364870322f;
        u.k0 = p.k_b + (size_t)(b * SEQ) * 1536 + h * 192; u.ks0 = 1536; u.vt0 = p.vt_mla_ctx + ((size_t)(b * 8 + h) * 128) * SEQ; u.ldv0 = SEQ; u.nt0 = SEQ / 32;
        u.out = p.mix_b + (size_t)t0 * D + h * 128;
        attn_unit<192>(u);
    } else {
        const int qt = idx % 8, h = (idx / 8) % 4, b = idx / 32, t0 = b * SEQ + qt * 32;
        u.q = p.qna_b + (size_t)t0 * 512 + h * 128; u.qstride = 512; u.scale = 0.08838834764831845f;
        u.k0 = p.kna_b + (size_t)(b * SEQ) * 512 + h * 128; u.ks0 = 512; u.vt0 = p.vt_na_ctx + ((size_t)(b * 4 + h) * 128) * SEQ; u.ldv0 = SEQ; u.nt0 = SEQ / 32;
        u.out = p.mix_b + (size_t)t0 * D + 1024 + h * 128;
        attn_unit<128>(u);
    }
}
struct AttnBlk {
    const bf16_t* q; int qstride;
    const bf16_t *k0, *vt0; int ks0, ldv0, nst0;
    const bf16_t *k1, *vt1; int ks1, ldv1, nst1;
    bf16_t* out; float scale;
};
template <int DQ>
DEVI void attn_block(const AttnBlk& u, float* ldsf) {
    constexpr int KROW = DQ * 2 + 16, VROW = 136, KBYTES = 64 * KROW, STAGE = KBYTES + 128 * VROW;
    constexpr int KCH = DQ / 8, NKC = 64 * KCH / NTHREADS;
    unsigned char* lds = (unsigned char*)ldsf;
    const int tid = tidx(), lane = tid & 63, w = tid >> 6, r = lane & 31, h = lane >> 5;
    bf16x8_t qf[DQ / 16];
    {
        const bf16_t* qrow = u.q + (size_t)(w * 32 + r) * u.qstride + 8 * h;
#pragma unroll
        for (int kk = 0; kk < DQ / 16; ++kk) qf[kk] = *(const bf16x8_t*)(qrow + kk * 16);
    }
    f32x16_t ot[4];
#pragma unroll
    for (int b = 0; b < 4; ++b)
#pragma unroll
        for (int i = 0; i < 16; ++i) ot[b][i] = 0.f;
    float m = -INFINITY, l = 0.f;
    const int nst = u.nst0 + u.nst1;
    uint4 kr0, kr1, kr2, vr0, vr1;
    kr2 = make_uint4(0u, 0u, 0u, 0u);
    const int krow0 = tid / KCH, kcol0 = tid % KCH, krow1 = (tid + NTHREADS) / KCH, kcol1 = (tid + NTHREADS) % KCH, krow2 = (tid + 2 * NTHREADS) / KCH, kcol2 = (tid + 2 * NTHREADS) % KCH;
    const int vrow0 = tid >> 3, vc0 = tid & 7, vrow1 = (tid + NTHREADS) >> 3;
#define STAGE_LOAD(s_) do { const int s__ = (s_); const bf16_t *kp, *vp; int ks, ldv; \
        if (s__ < u.nst0) { kp = u.k0 + (size_t)s__ * 64 * u.ks0; ks = u.ks0; vp = u.vt0 + s__ * 64; ldv = u.ldv0; } \
        else { const int s1 = s__ - u.nst0; kp = u.k1 + (size_t)s1 * 64 * u.ks1; ks = u.ks1; vp = u.vt1 + s1 * 64; ldv = u.ldv1; } \
        kr0 = *(const uint4*)(kp + (size_t)krow0 * ks + kcol0 * 8); kr1 = *(const uint4*)(kp + (size_t)krow1 * ks + kcol1 * 8); \
        if constexpr (NKC == 3) kr2 = *(const uint4*)(kp + (size_t)krow2 * ks + kcol2 * 8); \
        vr0 = *(const uint4*)(vp + (size_t)vrow0 * ldv + vc0 * 8); vr1 = *(const uint4*)(vp + (size_t)vrow1 * ldv + vc0 * 8); } while (0)
#define STAGE_STORE(buf_) do { unsigned char* base = lds + (buf_) * STAGE; \
        *(uint4*)(base + krow0 * KROW + kcol0 * 16) = kr0; *(uint4*)(base + krow1 * KROW + kcol1 * 16) = kr1; \
        if constexpr (NKC == 3) *(uint4*)(base + krow2 * KROW + kcol2 * 16) = kr2; \
        { unsigned char* v0_ = base + KBYTES + vrow0 * VROW + vc0 * 16; unsigned char* v1_ = base + KBYTES + vrow1 * VROW + vc0 * 16;     \
          *(uint2*)v0_ = make_uint2(vr0.x, vr0.y); *(uint2*)(v0_ + 8) = make_uint2(vr0.z, vr0.w); *(uint2*)v1_ = make_uint2(vr1.x, vr1.y); *(uint2*)(v1_ + 8) = make_uint2(vr1.z, vr1.w); } } while (0)
    STAGE_LOAD(0); STAGE_STORE(0);
    __syncthreads();
    for (int s = 0; s < nst; ++s) {
        if (s + 1 < nst) STAGE_LOAD(s + 1);
        const unsigned char* kb = lds + (s & 1) * STAGE;
        const unsigned char* vb = kb + KBYTES;
#pragma unroll
        for (int sub = 0; sub < 2; ++sub) {
            f32x16_t st;
#pragma unroll
            for (int i = 0; i < 16; ++i) st[i] = 0.f;
            {
                const unsigned char* krow = kb + (sub * 32 + r) * KROW + 16 * h;
#pragma unroll
                for (int kk = 0; kk < DQ / 16; ++kk) { const bf16x8_t a = *(const bf16x8_t*)(krow + kk * 32); st = MFMA32(a, qf[kk], st); }
            }
            float sv[16], mx = -INFINITY;
#pragma unroll
            for (int i = 0; i < 16; ++i) { sv[i] = st[i] * u.scale; mx = fmaxf(mx, sv[i]); }
            mx = fmaxf(mx, __shfl_xor(mx, 32));
            const float mnew = fmaxf(m, mx), alpha = __expf(m - mnew);
            m = mnew;
            float ls = 0.f;
#pragma unroll
            for (int i = 0; i < 16; ++i) { sv[i] = __expf(sv[i] - mnew); ls += sv[i]; }
            l = l * alpha + ls;
#pragma unroll
            for (int b = 0; b < 4; ++b)
#pragma unroll
                for (int i = 0; i < 16; ++i) ot[b][i] *= alpha;
#pragma unroll
            for (int s2 = 0; s2 < 2; ++s2) {
                uint4 pk; pk.x = cvtpk(sv[8 * s2 + 0], sv[8 * s2 + 1]); pk.y = cvtpk(sv[8 * s2 + 2], sv[8 * s2 + 3]); pk.z = cvtpk(sv[8 * s2 + 4], sv[8 * s2 + 5]); pk.w = cvtpk(sv[8 * s2 + 6], sv[8 * s2 + 7]);
                const bf16x8_t xs = __builtin_bit_cast(bf16x8_t, pk);
#pragma unroll
                for (int b = 0; b < 4; ++b) {
                    const unsigned char* vrow = vb + (32 * b + r) * VROW + (sub * 32 + 16 * s2 + 4 * h) * 2;
                    const uint2 lo = *(const uint2*)vrow, hi = *(const uint2*)(vrow + 16);
                    const bf16x8_t pa = __builtin_bit_cast(bf16x8_t, make_uint4(lo.x, lo.y, hi.x, hi.y));
                    ot[b] = MFMA32(pa, xs, ot[b]);
                }
            }
        }
        if (s + 1 < nst) STAGE_STORE((s + 1) & 1);
        __syncthreads();
    }
    l += __shfl_xor(l, 32);
    const float inv = 1.f / l;
    bf16_t* orow = u.out + (size_t)(w * 32 + r) * D;
#pragma unroll
    for (int b = 0; b < 4; ++b)
#pragma unroll
        for (int g = 0; g < 4; ++g)
            *(uint2*)(orow + 32 * b + 8 * g + 4 * h) = make_uint2(cvtpk(ot[b][4 * g] * inv, ot[b][4 * g + 1] * inv), cvtpk(ot[b][4 * g + 2] * inv, ot[b][4 * g + 3] * inv));
}
#undef STAGE_LOAD
#undef STAGE_STORE
DEVI void attn_block_dispatch(CParams& p, int kind, int idx, float* lds) {
    AttnBlk u;
    u.k1 = nullptr; u.vt1 = nullptr; u.ks1 = 0; u.ldv1 = 0; u.nst1 = 0;
    if (kind == 0) {
        const int qb = idx % 4, h = (idx / 4) % 8, b = idx / 32, t0 = NCTX + b * DS + qb * 256;
        u.q = p.q_b + (size_t)t0 * 1536 + h * 192; u.qstride = 1536; u.scale = 0.07216878364870322f;
        u.k0 = p.k_b + (size_t)(T + b * PAST) * 1536 + h * 192; u.ks0 = 1536; u.vt0 = p.vt_mla_lat + ((size_t)(b * 8 + h) * 128) * (PAST + DS); u.ldv0 = PAST + DS; u.nst0 = PAST / 64;
        u.k1 = p.k_b + (size_t)(NCTX + b * DS) * 1536 + h * 192; u.ks1 = 1536; u.vt1 = u.vt0 + PAST; u.ldv1 = PAST + DS; u.nst1 = DS / 64;
        u.out = p.mix_b + (size_t)t0 * D + h * 128;
        attn_block<192>(u, lds);
    } else if (kind == 2) {
        const int h = idx % 8, b = idx / 8, t0 = b * SEQ;
        u.q = p.q_b + (size_t)t0 * 1536 + h * 192; u.qstride = 1536; u.scale = 0.07216878364870322f;
        u.k0 = p.k_b + (size_t)t0 * 1536 + h * 192; u.ks0 = 1536; u.vt0 = p.vt_mla_ctx + ((size_t)(b * 8 + h) * 128) * SEQ; u.ldv0 = SEQ; u.nst0 = SEQ / 64;
        u.out = p.mix_b + (size_t)t0 * D + h * 128;
        attn_block<192>(u, lds);
    } else {
        const int h = idx % 4, b = idx / 4, t0 = b * SEQ;
        u.q = p.qna_b + (size_t)t0 * 512 + h * 128; u.qstride = 512; u.scale = 0.08838834764831845f;
        u.k0 = p.kna_b + (size_t)t0 * 512 + h * 128; u.ks0 = 512; u.vt0 = p.vt_na_ctx + ((size_t)(b * 4 + h) * 128) * SEQ; u.ldv0 = SEQ; u.nst0 = SEQ / 64;
        u.out = p.mix_b + (size_t)t0 * D + 1024 + h * 128;
        attn_block<128>(u, lds);
    }
}
DEVI void phase_attn(CParams& p, int layer, int bid, int nb, float* lds) {
    constexpr int N_LNA = DB * 4 * (DS / 32), N_HV = DB * 8 * (DS / 256), N_CM = BATCH * 8, N_CN = BATCH * 4;
    const int nA = nb / 8, nH = nb / 4;
    if (bid < nA) {
        const int w = __builtin_amdgcn_readfirstlane(tidx() >> 6);
        for (int it = w * nA + bid; it < N_LNA; it += nA * NWAVES) attn_dispatch(p, layer, 1, it);
    } else if (bid < nA + nH) {
        for (int it = bid - nA; it < N_HV; it += nH) attn_block_dispatch(p, 0, it, lds);
    } else {
        for (int it = bid - nA - nH; it < N_CM + N_CN; it += nb - nA - nH) {
            if (it < N_CM) attn_block_dispatch(p, 2, it, lds); else attn_block_dispatch(p, 3, it - N_CM, lds);
        }
    }
}

template <int N, int K, int J>
DEVI void bitonic_stage(float (&v)[N]) {
#pragma unroll
    for (int i = 0; i < N; ++i) {
        const int l = i ^ J;
        if (l > i) { const bool desc = ((i & K) == 0); const float a = v[i], b = v[l], mx = fmaxf(a, b), mn = fminf(a, b); v[i] = desc ? mx : mn; v[l] = desc ? mn : mx; }
    }
}
template <int N, int K, int J> DEVI void bitonic_j(float (&v)[N]) { bitonic_stage<N, K, J>(v); if constexpr (J > 1) bitonic_j<N, K, J / 2>(v); }
template <int N, int K> DEVI void bitonic_k(float (&v)[N]) { bitonic_j<N, K, K / 2>(v); if constexpr (K < N) bitonic_k<N, K * 2>(v); }
template <int N> DEVI void bitonic_sort_desc(float (&v)[N]) { bitonic_k<N, 2>(v); }
DEVI void merge_top16(float (&a)[16], const float (&b)[16]) {
#pragma unroll
    for (int i = 0; i < 16; ++i) a[i] = fmaxf(a[i], b[15 - i]);
    bitonic_j<16, 16, 8>(a);
}
constexpr int cand_ab(int idx) { int n = 0; for (int a = 0; a < 16; ++a) for (int b = 0; b < 16; ++b) if ((a + 1) * (b + 1) <= 16) { if (n == idx) return a * 16 + b; ++n; } return -1; }
template <int CH, int I>
DEVI void cand_fill(float (&c)[16], const float (&s1)[16], const float (&s2)[16]) {
    constexpr int ab = cand_ab(CH * 16 + I);
    if constexpr (ab >= 0) c[I] = __uint_as_float((__float_as_uint(s1[ab >> 4] + s2[ab & 15]) & ~255u) | (unsigned)ab); else c[I] = -INFINITY;
    if constexpr (I + 1 < 16) cand_fill<CH, I + 1>(c, s1, s2);
}
DEVI float packkey(float v, unsigned id, unsigned mask) { return __uint_as_float((__float_as_uint(v) & ~mask) | id); }

DEVI void phase_route(CParams& p, int layer, int bid, int nb, float* lds) {
    const int lane = tidx() & 63, w = __builtin_amdgcn_readfirstlane(tidx() >> 6), r = lane & 31, h = lane >> 5;
    unsigned char* ix = (unsigned char*)lds + w * 2048;
    for (int it = bid * NWAVES + w; it < (T / 32) * 8; it += nb * NWAVES) {
        const int tt = it >> 3, hh = it & 7, t0 = tt * 32;
        float s12[2][16];
#pragma unroll
        for (int pp = 0; pp < 2; ++pp) {
            bf16x8_t qf[8];
            const bf16_t* qrow = p.qp_b + (size_t)(t0 + r) * D + hh * 256 + pp * 128 + 8 * h;
#pragma unroll
            for (int kk = 0; kk < 8; ++kk) qf[kk] = *(const bf16x8_t*)(qrow + kk * 16);
            const bf16_t* sk = p.sk_b + (((size_t)layer * 8 + hh) * 2 + pp) * 128 * 128 + (size_t)r * 128 + 8 * h;
            float top[16];
#pragma unroll
            for (int i = 0; i < 16; ++i) top[i] = -INFINITY;
#pragma unroll 1
            for (int blk = 0; blk < 4; ++blk) {
                const bf16_t* skb = sk + (size_t)blk * 32 * 128;
                asm volatile("" : "+v"(skb));
                f32x16_t acc;
#pragma unroll
                for (int i = 0; i < 16; ++i) acc[i] = 0.f;
#pragma unroll
                for (int kk = 0; kk < 8; ++kk) { const bf16x8_t a = *(const bf16x8_t*)(skb + kk * 16); acc = MFMA32(a, qf[kk], acc); }
                float c[16];
#pragma unroll
                for (int i = 0; i < 16; ++i) c[i] = packkey(acc[i], (unsigned)(32 * blk + crow(i, h)), 127u);
                bitonic_sort_desc<16>(c);
                merge_top16(top, c);
            }
            float o[16];
#pragma unroll
            for (int i = 0; i < 16; ++i) o[i] = __shfl_xor(top[i], 32);
            merge_top16(top, o);
#pragma unroll
            for (int i = 0; i < 16; ++i) { s12[pp][i] = top[i]; ix[(pp * 16 + i) * 64 + lane] = (unsigned char)(__float_as_uint(top[i]) & 127u); }
        }
        float best[16];
        {
            float c[16];
            cand_fill<0, 0>(best, s12[0], s12[1]); bitonic_sort_desc<16>(best);
            cand_fill<1, 0>(c, s12[0], s12[1]); bitonic_sort_desc<16>(c); merge_top16(best, c);
            cand_fill<2, 0>(c, s12[0], s12[1]); bitonic_sort_desc<16>(c); merge_top16(best, c);
            cand_fill<3, 0>(c, s12[0], s12[1]); bitonic_sort_desc<16>(c); merge_top16(best, c);
        }
        __builtin_amdgcn_wave_barrier();
        float g[16], sum = 0.f; int ex[16];
        const float mx = __uint_as_float(__float_as_uint(best[0]) & ~255u);
#pragma unroll
        for (int k = 0; k < 16; ++k) {
            const unsigned bits = __float_as_uint(best[k]), id = bits & 255u;
            g[k] = __expf(__uint_as_float(bits & ~255u) - mx); sum += g[k];
            ex[k] = (int)ix[(id >> 4) * 64 + lane] * 128 + (int)ix[(16 + (id & 15)) * 64 + lane];
        }
        const float inv = 1.f / sum;
        if (h == 0) {
            int* eo = p.eidx + (size_t)(t0 + r) * 128 + hh * 16; float* go = p.gate + (size_t)(t0 + r) * 128 + hh * 16;
#pragma unroll
            for (int k = 0; k < 16; k += 4) { *(int4*)(eo + k) = make_int4(ex[k], ex[k + 1], ex[k + 2], ex[k + 3]); *(float4*)(go + k) = make_float4(g[k] * inv, g[k + 1] * inv, g[k + 2] * inv, g[k + 3] * inv); }
        }
        __builtin_amdgcn_wave_barrier();
    }
}

typedef float f32x2v __attribute__((ext_vector_type(2)));
DEVI void phase_experts(CParams& p, int layer, int bid, int nb, float* lds) {
    const int lane = tidx() & 63, w = tidx() >> 6;
    float* wgt = lds + w * 128;
    const unsigned char* U = p.pu8 + (size_t)layer * 16384 * D;
    const unsigned char* V = p.pv8 + (size_t)layer * 16384 * D;
    const float* SU = p.su8 + (size_t)layer * 16384;
    const float* SV = p.sv8 + (size_t)layer * 16384;
    for (int t = bid * NWAVES + w; t < T; t += nb * NWAVES) {
        f32x2v x[2][8];
#pragma unroll
        for (int j = 0; j < 2; ++j) {
            const uint4 a = *(const uint4*)(p.hn_b + (size_t)t * D + j * 1024 + lane * 16), b = *(const uint4*)(p.hn_b + (size_t)t * D + j * 1024 + lane * 16 + 8);
            x[j][0] = (f32x2v){__uint_as_float(a.x << 16), __uint_as_float(a.x & 0xffff0000u)}; x[j][1] = (f32x2v){__uint_as_float(a.y << 16), __uint_as_float(a.y & 0xffff0000u)};
            x[j][2] = (f32x2v){__uint_as_float(a.z << 16), __uint_as_float(a.z & 0xffff0000u)}; x[j][3] = (f32x2v){__uint_as_float(a.w << 16), __uint_as_float(a.w & 0xffff0000u)};
            x[j][4] = (f32x2v){__uint_as_float(b.x << 16), __uint_as_float(b.x & 0xffff0000u)}; x[j][5] = (f32x2v){__uint_as_float(b.y << 16), __uint_as_float(b.y & 0xffff0000u)};
            x[j][6] = (f32x2v){__uint_as_float(b.z << 16), __uint_as_float(b.z & 0xffff0000u)}; x[j][7] = (f32x2v){__uint_as_float(b.w << 16), __uint_as_float(b.w & 0xffff0000u)};
        }
        const int* eix = p.eidx + (size_t)t * 128;
        const float* gat = p.gate + (size_t)t * 128;
        for (int c = 0; c < 16; ++c) {
            uint4 u[8][2];
#pragma unroll
            for (int e = 0; e < 8; ++e) {
                const int idx = __builtin_amdgcn_readfirstlane(eix[c * 8 + e]);
                const unsigned char* ur = U + (size_t)idx * D + lane * 16;
                u[e][0] = *(const uint4*)ur; u[e][1] = *(const uint4*)(ur + 1024);
            }
            float d[8];
#pragma unroll
            for (int e = 0; e < 8; ++e) {
                f32x2v a = {0.f, 0.f};
#pragma unroll
                for (int j = 0; j < 2; ++j) {
                    const unsigned q[4] = {u[e][j].x, u[e][j].y, u[e][j].z, u[e][j].w};
#pragma unroll
                    for (int k = 0; k < 4; ++k) {
                        a = __builtin_elementwise_fma(__builtin_amdgcn_cvt_pk_f32_fp8((int)q[k], false), x[j][2 * k], a);
                        a = __builtin_elementwise_fma(__builtin_amdgcn_cvt_pk_f32_fp8((int)q[k], true), x[j][2 * k + 1], a);
                    }
                }
                d[e] = a.x + a.y;
            }
            const bool b5 = lane & 32, b4 = lane & 16, b3 = lane & 8;
            float r4[4];
#pragma unroll
            for (int i = 0; i < 4; ++i) { const float mine = b5 ? d[4 + i] : d[i], theirs = b5 ? d[i] : d[4 + i]; r4[i] = mine + __shfl_xor(theirs, 32); }
            float r2[2];
#pragma unroll
            for (int i = 0; i < 2; ++i) { const float mine = b4 ? r4[2 + i] : r4[i], theirs = b4 ? r4[i] : r4[2 + i]; r2[i] = mine + __shfl_xor(theirs, 16); }
            float r1;
            { const float mine = b3 ? r2[1] : r2[0], theirs = b3 ? r2[0] : r2[1]; r1 = mine + __shfl_xor(theirs, 8); }
            r1 += __shfl_xor(r1, 4); r1 += __shfl_xor(r1, 2); r1 += __shfl_xor(r1, 1);
            const int e = (lane >> 3) & 7;
            const int myidx = eix[c * 8 + e];
            r1 *= SU[myidx];
            const float a = 0.5f * r1 * (1.f + erff(r1 * 0.70710678118654752f));
            if ((lane & 7) == 0) wgt[c * 8 + e] = a * gat[c * 8 + e] * SV[myidx];
        }
        __builtin_amdgcn_wave_barrier();
        f32x2v o[2][8];
#pragma unroll
        for (int j = 0; j < 2; ++j)
#pragma unroll
            for (int i = 0; i < 8; ++i) o[j][i] = (f32x2v){0.f, 0.f};
        for (int c = 0; c < 16; ++c) {
            uint4 v[8][2];
#pragma unroll
            for (int e = 0; e < 8; ++e) {
                const int idx = __builtin_amdgcn_readfirstlane(eix[c * 8 + e]);
                const unsigned char* vr = V + (size_t)idx * D + lane * 16;
                v[e][0] = *(const uint4*)vr; v[e][1] = *(const uint4*)(vr + 1024);
            }
#pragma unroll
            for (int e = 0; e < 8; ++e) {
                const float wg1 = wgt[c * 8 + e];
                const f32x2v wg = {wg1, wg1};
#pragma unroll
                for (int j = 0; j < 2; ++j) {
                    const unsigned q[4] = {v[e][j].x, v[e][j].y, v[e][j].z, v[e][j].w};
#pragma unroll
                    for (int k = 0; k < 4; ++k) {
                        o[j][2 * k] = __builtin_elementwise_fma(__builtin_amdgcn_cvt_pk_f32_fp8((int)q[k], false), wg, o[j][2 * k]);
                        o[j][2 * k + 1] = __builtin_elementwise_fma(__builtin_amdgcn_cvt_pk_f32_fp8((int)q[k], true), wg, o[j][2 * k + 1]);
                    }
                }
            }
        }
        __builtin_amdgcn_wave_barrier();
        const int cond = cond_of(t);
        const float* g2 = p.ada + ((size_t)layer * 3 + cond) * 6 * D + 5 * D;
        float* xo = p.out + (size_t)t * D;
        float ss = 0.f;
#pragma unroll
        for (int j = 0; j < 2; ++j) {
            const int cb = j * 1024 + lane * 16;
#pragma unroll
            for (int q = 0; q < 4; ++q) {
                float4 xv = *(const float4*)(xo + cb + q * 4); const float4 gv = *(const float4*)(g2 + cb + q * 4);
                xv.x += gv.x * o[j][2 * q].x; xv.y += gv.y * o[j][2 * q].y; xv.z += gv.z * o[j][2 * q + 1].x; xv.w += gv.w * o[j][2 * q + 1].y;
                *(float4*)(xo + cb + q * 4) = xv;
                o[j][2 * q] = (f32x2v){xv.x, xv.y}; o[j][2 * q + 1] = (f32x2v){xv.z, xv.w};
                ss += xv.x * xv.x + xv.y * xv.y + xv.z * xv.z + xv.w * xv.w;
            }
        }
        if (layer + 1 < DEPTH) {
            ss = wave_sum(ss);
            const float rr = rsqrtf(ss / D + EPS);
            const float* g = p.norm_mix_g + (size_t)(layer + 1) * D;
            const float* ad = p.ada + ((size_t)(layer + 1) * 3 + cond) * 6 * D;
#pragma unroll
            for (int j = 0; j < 2; ++j) {
                const int cb = j * 1024 + lane * 16;
                unsigned hv[8];
#pragma unroll
                for (int q = 0; q < 4; ++q) {
                    const float4 gg = *(const float4*)(g + cb + q * 4), sh = *(const float4*)(ad + cb + q * 4), sc = *(const float4*)(ad + D + cb + q * 4);
                    hv[2 * q] = cvtpk(o[j][2 * q].x * rr * gg.x * (1.f + sc.x) + sh.x, o[j][2 * q].y * rr * gg.y * (1.f + sc.y) + sh.y);
                    hv[2 * q + 1] = cvtpk(o[j][2 * q + 1].x * rr * gg.z * (1.f + sc.z) + sh.z, o[j][2 * q + 1].y * rr * gg.w * (1.f + sc.w) + sh.w);
                }
                *(uint4*)(p.hn_b + (size_t)t * D + cb) = make_uint4(hv[0], hv[1], hv[2], hv[3]);
                *(uint4*)(p.hn_b + (size_t)t * D + cb + 8) = make_uint4(hv[4], hv[5], hv[6], hv[7]);
            }
        }
    }
}

enum { PH_ADA = 0, PH_NORM1, PH_WIN, PH_POSTZ, PH_UQKV, PH_HEADNORM, PH_ATTN, PH_WOUT, PH_NORM2, PH_WQ, PH_SCORES, PH_ROUTE, PH_EXPERTS, PH_COUNT };

template <int PH>
DEVI void run_phase(CParams& p, int layer, int bid, int nb, float* lds) {
    if constexpr (PH == PH_ADA) { phase_ada(p, bid, nb, lds); phase_weights(p, bid, nb, lds); }
    if constexpr (PH == PH_NORM1) phase_modnorm(p, layer, 0, bid, nb);
    if constexpr (PH == PH_WIN) mfma_gemm(p.hn_b, p.wt_in + (size_t)layer * DINP * D, T, DINP, D, EpiF32{p.z, DIN, DIN}, bid, nb, lds);
    if constexpr (PH == PH_POSTZ) phase_postz(p, layer, bid, nb);
    if constexpr (PH == PH_UQKV) {
        mfma_gemm(p.cqn_b, p.wt_uq + (size_t)layer * 1536 * 512, T, 1536, 512, EpiF32{p.qm, 1536, 1536}, bid, nb, lds);
        mfma_gemm(p.ckv_b, p.wt_ukv + (size_t)layer * 2048 * 256, TKV, 2048, 256, EpiF32{p.kvr, 2048, 2048}, bid, nb, lds);
    }
    if constexpr (PH == PH_HEADNORM) phase_headnorm(p, layer, bid, nb, lds);
    if constexpr (PH == PH_ATTN) phase_attn(p, layer, bid, nb, lds);
    if constexpr (PH == PH_WOUT) mfma_gemm(p.mix_b, p.wt_out + (size_t)layer * D * D, T, D, D, EpiResidMF{&p, layer}, bid, nb, lds);
    if constexpr (PH == PH_NORM2) phase_modnorm(p, layer, 1, bid, nb);
    if constexpr (PH == PH_WQ) mfma_gemm(p.hn_b, p.wt_q + (size_t)layer * D * D, T, D, D, EpiBf16Store{p.qp_b, D}, bid, nb, lds);
    if constexpr (PH == PH_ROUTE) phase_route(p, layer, bid, nb, lds);
    if constexpr (PH == PH_EXPERTS) phase_experts(p, layer, bid, nb, lds);
}

#ifndef MK_ONE_LAUNCH
#define MK_ONE_LAUNCH 1
#endif
constexpr size_t LDS_BYTES = LDS_TOTAL;

#if MK_ONE_LAUNCH
#ifndef PROBE_MASK
#define PROBE_MASK 0
#endif
#define PHASE1(PH, l) do { CParams* q_ = pp; asm volatile("" : "+s"(q_)); run_phase<PH>(*q_, l, (int)blockIdx.x, (int)gridDim.x, lds); \
    XcdBarrier b_; b_.bar = q_->bar; b_.x = xb_xcc_id(); b_.st = (volatile LAS unsigned*)(lds_raw + MISC_OFF); xcd_barrier(b_); } while (0)
#define PHASE(PH, l) do { PHASE1(PH, l); if constexpr ((PROBE_MASK >> PH) & 1) { PHASE1(PH, l); PHASE1(PH, l); } } while (0)
__global__ void __launch_bounds__(NTHREADS, 2) k_fwd(Params p_unused) {
    CParams* pp = (CParams*)__builtin_amdgcn_kernarg_segment_ptr();
    extern __shared__ __attribute__((aligned(16))) unsigned char lds_raw[];
    float* lds = (float*)lds_raw;
    if (threadIdx.x == 0) *(uint4*)(lds_raw + MISC_OFF) = make_uint4(0u, 0u, 0u, 0u);
    __syncthreads();
    (void)xcd_barrier_post(pp->bar, (volatile LAS unsigned*)(lds_raw + MISC_OFF));
    PHASE(PH_ADA, 0);
    for (int l = 0; l < DEPTH; ++l) {
        if (l == 0) PHASE(PH_NORM1, l);
        PHASE(PH_WIN, l);
        PHASE(PH_POSTZ, l);
        PHASE(PH_UQKV, l);
        PHASE(PH_HEADNORM, l);
        PHASE(PH_ATTN, l);
        PHASE(PH_WOUT, l);
        PHASE(PH_NORM2, l);
        PHASE(PH_WQ, l);
        PHASE(PH_ROUTE, l);
        PHASE(PH_EXPERTS, l);
    }
}
#else
template <int PH>
__global__ void __launch_bounds__(NTHREADS, 4) k_phase(Params p, int layer) {
    extern __shared__ float4 lds4[];
    CParams* pp = (CParams*)__builtin_amdgcn_kernarg_segment_ptr();
    run_phase<PH>(*pp, layer, blockIdx.x, gridDim.x, (float*)lds4);
}
template <int PH>
void launch_phase(const Params& p, int layer, hipStream_t stream) {
    hipLaunchKernelGGL(k_phase<PH>, dim3(1024), dim3(NTHREADS), LDS_BYTES, stream, p, layer);
}
#endif

}

extern "C" void kernel_launch(void* const* d_in, const int* in_sizes, int n_in, void* d_out, int out_size, void* d_ws, size_t ws_size, hipStream_t stream) {
    Params p{};
    const float* const* in = (const float* const*)d_in;
    p.x_prompt = in[0]; p.x_sample = in[1]; p.cache_ckv = in[2]; p.cache_kpe = in[3]; p.cache_nak = in[4]; p.cache_nav = in[5]; p.c = in[6]; p.c_ctx = in[7];
    p.ada_w = in[8]; p.ada_b = in[9]; p.norm_mix_g = in[10]; p.norm_ffn_g = in[11]; p.w_in = in[12]; p.q_norm_g = in[13]; p.w_uq = in[14]; p.kv_norm_g = in[15]; p.w_ukv = in[16];
    p.q_head_g = in[17]; p.k_head_g = in[18]; p.naq_g = in[19]; p.nak_g = in[20]; p.rel_bias = in[21]; p.conv_w = in[22]; p.w_out = in[23]; p.peer_wq = in[24]; p.sub_keys = in[25];
    p.peer_u = in[26]; p.peer_v = in[27];
    float* out = (float*)d_out;
    p.out = out;
    p.o_ckv = out + (size_t)T * D;
    p.o_kpe = p.o_ckv + (size_t)BATCH * DEPTH * SEQ * 256;
    p.o_nak = p.o_kpe + (size_t)BATCH * DEPTH * SEQ * 64;
    p.o_nav = p.o_nak + (size_t)BATCH * DEPTH * 4 * SEQ * 128;
    char* ws = (char*)d_ws; size_t off = 0;
    auto carve = [&](size_t bytes) { void* r = ws + off; off += (bytes + 255) & ~(size_t)255; return r; };
    p.bar = (unsigned*)carve(16384);
    p.ada = (float*)carve((size_t)DEPTH * 3 * 6 * D * 4);
    p.hn = (float*)carve((size_t)T * D * 4);
    p.z = (float*)carve((size_t)(T + 1) * DIN * 4);
    p.cqn = (float*)carve((size_t)T * 512 * 4);
    p.ckv = (float*)carve((size_t)TKV * 256 * 4);
    p.qm = (float*)carve((size_t)T * 1536 * 4);
    p.kvr = (float*)carve((size_t)TKV * 2048 * 4);
    p.km = (float*)carve((size_t)TKV * 1536 * 4);
    p.qna = (float*)carve((size_t)T * 512 * 4);
    p.kna = (float*)carve((size_t)T * 512 * 4);
    p.mix = (float*)carve((size_t)T * D * 4);
    p.qp = (float*)carve((size_t)T * D * 4);
    p.sc = (float*)carve((size_t)T * D * 4);
    p.gate = (float*)carve((size_t)T * 128 * 4);
    p.eidx = (int*)carve((size_t)T * 128 * 4);
    p.wt_in = (bf16_t*)carve((size_t)DEPTH * DINP * D * 2);
    p.wt_uq = (bf16_t*)carve((size_t)DEPTH * 1536 * 512 * 2);
    p.wt_ukv = (bf16_t*)carve((size_t)DEPTH * 2048 * 256 * 2);
    p.wt_out = (bf16_t*)carve((size_t)DEPTH * D * D * 2);
    p.wt_q = (bf16_t*)carve((size_t)DEPTH * D * D * 2);
    p.hn_b = (bf16_t*)carve((size_t)T * D * 2);
    p.cqn_b = (bf16_t*)carve((size_t)T * 512 * 2);
    p.ckv_b = (bf16_t*)carve((size_t)TKV * 256 * 2);
    p.mix_b = (bf16_t*)carve((size_t)T * D * 2);
    p.q_b = (bf16_t*)carve((size_t)T * 1536 * 2);
    p.qp_b = (bf16_t*)carve((size_t)T * D * 2);
    p.sk_b = (bf16_t*)carve((size_t)DEPTH * 8 * 2 * 128 * 128 * 2);
    p.pu8 = (unsigned char*)carve((size_t)DEPTH * 16384 * D);
    p.pv8 = (unsigned char*)carve((size_t)DEPTH * 16384 * D);
    p.su8 = (float*)carve((size_t)DEPTH * 16384 * 4);
    p.sv8 = (float*)carve((size_t)DEPTH * 16384 * 4);
    p.k_b = (bf16_t*)carve((size_t)TKV * 1536 * 2);
    p.qna_b = (bf16_t*)carve((size_t)T * 512 * 2);
    p.kna_b = (bf16_t*)carve((size_t)T * 512 * 2);
    p.cnak_b = (bf16_t*)carve((size_t)DB * 4 * PAST * 128 * 2);
    p.vt_mla_ctx = (bf16_t*)carve((size_t)BATCH * 8 * 128 * SEQ * 2);
    p.vt_mla_lat = (bf16_t*)carve((size_t)DB * 8 * 128 * (PAST + DS) * 2);
    p.vt_na_ctx = (bf16_t*)carve((size_t)BATCH * 4 * 128 * SEQ * 2);
    p.vt_na_lat = (bf16_t*)carve((size_t)DB * 4 * 128 * DS * 2);
    p.vt_na_cache = (bf16_t*)carve((size_t)DB * 4 * 128 * PAST * 2);

#if MK_ONE_LAUNCH
    static int grid = 0;
    if (!grid) {
        int dev = 0, cus = 0, per_cu = 0;
        hipGetDevice(&dev);
        hipDeviceGetAttribute(&cus, hipDeviceAttributeMultiprocessorCount, dev);
        hipFuncSetAttribute((const void*)k_fwd, hipFuncAttributeMaxDynamicSharedMemorySize, (int)LDS_BYTES);
        hipOccupancyMaxActiveBlocksPerMultiprocessor(&per_cu, k_fwd, NTHREADS, LDS_BYTES);
        if (per_cu < 1) per_cu = 1;
        grid = cus * (per_cu < 1 ? per_cu : 1);
    }
    hipMemsetAsync(p.bar, 0, XCD_BAR_WORDS * sizeof(unsigned), stream);
    hipLaunchKernelGGL(k_fwd, dim3(grid), dim3(NTHREADS), LDS_BYTES, stream, p);
#else
    launch_phase<PH_ADA>(p, 0, stream);
    for (int l = 0; l < DEPTH; ++l) {
        if (l == 0) launch_phase<PH_NORM1>(p, l, stream);
        launch_phase<PH_WIN>(p, l, stream);
        launch_phase<PH_POSTZ>(p, l, stream);
        launch_phase<PH_UQKV>(p, l, stream);
        launch_phase<PH_HEADNORM>(p, l, stream);
        launch_phase<PH_ATTN>(p, l, stream);
        launch_phase<PH_WOUT>(p, l, stream);
        launch_phase<PH_NORM2>(p, l, stream);
        launch_phase<PH_WQ>(p, l, stream);
        launch_phase<PH_ROUTE>(p, l, stream);
        launch_phase<PH_EXPERTS>(p, l, stream);
    }
#endif
}
```

```cpp
#include <hip/hip_runtime.h>
#include <stdint.h>

#define DEVI __device__ __forceinline__

#define XB_TMO      128
#define XB_XCNT(j)  (256  + 64 * (j))
#define XB_XSUB(j)  (1280 + 64 * (j))
#define XB_XGEN(j)  (2304 + 64 * (j))
#define XB_TOP      3328
#define XB_TOPGEN   3392
#define XCD_BAR_WORDS 3456
#define XB_SPIN_CAP (1u << 18)
#define LAS __attribute__((address_space(3)))

__device__ __forceinline__ unsigned xb_ld(unsigned* p)              { return __hip_atomic_load(p, __ATOMIC_RELAXED, __HIP_MEMORY_SCOPE_AGENT); }
__device__ __forceinline__ unsigned xb_add(unsigned* p, unsigned v) { return __hip_atomic_fetch_add(p, v, __ATOMIC_RELAXED, __HIP_MEMORY_SCOPE_AGENT); }
__device__ __forceinline__ unsigned xb_xcc_id() { return (unsigned)__builtin_amdgcn_s_getreg((3 << 11) | 20) & 0xFu; }
#define XB_SPIN(cond, bar) do { unsigned _sp = 0; while (cond) { __builtin_amdgcn_s_sleep(1); \
    if ((++_sp & 255u) == 0u) { if (xb_ld(&(bar)[XB_TMO])) break; if (_sp > XB_SPIN_CAP) { atomicAdd(&(bar)[XB_TMO], 1u); break; } } } } while (0)

struct XcdBarrier {
    unsigned* bar; unsigned x;
    volatile LAS unsigned* st;
};

__device__ __forceinline__ XcdBarrier xcd_barrier_post(unsigned* bar, volatile LAS unsigned* st) {
    XcdBarrier b; b.bar = bar; b.x = xb_xcc_id(); b.st = st;
    if (threadIdx.x == 0) (void)xb_add(&bar[XB_XCNT(b.x)], 1u);
    return b;
}
__device__ __forceinline__ void xcd_barrier_complete(unsigned* bar, unsigned x, unsigned& nloc, unsigned& nx) {
    const unsigned G = gridDim.x * gridDim.y * gridDim.z;
    unsigned sum, cnt, mine, sp = 0u;
    for (;;) {
        sum = 0u; cnt = 0u; mine = 0u;
#pragma unroll
        for (unsigned j = 0; j < 16; ++j) { const unsigned c = xb_ld(&bar[XB_XCNT(j)]); sum += c; cnt += (c > 0u) ? 1u : 0u; mine = (j == x) ? c : mine; }
        if (sum == G) break;
        __builtin_amdgcn_s_sleep(1);
        if ((++sp & 255u) == 0u) { if (xb_ld(&bar[XB_TMO])) break; if (sp > XB_SPIN_CAP) { atomicAdd(&bar[XB_TMO], 1u); break; } }
    }
    nloc = mine > 0u ? mine : 1u; nx = cnt > 0u ? cnt : 1u;
}

__device__ __forceinline__ void xcd_barrier(const XcdBarrier& b) {
    asm volatile("s_waitcnt vmcnt(0)" ::: "memory");
    __syncthreads();
    if (threadIdx.x == 0) {
        unsigned* bar = b.bar;
        __builtin_amdgcn_s_waitcnt(0);
        unsigned nloc = b.st[0], nx = b.st[1];
        if (nloc == 0u) { xcd_barrier_complete(bar, b.x, nloc, nx); b.st[0] = nloc; b.st[1] = nx; }
        const unsigned old = xb_add(&bar[XB_XSUB(b.x)], 1u);
        const unsigned gen = old / nloc;
        if (old + 1u == (gen + 1u) * nloc) {
            __builtin_amdgcn_fence(__ATOMIC_RELEASE, "agent");
            asm volatile("s_waitcnt vmcnt(0)" ::: "memory");
            const unsigned og = xb_add(&bar[XB_TOP], 1u);
            const unsigned tg = og / nx;
            if (og + 1u == (tg + 1u) * nx) xb_add(&bar[XB_TOPGEN], 1u);
            else XB_SPIN(xb_ld(&bar[XB_TOPGEN]) == tg, bar);
            __builtin_amdgcn_fence(__ATOMIC_ACQUIRE, "agent");
            xb_add(&bar[XB_XGEN(b.x)], 1u);
            asm volatile("s_waitcnt vmcnt(0)" ::: "memory");
        } else {
            XB_SPIN(xb_ld(&bar[XB_XGEN(b.x)]) == gen, bar);
            __builtin_amdgcn_fence(__ATOMIC_ACQUIRE, "agent");
            asm volatile("s_waitcnt vmcnt(0)" ::: "memory");
        }
    }
    __syncthreads();
}


namespace pg8 {
#define PG8_LAS __attribute__((address_space(3)))
typedef unsigned short bf16_t;
typedef short bf16x8 __attribute__((ext_vector_type(8)));
typedef float f32x4 __attribute__((ext_vector_type(4)));
typedef unsigned u32x4 __attribute__((ext_vector_type(4)));
constexpr int BM = 256, BK = 64, HALF = 128, HTB = HALF * BK * 2  , STAGE_BYTES = 8 * HTB, NXCD = 8, WGM = 8;

__host__ __device__ __forceinline__ int lds_byte(int r, int c) { const int st = (r >> 4) * 2 + (c >> 5), rr = r & 15, cc = c & 31, ob = rr * 64 + cc * 2; return st * 1024 + (ob ^ (((ob >> 9) & 1) << 5)); }
__host__ __device__ __forceinline__ void stage_rc(int b, int& R, int& C) { const int st = b / 1024, sb = b % 1024, swz = sb ^ (((sb >> 9) & 1) << 5); R = (st >> 1) * 16 + swz / 64; C = (st & 1) * 32 + (swz % 64) / 2; }
__host__ __device__ __forceinline__ int perm32(int rho) { const int n = rho >> 4, i = rho & 15; return 8 * (i >> 2) + 4 * n + (i & 3); }

struct Unit { int pm, pn; };
struct Gemm { const bf16_t* A; const bf16_t* Bt; int M, N, K; };

struct StaticOrder {
    int nM, nN, nwg, G, c;
    __host__ __device__ void init(int M, int N, int G_, int c_) { nM = M / BM; nN = N / BM; nwg = nM * nN; G = G_; c = c_; }
    __host__ __device__ bool next(int i, Unit& u) const {
        const long L = (long)i * G + c; if (L >= nwg) return false;
        int wgid = (int)L; { const int q = nwg / NXCD, r = nwg % NXCD, xcd = wgid % NXCD, off = wgid / NXCD; wgid = (xcd < r ? xcd * (q + 1) : r * (q + 1) + (xcd - r) * q) + off; }
        const int nig = WGM * nN, gid = wgid / nig, fm = gid * WGM, gsz = (nM - fm) < WGM ? (nM - fm) : WGM;
        u.pm = fm + ((wgid % nig) % gsz); u.pn = (wgid % nig) / gsz; return true;
    }
    __device__ __forceinline__ void a_ready(const Unit&) const {}
    __device__ __forceinline__ void done(const Unit&) const {}
};

__device__ __forceinline__ unsigned cvt_pk_bf16(float lo, float hi) { unsigned r; asm volatile("v_cvt_pk_bf16_f32 %0, %1, %2" : "=v"(r) : "v"(lo), "v"(hi)); return r; }
typedef float f32x2 __attribute__((ext_vector_type(2)));
template <class Epi, class Sched, bool ALIGN_EPI = false, bool SP2 = false>
__device__ __forceinline__ void gemm_phase(PG8_LAS unsigned char* lds, const Gemm g, const Sched& S, const Epi& E) {
    int tid = threadIdx.x; asm volatile("" : "+v"(tid));
    const int wid = __builtin_amdgcn_readfirstlane(tid >> 6), lane = tid & 63, wr = wid >> 2, wc = wid & 3, fr = lane & 15, fq = lane >> 4;
    const int K = g.K, nt = K / BK;
    unsigned voffA[2], voffB[2];
#pragma unroll
    for (int i = 0; i < 2; ++i) { int R, C; stage_rc(tid * 16 + i * 8192, R, C); const int Rb = Epi::PERM ? ((R & ~31) + perm32(R & 31)) : R;
        voffA[i] = (unsigned)(R * K + C) * 2u; voffB[i] = (unsigned)(Rb * K + C) * 2u; }
    const size_t kstep = (size_t)(BK * 2);
    const size_t hstep = (size_t)HALF * K * 2;
    const size_t tstep = 2 * hstep;
    const unsigned ldsw = (unsigned)wid * 1024u;
    const int aoff = lds_byte(wr * 64 + fr, fq * 8), boff = lds_byte(wc * 32 + fr, fq * 8);
#define PG8_SA(b, h) (((b) * 2 + (h)) * HTB)
#define PG8_SB(b, h) ((4 + (b) * 2 + (h)) * HTB)
#define PG8_STAGE(bufoff, gbase, voff) do { _Pragma("unroll") for (int _i = 0; _i < 2; ++_i) \
        __builtin_amdgcn_global_load_lds((const unsigned*)((const char*)(gbase) + (voff)[_i]), (PG8_LAS unsigned*)(lds + (bufoff) + ldsw + _i * 8192), 16, 0, 0); } while (0)
#define PG8_LDA(dst, b, h) do { _Pragma("unroll") for (int m = 0; m < 4; ++m) _Pragma("unroll") for (int k = 0; k < 2; ++k) dst[m][k] = *(const PG8_LAS bf16x8*)(lds + PG8_SA(b, h) + aoff + m * 2048 + k * 1024); } while (0)
#define PG8_LDB(dst, b, h) do { _Pragma("unroll") for (int n = 0; n < 2; ++n) _Pragma("unroll") for (int k = 0; k < 2; ++k) dst[n][k] = *(const PG8_LAS bf16x8*)(lds + PG8_SB(b, h) + boff + n * 2048 + k * 1024); } while (0)
#define PG8_MMA(ai, bj, At, Bt) do { __builtin_amdgcn_s_setprio(1); _Pragma("unroll") for (int m = 0; m < 4; ++m) _Pragma("unroll") for (int n = 0; n < 2; ++n) _Pragma("unroll") for (int k = 0; k < 2; ++k) \
        acc[ai][bj][m][n] = __builtin_amdgcn_mfma_f32_16x16x32_bf16(Bt[n][k], At[m][k], acc[ai][bj][m][n], 0, 0, 0); __builtin_amdgcn_s_setprio(0); } while (0)
#define PG8_WAIT_V(n) asm volatile("s_waitcnt vmcnt(" #n ")" ::: "memory")
#define PG8_WAIT_L(n) asm volatile("s_waitcnt lgkmcnt(" #n ")" ::: "memory")
#define PG8_BAR __builtin_amdgcn_s_barrier()
#define PG8_SCHED __builtin_amdgcn_sched_barrier(0)
    Unit cur, nxt; int ui = 0;
    if (!S.next(0, cur)) return;
    f32x4 acc[2][2][4][2];
#pragma unroll
    for (int a = 0; a < 2; ++a)
#pragma unroll
        for (int b = 0; b < 2; ++b)
#pragma unroll
            for (int m = 0; m < 4; ++m)
#pragma unroll
                for (int n = 0; n < 2; ++n) acc[a][b][m][n] = (f32x4){0.f, 0.f, 0.f, 0.f};
    bf16x8 At[4][2], B0[2][2], B1[2][2];
    const char* cA = (const char*)g.A + (size_t)cur.pm * tstep; const char* cB = (const char*)g.Bt + (size_t)cur.pn * tstep;
    S.a_ready(cur);
    if constexpr (SP2) {
        PG8_STAGE(PG8_SB(0, 0), cB, voffB); PG8_STAGE(PG8_SB(0, 1), cB + hstep, voffB); PG8_STAGE(PG8_SA(0, 0), cA, voffA); PG8_STAGE(PG8_SA(0, 1), cA + hstep, voffA);
        if (wr == 1) PG8_BAR;
        PG8_WAIT_V(2); PG8_BAR;
        PG8_STAGE(PG8_SB(1, 0), cB + kstep, voffB); PG8_STAGE(PG8_SA(1, 0), cA + kstep, voffA); PG8_STAGE(PG8_SB(1, 1), cB + hstep + kstep, voffB);
        PG8_WAIT_V(6); PG8_BAR;
    } else {
        PG8_STAGE(PG8_SB(0, 0), cB, voffB); PG8_STAGE(PG8_SA(0, 0), cA, voffA); PG8_STAGE(PG8_SB(0, 1), cB + hstep, voffB); PG8_STAGE(PG8_SA(0, 1), cA + hstep, voffA);
        if (wr == 1) PG8_BAR;
        PG8_WAIT_V(4); PG8_BAR;
        PG8_STAGE(PG8_SB(1, 0), cB + kstep, voffB); PG8_STAGE(PG8_SA(1, 0), cA + kstep, voffA); PG8_STAGE(PG8_SB(1, 1), cB + hstep + kstep, voffB);
        PG8_WAIT_V(6); PG8_BAR;
    }
    for (;;) {
        const bool has_next = S.next(ui + 1, nxt);
        const char* nA = has_next ? (const char*)g.A + (size_t)nxt.pm * tstep : cA; const char* nB = has_next ? (const char*)g.Bt + (size_t)nxt.pn * tstep : cB;
        for (int t = 0; t < nt; t += 2) {
            const bool last = (t == nt - 2);
            const char* a1 = cA + (size_t)(t + 1) * kstep;
            const char* a2 = last ? nA : cA + (size_t)(t + 2) * kstep; const char* b2 = last ? nB : cB + (size_t)(t + 2) * kstep;
            const char* a3 = a2 + kstep; const char* b3 = b2 + kstep;
            if (last && has_next) S.a_ready(nxt);
            if constexpr (SP2) {
            PG8_LDB(B0, 0, 0); PG8_LDB(B1, 0, 1); PG8_SCHED; PG8_LDA(At, 0, 0); PG8_STAGE(PG8_SA(1, 1), a1 + hstep, voffA);
            PG8_WAIT_V(8); PG8_WAIT_L(0); PG8_BAR; PG8_MMA(0, 0, At, B0); PG8_MMA(0, 1, At, B1); PG8_BAR; PG8_SCHED;
            PG8_LDA(At, 0, 1); PG8_STAGE(PG8_SB(0, 0), b2, voffB); PG8_STAGE(PG8_SB(0, 1), b2 + hstep, voffB); PG8_STAGE(PG8_SA(0, 0), a2, voffA);
            PG8_WAIT_V(8); PG8_WAIT_L(0); PG8_BAR; PG8_MMA(1, 0, At, B0); PG8_MMA(1, 1, At, B1); PG8_BAR; PG8_SCHED;
            PG8_LDB(B0, 1, 0); PG8_LDB(B1, 1, 1); PG8_SCHED; PG8_LDA(At, 1, 0); PG8_STAGE(PG8_SA(0, 1), a2 + hstep, voffA);
            PG8_WAIT_V(8); PG8_WAIT_L(0); PG8_BAR; PG8_MMA(0, 0, At, B0); PG8_MMA(0, 1, At, B1); PG8_BAR; PG8_SCHED;
            PG8_LDA(At, 1, 1); PG8_STAGE(PG8_SB(1, 0), b3, voffB); PG8_STAGE(PG8_SB(1, 1), b3 + hstep, voffB); PG8_STAGE(PG8_SA(1, 0), a3, voffA);
            PG8_WAIT_V(8); PG8_WAIT_L(0); PG8_BAR; PG8_MMA(1, 0, At, B0); PG8_MMA(1, 1, At, B1); PG8_BAR; PG8_SCHED;
            } else {
            PG8_LDB(B0, 0, 0); PG8_SCHED; PG8_LDA(At, 0, 0); PG8_STAGE(PG8_SA(1, 1), a1 + hstep, voffA);
            PG8_WAIT_L(8); PG8_BAR; PG8_WAIT_L(0); PG8_MMA(0, 0, At, B0); PG8_BAR; PG8_SCHED;
            PG8_LDB(B1, 0, 1); PG8_STAGE(PG8_SB(0, 0), b2, voffB);
            PG8_BAR; PG8_WAIT_L(0); PG8_MMA(0, 1, At, B1); PG8_BAR;
            PG8_LDA(At, 0, 1); PG8_STAGE(PG8_SA(0, 0), a2, voffA);
            PG8_BAR; PG8_WAIT_L(0); PG8_MMA(1, 0, At, B0); PG8_BAR; PG8_SCHED;
            PG8_STAGE(PG8_SB(0, 1), b2 + hstep, voffB);
            PG8_WAIT_V(6); PG8_BAR; PG8_MMA(1, 1, At, B1); PG8_BAR;
            PG8_LDB(B0, 1, 0); PG8_SCHED; PG8_LDA(At, 1, 0); PG8_STAGE(PG8_SA(0, 1), a2 + hstep, voffA);
            PG8_WAIT_L(8); PG8_BAR; PG8_WAIT_L(0); PG8_MMA(0, 0, At, B0); PG8_BAR; PG8_SCHED;
            PG8_LDB(B1, 1, 1); PG8_STAGE(PG8_SB(1, 0), b3, voffB);
            PG8_BAR; PG8_WAIT_L(0); PG8_MMA(0, 1, At, B1); PG8_BAR;
            PG8_LDA(At, 1, 1); PG8_STAGE(PG8_SA(1, 0), a3, voffA);
            PG8_BAR; PG8_WAIT_L(0); PG8_MMA(1, 0, At, B0); PG8_BAR; PG8_SCHED;
            PG8_STAGE(PG8_SB(1, 1), b3 + hstep, voffB);
            PG8_WAIT_V(6); PG8_BAR; PG8_MMA(1, 1, At, B1); PG8_BAR;
            }
        }
        if constexpr (ALIGN_EPI) { if (wr == 0) PG8_BAR; }
        if constexpr (!Epi::AFTER_DRAIN) { E(acc, cur, wr, wc, fr, fq); S.done(cur); }
        if (!has_next) break;
#pragma unroll
        for (int a = 0; a < 2; ++a)
#pragma unroll
            for (int b = 0; b < 2; ++b)
#pragma unroll
                for (int m = 0; m < 4; ++m)
#pragma unroll
                    for (int n = 0; n < 2; ++n) acc[a][b][m][n] = (f32x4){0.f, 0.f, 0.f, 0.f};
        cur = nxt; cA = nA; cB = nB; ++ui;
        if constexpr (ALIGN_EPI) { if (wr == 1) PG8_BAR; }
    }
    PG8_WAIT_V(0);
    if constexpr (!ALIGN_EPI) { if (wr == 0) PG8_BAR; }
    PG8_BAR;
    if constexpr (Epi::AFTER_DRAIN) { E.fused(acc, cur, wr, wc, fr, fq, lds, wid, lane); S.done(cur); }
#undef PG8_SA
#undef PG8_SB
#undef PG8_STAGE
#undef PG8_LDA
#undef PG8_LDB
#undef PG8_MMA
#undef PG8_WAIT_V
#undef PG8_WAIT_L
#undef PG8_BAR
#undef PG8_SCHED
}
}


namespace {

constexpr int D = 2048, BATCH = 32, SEQ = 256, DEPTH = 4, DB = 2, DS = 1024, PAST = 512;
constexpr int NCTX = BATCH * SEQ, NLAT = DB * DS, T = NCTX + NLAT, TKV = T + DB * PAST;
constexpr int DIN = 3904, DINP = 4096;
constexpr int RING_OFF = 0, MISC_OFF = 131072, LDS_TOTAL = 147456;
typedef unsigned short bf16_t;
constexpr int O_CQ = 0, O_CKV = 512, O_KPE = 768, O_NAQ = 832, O_NAK = 1344, O_NAV = 1856, O_GB = 2368, O_GC = 2880, O_U = 3392;
constexpr float EPS = 1e-6f;
constexpr int NTHREADS = 512, NWAVES = NTHREADS / 64;

struct Params {
    const float *x_prompt, *x_sample, *cache_ckv, *cache_kpe, *cache_nak, *cache_nav, *c, *c_ctx;
    const float *ada_w, *ada_b, *norm_mix_g, *norm_ffn_g, *w_in, *q_norm_g, *w_uq, *kv_norm_g, *w_ukv;
    const float *q_head_g, *k_head_g, *naq_g, *nak_g, *rel_bias, *conv_w, *w_out, *peer_wq, *sub_keys, *peer_u, *peer_v;
    float* out;
    float *o_ckv, *o_kpe, *o_nak, *o_nav;
    unsigned* bar;
    float *ada, *hn, *z, *cqn, *ckv, *qm, *kvr, *km, *qna, *kna, *mix, *qp, *sc, *gate;
    int* eidx;
    unsigned short *wt_in, *wt_uq, *wt_ukv, *wt_out, *wt_q;
    unsigned short *hn_b, *cqn_b, *ckv_b, *mix_b;
    unsigned short *qp_b, *sk_b;
    unsigned char *pu8, *pv8; float *su8, *sv8;
    unsigned short *q_b, *k_b, *qna_b, *kna_b, *cnak_b;
    unsigned short *vt_mla_ctx, *vt_mla_lat, *vt_na_ctx, *vt_na_lat, *vt_na_cache;
};

typedef const __attribute__((address_space(4))) Params CParams;

DEVI int tidx() { int t = threadIdx.x; asm volatile("" : "+v"(t)); return t; }
DEVI float wave_sum(float v) {
#pragma unroll
    for (int o = 32; o > 0; o >>= 1) v += __shfl_xor(v, o);
    return v;
}
DEVI float wave_max(float v) {
#pragma unroll
    for (int o = 32; o > 0; o >>= 1) v = fmaxf(v, __shfl_xor(v, o));
    return v;
}
DEVI void wave_argmax(float& v, int& idx) {
#pragma unroll
    for (int o = 32; o > 0; o >>= 1) {
        float ov = __shfl_xor(v, o); int oi = __shfl_xor(idx, o);
        if (ov > v || (ov == v && oi < idx)) { v = ov; idx = oi; }
    }
}
typedef float f32x2_t __attribute__((ext_vector_type(2))); typedef __bf16 bf16x2_t __attribute__((ext_vector_type(2)));
DEVI unsigned cvtpk(float lo, float hi) { f32x2_t v = {lo, hi}; bf16x2_t b = __builtin_convertvector(v, bf16x2_t); return __builtin_bit_cast(unsigned, b); }
DEVI bf16_t f2bf(float v) { return (bf16_t)(cvtpk(v, 0.f) & 0xffffu); }
DEVI int cond_of(int t) { return t < NCTX ? 2 : (t - NCTX) / DS; }
DEVI const float* xrow(CParams& p, int layer, int t) {
    if (layer == 0) return t < NCTX ? p.x_prompt + (size_t)t * D : p.x_sample + (size_t)(t - NCTX) * D;
    return p.out + (size_t)t * D;
}

DEVI void phase_ada(CParams& p, int bid, int nb, float* lds) {
    float* sv = lds;
    float* red = lds + 3 * D;
    const int tid = tidx(), lane = tid & 63, w = tid >> 6;
    for (int i = tid; i < 3 * D; i += NTHREADS) {
        int j = i / D, k = i % D;
        float v = j < 2 ? p.c[j * D + k] : p.c_ctx[k];
        sv[i] = v / (1.f + __expf(-v));
    }
    __syncthreads();
    const int nitems = DEPTH * (6 * D / 64);
    for (int it = bid; it < nitems; it += nb) {
        const int l = it / (6 * D / 64), n = (it % (6 * D / 64)) * 64 + lane;
        const float* W = p.ada_w + (size_t)l * D * 6 * D + n;
        float a0 = 0.f, a1 = 0.f, a2 = 0.f;
        const int k0 = w * (D / NWAVES);
#pragma unroll 8
        for (int k = k0; k < k0 + D / NWAVES; ++k) {
            float wv = W[(size_t)k * 6 * D];
            a0 += sv[k] * wv; a1 += sv[D + k] * wv; a2 += sv[2 * D + k] * wv;
        }
        red[(w * 3 + 0) * 64 + lane] = a0; red[(w * 3 + 1) * 64 + lane] = a1; red[(w * 3 + 2) * 64 + lane] = a2;
        __syncthreads();
        if (tid < 192) {
            int j = tid / 64, ln = tid % 64;
            float s = 0.f;
            for (int ww = 0; ww < NWAVES; ++ww) s += red[(ww * 3 + j) * 64 + ln];
            int nn = (it % (6 * D / 64)) * 64 + ln;
            p.ada[((size_t)l * 3 + j) * 6 * D + nn] = s + p.ada_b[(size_t)l * 6 * D + nn];
        }
        __syncthreads();
    }
}

DEVI void phase_modnorm(CParams& p, int layer, int which, int bid, int nb) {
    const int lane = tidx() & 63, w = tidx() >> 6;
    const float* g = (which == 0 ? p.norm_mix_g : p.norm_ffn_g) + (size_t)layer * D;
    for (int t = bid * NWAVES + w; t < T; t += nb * NWAVES) {
        const float* x = which == 0 ? xrow(p, layer, t) : p.out + (size_t)t * D;
        const float* ad = p.ada + ((size_t)layer * 3 + cond_of(t)) * 6 * D + (which == 0 ? 0 : 3 * D);
        float4 v[8]; float ss = 0.f;
#pragma unroll
        for (int i = 0; i < 8; ++i) { v[i] = *(const float4*)(x + i * 256 + lane * 4); ss += v[i].x * v[i].x + v[i].y * v[i].y + v[i].z * v[i].z + v[i].w * v[i].w; }
        ss = wave_sum(ss);
        const float r = rsqrtf(ss / D + EPS);
#pragma unroll
        for (int i = 0; i < 8; ++i) {
            const int c = i * 256 + lane * 4;
            float4 gg = *(const float4*)(g + c), sh = *(const float4*)(ad + c), sc = *(const float4*)(ad + D + c), o;
            o.x = v[i].x * r * gg.x * (1.f + sc.x) + sh.x; o.y = v[i].y * r * gg.y * (1.f + sc.y) + sh.y;
            o.z = v[i].z * r * gg.z * (1.f + sc.z) + sh.z; o.w = v[i].w * r * gg.w * (1.f + sc.w) + sh.w;
            *(uint2*)(p.hn_b + (size_t)t * D + c) = make_uint2(pg8::cvt_pk_bf16(o.x, o.y), pg8::cvt_pk_bf16(o.z, o.w));
        }
    }
}

template <bool BT, class Epi>
DEVI void gemm_tile(const float* A, int lda, const float* W, int ldw, int K, int m0, int n0, const Epi& epi, float* lds) {
    float (*As)[132] = (float (*)[132])lds;
    float (*Bs)[68] = (float (*)[68])(lds + 16 * 132);
    const int tid = tidx(), tx = tid & 15, ty = tid >> 4;
    float acc[4][4];
#pragma unroll
    for (int i = 0; i < 4; ++i)
#pragma unroll
        for (int j = 0; j < 4; ++j) acc[i][j] = 0.f;
    for (int k0 = 0; k0 < K; k0 += 16) {
        {
            const int row = tid >> 2, kq = tid & 3;
            float4 v = *(const float4*)(A + (size_t)(m0 + row) * lda + k0 + kq * 4);
            As[kq * 4 + 0][row] = v.x; As[kq * 4 + 1][row] = v.y; As[kq * 4 + 2][row] = v.z; As[kq * 4 + 3][row] = v.w;
        }
        if (tid < 256) {
            if (!BT) {
                const int k = tid >> 4, n4 = tid & 15;
                float4 v = *(const float4*)(W + (size_t)(k0 + k) * ldw + n0 + n4 * 4);
                *(float4*)&Bs[k][n4 * 4] = v;
            } else {
                const int n = tid >> 2, kq = tid & 3;
                float4 v = *(const float4*)(W + (size_t)(n0 + n) * ldw + k0 + kq * 4);
                Bs[kq * 4 + 0][n] = v.x; Bs[kq * 4 + 1][n] = v.y; Bs[kq * 4 + 2][n] = v.z; Bs[kq * 4 + 3][n] = v.w;
            }
        }
        __syncthreads();
#pragma unroll
        for (int k = 0; k < 16; ++k) {
            float4 a = *(const float4*)&As[k][ty * 4], b = *(const float4*)&Bs[k][tx * 4];
            const float av[4] = {a.x, a.y, a.z, a.w}, bv[4] = {b.x, b.y, b.z, b.w};
#pragma unroll
            for (int i = 0; i < 4; ++i)
#pragma unroll
                for (int j = 0; j < 4; ++j) acc[i][j] += av[i] * bv[j];
        }
        __syncthreads();
    }
#pragma unroll
    for (int i = 0; i < 4; ++i) epi(m0 + ty * 4 + i, n0 + tx * 4, make_float4(acc[i][0], acc[i][1], acc[i][2], acc[i][3]));
}
template <bool BT, class Epi>
DEVI void gemm_f32(const float* A, int lda, const float* W, int ldw, int M, int N, int K, const Epi& epi, int bid, int nb, float* lds) {
    const int nn = N / 64, nt = (M / 128) * nn;
    for (int tile = bid; tile < nt; tile += nb) gemm_tile<BT>(A, lda, W, ldw, K, (tile / nn) * 128, (tile % nn) * 64, epi, lds);
}
struct EpiStore { float* C; int ldc; DEVI void operator()(int r, int c, float4 v) const { *(float4*)(C + (size_t)r * ldc + c) = v; } };
struct EpiResid {
    CParams* p; int layer;
    DEVI void operator()(int r, int c, float4 v) const {
        const float* x = xrow(*p, layer, r) + c;
        const float* g1 = p->ada + ((size_t)layer * 3 + cond_of(r)) * 6 * D + 2 * D + c;
        float4 xv = *(const float4*)x, gv = *(const float4*)g1, o;
        o.x = xv.x + gv.x * v.x; o.y = xv.y + gv.y * v.y; o.z = xv.z + gv.z * v.z; o.w = xv.w + gv.w * v.w;
        *(float4*)(p->out + (size_t)r * D + c) = o;
    }
};


struct EpiF32 {
    static constexpr bool PERM = false, AFTER_DRAIN = false;
    float* C; int ldc, ncols;
    DEVI void operator()(const pg8::f32x4 (&acc)[2][2][4][2], const pg8::Unit& u, int wr, int wc, int fr, int fq) const {
        const int row0 = u.pm * 256 + wr * 64 + fr, col0 = u.pn * 256 + wc * 32 + 4 * fq;
#pragma unroll
        for (int ai = 0; ai < 2; ++ai)
#pragma unroll
            for (int m = 0; m < 4; ++m) { float* rowp = C + (size_t)(row0 + ai * 128 + m * 16) * ldc;
#pragma unroll
                for (int bj = 0; bj < 2; ++bj)
#pragma unroll
                    for (int n = 0; n < 2; ++n) { const int c = col0 + bj * 128 + n * 16; if (c < ncols) *(pg8::f32x4*)(rowp + c) = acc[ai][bj][m][n]; } }
    }
};
struct EpiResidMF {
    static constexpr bool PERM = false, AFTER_DRAIN = false;
    CParams* p; int layer;
    DEVI void operator()(const pg8::f32x4 (&acc)[2][2][4][2], const pg8::Unit& u, int wr, int wc, int fr, int fq) const {
        const int row0 = u.pm * 256 + wr * 64 + fr, col0 = u.pn * 256 + wc * 32 + 4 * fq;
#pragma unroll
        for (int ai = 0; ai < 2; ++ai)
#pragma unroll
            for (int m = 0; m < 4; ++m) {
                const int r = row0 + ai * 128 + m * 16;
                const float* x = xrow(*p, layer, r);
                const float* g1 = p->ada + ((size_t)layer * 3 + cond_of(r)) * 6 * D + 2 * D;
                float* o = p->out + (size_t)r * D;
#pragma unroll
                for (int bj = 0; bj < 2; ++bj)
#pragma unroll
                    for (int n = 0; n < 2; ++n) { const int c = col0 + bj * 128 + n * 16;
                        const pg8::f32x4 xv = *(const pg8::f32x4*)(x + c), gv = *(const pg8::f32x4*)(g1 + c);
                        *(pg8::f32x4*)(o + c) = xv + gv * acc[ai][bj][m][n]; } }
    }
};
struct EpiBf16Store {
    static constexpr bool PERM = true, AFTER_DRAIN = false;
    bf16_t* O; int ldc;
    DEVI void operator()(const pg8::f32x4 (&acc)[2][2][4][2], const pg8::Unit& u, int wr, int wc, int fr, int fq) const {
        const int row0 = u.pm * 256 + wr * 64 + fr, col0 = u.pn * 256 + wc * 32 + 8 * fq;
#pragma unroll
        for (int ai = 0; ai < 2; ++ai)
#pragma unroll
            for (int m = 0; m < 4; ++m) { bf16_t* rowp = O + (size_t)(row0 + ai * 128 + m * 16) * ldc + col0;
#pragma unroll
                for (int bj = 0; bj < 2; ++bj) { const pg8::f32x4 v0 = acc[ai][bj][m][0], v1 = acc[ai][bj][m][1];
                    *(uint4*)(rowp + bj * 128) = make_uint4(cvtpk(v0[0], v0[1]), cvtpk(v0[2], v0[3]), cvtpk(v1[0], v1[1]), cvtpk(v1[2], v1[3])); } }
    }
};
template <class Epi>
DEVI void mfma_gemm(const bf16_t* A, const bf16_t* Bt, int M, int N, int K, const Epi& E, int bid, int nb, float* lds) {
    pg8::Gemm g{A, Bt, M, N, K};
    pg8::StaticOrder S; S.init(M, N, nb, bid);
    pg8::gemm_phase<Epi, pg8::StaticOrder, true, true>((PG8_LAS unsigned char*)lds + RING_OFF, g, S, E);
    __syncthreads();
}

DEVI void transpose_tile(const float* W, int ldw, bf16_t* Wt, int ldt, int k0, int n0, float* lds) {
    float (*tl)[65] = (float (*)[65])lds;
    const int tid = tidx();
#pragma unroll
    for (int rep = 0; rep < 2; ++rep) {
        const int k = (tid >> 4) + rep * 32, n4 = (tid & 15) * 4;
        const float4 v = *(const float4*)(W + (size_t)(k0 + k) * ldw + n0 + n4);
        tl[k][n4] = v.x; tl[k][n4 + 1] = v.y; tl[k][n4 + 2] = v.z; tl[k][n4 + 3] = v.w;
    }
    __syncthreads();
    {
        const int n = tid >> 3, k8 = (tid & 7) * 8;
        uint4 o;
        o.x = pg8::cvt_pk_bf16(tl[k8 + 0][n], tl[k8 + 1][n]); o.y = pg8::cvt_pk_bf16(tl[k8 + 2][n], tl[k8 + 3][n]);
        o.z = pg8::cvt_pk_bf16(tl[k8 + 4][n], tl[k8 + 5][n]); o.w = pg8::cvt_pk_bf16(tl[k8 + 6][n], tl[k8 + 7][n]);
        *(uint4*)(Wt + (size_t)(n0 + n) * ldt + k0 + k8) = o;
    }
    __syncthreads();
}
DEVI void phase_weights(CParams& p, int bid, int nb, float* lds) {
    constexpr int N_IN = 32 * 61, N_UQ = 8 * 24, N_UKV = 4 * 32, N_SQ = 32 * 32, PER = N_IN + N_UQ + N_UKV + 2 * N_SQ;
    for (int it = bid; it < DEPTH * PER; it += nb) {
        const int l = it / PER; int j = it % PER;
        if (j < N_IN) { transpose_tile(p.w_in + (size_t)l * D * DIN, DIN, p.wt_in + (size_t)l * DINP * D, D, (j / 61) * 64, (j % 61) * 64, lds); continue; }
        j -= N_IN;
        if (j < N_UQ) { transpose_tile(p.w_uq + (size_t)l * 512 * 1536, 1536, p.wt_uq + (size_t)l * 1536 * 512, 512, (j / 24) * 64, (j % 24) * 64, lds); continue; }
        j -= N_UQ;
        if (j < N_UKV) { transpose_tile(p.w_ukv + (size_t)l * 256 * 2048, 2048, p.wt_ukv + (size_t)l * 2048 * 256, 256, (j / 32) * 64, (j % 32) * 64, lds); continue; }
        j -= N_UKV;
        if (j < N_SQ) { transpose_tile(p.w_out + (size_t)l * D * D, D, p.wt_out + (size_t)l * D * D, D, (j / 32) * 64, (j % 32) * 64, lds); continue; }
        j -= N_SQ;
        transpose_tile(p.peer_wq + (size_t)l * D * D, D, p.wt_q + (size_t)l * D * D, D, (j / 32) * 64, (j % 32) * 64, lds);
    }
    for (int i = bid * NTHREADS + tidx(); i < DEPTH * 8 * 2 * 128 * 128 / 4; i += nb * NTHREADS) {
        const float4 v = *(const float4*)(p.sub_keys + (size_t)i * 4);
        *(uint2*)(p.sk_b + (size_t)i * 4) = make_uint2(cvtpk(v.x, v.y), cvtpk(v.z, v.w));
    }
    {
        const int lane = tidx() & 63, w = tidx() >> 6;
        for (int row = bid * NWAVES + w; row < 2 * DEPTH * 16384; row += nb * NWAVES) {
            const bool isv = row >= DEPTH * 16384; const int rr = isv ? row - DEPTH * 16384 : row;
            const float* src = (isv ? p.peer_v : p.peer_u) + (size_t)rr * D;
            float4 v[8]; float mx = 0.f;
#pragma unroll
            for (int i = 0; i < 8; ++i) { v[i] = *(const float4*)(src + i * 256 + lane * 4); mx = fmaxf(mx, fmaxf(fmaxf(fabsf(v[i].x), fabsf(v[i].y)), fmaxf(fabsf(v[i].z), fabsf(v[i].w)))); }
            mx = wave_max(mx);
            const float scale = mx > 0.f ? mx * (1.f / 440.f) : 1.f, inv = 1.f / scale;
            unsigned char* dst = (isv ? p.pv8 : p.pu8) + (size_t)rr * D;
#pragma unroll
            for (int i = 0; i < 8; ++i) {
                int pk = 0;
                pk = __builtin_amdgcn_cvt_pk_fp8_f32(v[i].x * inv, v[i].y * inv, pk, false);
                pk = __builtin_amdgcn_cvt_pk_fp8_f32(v[i].z * inv, v[i].w * inv, pk, true);
                *(int*)(dst + i * 256 + lane * 4) = pk;
            }
            if (lane == 0) (isv ? p.sv8 : p.su8)[rr] = scale;
        }
    }
    const int nz = DEPTH * (DINP - DIN) * D / 8;
    for (int i = bid * NTHREADS + tidx(); i < nz; i += nb * NTHREADS) {
        const int per = (DINP - DIN) * D / 8, l = i / per, r = i % per;
        *(uint4*)(p.wt_in + ((size_t)l * DINP + DIN) * D + (size_t)r * 8) = make_uint4(0u, 0u, 0u, 0u);
    }
}

DEVI void phase_postz(CParams& p, int layer, int bid, int nb) {
    const int lane = tidx() & 63, w = tidx() >> 6;
    for (int r = bid * NWAVES + w; r < TKV; r += nb * NWAVES) {
        if (r >= T) {
            const int b = (r - T) / PAST, j = (r - T) % PAST;
            const float* src = p.cache_ckv + (((size_t)b * DEPTH + layer) * PAST + j) * 256;
            { float4 v = *(const float4*)(src + lane * 4); *(uint2*)(p.ckv_b + (size_t)r * 256 + lane * 4) = make_uint2(pg8::cvt_pk_bf16(v.x, v.y), pg8::cvt_pk_bf16(v.z, v.w)); }
            continue;
        }
        const float* z = p.z + (size_t)r * DIN;
        const bool ctx = r < NCTX;
        const int b = ctx ? r / SEQ : (r - NCTX) / DS, s = ctx ? r % SEQ : (r - NCTX) % DS;
        {
            float v[8], ss = 0.f;
#pragma unroll
            for (int i = 0; i < 8; ++i) { v[i] = z[O_CQ + i * 64 + lane]; ss += v[i] * v[i]; }
            ss = wave_sum(ss); const float rr = rsqrtf(ss / 512.f + EPS);
#pragma unroll
            for (int i = 0; i < 8; ++i) p.cqn_b[(size_t)r * 512 + i * 64 + lane] = f2bf(v[i] * rr * p.q_norm_g[layer * 512 + i * 64 + lane]);
        }
        {
            float v[4], ss = 0.f;
#pragma unroll
            for (int i = 0; i < 4; ++i) { v[i] = z[O_CKV + i * 64 + lane]; ss += v[i] * v[i]; }
            ss = wave_sum(ss); const float rr = rsqrtf(ss / 256.f + EPS);
#pragma unroll
            for (int i = 0; i < 4; ++i) {
                const float o = v[i] * rr * p.kv_norm_g[layer * 256 + i * 64 + lane];
                p.ckv_b[(size_t)r * 256 + i * 64 + lane] = f2bf(o);
                if (ctx) p.o_ckv[(((size_t)b * DEPTH + layer) * SEQ + s) * 256 + i * 64 + lane] = o;
            }
        }
        if (ctx) p.o_kpe[(((size_t)b * DEPTH + layer) * SEQ + s) * 64 + lane] = z[O_KPE + lane];
#pragma unroll
        for (int h = 0; h < 4; ++h) {
            float q0 = z[O_NAQ + h * 128 + lane], q1 = z[O_NAQ + h * 128 + 64 + lane];
            float ss = wave_sum(q0 * q0 + q1 * q1); float rr = rsqrtf(ss / 128.f + EPS);
            p.qna_b[(size_t)r * 512 + h * 128 + lane] = f2bf(q0 * rr * p.naq_g[layer * 128 + lane]);
            p.qna_b[(size_t)r * 512 + h * 128 + 64 + lane] = f2bf(q1 * rr * p.naq_g[layer * 128 + 64 + lane]);
            float k0 = z[O_NAK + h * 128 + lane], k1 = z[O_NAK + h * 128 + 64 + lane];
            ss = wave_sum(k0 * k0 + k1 * k1); rr = rsqrtf(ss / 128.f + EPS);
            k0 = k0 * rr * p.nak_g[layer * 128 + lane]; k1 = k1 * rr * p.nak_g[layer * 128 + 64 + lane];
            p.kna_b[(size_t)r * 512 + h * 128 + lane] = f2bf(k0); p.kna_b[(size_t)r * 512 + h * 128 + 64 + lane] = f2bf(k1);
            if (ctx) {
                const size_t o = ((((size_t)b * DEPTH + layer) * 4 + h) * SEQ + s) * 128;
                p.o_nak[o + lane] = k0; p.o_nak[o + 64 + lane] = k1;
                p.o_nav[o + lane] = z[O_NAV + h * 128 + lane]; p.o_nav[o + 64 + lane] = z[O_NAV + h * 128 + 64 + lane];
            }
        }
        {
            const int S = ctx ? SEQ : DS;
#pragma unroll
            for (int i = 0; i < 8; ++i) {
                const int ch = i * 64 + lane;
                const float* cw = p.conv_w + ((size_t)layer * 512 + ch) * 3;
                float acc = z[O_GC + ch] * z[O_U + ch] * cw[1];
                if (s > 0) acc += (z - DIN)[O_GC + ch] * (z - DIN)[O_U + ch] * cw[0];
                if (s < S - 1) acc += (z + DIN)[O_GC + ch] * (z + DIN)[O_U + ch] * cw[2];
                p.mix_b[(size_t)r * D + 1536 + ch] = f2bf(z[O_GB + ch] * acc);
            }
        }
    }
}

DEVI float rope_angle(int pos, int j) {
    const int row = pos / 64, col = pos % 64;
    const int f = j & 15;
    const float inv = powf(10000.f, -(float)f / 16.f);
    return (j < 16 ? (float)row : (float)col) * inv;
}

DEVI void transpose_v(const float* src, size_t sstride, bf16_t* dst, int ldv, float* lds) {
    float (*tl)[129] = (float (*)[129])lds;
    const int tid = tidx();
#pragma unroll
    for (int rep = 0; rep < 4; ++rep) {
        const int row = (tid >> 5) + 16 * rep, c4 = (tid & 31) * 4;
        const float4 v = *(const float4*)(src + (size_t)row * sstride + c4);
        tl[row][c4] = v.x; tl[row][c4 + 1] = v.y; tl[row][c4 + 2] = v.z; tl[row][c4 + 3] = v.w;
    }
    __syncthreads();
    {
        const int d = tid >> 2, k16 = (tid & 3) * 16;
        uint4 o0, o1;
        o0.x = cvtpk(tl[k16 + 0][d], tl[k16 + 1][d]); o0.y = cvtpk(tl[k16 + 2][d], tl[k16 + 3][d]); o0.z = cvtpk(tl[k16 + 4][d], tl[k16 + 5][d]); o0.w = cvtpk(tl[k16 + 6][d], tl[k16 + 7][d]);
        o1.x = cvtpk(tl[k16 + 8][d], tl[k16 + 9][d]); o1.y = cvtpk(tl[k16 + 10][d], tl[k16 + 11][d]); o1.z = cvtpk(tl[k16 + 12][d], tl[k16 + 13][d]); o1.w = cvtpk(tl[k16 + 14][d], tl[k16 + 15][d]);
        bf16_t* o = dst + (size_t)d * ldv + k16;
        *(uint4*)o = o0; *(uint4*)(o + 8) = o1;
    }
    __syncthreads();
}
DEVI void phase_headnorm(CParams& p, int layer, int bid, int nb, float* lds) {
    const int lane = tidx() & 63, w = tidx() >> 6;
    const int nq = T * 8, nk = TKV * 8;
    for (int it = bid * NWAVES + w; it < nq + nk; it += nb * NWAVES) {
        const bool isq = it < nq;
        const int r = isq ? it / 8 : (it - nq) / 8, h = it % 8;
        float v0, v1, v2; const float* g; bf16_t* dst; int pos = -1;
        if (isq) {
            const float* q = p.qm + (size_t)r * 1536 + h * 192;
            v0 = q[lane]; v1 = q[64 + lane]; v2 = q[128 + lane]; g = p.q_head_g + layer * 192; dst = p.q_b + (size_t)r * 1536 + h * 192;
            if (r >= NCTX) pos = (r - NCTX) % DS;
        } else {
            const float* kv = p.kvr + (size_t)r * 2048 + h * 256;
            v0 = kv[lane]; v1 = kv[64 + lane];
            if (r < T) v2 = p.z[(size_t)r * DIN + O_KPE + lane];
            else { const int b = (r - T) / PAST, j = (r - T) % PAST; v2 = p.cache_kpe[(((size_t)b * DEPTH + layer) * PAST + j) * 64 + lane]; }
            g = p.k_head_g + layer * 192; dst = p.k_b + (size_t)r * 1536 + h * 192;
            if (r >= NCTX && r < T) pos = (r - NCTX) % DS;
        }
        const float ss = wave_sum(v0 * v0 + v1 * v1 + v2 * v2);
        const float rr = rsqrtf(ss / 192.f + EPS);
        v0 *= rr * g[lane]; v1 *= rr * g[64 + lane]; v2 *= rr * g[128 + lane];
        if (pos >= 0) {
            const float other = __shfl_xor(v2, 32);
            const float ang = rope_angle(pos, lane & 31);
            const float cs = cosf(ang), sn = sinf(ang);
            v2 = lane < 32 ? v2 * cs - other * sn : other * sn + v2 * cs;
        }
        dst[lane] = f2bf(v0); dst[64 + lane] = f2bf(v1); dst[128 + lane] = f2bf(v2);
    }
    for (int i = bid * NTHREADS + tidx(); i < DB * 4 * PAST * 128 / 4; i += nb * NTHREADS) {
        const int e = i * 4, bh = e / (PAST * 128), rem = e % (PAST * 128), b = bh / 4, h = bh % 4;
        const float4 v = *(const float4*)(p.cache_nak + (((size_t)b * DEPTH + layer) * 4 + h) * PAST * 128 + rem);
        *(uint2*)(p.cnak_b + (size_t)e) = make_uint2(cvtpk(v.x, v.y), cvtpk(v.z, v.w));
    }
    constexpr int N_MLA = (TKV / 64) * 8, N_NA = (T / 64) * 4, N_NC = DB * 4 * (PAST / 64);
    for (int it = bid; it < N_MLA + N_NA + N_NC; it += nb) {
        if (it < N_MLA) {
            const int kt = it / 8, h = it % 8, r0 = kt * 64;
            const float* src = p.kvr + (size_t)r0 * 2048 + h * 256 + 128;
            bf16_t* dst; int ldv;
            if (r0 < NCTX) { const int b = r0 / SEQ; dst = p.vt_mla_ctx + ((size_t)(b * 8 + h) * 128) * SEQ + r0 % SEQ; ldv = SEQ; }
            else if (r0 < T) { const int b = (r0 - NCTX) / DS; dst = p.vt_mla_lat + ((size_t)(b * 8 + h) * 128) * (PAST + DS) + PAST + (r0 - NCTX) % DS; ldv = PAST + DS; }
            else { const int b = (r0 - T) / PAST; dst = p.vt_mla_lat + ((size_t)(b * 8 + h) * 128) * (PAST + DS) + (r0 - T) % PAST; ldv = PAST + DS; }
            transpose_v(src, 2048, dst, ldv, lds);
        } else if (it < N_MLA + N_NA) {
            const int j = it - N_MLA, kt = j / 4, h = j % 4, r0 = kt * 64;
            const float* src = p.z + (size_t)r0 * DIN + O_NAV + h * 128;
            bf16_t* dst; int ldv;
            if (r0 < NCTX) { const int b = r0 / SEQ; dst = p.vt_na_ctx + ((size_t)(b * 4 + h) * 128) * SEQ + r0 % SEQ; ldv = SEQ; }
            else { const int b = (r0 - NCTX) / DS; dst = p.vt_na_lat + ((size_t)(b * 4 + h) * 128) * DS + (r0 - NCTX) % DS; ldv = DS; }
            transpose_v(src, DIN, dst, ldv, lds);
        } else {
            const int j = it - N_MLA - N_NA, bh = j / (PAST / 64), jt = j % (PAST / 64), b = bh / 4, h = bh % 4;
            const float* src = p.cache_nav + ((((size_t)b * DEPTH + layer) * 4 + h) * PAST + jt * 64) * 128;
            transpose_v(src, 128, p.vt_na_cache + ((size_t)(b * 4 + h) * 128) * PAST + jt * 64, PAST, lds);
        }
    }
}

typedef short bf16x8_t __attribute__((ext_vector_type(8)));
typedef float f32x16_t __attribute__((ext_vector_type(16)));
#define MFMA32(a, b, c) __builtin_amdgcn_mfma_f32_32x32x16_bf16((a), (b), (c), 0, 0, 0)
DEVI int crow(int reg, int h) { return (reg & 3) + 8 * (reg >> 2) + 4 * h; }

struct AttnUnit {
    const bf16_t* q; int qstride;
    const bf16_t *k0, *vt0; int ks0, ldv0, nt0;
    const bf16_t *k1, *vt1; int ks1, ldv1, nt1;
    const bf16_t *kl, *vtl; int nloc;
    const float* bias; int qr, c0, rs;
    bf16_t* out;
    float scale;
};

template <int DQ>
DEVI void attn_unit(const AttnUnit& u) {
    const int lane = tidx() & 63, r = lane & 31, h = lane >> 5;
    bf16x8_t qf[DQ / 16];
    {
        const bf16_t* qrow = u.q + (size_t)r * u.qstride + 8 * h;
#pragma unroll
        for (int kk = 0; kk < DQ / 16; ++kk) qf[kk] = *(const bf16x8_t*)(qrow + kk * 16);
    }
    f32x16_t ot[4];
#pragma unroll
    for (int b = 0; b < 4; ++b)
#pragma unroll
        for (int i = 0; i < 16; ++i) ot[b][i] = 0.f;
    float m = -INFINITY, l = 0.f;
    const int ntiles = u.nt0 + u.nt1 + u.nloc;
    for (int t = 0; t < ntiles; ++t) {
        const bf16_t *kp, *vp; int ks, ldv, lrow = -1, lcol = 0;
        if (t < u.nt0) { kp = u.k0 + (size_t)t * 32 * u.ks0; ks = u.ks0; vp = u.vt0 + t * 32; ldv = u.ldv0; }
        else if (t < u.nt0 + u.nt1) { const int tt = t - u.nt0; kp = u.k1 + (size_t)tt * 32 * u.ks1; ks = u.ks1; vp = u.vt1 + tt * 32; ldv = u.ldv1; }
        else { const int tt = t - u.nt0 - u.nt1; lrow = u.rs + (tt >> 1); lcol = (tt & 1) * 32; kp = u.kl + (size_t)(lrow * 64 + lcol) * 512; ks = 512; vp = u.vtl + lrow * 64 + lcol; ldv = DS; }
        f32x16_t st;
#pragma unroll
        for (int i = 0; i < 16; ++i) st[i] = 0.f;
        {
            const bf16_t* krow = kp + (size_t)r * ks + 8 * h;
#pragma unroll
            for (int kk = 0; kk < DQ / 16; ++kk) { const bf16x8_t a = *(const bf16x8_t*)(krow + kk * 16); st = MFMA32(a, qf[kk], st); }
        }
        float sv[16], mx = -INFINITY;
        if (lrow >= 0) {
            const int qc = u.c0 + r, cs = min(max(qc - 8, 0), 48);
            const float* brow = u.bias + (lrow - u.qr + 7) * 31 + (15 - qc);
#pragma unroll
            for (int i = 0; i < 16; ++i) {
                const int kc = lcol + crow(i, h);
                const bool valid = kc >= cs && kc < cs + 16;
                const float bv = valid ? brow[kc] : 0.f;
                sv[i] = valid ? st[i] * u.scale + bv : -INFINITY; mx = fmaxf(mx, sv[i]);
            }
        } else {
#pragma unroll
            for (int i = 0; i < 16; ++i) { sv[i] = st[i] * u.scale; mx = fmaxf(mx, sv[i]); }
        }
        mx = fmaxf(mx, __shfl_xor(mx, 32));
        const float mnew = fmaxf(m, mx), alpha = __expf(m - mnew);
        m = mnew;
        float ls = 0.f;
#pragma unroll
        for (int i = 0; i < 16; ++i) { sv[i] = __expf(sv[i] - mnew); ls += sv[i]; }
        l = l * alpha + ls;
#pragma unroll
        for (int b = 0; b < 4; ++b)
#pragma unroll
            for (int i = 0; i < 16; ++i) ot[b][i] *= alpha;
#pragma unroll
        for (int s2 = 0; s2 < 2; ++s2) {
            uint4 pk; pk.x = cvtpk(sv[8 * s2 + 0], sv[8 * s2 + 1]); pk.y = cvtpk(sv[8 * s2 + 2], sv[8 * s2 + 3]); pk.z = cvtpk(sv[8 * s2 + 4], sv[8 * s2 + 5]); pk.w = cvtpk(sv[8 * s2 + 6], sv[8 * s2 + 7]);
            const bf16x8_t xs = __builtin_bit_cast(bf16x8_t, pk);
#pragma unroll
            for (int b = 0; b < 4; ++b) {
                const bf16_t* vrow = vp + (size_t)(32 * b + r) * ldv + 16 * s2 + 4 * h;
                const uint2 lo = *(const uint2*)vrow, hi = *(const uint2*)(vrow + 8);
                const bf16x8_t pa = __builtin_bit_cast(bf16x8_t, make_uint4(lo.x, lo.y, hi.x, hi.y));
                ot[b] = MFMA32(pa, xs, ot[b]);
            }
        }
    }
    l += __shfl_xor(l, 32);
    const float inv = 1.f / l;
    bf16_t* orow = u.out + (size_t)r * D;
#pragma unroll
    for (int b = 0; b < 4; ++b)
#pragma unroll
        for (int g = 0; g < 4; ++g)
            *(uint2*)(orow + 32 * b + 8 * g + 4 * h) = make_uint2(cvtpk(ot[b][4 * g] * inv, ot[b][4 * g + 1] * inv), cvtpk(ot[b][4 * g + 2] * inv, ot[b][4 * g + 3] * inv));
}

DEVI void attn_dispatch(CParams& p, int layer, int kind, int idx) {
    AttnUnit u;
    u.k1 = nullptr; u.vt1 = nullptr; u.ks1 = 0; u.ldv1 = 0; u.nt1 = 0; u.kl = nullptr; u.vtl = nullptr; u.nloc = 0; u.bias = nullptr; u.qr = 0; u.c0 = 0; u.rs = 0;
    if (kind == 0) {
        const int qt = idx % 32, h = (idx / 32) % 8, b = idx / 256, t0 = NCTX + b * DS + qt * 32;
        u.q = p.q_b + (size_t)t0 * 1536 + h * 192; u.qstride = 1536; u.scale = 0.07216878364870322f;
        u.k0 = p.k_b + (size_t)(T + b * PAST) * 1536 + h * 192; u.ks0 = 1536; u.vt0 = p.vt_mla_lat + ((size_t)(b * 8 + h) * 128) * (PAST + DS); u.ldv0 = PAST + DS; u.nt0 = PAST / 32;
        u.k1 = p.k_b + (size_t)(NCTX + b * DS) * 1536 + h * 192; u.ks1 = 1536; u.vt1 = u.vt0 + PAST; u.ldv1 = PAST + DS; u.nt1 = DS / 32;
        u.out = p.mix_b + (size_t)t0 * D + h * 128;
        attn_unit<192>(u);
    } else if (kind == 1) {
        const int qt = idx % 32, h = (idx / 32) % 4, b = idx / 128, t0 = NCTX + b * DS + qt * 32;
        u.q = p.qna_b + (size_t)t0 * 512 + h * 128; u.qstride = 512; u.scale = 0.08838834764831845f;
        u.k0 = p.cnak_b + ((size_t)(b * 4 + h) * PAST) * 128; u.ks0 = 128; u.vt0 = p.vt_na_cache + ((size_t)(b * 4 + h) * 128) * PAST; u.ldv0 = PAST; u.nt0 = PAST / 32;
        u.kl = p.kna_b + (size_t)(NCTX + b * DS) * 512 + h * 128; u.vtl = p.vt_na_lat + ((size_t)(b * 4 + h) * 128) * DS; u.nloc = 16;
        u.bias = p.rel_bias + ((size_t)layer * 4 + h) * 15 * 31; u.qr = qt >> 1; u.c0 = (qt & 1) * 32; u.rs = min(max(u.qr - 4, 0), 8);
        u.out = p.mix_b + (size_t)t0 * D + 1024 + h * 128;
        attn_unit<128>(u);
    } else if (kind == 2) {
        const int qt = idx % 8, h = (idx / 8) % 8, b = idx / 64, t0 = b * SEQ + qt * 32;
        u.q = p.q_b + (size_t)t0 * 1536 + h * 192; u.qstride = 1536; u.scale = 0.07216878364870322f;
        u.k0 = p.k_b + (size_t)(b * SEQ) * 1536 + h * 192; u.ks0 = 1536; u.vt0 = p.vt_mla_ctx + ((size_t)(b * 8 + h) * 128) * SEQ; u.ldv0 = SEQ; u.nt0 = SEQ / 32;
        u.out = p.mix_b + (size_t)t0 * D + h * 128;
        attn_unit<192>(u);
    } else {
        const int qt = idx % 8, h = (idx / 8) % 4, b = idx / 32, t0 = b * SEQ + qt * 32;
        u.q = p.qna_b + (size_t)t0 * 512 + h * 128; u.qstride = 512; u.scale = 0.08838834764831845f;
        u.k0 = p.kna_b + (size_t)(b * SEQ) * 512 + h * 128; u.ks0 = 512; u.vt0 = p.vt_na_ctx + ((size_t)(b * 4 + h) * 128) * SEQ; u.ldv0 = SEQ; u.nt0 = SEQ / 32;
        u.out = p.mix_b + (size_t)t0 * D + 1024 + h * 128;
        attn_unit<128>(u);
    }
}
struct AttnBlk {
    const bf16_t* q; int qstride;
    const bf16_t *k0, *vt0; int ks0, ldv0, nst0;
    const bf16_t *k1, *vt1; int ks1, ldv1, nst1;
    bf16_t* out; float scale;
    const float* bias; int row0, rs_min;
};
template <int DQ, bool LOCAL>
DEVI void attn_block(const AttnBlk& u, float* ldsf) {
    constexpr int KROW = DQ * 2 + 16, VROW = 136, KBYTES = 64 * KROW, STAGE = KBYTES + 128 * VROW;
    constexpr int KCH = DQ / 8, NKC = 64 * KCH / NTHREADS;
    unsigned char* lds = (unsigned char*)ldsf;
    const int tid = tidx(), lane = tid & 63, w = tid >> 6, r = lane & 31, h = lane >> 5;
    bf16x8_t qf[DQ / 16];
    {
        const bf16_t* qrow = u.q + (size_t)(w * 32 + r) * u.qstride + 8 * h;
#pragma unroll
        for (int kk = 0; kk < DQ / 16; ++kk) qf[kk] = *(const bf16x8_t*)(qrow + kk * 16);
    }
    f32x16_t ot[4];
#pragma unroll
    for (int b = 0; b < 4; ++b)
#pragma unroll
        for (int i = 0; i < 16; ++i) ot[b][i] = 0.f;
    float m = -INFINITY, l = 0.f;
    const int myqr = u.row0 + (w >> 1), myc0 = (w & 1) * 32, myrs = min(max(myqr - 4, 0), 8);
    const int nst = u.nst0 + u.nst1;
    uint4 kr0, kr1, kr2, vr0, vr1;
    kr2 = make_uint4(0u, 0u, 0u, 0u);
    const int krow0 = tid / KCH, kcol0 = tid % KCH, krow1 = (tid + NTHREADS) / KCH, kcol1 = (tid + NTHREADS) % KCH, krow2 = (tid + 2 * NTHREADS) / KCH, kcol2 = (tid + 2 * NTHREADS) % KCH;
    const int vrow0 = tid >> 3, vc0 = tid & 7, vrow1 = (tid + NTHREADS) >> 3;
#define STAGE_LOAD(s_) do { const int s__ = (s_); const bf16_t *kp, *vp; int ks, ldv; \
        if (s__ < u.nst0) { kp = u.k0 + (size_t)s__ * 64 * u.ks0; ks = u.ks0; vp = u.vt0 + s__ * 64; ldv = u.ldv0; } \
        else { const int s1 = s__ - u.nst0; kp = u.k1 + (size_t)s1 * 64 * u.ks1; ks = u.ks1; vp = u.vt1 + s1 * 64; ldv = u.ldv1; } \
        kr0 = *(const uint4*)(kp + (size_t)krow0 * ks + kcol0 * 8); kr1 = *(const uint4*)(kp + (size_t)krow1 * ks + kcol1 * 8); \
        if constexpr (NKC == 3) kr2 = *(const uint4*)(kp + (size_t)krow2 * ks + kcol2 * 8); \
        vr0 = *(const uint4*)(vp + (size_t)vrow0 * ldv + vc0 * 8); vr1 = *(const uint4*)(vp + (size_t)vrow1 * ldv + vc0 * 8); } while (0)
#define STAGE_STORE(buf_) do { unsigned char* base = lds + (buf_) * STAGE; \
        *(uint4*)(base + krow0 * KROW + kcol0 * 16) = kr0; *(uint4*)(base + krow1 * KROW + kcol1 * 16) = kr1; \
        if constexpr (NKC == 3) *(uint4*)(base + krow2 * KROW + kcol2 * 16) = kr2; \
        { unsigned char* v0_ = base + KBYTES + vrow0 * VROW + vc0 * 16; unsigned char* v1_ = base + KBYTES + vrow1 * VROW + vc0 * 16;     \
          *(uint2*)v0_ = make_uint2(vr0.x, vr0.y); *(uint2*)(v0_ + 8) = make_uint2(vr0.z, vr0.w); *(uint2*)v1_ = make_uint2(vr1.x, vr1.y); *(uint2*)(v1_ + 8) = make_uint2(vr1.z, vr1.w); } } while (0)
    STAGE_LOAD(0); STAGE_STORE(0);
    __syncthreads();
    for (int s = 0; s < nst; ++s) {
        if (s + 1 < nst) STAGE_LOAD(s + 1);
        const unsigned char* kb = lds + (s & 1) * STAGE;
        const unsigned char* vb = kb + KBYTES;
        int lrow = -1; bool active = true;
        if (LOCAL && s >= u.nst0) { lrow = u.rs_min + (s - u.nst0); active = lrow >= myrs && lrow < myrs + 8; }
        if (active)
#pragma unroll
        for (int sub = 0; sub < 2; ++sub) {
            f32x16_t st;
#pragma unroll
            for (int i = 0; i < 16; ++i) st[i] = 0.f;
            {
                const unsigned char* krow = kb + (sub * 32 + r) * KROW + 16 * h;
#pragma unroll
                for (int kk = 0; kk < DQ / 16; ++kk) { const bf16x8_t a = *(const bf16x8_t*)(krow + kk * 32); st = MFMA32(a, qf[kk], st); }
            }
            float sv[16], mx = -INFINITY;
            if (LOCAL && lrow >= 0) {
                const int qc = myc0 + r, cs = min(max(qc - 8, 0), 48);
                const float* brow = u.bias + (lrow - myqr + 7) * 31 + (15 - qc);
#pragma unroll
                for (int i = 0; i < 16; ++i) {
                    const int kc = sub * 32 + crow(i, h);
                    const bool valid = kc >= cs && kc < cs + 16;
                    const float bv = valid ? brow[kc] : 0.f;
                    sv[i] = valid ? st[i] * u.scale + bv : -INFINITY; mx = fmaxf(mx, sv[i]);
                }
            } else {
#pragma unroll
                for (int i = 0; i < 16; ++i) { sv[i] = st[i] * u.scale; mx = fmaxf(mx, sv[i]); }
            }
            mx = fmaxf(mx, __shfl_xor(mx, 32));
            const float mnew = fmaxf(m, mx), alpha = __expf(m - mnew);
            m = mnew;
            float ls = 0.f;
#pragma unroll
            for (int i = 0; i < 16; ++i) { sv[i] = __expf(sv[i] - mnew); ls += sv[i]; }
            l = l * alpha + ls;
#pragma unroll
            for (int b = 0; b < 4; ++b)
#pragma unroll
                for (int i = 0; i < 16; ++i) ot[b][i] *= alpha;
#pragma unroll
            for (int s2 = 0; s2 < 2; ++s2) {
                uint4 pk; pk.x = cvtpk(sv[8 * s2 + 0], sv[8 * s2 + 1]); pk.y = cvtpk(sv[8 * s2 + 2], sv[8 * s2 + 3]); pk.z = cvtpk(sv[8 * s2 + 4], sv[8 * s2 + 5]); pk.w = cvtpk(sv[8 * s2 + 6], sv[8 * s2 + 7]);
                const bf16x8_t xs = __builtin_bit_cast(bf16x8_t, pk);
#pragma unroll
                for (int b = 0; b < 4; ++b) {
                    const unsigned char* vrow = vb + (32 * b + r) * VROW + (sub * 32 + 16 * s2 + 4 * h) * 2;
                    const uint2 lo = *(const uint2*)vrow, hi = *(const uint2*)(vrow + 16);
                    const bf16x8_t pa = __builtin_bit_cast(bf16x8_t, make_uint4(lo.x, lo.y, hi.x, hi.y));
                    ot[b] = MFMA32(pa, xs, ot[b]);
                }
            }
        }
        if (s + 1 < nst) STAGE_STORE((s + 1) & 1);
        __syncthreads();
    }
    l += __shfl_xor(l, 32);
    const float inv = 1.f / l;
    bf16_t* orow = u.out + (size_t)(w * 32 + r) * D;
#pragma unroll
    for (int b = 0; b < 4; ++b)
#pragma unroll
        for (int g = 0; g < 4; ++g)
            *(uint2*)(orow + 32 * b + 8 * g + 4 * h) = make_uint2(cvtpk(ot[b][4 * g] * inv, ot[b][4 * g + 1] * inv), cvtpk(ot[b][4 * g + 2] * inv, ot[b][4 * g + 3] * inv));
}
#undef STAGE_LOAD
#undef STAGE_STORE
DEVI void attn_block_dispatch(CParams& p, int layer, int kind, int idx, float* lds) {
    AttnBlk u;
    u.k1 = nullptr; u.vt1 = nullptr; u.ks1 = 0; u.ldv1 = 0; u.nst1 = 0; u.bias = nullptr; u.row0 = 0; u.rs_min = 0;
    if (kind == 1) {
        const int qb = idx % 4, h = (idx / 4) % 4, b = idx / 16, t0 = NCTX + b * DS + qb * 256;
        const int rlo = min(max(4 * qb - 4, 0), 8), rhi = min(max(4 * qb + 3 - 4, 0), 8) + 8;
        u.q = p.qna_b + (size_t)t0 * 512 + h * 128; u.qstride = 512; u.scale = 0.08838834764831845f;
        u.k0 = p.cnak_b + ((size_t)(b * 4 + h) * PAST) * 128; u.ks0 = 128; u.vt0 = p.vt_na_cache + ((size_t)(b * 4 + h) * 128) * PAST; u.ldv0 = PAST; u.nst0 = PAST / 64;
        u.k1 = p.kna_b + (size_t)(NCTX + b * DS + rlo * 64) * 512 + h * 128; u.ks1 = 512; u.vt1 = p.vt_na_lat + ((size_t)(b * 4 + h) * 128) * DS + rlo * 64; u.ldv1 = DS; u.nst1 = rhi - rlo;
        u.bias = p.rel_bias + ((size_t)layer * 4 + h) * 15 * 31; u.row0 = 4 * qb; u.rs_min = rlo;
        u.out = p.mix_b + (size_t)t0 * D + 1024 + h * 128;
        attn_block<128, true>(u, lds);
    } else if (kind == 0) {
        const int qb = idx % 4, h = (idx / 4) % 8, b = idx / 32, t0 = NCTX + b * DS + qb * 256;
        u.q = p.q_b + (size_t)t0 * 1536 + h * 192; u.qstride = 1536; u.scale = 0.07216878364870322f;
        u.k0 = p.k_b + (size_t)(T + b * PAST) * 1536 + h * 192; u.ks0 = 1536; u.vt0 = p.vt_mla_lat + ((size_t)(b * 8 + h) * 128) * (PAST + DS); u.ldv0 = PAST + DS; u.nst0 = PAST / 64;
        u.k1 = p.k_b + (size_t)(NCTX + b * DS) * 1536 + h * 192; u.ks1 = 1536; u.vt1 = u.vt0 + PAST; u.ldv1 = PAST + DS; u.nst1 = DS / 64;
        u.out = p.mix_b + (size_t)t0 * D + h * 128;
        attn_block<192, false>(u, lds);
    } else if (kind == 2) {
        const int h = idx % 8, b = idx / 8, t0 = b * SEQ;
        u.q = p.q_b + (size_t)t0 * 1536 + h * 192; u.qstride = 1536; u.scale = 0.07216878364870322f;
        u.k0 = p.k_b + (size_t)t0 * 1536 + h * 192; u.ks0 = 1536; u.vt0 = p.vt_mla_ctx + ((size_t)(b * 8 + h) * 128) * SEQ; u.ldv0 = SEQ; u.nst0 = SEQ / 64;
        u.out = p.mix_b + (size_t)t0 * D + h * 128;
        attn_block<192, false>(u, lds);
    } else {
        const int h = idx % 4, b = idx / 4, t0 = b * SEQ;
        u.q = p.qna_b + (size_t)t0 * 512 + h * 128; u.qstride = 512; u.scale = 0.08838834764831845f;
        u.k0 = p.kna_b + (size_t)t0 * 512 + h * 128; u.ks0 = 512; u.vt0 = p.vt_na_ctx + ((size_t)(b * 4 + h) * 128) * SEQ; u.ldv0 = SEQ; u.nst0 = SEQ / 64;
        u.out = p.mix_b + (size_t)t0 * D + 1024 + h * 128;
        attn_block<128, false>(u, lds);
    }
}
#ifndef ATTN_ROLE
#define ATTN_ROLE 0
#endif
DEVI void phase_attn(CParams& p, int layer, int bid, int nb, float* lds, int rep = 0) {
    const int role = rep ? ATTN_ROLE : 0;
    constexpr int N_LNA = DB * 4 * (DS / 256), N_HV = DB * 8 * (DS / 256), N_CM = BATCH * 8, N_CN = BATCH * 4;
    const int nA = nb / 8, nH = nb / 4;
    if (bid < nA) {
        if (role != 0 && role != 1) return;
        for (int it = bid; it < N_LNA; it += nA) attn_block_dispatch(p, layer, 1, it, lds);
    } else if (bid < nA + nH) {
        if (role != 0 && role != 2) return;
        for (int it = bid - nA; it < N_HV; it += nH) attn_block_dispatch(p, layer, 0, it, lds);
    } else {
        if (role != 0 && role != 3) return;
        for (int it = bid - nA - nH; it < N_CM + N_CN; it += nb - nA - nH) {
            if (it < N_CM) attn_block_dispatch(p, layer, 2, it, lds); else attn_block_dispatch(p, layer, 3, it - N_CM, lds);
        }
    }
}

template <int N, int K, int J>
DEVI void bitonic_stage(float (&v)[N]) {
#pragma unroll
    for (int i = 0; i < N; ++i) {
        const int l = i ^ J;
        if (l > i) { const bool desc = ((i & K) == 0); const float a = v[i], b = v[l], mx = fmaxf(a, b), mn = fminf(a, b); v[i] = desc ? mx : mn; v[l] = desc ? mn : mx; }
    }
}
template <int N, int K, int J> DEVI void bitonic_j(float (&v)[N]) { bitonic_stage<N, K, J>(v); if constexpr (J > 1) bitonic_j<N, K, J / 2>(v); }
template <int N, int K> DEVI void bitonic_k(float (&v)[N]) { bitonic_j<N, K, K / 2>(v); if constexpr (K < N) bitonic_k<N, K * 2>(v); }
template <int N> DEVI void bitonic_sort_desc(float (&v)[N]) { bitonic_k<N, 2>(v); }
DEVI void merge_top16(float (&a)[16], const float (&b)[16]) {
#pragma unroll
    for (int i = 0; i < 16; ++i) a[i] = fmaxf(a[i], b[15 - i]);
    bitonic_j<16, 16, 8>(a);
}
constexpr int cand_ab(int idx) { int n = 0; for (int a = 0; a < 16; ++a) for (int b = 0; b < 16; ++b) if ((a + 1) * (b + 1) <= 16) { if (n == idx) return a * 16 + b; ++n; } return -1; }
template <int CH, int I>
DEVI void cand_fill(float (&c)[16], const float (&s1)[16], const float (&s2)[16]) {
    constexpr int ab = cand_ab(CH * 16 + I);
    if constexpr (ab >= 0) c[I] = __uint_as_float((__float_as_uint(s1[ab >> 4] + s2[ab & 15]) & ~255u) | (unsigned)ab); else c[I] = -INFINITY;
    if constexpr (I + 1 < 16) cand_fill<CH, I + 1>(c, s1, s2);
}
DEVI float packkey(float v, unsigned id, unsigned mask) { return __uint_as_float((__float_as_uint(v) & ~mask) | id); }

DEVI void phase_route(CParams& p, int layer, int bid, int nb, float* lds) {
    const int lane = tidx() & 63, w = __builtin_amdgcn_readfirstlane(tidx() >> 6), r = lane & 31, h = lane >> 5;
    unsigned char* ix = (unsigned char*)lds + w * 2048;
    for (int it = bid * NWAVES + w; it < (T / 32) * 8; it += nb * NWAVES) {
        const int tt = it >> 3, hh = it & 7, t0 = tt * 32;
        float s12[2][16];
#pragma unroll
        for (int pp = 0; pp < 2; ++pp) {
            bf16x8_t qf[8];
            const bf16_t* qrow = p.qp_b + (size_t)(t0 + r) * D + hh * 256 + pp * 128 + 8 * h;
#pragma unroll
            for (int kk = 0; kk < 8; ++kk) qf[kk] = *(const bf16x8_t*)(qrow + kk * 16);
            const bf16_t* sk = p.sk_b + (((size_t)layer * 8 + hh) * 2 + pp) * 128 * 128 + (size_t)r * 128 + 8 * h;
            float top[16];
#pragma unroll
            for (int i = 0; i < 16; ++i) top[i] = -INFINITY;
#pragma unroll 1
            for (int blk = 0; blk < 4; ++blk) {
                const bf16_t* skb = sk + (size_t)blk * 32 * 128;
                asm volatile("" : "+v"(skb));
                f32x16_t acc;
#pragma unroll
                for (int i = 0; i < 16; ++i) acc[i] = 0.f;
#pragma unroll
                for (int kk = 0; kk < 8; ++kk) { const bf16x8_t a = *(const bf16x8_t*)(skb + kk * 16); acc = MFMA32(a, qf[kk], acc); }
                float c[16];
#pragma unroll
                for (int i = 0; i < 16; ++i) c[i] = packkey(acc[i], (unsigned)(32 * blk + crow(i, h)), 127u);
                bitonic_sort_desc<16>(c);
                merge_top16(top, c);
            }
            float o[16];
#pragma unroll
            for (int i = 0; i < 16; ++i) o[i] = __shfl_xor(top[i], 32);
            merge_top16(top, o);
#pragma unroll
            for (int i = 0; i < 16; ++i) { s12[pp][i] = top[i]; ix[(pp * 16 + i) * 64 + lane] = (unsigned char)(__float_as_uint(top[i]) & 127u); }
        }
        float best[16];
        {
            float c[16];
            cand_fill<0, 0>(best, s12[0], s12[1]); bitonic_sort_desc<16>(best);
            cand_fill<1, 0>(c, s12[0], s12[1]); bitonic_sort_desc<16>(c); merge_top16(best, c);
            cand_fill<2, 0>(c, s12[0], s12[1]); bitonic_sort_desc<16>(c); merge_top16(best, c);
            cand_fill<3, 0>(c, s12[0], s12[1]); bitonic_sort_desc<16>(c); merge_top16(best, c);
        }
        __builtin_amdgcn_wave_barrier();
        float g[16], sum = 0.f; int ex[16];
        const float mx = __uint_as_float(__float_as_uint(best[0]) & ~255u);
#pragma unroll
        for (int k = 0; k < 16; ++k) {
            const unsigned bits = __float_as_uint(best[k]), id = bits & 255u;
            g[k] = __expf(__uint_as_float(bits & ~255u) - mx); sum += g[k];
            ex[k] = (int)ix[(id >> 4) * 64 + lane] * 128 + (int)ix[(16 + (id & 15)) * 64 + lane];
        }
        const float inv = 1.f / sum;
        if (h == 0) {
            int* eo = p.eidx + (size_t)(t0 + r) * 128 + hh * 16; float* go = p.gate + (size_t)(t0 + r) * 128 + hh * 16;
#pragma unroll
            for (int k = 0; k < 16; k += 4) { *(int4*)(eo + k) = make_int4(ex[k], ex[k + 1], ex[k + 2], ex[k + 3]); *(float4*)(go + k) = make_float4(g[k] * inv, g[k + 1] * inv, g[k + 2] * inv, g[k + 3] * inv); }
        }
        __builtin_amdgcn_wave_barrier();
    }
}

typedef float f32x2v __attribute__((ext_vector_type(2)));
DEVI void phase_experts(CParams& p, int layer, int bid, int nb, float* lds) {
    const int lane = tidx() & 63, w = tidx() >> 6;
    float* wgt = lds + w * 128;
    const unsigned char* U = p.pu8 + (size_t)layer * 16384 * D;
    const unsigned char* V = p.pv8 + (size_t)layer * 16384 * D;
    const float* SU = p.su8 + (size_t)layer * 16384;
    const float* SV = p.sv8 + (size_t)layer * 16384;
    for (int t = bid * NWAVES + w; t < T; t += nb * NWAVES) {
        f32x2v x[2][8];
#pragma unroll
        for (int j = 0; j < 2; ++j) {
            const uint4 a = *(const uint4*)(p.hn_b + (size_t)t * D + j * 1024 + lane * 16), b = *(const uint4*)(p.hn_b + (size_t)t * D + j * 1024 + lane * 16 + 8);
            x[j][0] = (f32x2v){__uint_as_float(a.x << 16), __uint_as_float(a.x & 0xffff0000u)}; x[j][1] = (f32x2v){__uint_as_float(a.y << 16), __uint_as_float(a.y & 0xffff0000u)};
            x[j][2] = (f32x2v){__uint_as_float(a.z << 16), __uint_as_float(a.z & 0xffff0000u)}; x[j][3] = (f32x2v){__uint_as_float(a.w << 16), __uint_as_float(a.w & 0xffff0000u)};
            x[j][4] = (f32x2v){__uint_as_float(b.x << 16), __uint_as_float(b.x & 0xffff0000u)}; x[j][5] = (f32x2v){__uint_as_float(b.y << 16), __uint_as_float(b.y & 0xffff0000u)};
            x[j][6] = (f32x2v){__uint_as_float(b.z << 16), __uint_as_float(b.z & 0xffff0000u)}; x[j][7] = (f32x2v){__uint_as_float(b.w << 16), __uint_as_float(b.w & 0xffff0000u)};
        }
        const int* eix = p.eidx + (size_t)t * 128;
        const float* gat = p.gate + (size_t)t * 128;
        for (int c = 0; c < 16; ++c) {
            uint4 u[8][2];
#pragma unroll
            for (int e = 0; e < 8; ++e) {
                const int idx = __builtin_amdgcn_readfirstlane(eix[c * 8 + e]);
                const unsigned char* ur = U + (size_t)idx * D + lane * 16;
                u[e][0] = *(const uint4*)ur; u[e][1] = *(const uint4*)(ur + 1024);
            }
            float d[8];
#pragma unroll
            for (int e = 0; e < 8; ++e) {
                f32x2v a = {0.f, 0.f};
#pragma unroll
                for (int j = 0; j < 2; ++j) {
                    const unsigned q[4] = {u[e][j].x, u[e][j].y, u[e][j].z, u[e][j].w};
#pragma unroll
                    for (int k = 0; k < 4; ++k) {
                        a = __builtin_elementwise_fma(__builtin_amdgcn_cvt_pk_f32_fp8((int)q[k], false), x[j][2 * k], a);
                        a = __builtin_elementwise_fma(__builtin_amdgcn_cvt_pk_f32_fp8((int)q[k], true), x[j][2 * k + 1], a);
                    }
                }
                d[e] = a.x + a.y;
            }
            const bool b5 = lane & 32, b4 = lane & 16, b3 = lane & 8;
            float r4[4];
#pragma unroll
            for (int i = 0; i < 4; ++i) { const float mine = b5 ? d[4 + i] : d[i], theirs = b5 ? d[i] : d[4 + i]; r4[i] = mine + __shfl_xor(theirs, 32); }
            float r2[2];
#pragma unroll
            for (int i = 0; i < 2; ++i) { const float mine = b4 ? r4[2 + i] : r4[i], theirs = b4 ? r4[i] : r4[2 + i]; r2[i] = mine + __shfl_xor(theirs, 16); }
            float r1;
            { const float mine = b3 ? r2[1] : r2[0], theirs = b3 ? r2[0] : r2[1]; r1 = mine + __shfl_xor(theirs, 8); }
            r1 += __shfl_xor(r1, 4); r1 += __shfl_xor(r1, 2); r1 += __shfl_xor(r1, 1);
            const int e = (lane >> 3) & 7;
            const int myidx = eix[c * 8 + e];
            r1 *= SU[myidx];
            const float a = 0.5f * r1 * (1.f + erff(r1 * 0.70710678118654752f));
            if ((lane & 7) == 0) wgt[c * 8 + e] = a * gat[c * 8 + e] * SV[myidx];
        }
        __builtin_amdgcn_wave_barrier();
        f32x2v o[2][8];
#pragma unroll
        for (int j = 0; j < 2; ++j)
#pragma unroll
            for (int i = 0; i < 8; ++i) o[j][i] = (f32x2v){0.f, 0.f};
        for (int c = 0; c < 16; ++c) {
            uint4 v[8][2];
#pragma unroll
            for (int e = 0; e < 8; ++e) {
                const int idx = __builtin_amdgcn_readfirstlane(eix[c * 8 + e]);
                const unsigned char* vr = V + (size_t)idx * D + lane * 16;
                v[e][0] = *(const uint4*)vr; v[e][1] = *(const uint4*)(vr + 1024);
            }
#pragma unroll
            for (int e = 0; e < 8; ++e) {
                const float wg1 = wgt[c * 8 + e];
                const f32x2v wg = {wg1, wg1};
#pragma unroll
                for (int j = 0; j < 2; ++j) {
                    const unsigned q[4] = {v[e][j].x, v[e][j].y, v[e][j].z, v[e][j].w};
#pragma unroll
                    for (int k = 0; k < 4; ++k) {
                        o[j][2 * k] = __builtin_elementwise_fma(__builtin_amdgcn_cvt_pk_f32_fp8((int)q[k], false), wg, o[j][2 * k]);
                        o[j][2 * k + 1] = __builtin_elementwise_fma(__builtin_amdgcn_cvt_pk_f32_fp8((int)q[k], true), wg, o[j][2 * k + 1]);
                    }
                }
            }
        }
        __builtin_amdgcn_wave_barrier();
        const int cond = cond_of(t);
        const float* g2 = p.ada + ((size_t)layer * 3 + cond) * 6 * D + 5 * D;
        float* xo = p.out + (size_t)t * D;
        float ss = 0.f;
#pragma unroll
        for (int j = 0; j < 2; ++j) {
            const int cb = j * 1024 + lane * 16;
#pragma unroll
            for (int q = 0; q < 4; ++q) {
                float4 xv = *(const float4*)(xo + cb + q * 4); const float4 gv = *(const float4*)(g2 + cb + q * 4);
                xv.x += gv.x * o[j][2 * q].x; xv.y += gv.y * o[j][2 * q].y; xv.z += gv.z * o[j][2 * q + 1].x; xv.w += gv.w * o[j][2 * q + 1].y;
                *(float4*)(xo + cb + q * 4) = xv;
                o[j][2 * q] = (f32x2v){xv.x, xv.y}; o[j][2 * q + 1] = (f32x2v){xv.z, xv.w};
                ss += xv.x * xv.x + xv.y * xv.y + xv.z * xv.z + xv.w * xv.w;
            }
        }
        if (layer + 1 < DEPTH) {
            ss = wave_sum(ss);
            const float rr = rsqrtf(ss / D + EPS);
            const float* g = p.norm_mix_g + (size_t)(layer + 1) * D;
            const float* ad = p.ada + ((size_t)(layer + 1) * 3 + cond) * 6 * D;
#pragma unroll
            for (int j = 0; j < 2; ++j) {
                const int cb = j * 1024 + lane * 16;
                unsigned hv[8];
#pragma unroll
                for (int q = 0; q < 4; ++q) {
                    const float4 gg = *(const float4*)(g + cb + q * 4), sh = *(const float4*)(ad + cb + q * 4), sc = *(const float4*)(ad + D + cb + q * 4);
                    hv[2 * q] = cvtpk(o[j][2 * q].x * rr * gg.x * (1.f + sc.x) + sh.x, o[j][2 * q].y * rr * gg.y * (1.f + sc.y) + sh.y);
                    hv[2 * q + 1] = cvtpk(o[j][2 * q + 1].x * rr * gg.z * (1.f + sc.z) + sh.z, o[j][2 * q + 1].y * rr * gg.w * (1.f + sc.w) + sh.w);
                }
                *(uint4*)(p.hn_b + (size_t)t * D + cb) = make_uint4(hv[0], hv[1], hv[2], hv[3]);
                *(uint4*)(p.hn_b + (size_t)t * D + cb + 8) = make_uint4(hv[4], hv[5], hv[6], hv[7]);
            }
        }
    }
}

enum { PH_ADA = 0, PH_NORM1, PH_WIN, PH_POSTZ, PH_UQKV, PH_HEADNORM, PH_ATTN, PH_WOUT, PH_NORM2, PH_WQ, PH_SCORES, PH_ROUTE, PH_EXPERTS, PH_COUNT };

template <int PH>
DEVI void run_phase(CParams& p, int layer, int bid, int nb, float* lds, int rep = 0) {
    if constexpr (PH == PH_ADA) { phase_ada(p, bid, nb, lds); phase_weights(p, bid, nb, lds); }
    if constexpr (PH == PH_NORM1) phase_modnorm(p, layer, 0, bid, nb);
    if constexpr (PH == PH_WIN) mfma_gemm(p.hn_b, p.wt_in + (size_t)layer * DINP * D, T, DINP, D, EpiF32{p.z, DIN, DIN}, bid, nb, lds);
    if constexpr (PH == PH_POSTZ) phase_postz(p, layer, bid, nb);
    if constexpr (PH == PH_UQKV) {
        mfma_gemm(p.cqn_b, p.wt_uq + (size_t)layer * 1536 * 512, T, 1536, 512, EpiF32{p.qm, 1536, 1536}, bid, nb, lds);
        mfma_gemm(p.ckv_b, p.wt_ukv + (size_t)layer * 2048 * 256, TKV, 2048, 256, EpiF32{p.kvr, 2048, 2048}, bid, nb, lds);
    }
    if constexpr (PH == PH_HEADNORM) phase_headnorm(p, layer, bid, nb, lds);
    if constexpr (PH == PH_ATTN) phase_attn(p, layer, bid, nb, lds, rep);
    if constexpr (PH == PH_WOUT) mfma_gemm(p.mix_b, p.wt_out + (size_t)layer * D * D, T, D, D, EpiResidMF{&p, layer}, bid, nb, lds);
    if constexpr (PH == PH_NORM2) phase_modnorm(p, layer, 1, bid, nb);
    if constexpr (PH == PH_WQ) mfma_gemm(p.hn_b, p.wt_q + (size_t)layer * D * D, T, D, D, EpiBf16Store{p.qp_b, D}, bid, nb, lds);
    if constexpr (PH == PH_ROUTE) phase_route(p, layer, bid, nb, lds);
    if constexpr (PH == PH_EXPERTS) phase_experts(p, layer, bid, nb, lds);
}

#ifndef MK_ONE_LAUNCH
#define MK_ONE_LAUNCH 1
#endif
constexpr size_t LDS_BYTES = LDS_TOTAL;

#if MK_ONE_LAUNCH
#ifndef PROBE_MASK
#define PROBE_MASK 0
#endif
#define PHASE1(PH, l, rep_) do { CParams* q_ = pp; asm volatile("" : "+s"(q_)); run_phase<PH>(*q_, l, (int)blockIdx.x, (int)gridDim.x, lds, rep_); \
    XcdBarrier b_; b_.bar = q_->bar; b_.x = xb_xcc_id(); b_.st = (volatile LAS unsigned*)(lds_raw + MISC_OFF); xcd_barrier(b_); } while (0)
#define PHASE(PH, l) do { PHASE1(PH, l, 0); if constexpr ((PROBE_MASK >> PH) & 1) { PHASE1(PH, l, 1); PHASE1(PH, l, 1); } } while (0)
__global__ void __launch_bounds__(NTHREADS, 2) k_fwd(Params p_unused) {
    CParams* pp = (CParams*)__builtin_amdgcn_kernarg_segment_ptr();
    extern __shared__ __attribute__((aligned(16))) unsigned char lds_raw[];
    float* lds = (float*)lds_raw;
    if (threadIdx.x == 0) *(uint4*)(lds_raw + MISC_OFF) = make_uint4(0u, 0u, 0u, 0u);
    __syncthreads();
    (void)xcd_barrier_post(pp->bar, (volatile LAS unsigned*)(lds_raw + MISC_OFF));
    PHASE(PH_ADA, 0);
    for (int l = 0; l < DEPTH; ++l) {
        if (l == 0) PHASE(PH_NORM1, l);
        PHASE(PH_WIN, l);
        PHASE(PH_POSTZ, l);
        PHASE(PH_UQKV, l);
        PHASE(PH_HEADNORM, l);
        PHASE(PH_ATTN, l);
        PHASE(PH_WOUT, l);
        PHASE(PH_NORM2, l);
        PHASE(PH_WQ, l);
        PHASE(PH_ROUTE, l);
        PHASE(PH_EXPERTS, l);
    }
}
#else
template <int PH>
__global__ void __launch_bounds__(NTHREADS, 4) k_phase(Params p, int layer) {
    extern __shared__ float4 lds4[];
    CParams* pp = (CParams*)__builtin_amdgcn_kernarg_segment_ptr();
    run_phase<PH>(*pp, layer, blockIdx.x, gridDim.x, (float*)lds4);
}
template <int PH>
void launch_phase(const Params& p, int layer, hipStream_t stream) {
    hipLaunchKernelGGL(k_phase<PH>, dim3(1024), dim3(NTHREADS), LDS_BYTES, stream, p, layer);
}
#endif

}

extern "C" void kernel_launch(void* const* d_in, const int* in_sizes, int n_in, void* d_out, int out_size, void* d_ws, size_t ws_size, hipStream_t stream) {
    Params p{};
    const float* const* in = (const float* const*)d_in;
    p.x_prompt = in[0]; p.x_sample = in[1]; p.cache_ckv = in[2]; p.cache_kpe = in[3]; p.cache_nak = in[4]; p.cache_nav = in[5]; p.c = in[6]; p.c_ctx = in[7];
    p.ada_w = in[8]; p.ada_b = in[9]; p.norm_mix_g = in[10]; p.norm_ffn_g = in[11]; p.w_in = in[12]; p.q_norm_g = in[13]; p.w_uq = in[14]; p.kv_norm_g = in[15]; p.w_ukv = in[16];
    p.q_head_g = in[17]; p.k_head_g = in[18]; p.naq_g = in[19]; p.nak_g = in[20]; p.rel_bias = in[21]; p.conv_w = in[22]; p.w_out = in[23]; p.peer_wq = in[24]; p.sub_keys = in[25];
    p.peer_u = in[26]; p.peer_v = in[27];
    float* out = (float*)d_out;
    p.out = out;
    p.o_ckv = out + (size_t)T * D;
    p.o_kpe = p.o_ckv + (size_t)BATCH * DEPTH * SEQ * 256;
    p.o_nak = p.o_kpe + (size_t)BATCH * DEPTH * SEQ * 64;
    p.o_nav = p.o_nak + (size_t)BATCH * DEPTH * 4 * SEQ * 128;
    char* ws = (char*)d_ws; size_t off = 0;
    auto carve = [&](size_t bytes) { void* r = ws + off; off += (bytes + 255) & ~(size_t)255; return r; };
    p.bar = (unsigned*)carve(16384);
    p.ada = (float*)carve((size_t)DEPTH * 3 * 6 * D * 4);
    p.hn = (float*)carve((size_t)T * D * 4);
    p.z = (float*)carve((size_t)(T + 1) * DIN * 4);
    p.cqn = (float*)carve((size_t)T * 512 * 4);
    p.ckv = (float*)carve((size_t)TKV * 256 * 4);
    p.qm = (float*)carve((size_t)T * 1536 * 4);
    p.kvr = (float*)carve((size_t)TKV * 2048 * 4);
    p.km = (float*)carve((size_t)TKV * 1536 * 4);
    p.qna = (float*)carve((size_t)T * 512 * 4);
    p.kna = (float*)carve((size_t)T * 512 * 4);
    p.mix = (float*)carve((size_t)T * D * 4);
    p.qp = (float*)carve((size_t)T * D * 4);
    p.sc = (float*)carve((size_t)T * D * 4);
    p.gate = (float*)carve((size_t)T * 128 * 4);
    p.eidx = (int*)carve((size_t)T * 128 * 4);
    p.wt_in = (bf16_t*)carve((size_t)DEPTH * DINP * D * 2);
    p.wt_uq = (bf16_t*)carve((size_t)DEPTH * 1536 * 512 * 2);
    p.wt_ukv = (bf16_t*)carve((size_t)DEPTH * 2048 * 256 * 2);
    p.wt_out = (bf16_t*)carve((size_t)DEPTH * D * D * 2);
    p.wt_q = (bf16_t*)carve((size_t)DEPTH * D * D * 2);
    p.hn_b = (bf16_t*)carve((size_t)T * D * 2);
    p.cqn_b = (bf16_t*)carve((size_t)T * 512 * 2);
    p.ckv_b = (bf16_t*)carve((size_t)TKV * 256 * 2);
    p.mix_b = (bf16_t*)carve((size_t)T * D * 2);
    p.q_b = (bf16_t*)carve((size_t)T * 1536 * 2);
    p.qp_b = (bf16_t*)carve((size_t)T * D * 2);
    p.sk_b = (bf16_t*)carve((size_t)DEPTH * 8 * 2 * 128 * 128 * 2);
    p.pu8 = (unsigned char*)carve((size_t)DEPTH * 16384 * D);
    p.pv8 = (unsigned char*)carve((size_t)DEPTH * 16384 * D);
    p.su8 = (float*)carve((size_t)DEPTH * 16384 * 4);
    p.sv8 = (float*)carve((size_t)DEPTH * 16384 * 4);
    p.k_b = (bf16_t*)carve((size_t)TKV * 1536 * 2);
    p.qna_b = (bf16_t*)carve((size_t)T * 512 * 2);
    p.kna_b = (bf16_t*)carve((size_t)T * 512 * 2);
    p.cnak_b = (bf16_t*)carve((size_t)DB * 4 * PAST * 128 * 2);
    p.vt_mla_ctx = (bf16_t*)carve((size_t)BATCH * 8 * 128 * SEQ * 2);
    p.vt_mla_lat = (bf16_t*)carve((size_t)DB * 8 * 128 * (PAST + DS) * 2);
    p.vt_na_ctx = (bf16_t*)carve((size_t)BATCH * 4 * 128 * SEQ * 2);
    p.vt_na_lat = (bf16_t*)carve((size_t)DB * 4 * 128 * DS * 2);
    p.vt_na_cache = (bf16_t*)carve((size_t)DB * 4 * 128 * PAST * 2);

#if MK_ONE_LAUNCH
    static int grid = 0;
    if (!grid) {
        int dev = 0, cus = 0, per_cu = 0;
        hipGetDevice(&dev);
        hipDeviceGetAttribute(&cus, hipDeviceAttributeMultiprocessorCount, dev);
        hipFuncSetAttribute((const void*)k_fwd, hipFuncAttributeMaxDynamicSharedMemorySize, (int)LDS_BYTES);
        hipOccupancyMaxActiveBlocksPerMultiprocessor(&per_cu, k_fwd, NTHREADS, LDS_BYTES);
        if (per_cu < 1) per_cu = 1;
        grid = cus * (per_cu < 1 ? per_cu : 1);
    }
    hipMemsetAsync(p.bar, 0, XCD_BAR_WORDS * sizeof(unsigned), stream);
    hipLaunchKernelGGL(k_fwd, dim3(grid), dim3(NTHREADS), LDS_BYTES, stream, p);
#else
    launch_phase<PH_ADA>(p, 0, stream);
    for (int l = 0; l < DEPTH; ++l) {
        if (l == 0) launch_phase<PH_NORM1>(p, l, stream);
        launch_phase<PH_WIN>(p, l, stream);
        launch_phase<PH_POSTZ>(p, l, stream);
        launch_phase<PH_UQKV>(p, l, stream);
        launch_phase<PH_HEADNORM>(p, l, stream);
        launch_phase<PH_ATTN>(p, l, stream);
        launch_phase<PH_WOUT>(p, l, stream);
        launch_phase<PH_NORM2>(p, l, stream);
        launch_phase<PH_WQ>(p, l, stream);
        launch_phase<PH_ROUTE>(p, l, stream);
        launch_phase<PH_EXPERTS>(p, l, stream);
    }
#endif
}
```

```cpp
#include <hip/hip_runtime.h>
#include <stdint.h>

#define DEVI __device__ __forceinline__

#define XB_TMO      128
#define XB_XCNT(j)  (256  + 64 * (j))
#define XB_XSUB(j)  (1280 + 64 * (j))
#define XB_XGEN(j)  (2304 + 64 * (j))
#define XB_TOP      3328
#define XB_TOPGEN   3392
#define XCD_BAR_WORDS 3456
#define XB_SPIN_CAP (1u << 18)
#define LAS __attribute__((address_space(3)))

__device__ __forceinline__ unsigned xb_ld(unsigned* p)              { return __hip_atomic_load(p, __ATOMIC_RELAXED, __HIP_MEMORY_SCOPE_AGENT); }
__device__ __forceinline__ unsigned xb_add(unsigned* p, unsigned v) { return __hip_atomic_fetch_add(p, v, __ATOMIC_RELAXED, __HIP_MEMORY_SCOPE_AGENT); }
__device__ __forceinline__ unsigned xb_xcc_id() { return (unsigned)__builtin_amdgcn_s_getreg((3 << 11) | 20) & 0xFu; }
#define XB_SPIN(cond, bar) do { unsigned _sp = 0; while (cond) { __builtin_amdgcn_s_sleep(1); \
    if ((++_sp & 255u) == 0u) { if (xb_ld(&(bar)[XB_TMO])) break; if (_sp > XB_SPIN_CAP) { atomicAdd(&(bar)[XB_TMO], 1u); break; } } } } while (0)

struct XcdBarrier {
    unsigned* bar; unsigned x;
    volatile LAS unsigned* st;
};

__device__ __forceinline__ XcdBarrier xcd_barrier_post(unsigned* bar, volatile LAS unsigned* st) {
    XcdBarrier b; b.bar = bar; b.x = xb_xcc_id(); b.st = st;
    if (threadIdx.x == 0) (void)xb_add(&bar[XB_XCNT(b.x)], 1u);
    return b;
}
__device__ __forceinline__ void xcd_barrier_complete(unsigned* bar, unsigned x, unsigned& nloc, unsigned& nx) {
    const unsigned G = gridDim.x * gridDim.y * gridDim.z;
    unsigned sum, cnt, mine, sp = 0u;
    for (;;) {
        sum = 0u; cnt = 0u; mine = 0u;
#pragma unroll
        for (unsigned j = 0; j < 16; ++j) { const unsigned c = xb_ld(&bar[XB_XCNT(j)]); sum += c; cnt += (c > 0u) ? 1u : 0u; mine = (j == x) ? c : mine; }
        if (sum == G) break;
        __builtin_amdgcn_s_sleep(1);
        if ((++sp & 255u) == 0u) { if (xb_ld(&bar[XB_TMO])) break; if (sp > XB_SPIN_CAP) { atomicAdd(&bar[XB_TMO], 1u); break; } }
    }
    nloc = mine > 0u ? mine : 1u; nx = cnt > 0u ? cnt : 1u;
}

__device__ __forceinline__ void xcd_barrier(const XcdBarrier& b) {
    asm volatile("s_waitcnt vmcnt(0)" ::: "memory");
    __syncthreads();
    if (threadIdx.x == 0) {
        unsigned* bar = b.bar;
        __builtin_amdgcn_s_waitcnt(0);
        unsigned nloc = b.st[0], nx = b.st[1];
        if (nloc == 0u) { xcd_barrier_complete(bar, b.x, nloc, nx); b.st[0] = nloc; b.st[1] = nx; }
        const unsigned old = xb_add(&bar[XB_XSUB(b.x)], 1u);
        const unsigned gen = old / nloc;
        if (old + 1u == (gen + 1u) * nloc) {
            __builtin_amdgcn_fence(__ATOMIC_RELEASE, "agent");
            asm volatile("s_waitcnt vmcnt(0)" ::: "memory");
            const unsigned og = xb_add(&bar[XB_TOP], 1u);
            const unsigned tg = og / nx;
            if (og + 1u == (tg + 1u) * nx) xb_add(&bar[XB_TOPGEN], 1u);
            else XB_SPIN(xb_ld(&bar[XB_TOPGEN]) == tg, bar);
            __builtin_amdgcn_fence(__ATOMIC_ACQUIRE, "agent");
            xb_add(&bar[XB_XGEN(b.x)], 1u);
            asm volatile("s_waitcnt vmcnt(0)" ::: "memory");
        } else {
            XB_SPIN(xb_ld(&bar[XB_XGEN(b.x)]) == gen, bar);
            __builtin_amdgcn_fence(__ATOMIC_ACQUIRE, "agent");
            asm volatile("s_waitcnt vmcnt(0)" ::: "memory");
        }
    }
    __syncthreads();
}


namespace pg8 {
#define PG8_LAS __attribute__((address_space(3)))
typedef unsigned short bf16_t;
typedef short bf16x8 __attribute__((ext_vector_type(8)));
typedef float f32x4 __attribute__((ext_vector_type(4)));
typedef unsigned u32x4 __attribute__((ext_vector_type(4)));
constexpr int BM = 256, BK = 64, HALF = 128, HTB = HALF * BK * 2  , STAGE_BYTES = 8 * HTB, NXCD = 8, WGM = 8;

__host__ __device__ __forceinline__ int lds_byte(int r, int c) { const int st = (r >> 4) * 2 + (c >> 5), rr = r & 15, cc = c & 31, ob = rr * 64 + cc * 2; return st * 1024 + (ob ^ (((ob >> 9) & 1) << 5)); }
__host__ __device__ __forceinline__ void stage_rc(int b, int& R, int& C) { const int st = b / 1024, sb = b % 1024, swz = sb ^ (((sb >> 9) & 1) << 5); R = (st >> 1) * 16 + swz / 64; C = (st & 1) * 32 + (swz % 64) / 2; }
__host__ __device__ __forceinline__ int perm32(int rho) { const int n = rho >> 4, i = rho & 15; return 8 * (i >> 2) + 4 * n + (i & 3); }

struct Unit { int pm, pn; };
struct Gemm { const bf16_t* A; const bf16_t* Bt; int M, N, K; };

struct StaticOrder {
    int nM, nN, nwg, G, c;
    __host__ __device__ void init(int M, int N, int G_, int c_) { nM = M / BM; nN = N / BM; nwg = nM * nN; G = G_; c = c_; }
    __host__ __device__ bool next(int i, Unit& u) const {
        const long L = (long)i * G + c; if (L >= nwg) return false;
        int wgid = (int)L; { const int q = nwg / NXCD, r = nwg % NXCD, xcd = wgid % NXCD, off = wgid / NXCD; wgid = (xcd < r ? xcd * (q + 1) : r * (q + 1) + (xcd - r) * q) + off; }
        const int nig = WGM * nN, gid = wgid / nig, fm = gid * WGM, gsz = (nM - fm) < WGM ? (nM - fm) : WGM;
        u.pm = fm + ((wgid % nig) % gsz); u.pn = (wgid % nig) / gsz; return true;
    }
    __device__ __forceinline__ void a_ready(const Unit&) const {}
    __device__ __forceinline__ void done(const Unit&) const {}
};

__device__ __forceinline__ unsigned cvt_pk_bf16(float lo, float hi) { unsigned r; asm volatile("v_cvt_pk_bf16_f32 %0, %1, %2" : "=v"(r) : "v"(lo), "v"(hi)); return r; }
typedef float f32x2 __attribute__((ext_vector_type(2)));
template <class Epi, class Sched, bool ALIGN_EPI = false, bool SP2 = false>
__device__ __forceinline__ void gemm_phase(PG8_LAS unsigned char* lds, const Gemm g, const Sched& S, const Epi& E) {
    int tid = threadIdx.x; asm volatile("" : "+v"(tid));
    const int wid = __builtin_amdgcn_readfirstlane(tid >> 6), lane = tid & 63, wr = wid >> 2, wc = wid & 3, fr = lane & 15, fq = lane >> 4;
    const int K = g.K, nt = K / BK;
    unsigned voffA[2], voffB[2];
#pragma unroll
    for (int i = 0; i < 2; ++i) { int R, C; stage_rc(tid * 16 + i * 8192, R, C); const int Rb = Epi::PERM ? ((R & ~31) + perm32(R & 31)) : R;
        voffA[i] = (unsigned)(R * K + C) * 2u; voffB[i] = (unsigned)(Rb * K + C) * 2u; }
    const size_t kstep = (size_t)(BK * 2);
    const size_t hstep = (size_t)HALF * K * 2;
    const size_t tstep = 2 * hstep;
    const unsigned ldsw = (unsigned)wid * 1024u;
    const int aoff = lds_byte(wr * 64 + fr, fq * 8), boff = lds_byte(wc * 32 + fr, fq * 8);
#define PG8_SA(b, h) (((b) * 2 + (h)) * HTB)
#define PG8_SB(b, h) ((4 + (b) * 2 + (h)) * HTB)
#define PG8_STAGE(bufoff, gbase, voff) do { _Pragma("unroll") for (int _i = 0; _i < 2; ++_i) \
        __builtin_amdgcn_global_load_lds((const unsigned*)((const char*)(gbase) + (voff)[_i]), (PG8_LAS unsigned*)(lds + (bufoff) + ldsw + _i * 8192), 16, 0, 0); } while (0)
#define PG8_LDA(dst, b, h) do { _Pragma("unroll") for (int m = 0; m < 4; ++m) _Pragma("unroll") for (int k = 0; k < 2; ++k) dst[m][k] = *(const PG8_LAS bf16x8*)(lds + PG8_SA(b, h) + aoff + m * 2048 + k * 1024); } while (0)
#define PG8_LDB(dst, b, h) do { _Pragma("unroll") for (int n = 0; n < 2; ++n) _Pragma("unroll") for (int k = 0; k < 2; ++k) dst[n][k] = *(const PG8_LAS bf16x8*)(lds + PG8_SB(b, h) + boff + n * 2048 + k * 1024); } while (0)
#define PG8_MMA(ai, bj, At, Bt) do { __builtin_amdgcn_s_setprio(1); _Pragma("unroll") for (int m = 0; m < 4; ++m) _Pragma("unroll") for (int n = 0; n < 2; ++n) _Pragma("unroll") for (int k = 0; k < 2; ++k) \
        acc[ai][bj][m][n] = __builtin_amdgcn_mfma_f32_16x16x32_bf16(Bt[n][k], At[m][k], acc[ai][bj][m][n], 0, 0, 0); __builtin_amdgcn_s_setprio(0); } while (0)
#define PG8_WAIT_V(n) asm volatile("s_waitcnt vmcnt(" #n ")" ::: "memory")
#define PG8_WAIT_L(n) asm volatile("s_waitcnt lgkmcnt(" #n ")" ::: "memory")
#define PG8_BAR __builtin_amdgcn_s_barrier()
#define PG8_SCHED __builtin_amdgcn_sched_barrier(0)
    Unit cur, nxt; int ui = 0;
    if (!S.next(0, cur)) return;
    f32x4 acc[2][2][4][2];
#pragma unroll
    for (int a = 0; a < 2; ++a)
#pragma unroll
        for (int b = 0; b < 2; ++b)
#pragma unroll
            for (int m = 0; m < 4; ++m)
#pragma unroll
                for (int n = 0; n < 2; ++n) acc[a][b][m][n] = (f32x4){0.f, 0.f, 0.f, 0.f};
    bf16x8 At[4][2], B0[2][2], B1[2][2];
    const char* cA = (const char*)g.A + (size_t)cur.pm * tstep; const char* cB = (const char*)g.Bt + (size_t)cur.pn * tstep;
    S.a_ready(cur);
    if constexpr (SP2) {
        PG8_STAGE(PG8_SB(0, 0), cB, voffB); PG8_STAGE(PG8_SB(0, 1), cB + hstep, voffB); PG8_STAGE(PG8_SA(0, 0), cA, voffA); PG8_STAGE(PG8_SA(0, 1), cA + hstep, voffA);
        if (wr == 1) PG8_BAR;
        PG8_WAIT_V(2); PG8_BAR;
        PG8_STAGE(PG8_SB(1, 0), cB + kstep, voffB); PG8_STAGE(PG8_SA(1, 0), cA + kstep, voffA); PG8_STAGE(PG8_SB(1, 1), cB + hstep + kstep, voffB);
        PG8_WAIT_V(6); PG8_BAR;
    } else {
        PG8_STAGE(PG8_SB(0, 0), cB, voffB); PG8_STAGE(PG8_SA(0, 0), cA, voffA); PG8_STAGE(PG8_SB(0, 1), cB + hstep, voffB); PG8_STAGE(PG8_SA(0, 1), cA + hstep, voffA);
        if (wr == 1) PG8_BAR;
        PG8_WAIT_V(4); PG8_BAR;
        PG8_STAGE(PG8_SB(1, 0), cB + kstep, voffB); PG8_STAGE(PG8_SA(1, 0), cA + kstep, voffA); PG8_STAGE(PG8_SB(1, 1), cB + hstep + kstep, voffB);
        PG8_WAIT_V(6); PG8_BAR;
    }
    for (;;) {
        const bool has_next = S.next(ui + 1, nxt);
        const char* nA = has_next ? (const char*)g.A + (size_t)nxt.pm * tstep : cA; const char* nB = has_next ? (const char*)g.Bt + (size_t)nxt.pn * tstep : cB;
        for (int t = 0; t < nt; t += 2) {
            const bool last = (t == nt - 2);
            const char* a1 = cA + (size_t)(t + 1) * kstep;
            const char* a2 = last ? nA : cA + (size_t)(t + 2) * kstep; const char* b2 = last ? nB : cB + (size_t)(t + 2) * kstep;
            const char* a3 = a2 + kstep; const char* b3 = b2 + kstep;
            if (last && has_next) S.a_ready(nxt);
            if constexpr (SP2) {
            PG8_LDB(B0, 0, 0); PG8_LDB(B1, 0, 1); PG8_SCHED; PG8_LDA(At, 0, 0); PG8_STAGE(PG8_SA(1, 1), a1 + hstep, voffA);
            PG8_WAIT_V(8); PG8_WAIT_L(0); PG8_BAR; PG8_MMA(0, 0, At, B0); PG8_MMA(0, 1, At, B1); PG8_BAR; PG8_SCHED;
            PG8_LDA(At, 0, 1); PG8_STAGE(PG8_SB(0, 0), b2, voffB); PG8_STAGE(PG8_SB(0, 1), b2 + hstep, voffB); PG8_STAGE(PG8_SA(0, 0), a2, voffA);
            PG8_WAIT_V(8); PG8_WAIT_L(0); PG8_BAR; PG8_MMA(1, 0, At, B0); PG8_MMA(1, 1, At, B1); PG8_BAR; PG8_SCHED;
            PG8_LDB(B0, 1, 0); PG8_LDB(B1, 1, 1); PG8_SCHED; PG8_LDA(At, 1, 0); PG8_STAGE(PG8_SA(0, 1), a2 + hstep, voffA);
            PG8_WAIT_V(8); PG8_WAIT_L(0); PG8_BAR; PG8_MMA(0, 0, At, B0); PG8_MMA(0, 1, At, B1); PG8_BAR; PG8_SCHED;
            PG8_LDA(At, 1, 1); PG8_STAGE(PG8_SB(1, 0), b3, voffB); PG8_STAGE(PG8_SB(1, 1), b3 + hstep, voffB); PG8_STAGE(PG8_SA(1, 0), a3, voffA);
            PG8_WAIT_V(8); PG8_WAIT_L(0); PG8_BAR; PG8_MMA(1, 0, At, B0); PG8_MMA(1, 1, At, B1); PG8_BAR; PG8_SCHED;
            } else {
            PG8_LDB(B0, 0, 0); PG8_SCHED; PG8_LDA(At, 0, 0); PG8_STAGE(PG8_SA(1, 1), a1 + hstep, voffA);
            PG8_WAIT_L(8); PG8_BAR; PG8_WAIT_L(0); PG8_MMA(0, 0, At, B0); PG8_BAR; PG8_SCHED;
            PG8_LDB(B1, 0, 1); PG8_STAGE(PG8_SB(0, 0), b2, voffB);
            PG8_BAR; PG8_WAIT_L(0); PG8_MMA(0, 1, At, B1); PG8_BAR;
            PG8_LDA(At, 0, 1); PG8_STAGE(PG8_SA(0, 0), a2, voffA);
            PG8_BAR; PG8_WAIT_L(0); PG8_MMA(1, 0, At, B0); PG8_BAR; PG8_SCHED;
            PG8_STAGE(PG8_SB(0, 1), b2 + hstep, voffB);
            PG8_WAIT_V(6); PG8_BAR; PG8_MMA(1, 1, At, B1); PG8_BAR;
            PG8_LDB(B0, 1, 0); PG8_SCHED; PG8_LDA(At, 1, 0); PG8_STAGE(PG8_SA(0, 1), a2 + hstep, voffA);
            PG8_WAIT_L(8); PG8_BAR; PG8_WAIT_L(0); PG8_MMA(0, 0, At, B0); PG8_BAR; PG8_SCHED;
            PG8_LDB(B1, 1, 1); PG8_STAGE(PG8_SB(1, 0), b3, voffB);
            PG8_BAR; PG8_WAIT_L(0); PG8_MMA(0, 1, At, B1); PG8_BAR;
            PG8_LDA(At, 1, 1); PG8_STAGE(PG8_SA(1, 0), a3, voffA);
            PG8_BAR; PG8_WAIT_L(0); PG8_MMA(1, 0, At, B0); PG8_BAR; PG8_SCHED;
            PG8_STAGE(PG8_SB(1, 1), b3 + hstep, voffB);
            PG8_WAIT_V(6); PG8_BAR; PG8_MMA(1, 1, At, B1); PG8_BAR;
            }
        }
        if constexpr (ALIGN_EPI) { if (wr == 0) PG8_BAR; }
        if constexpr (!Epi::AFTER_DRAIN) { E(acc, cur, wr, wc, fr, fq); S.done(cur); }
        if (!has_next) break;
#pragma unroll
        for (int a = 0; a < 2; ++a)
#pragma unroll
            for (int b = 0; b < 2; ++b)
#pragma unroll
                for (int m = 0; m < 4; ++m)
#pragma unroll
                    for (int n = 0; n < 2; ++n) acc[a][b][m][n] = (f32x4){0.f, 0.f, 0.f, 0.f};
        cur = nxt; cA = nA; cB = nB; ++ui;
        if constexpr (ALIGN_EPI) { if (wr == 1) PG8_BAR; }
    }
    PG8_WAIT_V(0);
    if constexpr (!ALIGN_EPI) { if (wr == 0) PG8_BAR; }
    PG8_BAR;
    if constexpr (Epi::AFTER_DRAIN) { E.fused(acc, cur, wr, wc, fr, fq, lds, wid, lane); S.done(cur); }
#undef PG8_SA
#undef PG8_SB
#undef PG8_STAGE
#undef PG8_LDA
#undef PG8_LDB
#undef PG8_MMA
#undef PG8_WAIT_V
#undef PG8_WAIT_L
#undef PG8_BAR
#undef PG8_SCHED
}
}


namespace {

constexpr int D = 2048, BATCH = 32, SEQ = 256, DEPTH = 4, DB = 2, DS = 1024, PAST = 512;
constexpr int NCTX = BATCH * SEQ, NLAT = DB * DS, T = NCTX + NLAT, TKV = T + DB * PAST;
constexpr int DIN = 3904, DINP = 4096;
constexpr int RING_OFF = 0, MISC_OFF = 131072, LDS_TOTAL = 147456;
typedef unsigned short bf16_t;
constexpr int O_CQ = 0, O_CKV = 512, O_KPE = 768, O_NAQ = 832, O_NAK = 1344, O_NAV = 1856, O_GB = 2368, O_GC = 2880, O_U = 3392;
constexpr float EPS = 1e-6f;
constexpr int NTHREADS = 512, NWAVES = NTHREADS / 64;

struct Params {
    const float *x_prompt, *x_sample, *cache_ckv, *cache_kpe, *cache_nak, *cache_nav, *c, *c_ctx;
    const float *ada_w, *ada_b, *norm_mix_g, *norm_ffn_g, *w_in, *q_norm_g, *w_uq, *kv_norm_g, *w_ukv;
    const float *q_head_g, *k_head_g, *naq_g, *nak_g, *rel_bias, *conv_w, *w_out, *peer_wq, *sub_keys, *peer_u, *peer_v;
    float* out;
    float *o_ckv, *o_kpe, *o_nak, *o_nav;
    unsigned* bar;
    float *ada, *hn, *z, *cqn, *ckv, *qm, *kvr, *km, *qna, *kna, *mix, *qp, *sc, *gate;
    int* eidx;
    unsigned short *wt_in, *wt_uq, *wt_ukv, *wt_out, *wt_q;
    unsigned short *hn_b, *cqn_b, *ckv_b, *mix_b;
    unsigned short *z_b, *qm_b, *kvr_b; float* rope_cs;
    unsigned short *qp_b, *sk_b;
    unsigned char *pu8, *pv8; float *su8, *sv8;
    unsigned short *q_b, *k_b, *qna_b, *kna_b, *cnak_b;
    unsigned short *vt_mla_ctx, *vt_mla_lat, *vt_na_ctx, *vt_na_lat, *vt_na_cache;
};

typedef const __attribute__((address_space(4))) Params CParams;

DEVI int tidx() { int t = threadIdx.x; asm volatile("" : "+v"(t)); return t; }
DEVI float wave_sum(float v) {
#pragma unroll
    for (int o = 32; o > 0; o >>= 1) v += __shfl_xor(v, o);
    return v;
}
DEVI float wave_max(float v) {
#pragma unroll
    for (int o = 32; o > 0; o >>= 1) v = fmaxf(v, __shfl_xor(v, o));
    return v;
}
DEVI void wave_argmax(float& v, int& idx) {
#pragma unroll
    for (int o = 32; o > 0; o >>= 1) {
        float ov = __shfl_xor(v, o); int oi = __shfl_xor(idx, o);
        if (ov > v || (ov == v && oi < idx)) { v = ov; idx = oi; }
    }
}
typedef float f32x2_t __attribute__((ext_vector_type(2))); typedef __bf16 bf16x2_t __attribute__((ext_vector_type(2)));
DEVI unsigned cvtpk(float lo, float hi) { f32x2_t v = {lo, hi}; bf16x2_t b = __builtin_convertvector(v, bf16x2_t); return __builtin_bit_cast(unsigned, b); }
DEVI bf16_t f2bf(float v) { return (bf16_t)(cvtpk(v, 0.f) & 0xffffu); }
DEVI int cond_of(int t) { return t < NCTX ? 2 : (t - NCTX) / DS; }
DEVI const float* xrow(CParams& p, int layer, int t) {
    if (layer == 0) return t < NCTX ? p.x_prompt + (size_t)t * D : p.x_sample + (size_t)(t - NCTX) * D;
    return p.out + (size_t)t * D;
}

DEVI void phase_ada(CParams& p, int bid, int nb, float* lds) {
    float* sv = lds;
    float* red = lds + 3 * D;
    const int tid = tidx(), lane = tid & 63, w = tid >> 6;
    for (int i = tid; i < 3 * D; i += NTHREADS) {
        int j = i / D, k = i % D;
        float v = j < 2 ? p.c[j * D + k] : p.c_ctx[k];
        sv[i] = v / (1.f + __expf(-v));
    }
    __syncthreads();
    const int nitems = DEPTH * (6 * D / 64);
    for (int it = bid; it < nitems; it += nb) {
        const int l = it / (6 * D / 64), n = (it % (6 * D / 64)) * 64 + lane;
        const float* W = p.ada_w + (size_t)l * D * 6 * D + n;
        float a0 = 0.f, a1 = 0.f, a2 = 0.f;
        const int k0 = w * (D / NWAVES);
#pragma unroll 8
        for (int k = k0; k < k0 + D / NWAVES; ++k) {
            float wv = W[(size_t)k * 6 * D];
            a0 += sv[k] * wv; a1 += sv[D + k] * wv; a2 += sv[2 * D + k] * wv;
        }
        red[(w * 3 + 0) * 64 + lane] = a0; red[(w * 3 + 1) * 64 + lane] = a1; red[(w * 3 + 2) * 64 + lane] = a2;
        __syncthreads();
        if (tid < 192) {
            int j = tid / 64, ln = tid % 64;
            float s = 0.f;
            for (int ww = 0; ww < NWAVES; ++ww) s += red[(ww * 3 + j) * 64 + ln];
            int nn = (it % (6 * D / 64)) * 64 + ln;
            p.ada[((size_t)l * 3 + j) * 6 * D + nn] = s + p.ada_b[(size_t)l * 6 * D + nn];
        }
        __syncthreads();
    }
}

DEVI void phase_modnorm(CParams& p, int layer, int which, int bid, int nb) {
    const int lane = tidx() & 63, w = tidx() >> 6;
    const float* g = (which == 0 ? p.norm_mix_g : p.norm_ffn_g) + (size_t)layer * D;
    for (int t = bid * NWAVES + w; t < T; t += nb * NWAVES) {
        const float* x = which == 0 ? xrow(p, layer, t) : p.out + (size_t)t * D;
        const float* ad = p.ada + ((size_t)layer * 3 + cond_of(t)) * 6 * D + (which == 0 ? 0 : 3 * D);
        float4 v[8]; float ss = 0.f;
#pragma unroll
        for (int i = 0; i < 8; ++i) { v[i] = *(const float4*)(x + i * 256 + lane * 4); ss += v[i].x * v[i].x + v[i].y * v[i].y + v[i].z * v[i].z + v[i].w * v[i].w; }
        ss = wave_sum(ss);
        const float r = rsqrtf(ss / D + EPS);
#pragma unroll
        for (int i = 0; i < 8; ++i) {
            const int c = i * 256 + lane * 4;
            float4 gg = *(const float4*)(g + c), sh = *(const float4*)(ad + c), sc = *(const float4*)(ad + D + c), o;
            o.x = v[i].x * r * gg.x * (1.f + sc.x) + sh.x; o.y = v[i].y * r * gg.y * (1.f + sc.y) + sh.y;
            o.z = v[i].z * r * gg.z * (1.f + sc.z) + sh.z; o.w = v[i].w * r * gg.w * (1.f + sc.w) + sh.w;
            *(uint2*)(p.hn_b + (size_t)t * D + c) = make_uint2(pg8::cvt_pk_bf16(o.x, o.y), pg8::cvt_pk_bf16(o.z, o.w));
        }
    }
}

template <bool BT, class Epi>
DEVI void gemm_tile(const float* A, int lda, const float* W, int ldw, int K, int m0, int n0, const Epi& epi, float* lds) {
    float (*As)[132] = (float (*)[132])lds;
    float (*Bs)[68] = (float (*)[68])(lds + 16 * 132);
    const int tid = tidx(), tx = tid & 15, ty = tid >> 4;
    float acc[4][4];
#pragma unroll
    for (int i = 0; i < 4; ++i)
#pragma unroll
        for (int j = 0; j < 4; ++j) acc[i][j] = 0.f;
    for (int k0 = 0; k0 < K; k0 += 16) {
        {
            const int row = tid >> 2, kq = tid & 3;
            float4 v = *(const float4*)(A + (size_t)(m0 + row) * lda + k0 + kq * 4);
            As[kq * 4 + 0][row] = v.x; As[kq * 4 + 1][row] = v.y; As[kq * 4 + 2][row] = v.z; As[kq * 4 + 3][row] = v.w;
        }
        if (tid < 256) {
            if (!BT) {
                const int k = tid >> 4, n4 = tid & 15;
                float4 v = *(const float4*)(W + (size_t)(k0 + k) * ldw + n0 + n4 * 4);
                *(float4*)&Bs[k][n4 * 4] = v;
            } else {
                const int n = tid >> 2, kq = tid & 3;
                float4 v = *(const float4*)(W + (size_t)(n0 + n) * ldw + k0 + kq * 4);
                Bs[kq * 4 + 0][n] = v.x; Bs[kq * 4 + 1][n] = v.y; Bs[kq * 4 + 2][n] = v.z; Bs[kq * 4 + 3][n] = v.w;
            }
        }
        __syncthreads();
#pragma unroll
        for (int k = 0; k < 16; ++k) {
            float4 a = *(const float4*)&As[k][ty * 4], b = *(const float4*)&Bs[k][tx * 4];
            const float av[4] = {a.x, a.y, a.z, a.w}, bv[4] = {b.x, b.y, b.z, b.w};
#pragma unroll
            for (int i = 0; i < 4; ++i)
#pragma unroll
                for (int j = 0; j < 4; ++j) acc[i][j] += av[i] * bv[j];
        }
        __syncthreads();
    }
#pragma unroll
    for (int i = 0; i < 4; ++i) epi(m0 + ty * 4 + i, n0 + tx * 4, make_float4(acc[i][0], acc[i][1], acc[i][2], acc[i][3]));
}
template <bool BT, class Epi>
DEVI void gemm_f32(const float* A, int lda, const float* W, int ldw, int M, int N, int K, const Epi& epi, int bid, int nb, float* lds) {
    const int nn = N / 64, nt = (M / 128) * nn;
    for (int tile = bid; tile < nt; tile += nb) gemm_tile<BT>(A, lda, W, ldw, K, (tile / nn) * 128, (tile % nn) * 64, epi, lds);
}
struct EpiStore { float* C; int ldc; DEVI void operator()(int r, int c, float4 v) const { *(float4*)(C + (size_t)r * ldc + c) = v; } };
struct EpiResid {
    CParams* p; int layer;
    DEVI void operator()(int r, int c, float4 v) const {
        const float* x = xrow(*p, layer, r) + c;
        const float* g1 = p->ada + ((size_t)layer * 3 + cond_of(r)) * 6 * D + 2 * D + c;
        float4 xv = *(const float4*)x, gv = *(const float4*)g1, o;
        o.x = xv.x + gv.x * v.x; o.y = xv.y + gv.y * v.y; o.z = xv.z + gv.z * v.z; o.w = xv.w + gv.w * v.w;
        *(float4*)(p->out + (size_t)r * D + c) = o;
    }
};


struct EpiF32 {
    static constexpr bool PERM = false, AFTER_DRAIN = false;
    float* C; int ldc, ncols;
    DEVI void operator()(const pg8::f32x4 (&acc)[2][2][4][2], const pg8::Unit& u, int wr, int wc, int fr, int fq) const {
        const int row0 = u.pm * 256 + wr * 64 + fr, col0 = u.pn * 256 + wc * 32 + 4 * fq;
#pragma unroll
        for (int ai = 0; ai < 2; ++ai)
#pragma unroll
            for (int m = 0; m < 4; ++m) { float* rowp = C + (size_t)(row0 + ai * 128 + m * 16) * ldc;
#pragma unroll
                for (int bj = 0; bj < 2; ++bj)
#pragma unroll
                    for (int n = 0; n < 2; ++n) { const int c = col0 + bj * 128 + n * 16; if (c < ncols) *(pg8::f32x4*)(rowp + c) = acc[ai][bj][m][n]; } }
    }
};
struct EpiResidMF {
    static constexpr bool PERM = false, AFTER_DRAIN = false;
    CParams* p; int layer;
    DEVI void operator()(const pg8::f32x4 (&acc)[2][2][4][2], const pg8::Unit& u, int wr, int wc, int fr, int fq) const {
        const int row0 = u.pm * 256 + wr * 64 + fr, col0 = u.pn * 256 + wc * 32 + 4 * fq;
#pragma unroll
        for (int ai = 0; ai < 2; ++ai)
#pragma unroll
            for (int m = 0; m < 4; ++m) {
                const int r = row0 + ai * 128 + m * 16;
                const float* x = xrow(*p, layer, r);
                const float* g1 = p->ada + ((size_t)layer * 3 + cond_of(r)) * 6 * D + 2 * D;
                float* o = p->out + (size_t)r * D;
#pragma unroll
                for (int bj = 0; bj < 2; ++bj)
#pragma unroll
                    for (int n = 0; n < 2; ++n) { const int c = col0 + bj * 128 + n * 16;
                        const pg8::f32x4 xv = *(const pg8::f32x4*)(x + c), gv = *(const pg8::f32x4*)(g1 + c);
                        *(pg8::f32x4*)(o + c) = xv + gv * acc[ai][bj][m][n]; } }
    }
};
struct EpiBf16Store {
    static constexpr bool PERM = true, AFTER_DRAIN = false;
    bf16_t* O; int ldc, ncols;
    DEVI void operator()(const pg8::f32x4 (&acc)[2][2][4][2], const pg8::Unit& u, int wr, int wc, int fr, int fq) const {
        const int row0 = u.pm * 256 + wr * 64 + fr, col0 = u.pn * 256 + wc * 32 + 8 * fq;
#pragma unroll
        for (int ai = 0; ai < 2; ++ai)
#pragma unroll
            for (int m = 0; m < 4; ++m) { bf16_t* rowp = O + (size_t)(row0 + ai * 128 + m * 16) * ldc + col0;
#pragma unroll
                for (int bj = 0; bj < 2; ++bj) { const pg8::f32x4 v0 = acc[ai][bj][m][0], v1 = acc[ai][bj][m][1];
                    if (col0 + bj * 128 < ncols) *(uint4*)(rowp + bj * 128) = make_uint4(cvtpk(v0[0], v0[1]), cvtpk(v0[2], v0[3]), cvtpk(v1[0], v1[1]), cvtpk(v1[2], v1[3])); } }
    }
};
template <class Epi>
DEVI void mfma_gemm(const bf16_t* A, const bf16_t* Bt, int M, int N, int K, const Epi& E, int bid, int nb, float* lds) {
    pg8::Gemm g{A, Bt, M, N, K};
    pg8::StaticOrder S; S.init(M, N, nb, bid);
    pg8::gemm_phase<Epi, pg8::StaticOrder, true, true>((PG8_LAS unsigned char*)lds + RING_OFF, g, S, E);
    __syncthreads();
}

DEVI float rope_angle(int pos, int j) {
    const int row = pos / 64, col = pos % 64;
    const int f = j & 15;
    const float inv = powf(10000.f, -(float)f / 16.f);
    return (j < 16 ? (float)row : (float)col) * inv;
}

DEVI void transpose_tile(const float* W, int ldw, bf16_t* Wt, int ldt, int k0, int n0, float* lds) {
    float (*tl)[65] = (float (*)[65])lds;
    const int tid = tidx();
#pragma unroll
    for (int rep = 0; rep < 2; ++rep) {
        const int k = (tid >> 4) + rep * 32, n4 = (tid & 15) * 4;
        const float4 v = *(const float4*)(W + (size_t)(k0 + k) * ldw + n0 + n4);
        tl[k][n4] = v.x; tl[k][n4 + 1] = v.y; tl[k][n4 + 2] = v.z; tl[k][n4 + 3] = v.w;
    }
    __syncthreads();
    {
        const int n = tid >> 3, k8 = (tid & 7) * 8;
        uint4 o;
        o.x = pg8::cvt_pk_bf16(tl[k8 + 0][n], tl[k8 + 1][n]); o.y = pg8::cvt_pk_bf16(tl[k8 + 2][n], tl[k8 + 3][n]);
        o.z = pg8::cvt_pk_bf16(tl[k8 + 4][n], tl[k8 + 5][n]); o.w = pg8::cvt_pk_bf16(tl[k8 + 6][n], tl[k8 + 7][n]);
        *(uint4*)(Wt + (size_t)(n0 + n) * ldt + k0 + k8) = o;
    }
    __syncthreads();
}
DEVI void phase_weights(CParams& p, int bid, int nb, float* lds) {
    constexpr int N_IN = 32 * 61, N_UQ = 8 * 24, N_UKV = 4 * 32, N_SQ = 32 * 32, PER = N_IN + N_UQ + N_UKV + 2 * N_SQ;
    for (int it = bid; it < DEPTH * PER; it += nb) {
        const int l = it / PER; int j = it % PER;
        if (j < N_IN) { transpose_tile(p.w_in + (size_t)l * D * DIN, DIN, p.wt_in + (size_t)l * DINP * D, D, (j / 61) * 64, (j % 61) * 64, lds); continue; }
        j -= N_IN;
        if (j < N_UQ) { transpose_tile(p.w_uq + (size_t)l * 512 * 1536, 1536, p.wt_uq + (size_t)l * 1536 * 512, 512, (j / 24) * 64, (j % 24) * 64, lds); continue; }
        j -= N_UQ;
        if (j < N_UKV) { transpose_tile(p.w_ukv + (size_t)l * 256 * 2048, 2048, p.wt_ukv + (size_t)l * 2048 * 256, 256, (j / 32) * 64, (j % 32) * 64, lds); continue; }
        j -= N_UKV;
        if (j < N_SQ) { transpose_tile(p.w_out + (size_t)l * D * D, D, p.wt_out + (size_t)l * D * D, D, (j / 32) * 64, (j % 32) * 64, lds); continue; }
        j -= N_SQ;
        transpose_tile(p.peer_wq + (size_t)l * D * D, D, p.wt_q + (size_t)l * D * D, D, (j / 32) * 64, (j % 32) * 64, lds);
    }
    for (int i = bid * NTHREADS + tidx(); i < DS * 32; i += nb * NTHREADS) {
        const int pos = i >> 5, j = i & 31;
        const float ang = rope_angle(pos, j);
        p.rope_cs[(size_t)pos * 64 + j] = cosf(ang); p.rope_cs[(size_t)pos * 64 + 32 + j] = sinf(ang);
    }
    for (int i = bid * NTHREADS + tidx(); i < DEPTH * 8 * 2 * 128 * 128 / 4; i += nb * NTHREADS) {
        const float4 v = *(const float4*)(p.sub_keys + (size_t)i * 4);
        *(uint2*)(p.sk_b + (size_t)i * 4) = make_uint2(cvtpk(v.x, v.y), cvtpk(v.z, v.w));
    }
    {
        const int lane = tidx() & 63, w = tidx() >> 6;
        for (int row = bid * NWAVES + w; row < 2 * DEPTH * 16384; row += nb * NWAVES) {
            const bool isv = row >= DEPTH * 16384; const int rr = isv ? row - DEPTH * 16384 : row;
            const float* src = (isv ? p.peer_v : p.peer_u) + (size_t)rr * D;
            float4 v[8]; float mx = 0.f;
#pragma unroll
            for (int i = 0; i < 8; ++i) { v[i] = *(const float4*)(src + i * 256 + lane * 4); mx = fmaxf(mx, fmaxf(fmaxf(fabsf(v[i].x), fabsf(v[i].y)), fmaxf(fabsf(v[i].z), fabsf(v[i].w)))); }
            mx = wave_max(mx);
            const float scale = mx > 0.f ? mx * (1.f / 440.f) : 1.f, inv = 1.f / scale;
            unsigned char* dst = (isv ? p.pv8 : p.pu8) + (size_t)rr * D;
#pragma unroll
            for (int i = 0; i < 8; ++i) {
                int pk = 0;
                pk = __builtin_amdgcn_cvt_pk_fp8_f32(v[i].x * inv, v[i].y * inv, pk, false);
                pk = __builtin_amdgcn_cvt_pk_fp8_f32(v[i].z * inv, v[i].w * inv, pk, true);
                *(int*)(dst + i * 256 + lane * 4) = pk;
            }
            if (lane == 0) (isv ? p.sv8 : p.su8)[rr] = scale;
        }
    }
    const int nz = DEPTH * (DINP - DIN) * D / 8;
    for (int i = bid * NTHREADS + tidx(); i < nz; i += nb * NTHREADS) {
        const int per = (DINP - DIN) * D / 8, l = i / per, r = i % per;
        *(uint4*)(p.wt_in + ((size_t)l * DINP + DIN) * D + (size_t)r * 8) = make_uint4(0u, 0u, 0u, 0u);
    }
}

DEVI float bf_lo(unsigned v) { return __uint_as_float(v << 16); }
DEVI float bf_hi(unsigned v) { return __uint_as_float(v & 0xffff0000u); }
DEVI void unpack8(const uint4& v, float (&f)[8]) { f[0] = bf_lo(v.x); f[1] = bf_hi(v.x); f[2] = bf_lo(v.y); f[3] = bf_hi(v.y); f[4] = bf_lo(v.z); f[5] = bf_hi(v.z); f[6] = bf_lo(v.w); f[7] = bf_hi(v.w); }
DEVI uint4 pack8(const float (&f)[8]) { return make_uint4(cvtpk(f[0], f[1]), cvtpk(f[2], f[3]), cvtpk(f[4], f[5]), cvtpk(f[6], f[7])); }
DEVI void phase_postz(CParams& p, int layer, int bid, int nb) {
    const int lane = tidx() & 63, w = tidx() >> 6;
    for (int r = bid * NWAVES + w; r < TKV; r += nb * NWAVES) {
        if (r >= T) {
            const int b = (r - T) / PAST, j = (r - T) % PAST;
            const float4 v = *(const float4*)(p.cache_ckv + (((size_t)b * DEPTH + layer) * PAST + j) * 256 + lane * 4);
            *(uint2*)(p.ckv_b + (size_t)r * 256 + lane * 4) = make_uint2(cvtpk(v.x, v.y), cvtpk(v.z, v.w));
            continue;
        }
        const bf16_t* z = p.z_b + (size_t)r * DIN;
        const bool ctx = r < NCTX;
        const int b = ctx ? r / SEQ : (r - NCTX) / DS, s = ctx ? r % SEQ : (r - NCTX) % DS, S = ctx ? SEQ : DS;
        const bool hp = s > 0, hn = s < S - 1;
        const uint4 zero4 = make_uint4(0u, 0u, 0u, 0u);
        const uint4 cq4 = *(const uint4*)(z + O_CQ + lane * 8);
        const uint2 ckv2 = *(const uint2*)(z + O_CKV + lane * 4);
        const bf16_t kpe1 = z[O_KPE + lane];
        const uint4 naq4 = *(const uint4*)(z + O_NAQ + lane * 8), nak4 = *(const uint4*)(z + O_NAK + lane * 8), nav4 = *(const uint4*)(z + O_NAV + lane * 8);
        const uint4 gb4 = *(const uint4*)(z + O_GB + lane * 8), gc4 = *(const uint4*)(z + O_GC + lane * 8), u4 = *(const uint4*)(z + O_U + lane * 8);
        const uint4 gcm4 = hp ? *(const uint4*)(z - DIN + O_GC + lane * 8) : zero4, um4 = hp ? *(const uint4*)(z - DIN + O_U + lane * 8) : zero4;
        const uint4 gcp4 = hn ? *(const uint4*)(z + DIN + O_GC + lane * 8) : zero4, up4 = hn ? *(const uint4*)(z + DIN + O_U + lane * 8) : zero4;
        float cw[24];
        {
            const float* cwp = p.conv_w + ((size_t)layer * 512 + lane * 8) * 3;
#pragma unroll
            for (int q = 0; q < 6; ++q) { const float4 v = *(const float4*)(cwp + q * 4); cw[q * 4] = v.x; cw[q * 4 + 1] = v.y; cw[q * 4 + 2] = v.z; cw[q * 4 + 3] = v.w; }
        }
        float gq[8], gkv[4], gnq[8], gnk[8];
        {
            const float4 a = *(const float4*)(p.q_norm_g + layer * 512 + lane * 8), c = *(const float4*)(p.q_norm_g + layer * 512 + lane * 8 + 4);
            gq[0] = a.x; gq[1] = a.y; gq[2] = a.z; gq[3] = a.w; gq[4] = c.x; gq[5] = c.y; gq[6] = c.z; gq[7] = c.w;
            const float4 k = *(const float4*)(p.kv_norm_g + layer * 256 + lane * 4); gkv[0] = k.x; gkv[1] = k.y; gkv[2] = k.z; gkv[3] = k.w;
            const int d0 = (lane & 15) * 8;
            const float4 e = *(const float4*)(p.naq_g + layer * 128 + d0), f = *(const float4*)(p.naq_g + layer * 128 + d0 + 4);
            gnq[0] = e.x; gnq[1] = e.y; gnq[2] = e.z; gnq[3] = e.w; gnq[4] = f.x; gnq[5] = f.y; gnq[6] = f.z; gnq[7] = f.w;
            const float4 g = *(const float4*)(p.nak_g + layer * 128 + d0), hh = *(const float4*)(p.nak_g + layer * 128 + d0 + 4);
            gnk[0] = g.x; gnk[1] = g.y; gnk[2] = g.z; gnk[3] = g.w; gnk[4] = hh.x; gnk[5] = hh.y; gnk[6] = hh.z; gnk[7] = hh.w;
        }
        float cq[8], naq[8], nak[8], nav[8], ckv[4];
        unpack8(cq4, cq); unpack8(naq4, naq); unpack8(nak4, nak); unpack8(nav4, nav);
        ckv[0] = bf_lo(ckv2.x); ckv[1] = bf_hi(ckv2.x); ckv[2] = bf_lo(ckv2.y); ckv[3] = bf_hi(ckv2.y);
        float s_cq = 0.f, s_kv = 0.f, s_nq = 0.f, s_nk = 0.f;
#pragma unroll
        for (int i = 0; i < 8; ++i) { s_cq += cq[i] * cq[i]; s_nq += naq[i] * naq[i]; s_nk += nak[i] * nak[i]; }
#pragma unroll
        for (int i = 0; i < 4; ++i) s_kv += ckv[i] * ckv[i];
#pragma unroll
        for (int o = 1; o < 16; o <<= 1) { s_cq += __shfl_xor(s_cq, o); s_kv += __shfl_xor(s_kv, o); s_nq += __shfl_xor(s_nq, o); s_nk += __shfl_xor(s_nk, o); }
        s_cq += __shfl_xor(s_cq, 16); s_kv += __shfl_xor(s_kv, 16); s_cq += __shfl_xor(s_cq, 32); s_kv += __shfl_xor(s_kv, 32);
        const float r_cq = rsqrtf(s_cq / 512.f + EPS), r_kv = rsqrtf(s_kv / 256.f + EPS), r_nq = rsqrtf(s_nq / 128.f + EPS), r_nk = rsqrtf(s_nk / 128.f + EPS);
#pragma unroll
        for (int i = 0; i < 8; ++i) { cq[i] *= r_cq * gq[i]; naq[i] *= r_nq * gnq[i]; nak[i] *= r_nk * gnk[i]; }
#pragma unroll
        for (int i = 0; i < 4; ++i) ckv[i] *= r_kv * gkv[i];
        *(uint4*)(p.cqn_b + (size_t)r * 512 + lane * 8) = pack8(cq);
        *(uint2*)(p.ckv_b + (size_t)r * 256 + lane * 4) = make_uint2(cvtpk(ckv[0], ckv[1]), cvtpk(ckv[2], ckv[3]));
        *(uint4*)(p.qna_b + (size_t)r * 512 + lane * 8) = pack8(naq);
        *(uint4*)(p.kna_b + (size_t)r * 512 + lane * 8) = pack8(nak);
        if (ctx) {
            const size_t oc = ((size_t)b * DEPTH + layer) * SEQ + s;
            *(float4*)(p.o_ckv + oc * 256 + lane * 4) = make_float4(ckv[0], ckv[1], ckv[2], ckv[3]);
            p.o_kpe[oc * 64 + lane] = __uint_as_float((unsigned)kpe1 << 16);
            const int hd = lane >> 4, d0 = (lane & 15) * 8;
            const size_t on = ((((size_t)b * DEPTH + layer) * 4 + hd) * SEQ + s) * 128 + d0;
            *(float4*)(p.o_nak + on) = make_float4(nak[0], nak[1], nak[2], nak[3]); *(float4*)(p.o_nak + on + 4) = make_float4(nak[4], nak[5], nak[6], nak[7]);
            *(float4*)(p.o_nav + on) = make_float4(nav[0], nav[1], nav[2], nav[3]); *(float4*)(p.o_nav + on + 4) = make_float4(nav[4], nav[5], nav[6], nav[7]);
        }
        {
            float gb[8], gc[8], uu[8], gcm[8], um[8], gcp[8], up[8], o[8];
            unpack8(gb4, gb); unpack8(gc4, gc); unpack8(u4, uu); unpack8(gcm4, gcm); unpack8(um4, um); unpack8(gcp4, gcp); unpack8(up4, up);
#pragma unroll
            for (int i = 0; i < 8; ++i) o[i] = gb[i] * (gcm[i] * um[i] * cw[i * 3] + gc[i] * uu[i] * cw[i * 3 + 1] + gcp[i] * up[i] * cw[i * 3 + 2]);
            *(uint4*)(p.mix_b + (size_t)r * D + 1536 + lane * 8) = pack8(o);
        }
    }
}

DEVI void transpose_v(const bf16_t* src, size_t sstride, bf16_t* dst, int ldv, float* lds) {
    float (*tl)[129] = (float (*)[129])lds;
    const int tid = tidx();
#pragma unroll
    for (int rep = 0; rep < 2; ++rep) {
        const int c = tid + rep * NTHREADS, row = c >> 4, c8 = (c & 15) * 8;
        float f[8]; unpack8(*(const uint4*)(src + (size_t)row * sstride + c8), f);
#pragma unroll
        for (int i = 0; i < 8; ++i) tl[row][c8 + i] = f[i];
    }
    __syncthreads();
    {
        const int d = tid >> 2, k16 = (tid & 3) * 16;
        uint4 o0, o1;
        o0.x = cvtpk(tl[k16 + 0][d], tl[k16 + 1][d]); o0.y = cvtpk(tl[k16 + 2][d], tl[k16 + 3][d]); o0.z = cvtpk(tl[k16 + 4][d], tl[k16 + 5][d]); o0.w = cvtpk(tl[k16 + 6][d], tl[k16 + 7][d]);
        o1.x = cvtpk(tl[k16 + 8][d], tl[k16 + 9][d]); o1.y = cvtpk(tl[k16 + 10][d], tl[k16 + 11][d]); o1.z = cvtpk(tl[k16 + 12][d], tl[k16 + 13][d]); o1.w = cvtpk(tl[k16 + 14][d], tl[k16 + 15][d]);
        bf16_t* o = dst + (size_t)d * ldv + k16;
        *(uint4*)o = o0; *(uint4*)(o + 8) = o1;
    }
    __syncthreads();
}
DEVI void transpose_v32(const float* src, size_t sstride, bf16_t* dst, int ldv, float* lds) {
    float (*tl)[129] = (float (*)[129])lds;
    const int tid = tidx();
#pragma unroll
    for (int rep = 0; rep < 4; ++rep) {
        const int row = (tid >> 5) + 16 * rep, c4 = (tid & 31) * 4;
        const float4 v = *(const float4*)(src + (size_t)row * sstride + c4);
        tl[row][c4] = v.x; tl[row][c4 + 1] = v.y; tl[row][c4 + 2] = v.z; tl[row][c4 + 3] = v.w;
    }
    __syncthreads();
    {
        const int d = tid >> 2, k16 = (tid & 3) * 16;
        uint4 o0, o1;
        o0.x = cvtpk(tl[k16 + 0][d], tl[k16 + 1][d]); o0.y = cvtpk(tl[k16 + 2][d], tl[k16 + 3][d]); o0.z = cvtpk(tl[k16 + 4][d], tl[k16 + 5][d]); o0.w = cvtpk(tl[k16 + 6][d], tl[k16 + 7][d]);
        o1.x = cvtpk(tl[k16 + 8][d], tl[k16 + 9][d]); o1.y = cvtpk(tl[k16 + 10][d], tl[k16 + 11][d]); o1.z = cvtpk(tl[k16 + 12][d], tl[k16 + 13][d]); o1.w = cvtpk(tl[k16 + 14][d], tl[k16 + 15][d]);
        bf16_t* o = dst + (size_t)d * ldv + k16;
        *(uint4*)o = o0; *(uint4*)(o + 8) = o1;
    }
    __syncthreads();
}
DEVI void phase_headnorm(CParams& p, int layer, int bid, int nb, float* lds) {
    const int lane = tidx() & 63, w = tidx() >> 6;
    for (int r = bid * NWAVES + w; r < TKV; r += nb * NWAVES) {
        const bf16_t* kv = p.kvr_b + (size_t)r * 2048;
        const int cc = lane & 15, hA = lane >> 4, hB = 4 + (lane >> 4);
        float ka[8], kb[8], pe[8];
        unpack8(*(const uint4*)(kv + hA * 256 + cc * 8), ka);
        unpack8(*(const uint4*)(kv + hB * 256 + cc * 8), kb);
        const int kc = lane & 7, hh = lane >> 3;
        if (r < T) unpack8(*(const uint4*)(p.z_b + (size_t)r * DIN + O_KPE + kc * 8), pe);
        else {
            const int b = (r - T) / PAST, j = (r - T) % PAST;
            const float* cp = p.cache_kpe + (((size_t)b * DEPTH + layer) * PAST + j) * 64 + kc * 8;
            const float4 a = *(const float4*)cp, c = *(const float4*)(cp + 4);
            pe[0] = a.x; pe[1] = a.y; pe[2] = a.z; pe[3] = a.w; pe[4] = c.x; pe[5] = c.y; pe[6] = c.z; pe[7] = c.w;
        }
        float gn[8], gp[8];
        {
            const float* g = p.k_head_g + layer * 192;
            const float4 a = *(const float4*)(g + cc * 8), c = *(const float4*)(g + cc * 8 + 4), e = *(const float4*)(g + 128 + kc * 8), f = *(const float4*)(g + 128 + kc * 8 + 4);
            gn[0] = a.x; gn[1] = a.y; gn[2] = a.z; gn[3] = a.w; gn[4] = c.x; gn[5] = c.y; gn[6] = c.z; gn[7] = c.w;
            gp[0] = e.x; gp[1] = e.y; gp[2] = e.z; gp[3] = e.w; gp[4] = f.x; gp[5] = f.y; gp[6] = f.z; gp[7] = f.w;
        }
        float sa = 0.f, sb = 0.f, sp = 0.f;
#pragma unroll
        for (int i = 0; i < 8; ++i) { sa += ka[i] * ka[i]; sb += kb[i] * kb[i]; sp += pe[i] * pe[i]; }
#pragma unroll
        for (int o = 1; o < 16; o <<= 1) { sa += __shfl_xor(sa, o); sb += __shfl_xor(sb, o); }
        sp += __shfl_xor(sp, 1); sp += __shfl_xor(sp, 2); sp += __shfl_xor(sp, 4);
        const float rA = rsqrtf((sa + sp) / 192.f + EPS), rB = rsqrtf((sb + sp) / 192.f + EPS);
        const float sa_h = __shfl(sa, (hh & 3) * 16), sb_h = __shfl(sb, (hh & 3) * 16);
        const float rP = rsqrtf(((hh < 4 ? sa_h : sb_h) + sp) / 192.f + EPS);
#pragma unroll
        for (int i = 0; i < 8; ++i) { ka[i] *= rA * gn[i]; kb[i] *= rB * gn[i]; pe[i] *= rP * gp[i]; }
        if (r >= NCTX && r < T) {
            const int pos = (r - NCTX) % DS, j0 = (kc & 3) * 8;
            const float* cs = p.rope_cs + (size_t)pos * 64 + j0;
            const float4 c0 = *(const float4*)cs, c1 = *(const float4*)(cs + 4), s0 = *(const float4*)(cs + 32), s1 = *(const float4*)(cs + 36);
            const float cv[8] = {c0.x, c0.y, c0.z, c0.w, c1.x, c1.y, c1.z, c1.w}, sn[8] = {s0.x, s0.y, s0.z, s0.w, s1.x, s1.y, s1.z, s1.w};
#pragma unroll
            for (int i = 0; i < 8; ++i) {
                const float other = __shfl_xor(pe[i], 4);
                pe[i] = kc < 4 ? pe[i] * cv[i] - other * sn[i] : other * sn[i] + pe[i] * cv[i];
            }
        }
        bf16_t* ko = p.k_b + (size_t)r * 1536;
        *(uint4*)(ko + hA * 192 + cc * 8) = pack8(ka);
        *(uint4*)(ko + hB * 192 + cc * 8) = pack8(kb);
        *(uint4*)(ko + hh * 192 + 128 + kc * 8) = pack8(pe);
    }
    for (int i = bid * NTHREADS + tidx(); i < DB * 4 * PAST * 128 / 4; i += nb * NTHREADS) {
        const int e = i * 4, bh = e / (PAST * 128), rem = e % (PAST * 128), b = bh / 4, h = bh % 4;
        const float4 v = *(const float4*)(p.cache_nak + (((size_t)b * DEPTH + layer) * 4 + h) * PAST * 128 + rem);
        *(uint2*)(p.cnak_b + (size_t)e) = make_uint2(cvtpk(v.x, v.y), cvtpk(v.z, v.w));
    }
    constexpr int N_MLA = (TKV / 64) * 8, N_NA = (T / 64) * 4, N_NC = DB * 4 * (PAST / 64);
    for (int it = bid; it < N_MLA + N_NA + N_NC; it += nb) {
        if (it < N_MLA) {
            const int kt = it / 8, h = it % 8, r0 = kt * 64;
            const bf16_t* src = p.kvr_b + (size_t)r0 * 2048 + h * 256 + 128;
            bf16_t* dst; int ldv;
            if (r0 < NCTX) { const int b = r0 / SEQ; dst = p.vt_mla_ctx + ((size_t)(b * 8 + h) * 128) * SEQ + r0 % SEQ; ldv = SEQ; }
            else if (r0 < T) { const int b = (r0 - NCTX) / DS; dst = p.vt_mla_lat + ((size_t)(b * 8 + h) * 128) * (PAST + DS) + PAST + (r0 - NCTX) % DS; ldv = PAST + DS; }
            else { const int b = (r0 - T) / PAST; dst = p.vt_mla_lat + ((size_t)(b * 8 + h) * 128) * (PAST + DS) + (r0 - T) % PAST; ldv = PAST + DS; }
            transpose_v(src, 2048, dst, ldv, lds);
        } else if (it < N_MLA + N_NA) {
            const int j = it - N_MLA, kt = j / 4, h = j % 4, r0 = kt * 64;
            const bf16_t* src = p.z_b + (size_t)r0 * DIN + O_NAV + h * 128;
            bf16_t* dst; int ldv;
            if (r0 < NCTX) { const int b = r0 / SEQ; dst = p.vt_na_ctx + ((size_t)(b * 4 + h) * 128) * SEQ + r0 % SEQ; ldv = SEQ; }
            else { const int b = (r0 - NCTX) / DS; dst = p.vt_na_lat + ((size_t)(b * 4 + h) * 128) * DS + (r0 - NCTX) % DS; ldv = DS; }
            transpose_v(src, DIN, dst, ldv, lds);
        } else {
            const int j = it - N_MLA - N_NA, bh = j / (PAST / 64), jt = j % (PAST / 64), b = bh / 4, h = bh % 4;
            const float* src = p.cache_nav + ((((size_t)b * DEPTH + layer) * 4 + h) * PAST + jt * 64) * 128;
            transpose_v32(src, 128, p.vt_na_cache + ((size_t)(b * 4 + h) * 128) * PAST + jt * 64, PAST, lds);
        }
    }
}

typedef short bf16x8_t __attribute__((ext_vector_type(8)));
typedef float f32x16_t __attribute__((ext_vector_type(16)));
#define MFMA32(a, b, c) __builtin_amdgcn_mfma_f32_32x32x16_bf16((a), (b), (c), 0, 0, 0)
DEVI int crow(int reg, int h) { return (reg & 3) + 8 * (reg >> 2) + 4 * h; }

struct AttnBlk {
    const bf16_t* q; int qstride;
    const bf16_t *k0, *vt0; int ks0, ldv0, nst0;
    const bf16_t *k1, *vt1; int ks1, ldv1, nst1;
    bf16_t* out; float scale;
    const float *qg, *rope; int pos0;
    const float* bias; int row0, rs_min;
};
template <int DQ, bool LOCAL, bool QNORM>
DEVI void attn_block(const AttnBlk& u, float* ldsf) {
    constexpr int KROW = DQ * 2 + 16, VROW = 136, KBYTES = 64 * KROW, STAGE = KBYTES + 128 * VROW;
    constexpr int KCH = DQ / 8, NKC = 64 * KCH / NTHREADS;
    unsigned char* lds = (unsigned char*)ldsf;
    const int tid = tidx(), lane = tid & 63, w = tid >> 6, r = lane & 31, h = lane >> 5;
    bf16x8_t qf[DQ / 16];
    {
        const bf16_t* qrow = u.q + (size_t)(w * 32 + r) * u.qstride + 8 * h;
#pragma unroll
        for (int kk = 0; kk < DQ / 16; ++kk) qf[kk] = *(const bf16x8_t*)(qrow + kk * 16);
    }
    if constexpr (QNORM) {
        float ss = 0.f;
#pragma unroll
        for (int kk = 0; kk < DQ / 16; ++kk) { float t8[8]; unpack8(__builtin_bit_cast(uint4, qf[kk]), t8);
#pragma unroll
            for (int i = 0; i < 8; ++i) ss += t8[i] * t8[i]; }
        ss += __shfl_xor(ss, 32);
        const float rr = rsqrtf(ss / (float)DQ + EPS);
#pragma unroll 1
        for (int kk = 0; kk < DQ / 16; ++kk) {
            const float4 g0 = *(const float4*)(u.qg + kk * 16 + 8 * h), g1 = *(const float4*)(u.qg + kk * 16 + 8 * h + 4);
            uint4 raw = make_uint4(0u, 0u, 0u, 0u);
#pragma unroll
            for (int k2 = 0; k2 < DQ / 16; ++k2) if (k2 == kk) raw = __builtin_bit_cast(uint4, qf[k2]);
            float t8[8]; unpack8(raw, t8);
            t8[0] *= rr * g0.x; t8[1] *= rr * g0.y; t8[2] *= rr * g0.z; t8[3] *= rr * g0.w; t8[4] *= rr * g1.x; t8[5] *= rr * g1.y; t8[6] *= rr * g1.z; t8[7] *= rr * g1.w;
            const bf16x8_t nv = __builtin_bit_cast(bf16x8_t, pack8(t8));
#pragma unroll
            for (int k2 = 0; k2 < DQ / 16; ++k2) if (k2 == kk) qf[k2] = nv;
        }
        if (u.rope) {
            const float* cs = u.rope + (size_t)(u.pos0 + w * 32 + r) * 64 + 8 * h;
#pragma unroll
            for (int k2 = 0; k2 < 2; ++k2) {
                const float4 c0 = *(const float4*)(cs + k2 * 16), c1 = *(const float4*)(cs + k2 * 16 + 4), s0 = *(const float4*)(cs + 32 + k2 * 16), s1 = *(const float4*)(cs + 32 + k2 * 16 + 4);
                const float cv[8] = {c0.x, c0.y, c0.z, c0.w, c1.x, c1.y, c1.z, c1.w}, sn[8] = {s0.x, s0.y, s0.z, s0.w, s1.x, s1.y, s1.z, s1.w};
                float x1[8], x2[8];
                unpack8(__builtin_bit_cast(uint4, qf[8 + k2]), x1); unpack8(__builtin_bit_cast(uint4, qf[10 + k2]), x2);
#pragma unroll
                for (int i = 0; i < 8; ++i) { const float a = x1[i], b = x2[i]; x1[i] = a * cv[i] - b * sn[i]; x2[i] = a * sn[i] + b * cv[i]; }
                qf[8 + k2] = __builtin_bit_cast(bf16x8_t, pack8(x1)); qf[10 + k2] = __builtin_bit_cast(bf16x8_t, pack8(x2));
            }
        }
    }
    f32x16_t ot[4];
#pragma unroll
    for (int b = 0; b < 4; ++b)
#pragma unroll
        for (int i = 0; i < 16; ++i) ot[b][i] = 0.f;
    float m = -INFINITY, l = 0.f;
    const int myqr = u.row0 + (w >> 1), myc0 = (w & 1) * 32, myrs = min(max(myqr - 4, 0), 8);
    const int nst = u.nst0 + u.nst1;
    uint4 kr0, kr1, kr2, vr0, vr1;
    kr2 = make_uint4(0u, 0u, 0u, 0u);
    const int krow0 = tid / KCH, kcol0 = tid % KCH, krow1 = (tid + NTHREADS) / KCH, kcol1 = (tid + NTHREADS) % KCH, krow2 = (tid + 2 * NTHREADS) / KCH, kcol2 = (tid + 2 * NTHREADS) % KCH;
    const int vrow0 = tid >> 3, vc0 = tid & 7, vrow1 = (tid + NTHREADS) >> 3;
#define STAGE_LOAD(s_) do { const int s__ = (s_); const bf16_t *kp, *vp; int ks, ldv; \
        if (s__ < u.nst0) { kp = u.k0 + (size_t)s__ * 64 * u.ks0; ks = u.ks0; vp = u.vt0 + s__ * 64; ldv = u.ldv0; } \
        else { const int s1 = s__ - u.nst0; kp = u.k1 + (size_t)s1 * 64 * u.ks1; ks = u.ks1; vp = u.vt1 + s1 * 64; ldv = u.ldv1; } \
        kr0 = *(const uint4*)(kp + (size_t)krow0 * ks + kcol0 * 8); kr1 = *(const uint4*)(kp + (size_t)krow1 * ks + kcol1 * 8); \
        if constexpr (NKC == 3) kr2 = *(const uint4*)(kp + (size_t)krow2 * ks + kcol2 * 8); \
        vr0 = *(const uint4*)(vp + (size_t)vrow0 * ldv + vc0 * 8); vr1 = *(const uint4*)(vp + (size_t)vrow1 * ldv + vc0 * 8); } while (0)
#define STAGE_STORE(buf_) do { unsigned char* base = lds + (buf_) * STAGE; \
        *(uint4*)(base + krow0 * KROW + kcol0 * 16) = kr0; *(uint4*)(base + krow1 * KROW + kcol1 * 16) = kr1; \
        if constexpr (NKC == 3) *(uint4*)(base + krow2 * KROW + kcol2 * 16) = kr2; \
        { unsigned char* v0_ = base + KBYTES + vrow0 * VROW + vc0 * 16; unsigned char* v1_ = base + KBYTES + vrow1 * VROW + vc0 * 16;     \
          *(uint2*)v0_ = make_uint2(vr0.x, vr0.y); *(uint2*)(v0_ + 8) = make_uint2(vr0.z, vr0.w); *(uint2*)v1_ = make_uint2(vr1.x, vr1.y); *(uint2*)(v1_ + 8) = make_uint2(vr1.z, vr1.w); } } while (0)
    STAGE_LOAD(0); STAGE_STORE(0);
    __syncthreads();
    for (int s = 0; s < nst; ++s) {
        if (s + 1 < nst) STAGE_LOAD(s + 1);
        const unsigned char* kb = lds + (s & 1) * STAGE;
        const unsigned char* vb = kb + KBYTES;
        int lrow = -1; bool active = true;
        if (LOCAL && s >= u.nst0) { lrow = u.rs_min + (s - u.nst0); active = lrow >= myrs && lrow < myrs + 8; }
        if (active)
#pragma unroll
        for (int sub = 0; sub < 2; ++sub) {
            f32x16_t st;
#pragma unroll
            for (int i = 0; i < 16; ++i) st[i] = 0.f;
            {
                const unsigned char* krow = kb + (sub * 32 + r) * KROW + 16 * h;
#pragma unroll
                for (int kk = 0; kk < DQ / 16; ++kk) { const bf16x8_t a = *(const bf16x8_t*)(krow + kk * 32); st = MFMA32(a, qf[kk], st); }
            }
            float sv[16], mx = -INFINITY;
            if (LOCAL && lrow >= 0) {
                const int qc = myc0 + r, cs = min(max(qc - 8, 0), 48);
                const float* brow = u.bias + (lrow - myqr + 7) * 31 + (15 - qc);
#pragma unroll
                for (int i = 0; i < 16; ++i) {
                    const int kc = sub * 32 + crow(i, h);
                    const bool valid = kc >= cs && kc < cs + 16;
                    const float bv = valid ? brow[kc] : 0.f;
                    sv[i] = valid ? st[i] * u.scale + bv : -INFINITY; mx = fmaxf(mx, sv[i]);
                }
            } else {
#pragma unroll
                for (int i = 0; i < 16; ++i) { sv[i] = st[i] * u.scale; mx = fmaxf(mx, sv[i]); }
            }
            mx = fmaxf(mx, __shfl_xor(mx, 32));
            const float mnew = fmaxf(m, mx), alpha = __expf(m - mnew);
            m = mnew;
            float ls = 0.f;
#pragma unroll
            for (int i = 0; i < 16; ++i) { sv[i] = __expf(sv[i] - mnew); ls += sv[i]; }
            l = l * alpha + ls;
#pragma unroll
            for (int b = 0; b < 4; ++b)
#pragma unroll
                for (int i = 0; i < 16; ++i) ot[b][i] *= alpha;
#pragma unroll
            for (int s2 = 0; s2 < 2; ++s2) {
                uint4 pk; pk.x = cvtpk(sv[8 * s2 + 0], sv[8 * s2 + 1]); pk.y = cvtpk(sv[8 * s2 + 2], sv[8 * s2 + 3]); pk.z = cvtpk(sv[8 * s2 + 4], sv[8 * s2 + 5]); pk.w = cvtpk(sv[8 * s2 + 6], sv[8 * s2 + 7]);
                const bf16x8_t xs = __builtin_bit_cast(bf16x8_t, pk);
#pragma unroll
                for (int b = 0; b < 4; ++b) {
                    const unsigned char* vrow = vb + (32 * b + r) * VROW + (sub * 32 + 16 * s2 + 4 * h) * 2;
                    const uint2 lo = *(const uint2*)vrow, hi = *(const uint2*)(vrow + 16);
                    const bf16x8_t pa = __builtin_bit_cast(bf16x8_t, make_uint4(lo.x, lo.y, hi.x, hi.y));
                    ot[b] = MFMA32(pa, xs, ot[b]);
                }
            }
        }
        if (s + 1 < nst) STAGE_STORE((s + 1) & 1);
        __syncthreads();
    }
    l += __shfl_xor(l, 32);
    const float inv = 1.f / l;
    bf16_t* orow = u.out + (size_t)(w * 32 + r) * D;
#pragma unroll
    for (int b = 0; b < 4; ++b)
#pragma unroll
        for (int g = 0; g < 4; ++g)
            *(uint2*)(orow + 32 * b + 8 * g + 4 * h) = make_uint2(cvtpk(ot[b][4 * g] * inv, ot[b][4 * g + 1] * inv), cvtpk(ot[b][4 * g + 2] * inv, ot[b][4 * g + 3] * inv));
}
#undef STAGE_LOAD
#undef STAGE_STORE
DEVI void attn_block_dispatch(CParams& p, int layer, int kind, int idx, float* lds) {
    AttnBlk u;
    u.k1 = nullptr; u.vt1 = nullptr; u.ks1 = 0; u.ldv1 = 0; u.nst1 = 0; u.bias = nullptr; u.row0 = 0; u.rs_min = 0; u.qg = nullptr; u.rope = nullptr; u.pos0 = 0;
    if (kind == 1) {
        const int qb = idx % 4, h = (idx / 4) % 4, b = idx / 16, t0 = NCTX + b * DS + qb * 256;
        const int rlo = min(max(4 * qb - 4, 0), 8), rhi = min(max(4 * qb + 3 - 4, 0), 8) + 8;
        u.q = p.qna_b + (size_t)t0 * 512 + h * 128; u.qstride = 512; u.scale = 0.08838834764831845f;
        u.k0 = p.cnak_b + ((size_t)(b * 4 + h) * PAST) * 128; u.ks0 = 128; u.vt0 = p.vt_na_cache + ((size_t)(b * 4 + h) * 128) * PAST; u.ldv0 = PAST; u.nst0 = PAST / 64;
        u.k1 = p.kna_b + (size_t)(NCTX + b * DS + rlo * 64) * 512 + h * 128; u.ks1 = 512; u.vt1 = p.vt_na_lat + ((size_t)(b * 4 + h) * 128) * DS + rlo * 64; u.ldv1 = DS; u.nst1 = rhi - rlo;
        u.bias = p.rel_bias + ((size_t)layer * 4 + h) * 15 * 31; u.row0 = 4 * qb; u.rs_min = rlo;
        u.out = p.mix_b + (size_t)t0 * D + 1024 + h * 128;
        attn_block<128, true, false>(u, lds);
    } else if (kind == 0) {
        const int qb = idx % 4, h = (idx / 4) % 8, b = idx / 32, t0 = NCTX + b * DS + qb * 256;
        u.q = p.qm_b + (size_t)t0 * 1536 + h * 192; u.qstride = 1536; u.scale = 0.07216878364870322f; u.qg = p.q_head_g + layer * 192; u.rope = p.rope_cs; u.pos0 = qb * 256;
        u.k0 = p.k_b + (size_t)(T + b * PAST) * 1536 + h * 192; u.ks0 = 1536; u.vt0 = p.vt_mla_lat + ((size_t)(b * 8 + h) * 128) * (PAST + DS); u.ldv0 = PAST + DS; u.nst0 = PAST / 64;
        u.k1 = p.k_b + (size_t)(NCTX + b * DS) * 1536 + h * 192; u.ks1 = 1536; u.vt1 = u.vt0 + PAST; u.ldv1 = PAST + DS; u.nst1 = DS / 64;
        u.out = p.mix_b + (size_t)t0 * D + h * 128;
        attn_block<192, false, true>(u, lds);
    } else if (kind == 2) {
        const int h = idx % 8, b = idx / 8, t0 = b * SEQ;
        u.q = p.qm_b + (size_t)t0 * 1536 + h * 192; u.qstride = 1536; u.scale = 0.07216878364870322f; u.qg = p.q_head_g + layer * 192;
        u.k0 = p.k_b + (size_t)t0 * 1536 + h * 192; u.ks0 = 1536; u.vt0 = p.vt_mla_ctx + ((size_t)(b * 8 + h) * 128) * SEQ; u.ldv0 = SEQ; u.nst0 = SEQ / 64;
        u.out = p.mix_b + (size_t)t0 * D + h * 128;
        attn_block<192, false, true>(u, lds);
    } else {
        const int h = idx % 4, b = idx / 4, t0 = b * SEQ;
        u.q = p.qna_b + (size_t)t0 * 512 + h * 128; u.qstride = 512; u.scale = 0.08838834764831845f;
        u.k0 = p.kna_b + (size_t)t0 * 512 + h * 128; u.ks0 = 512; u.vt0 = p.vt_na_ctx + ((size_t)(b * 4 + h) * 128) * SEQ; u.ldv0 = SEQ; u.nst0 = SEQ / 64;
        u.out = p.mix_b + (size_t)t0 * D + 1024 + h * 128;
        attn_block<128, false, false>(u, lds);
    }
}
#ifndef ATTN_ROLE
#define ATTN_ROLE 0
#endif
DEVI void phase_attn(CParams& p, int layer, int bid, int nb, float* lds, int rep = 0) {
    const int role = rep ? ATTN_ROLE : 0;
    constexpr int N_LNA = DB * 4 * (DS / 256), N_HV = DB * 8 * (DS / 256), N_CM = BATCH * 8, N_CN = BATCH * 4;
    const int nA = nb / 8, nH = nb / 4;
    if (bid < nA) {
        if (role != 0 && role != 1) return;
        for (int it = bid; it < N_LNA; it += nA) attn_block_dispatch(p, layer, 1, it, lds);
    } else if (bid < nA + nH) {
        if (role != 0 && role != 2) return;
        for (int it = bid - nA; it < N_HV; it += nH) attn_block_dispatch(p, layer, 0, it, lds);
    } else {
        if (role != 0 && role != 3) return;
        for (int it = bid - nA - nH; it < N_CM + N_CN; it += nb - nA - nH) {
            if (it < N_CM) attn_block_dispatch(p, layer, 2, it, lds); else attn_block_dispatch(p, layer, 3, it - N_CM, lds);
        }
    }
}

template <int N, int K, int J>
DEVI void bitonic_stage(float (&v)[N]) {
#pragma unroll
    for (int i = 0; i < N; ++i) {
        const int l = i ^ J;
        if (l > i) { const bool desc = ((i & K) == 0); const float a = v[i], b = v[l], mx = fmaxf(a, b), mn = fminf(a, b); v[i] = desc ? mx : mn; v[l] = desc ? mn : mx; }
    }
}
template <int N, int K, int J> DEVI void bitonic_j(float (&v)[N]) { bitonic_stage<N, K, J>(v); if constexpr (J > 1) bitonic_j<N, K, J / 2>(v); }
template <int N, int K> DEVI void bitonic_k(float (&v)[N]) { bitonic_j<N, K, K / 2>(v); if constexpr (K < N) bitonic_k<N, K * 2>(v); }
template <int N> DEVI void bitonic_sort_desc(float (&v)[N]) { bitonic_k<N, 2>(v); }
DEVI void merge_top16(float (&a)[16], const float (&b)[16]) {
#pragma unroll
    for (int i = 0; i < 16; ++i) a[i] = fmaxf(a[i], b[15 - i]);
    bitonic_j<16, 16, 8>(a);
}
constexpr int cand_ab(int idx) { int n = 0; for (int a = 0; a < 16; ++a) for (int b = 0; b < 16; ++b) if ((a + 1) * (b + 1) <= 16) { if (n == idx) return a * 16 + b; ++n; } return -1; }
template <int CH, int I>
DEVI void cand_fill(float (&c)[16], const float (&s1)[16], const float (&s2)[16]) {
    constexpr int ab = cand_ab(CH * 16 + I);
    if constexpr (ab >= 0) c[I] = __uint_as_float((__float_as_uint(s1[ab >> 4] + s2[ab & 15]) & ~255u) | (unsigned)ab); else c[I] = -INFINITY;
    if constexpr (I + 1 < 16) cand_fill<CH, I + 1>(c, s1, s2);
}
DEVI float packkey(float v, unsigned id, unsigned mask) { return __uint_as_float((__float_as_uint(v) & ~mask) | id); }

DEVI void phase_route(CParams& p, int layer, int bid, int nb, float* lds) {
    const int lane = tidx() & 63, w = __builtin_amdgcn_readfirstlane(tidx() >> 6), r = lane & 31, h = lane >> 5;
    unsigned char* ix = (unsigned char*)lds + w * 2048;
    for (int it = bid * NWAVES + w; it < (T / 32) * 8; it += nb * NWAVES) {
        const int tt = it >> 3, hh = it & 7, t0 = tt * 32;
        float s12[2][16];
#pragma unroll
        for (int pp = 0; pp < 2; ++pp) {
            bf16x8_t qf[8];
            const bf16_t* qrow = p.qp_b + (size_t)(t0 + r) * D + hh * 256 + pp * 128 + 8 * h;
#pragma unroll
            for (int kk = 0; kk < 8; ++kk) qf[kk] = *(const bf16x8_t*)(qrow + kk * 16);
            const bf16_t* sk = p.sk_b + (((size_t)layer * 8 + hh) * 2 + pp) * 128 * 128 + (size_t)r * 128 + 8 * h;
            float top[16];
#pragma unroll
            for (int i = 0; i < 16; ++i) top[i] = -INFINITY;
#pragma unroll 1
            for (int blk = 0; blk < 4; ++blk) {
                const bf16_t* skb = sk + (size_t)blk * 32 * 128;
                asm volatile("" : "+v"(skb));
                f32x16_t acc;
#pragma unroll
                for (int i = 0; i < 16; ++i) acc[i] = 0.f;
#pragma unroll
                for (int kk = 0; kk < 8; ++kk) { const bf16x8_t a = *(const bf16x8_t*)(skb + kk * 16); acc = MFMA32(a, qf[kk], acc); }
                float c[16];
#pragma unroll
                for (int i = 0; i < 16; ++i) c[i] = packkey(acc[i], (unsigned)(32 * blk + crow(i, h)), 127u);
                bitonic_sort_desc<16>(c);
                merge_top16(top, c);
            }
            float o[16];
#pragma unroll
            for (int i = 0; i < 16; ++i) o[i] = __shfl_xor(top[i], 32);
            merge_top16(top, o);
#pragma unroll
            for (int i = 0; i < 16; ++i) { s12[pp][i] = top[i]; ix[(pp * 16 + i) * 64 + lane] = (unsigned char)(__float_as_uint(top[i]) & 127u); }
        }
        float best[16];
        {
            float c[16];
            cand_fill<0, 0>(best, s12[0], s12[1]); bitonic_sort_desc<16>(best);
            cand_fill<1, 0>(c, s12[0], s12[1]); bitonic_sort_desc<16>(c); merge_top16(best, c);
            cand_fill<2, 0>(c, s12[0], s12[1]); bitonic_sort_desc<16>(c); merge_top16(best, c);
            cand_fill<3, 0>(c, s12[0], s12[1]); bitonic_sort_desc<16>(c); merge_top16(best, c);
        }
        __builtin_amdgcn_wave_barrier();
        float g[16], sum = 0.f; int ex[16];
        const float mx = __uint_as_float(__float_as_uint(best[0]) & ~255u);
#pragma unroll
        for (int k = 0; k < 16; ++k) {
            const unsigned bits = __float_as_uint(best[k]), id = bits & 255u;
            g[k] = __expf(__uint_as_float(bits & ~255u) - mx); sum += g[k];
            ex[k] = (int)ix[(id >> 4) * 64 + lane] * 128 + (int)ix[(16 + (id & 15)) * 64 + lane];
        }
        const float inv = 1.f / sum;
        if (h == 0) {
            int* eo = p.eidx + (size_t)(t0 + r) * 128 + hh * 16; float* go = p.gate + (size_t)(t0 + r) * 128 + hh * 16;
#pragma unroll
            for (int k = 0; k < 16; k += 4) { *(int4*)(eo + k) = make_int4(ex[k], ex[k + 1], ex[k + 2], ex[k + 3]); *(float4*)(go + k) = make_float4(g[k] * inv, g[k + 1] * inv, g[k + 2] * inv, g[k + 3] * inv); }
        }
        __builtin_amdgcn_wave_barrier();
    }
}

typedef float f32x2v __attribute__((ext_vector_type(2)));
DEVI void phase_experts(CParams& p, int layer, int bid, int nb, float* lds) {
    const int lane = tidx() & 63, w = tidx() >> 6;
    float* wgt = lds + w * 128;
    const unsigned char* U = p.pu8 + (size_t)layer * 16384 * D;
    const unsigned char* V = p.pv8 + (size_t)layer * 16384 * D;
    const float* SU = p.su8 + (size_t)layer * 16384;
    const float* SV = p.sv8 + (size_t)layer * 16384;
    for (int t = bid * NWAVES + w; t < T; t += nb * NWAVES) {
        f32x2v x[2][8];
#pragma unroll
        for (int j = 0; j < 2; ++j) {
            const uint4 a = *(const uint4*)(p.hn_b + (size_t)t * D + j * 1024 + lane * 16), b = *(const uint4*)(p.hn_b + (size_t)t * D + j * 1024 + lane * 16 + 8);
            x[j][0] = (f32x2v){__uint_as_float(a.x << 16), __uint_as_float(a.x & 0xffff0000u)}; x[j][1] = (f32x2v){__uint_as_float(a.y << 16), __uint_as_float(a.y & 0xffff0000u)};
            x[j][2] = (f32x2v){__uint_as_float(a.z << 16), __uint_as_float(a.z & 0xffff0000u)}; x[j][3] = (f32x2v){__uint_as_float(a.w << 16), __uint_as_float(a.w & 0xffff0000u)};
            x[j][4] = (f32x2v){__uint_as_float(b.x << 16), __uint_as_float(b.x & 0xffff0000u)}; x[j][5] = (f32x2v){__uint_as_float(b.y << 16), __uint_as_float(b.y & 0xffff0000u)};
            x[j][6] = (f32x2v){__uint_as_float(b.z << 16), __uint_as_float(b.z & 0xffff0000u)}; x[j][7] = (f32x2v){__uint_as_float(b.w << 16), __uint_as_float(b.w & 0xffff0000u)};
        }
        const int* eix = p.eidx + (size_t)t * 128;
        const float* gat = p.gate + (size_t)t * 128;
        for (int c = 0; c < 16; ++c) {
            uint4 u[8][2];
#pragma unroll
            for (int e = 0; e < 8; ++e) {
                const int idx = __builtin_amdgcn_readfirstlane(eix[c * 8 + e]);
                const unsigned char* ur = U + (size_t)idx * D + lane * 16;
                u[e][0] = *(const uint4*)ur; u[e][1] = *(const uint4*)(ur + 1024);
            }
            float d[8];
#pragma unroll
            for (int e = 0; e < 8; ++e) {
                f32x2v a = {0.f, 0.f};
#pragma unroll
                for (int j = 0; j < 2; ++j) {
                    const unsigned q[4] = {u[e][j].x, u[e][j].y, u[e][j].z, u[e][j].w};
#pragma unroll
                    for (int k = 0; k < 4; ++k) {
                        a = __builtin_elementwise_fma(__builtin_amdgcn_cvt_pk_f32_fp8((int)q[k], false), x[j][2 * k], a);
                        a = __builtin_elementwise_fma(__builtin_amdgcn_cvt_pk_f32_fp8((int)q[k], true), x[j][2 * k + 1], a);
                    }
                }
                d[e] = a.x + a.y;
            }
            const bool b5 = lane & 32, b4 = lane & 16, b3 = lane & 8;
            float r4[4];
#pragma unroll
            for (int i = 0; i < 4; ++i) { const float mine = b5 ? d[4 + i] : d[i], theirs = b5 ? d[i] : d[4 + i]; r4[i] = mine + __shfl_xor(theirs, 32); }
            float r2[2];
#pragma unroll
            for (int i = 0; i < 2; ++i) { const float mine = b4 ? r4[2 + i] : r4[i], theirs = b4 ? r4[i] : r4[2 + i]; r2[i] = mine + __shfl_xor(theirs, 16); }
            float r1;
            { const float mine = b3 ? r2[1] : r2[0], theirs = b3 ? r2[0] : r2[1]; r1 = mine + __shfl_xor(theirs, 8); }
            r1 += __shfl_xor(r1, 4); r1 += __shfl_xor(r1, 2); r1 += __shfl_xor(r1, 1);
            const int e = (lane >> 3) & 7;
            const int myidx = eix[c * 8 + e];
            r1 *= SU[myidx];
            const float a = 0.5f * r1 * (1.f + erff(r1 * 0.70710678118654752f));
            if ((lane & 7) == 0) wgt[c * 8 + e] = a * gat[c * 8 + e] * SV[myidx];
        }
        __builtin_amdgcn_wave_barrier();
        f32x2v o[2][8];
#pragma unroll
        for (int j = 0; j < 2; ++j)
#pragma unroll
            for (int i = 0; i < 8; ++i) o[j][i] = (f32x2v){0.f, 0.f};
        for (int c = 0; c < 16; ++c) {
            uint4 v[8][2];
#pragma unroll
            for (int e = 0; e < 8; ++e) {
                const int idx = __builtin_amdgcn_readfirstlane(eix[c * 8 + e]);
                const unsigned char* vr = V + (size_t)idx * D + lane * 16;
                v[e][0] = *(const uint4*)vr; v[e][1] = *(const uint4*)(vr + 1024);
            }
#pragma unroll
            for (int e = 0; e < 8; ++e) {
                const float wg1 = wgt[c * 8 + e];
                const f32x2v wg = {wg1, wg1};
#pragma unroll
                for (int j = 0; j < 2; ++j) {
                    const unsigned q[4] = {v[e][j].x, v[e][j].y, v[e][j].z, v[e][j].w};
#pragma unroll
                    for (int k = 0; k < 4; ++k) {
                        o[j][2 * k] = __builtin_elementwise_fma(__builtin_amdgcn_cvt_pk_f32_fp8((int)q[k], false), wg, o[j][2 * k]);
                        o[j][2 * k + 1] = __builtin_elementwise_fma(__builtin_amdgcn_cvt_pk_f32_fp8((int)q[k], true), wg, o[j][2 * k + 1]);
                    }
                }
            }
        }
        __builtin_amdgcn_wave_barrier();
        const int cond = cond_of(t);
        const float* g2 = p.ada + ((size_t)layer * 3 + cond) * 6 * D + 5 * D;
        float* xo = p.out + (size_t)t * D;
        float ss = 0.f;
#pragma unroll
        for (int j = 0; j < 2; ++j) {
            const int cb = j * 1024 + lane * 16;
#pragma unroll
            for (int q = 0; q < 4; ++q) {
                float4 xv = *(const float4*)(xo + cb + q * 4); const float4 gv = *(const float4*)(g2 + cb + q * 4);
                xv.x += gv.x * o[j][2 * q].x; xv.y += gv.y * o[j][2 * q].y; xv.z += gv.z * o[j][2 * q + 1].x; xv.w += gv.w * o[j][2 * q + 1].y;
                *(float4*)(xo + cb + q * 4) = xv;
                o[j][2 * q] = (f32x2v){xv.x, xv.y}; o[j][2 * q + 1] = (f32x2v){xv.z, xv.w};
                ss += xv.x * xv.x + xv.y * xv.y + xv.z * xv.z + xv.w * xv.w;
            }
        }
        if (layer + 1 < DEPTH) {
            ss = wave_sum(ss);
            const float rr = rsqrtf(ss / D + EPS);
            const float* g = p.norm_mix_g + (size_t)(layer + 1) * D;
            const float* ad = p.ada + ((size_t)(layer + 1) * 3 + cond) * 6 * D;
#pragma unroll
            for (int j = 0; j < 2; ++j) {
                const int cb = j * 1024 + lane * 16;
                unsigned hv[8];
#pragma unroll
                for (int q = 0; q < 4; ++q) {
                    const float4 gg = *(const float4*)(g + cb + q * 4), sh = *(const float4*)(ad + cb + q * 4), sc = *(const float4*)(ad + D + cb + q * 4);
                    hv[2 * q] = cvtpk(o[j][2 * q].x * rr * gg.x * (1.f + sc.x) + sh.x, o[j][2 * q].y * rr * gg.y * (1.f + sc.y) + sh.y);
                    hv[2 * q + 1] = cvtpk(o[j][2 * q + 1].x * rr * gg.z * (1.f + sc.z) + sh.z, o[j][2 * q + 1].y * rr * gg.w * (1.f + sc.w) + sh.w);
                }
                *(uint4*)(p.hn_b + (size_t)t * D + cb) = make_uint4(hv[0], hv[1], hv[2], hv[3]);
                *(uint4*)(p.hn_b + (size_t)t * D + cb + 8) = make_uint4(hv[4], hv[5], hv[6], hv[7]);
            }
        }
    }
}

enum { PH_ADA = 0, PH_NORM1, PH_WIN, PH_POSTZ, PH_UQKV, PH_HEADNORM, PH_ATTN, PH_WOUT, PH_NORM2, PH_WQ, PH_SCORES, PH_ROUTE, PH_EXPERTS, PH_COUNT };

template <int PH>
DEVI void run_phase(CParams& p, int layer, int bid, int nb, float* lds, int rep = 0) {
    if constexpr (PH == PH_ADA) { phase_ada(p, bid, nb, lds); phase_weights(p, bid, nb, lds); }
    if constexpr (PH == PH_NORM1) phase_modnorm(p, layer, 0, bid, nb);
    if constexpr (PH == PH_WIN) mfma_gemm(p.hn_b, p.wt_in + (size_t)layer * DINP * D, T, DINP, D, EpiBf16Store{p.z_b, DIN, DIN}, bid, nb, lds);
    if constexpr (PH == PH_POSTZ) phase_postz(p, layer, bid, nb);
    if constexpr (PH == PH_UQKV) {
        mfma_gemm(p.cqn_b, p.wt_uq + (size_t)layer * 1536 * 512, T, 1536, 512, EpiBf16Store{p.qm_b, 1536, 1536}, bid, nb, lds);
        mfma_gemm(p.ckv_b, p.wt_ukv + (size_t)layer * 2048 * 256, TKV, 2048, 256, EpiBf16Store{p.kvr_b, 2048, 2048}, bid, nb, lds);
    }
    if constexpr (PH == PH_HEADNORM) phase_headnorm(p, layer, bid, nb, lds);
    if constexpr (PH == PH_ATTN) phase_attn(p, layer, bid, nb, lds, rep);
    if constexpr (PH == PH_WOUT) mfma_gemm(p.mix_b, p.wt_out + (size_t)layer * D * D, T, D, D, EpiResidMF{&p, layer}, bid, nb, lds);
    if constexpr (PH == PH_NORM2) phase_modnorm(p, layer, 1, bid, nb);
    if constexpr (PH == PH_WQ) mfma_gemm(p.hn_b, p.wt_q + (size_t)layer * D * D, T, D, D, EpiBf16Store{p.qp_b, D, D}, bid, nb, lds);
    if constexpr (PH == PH_ROUTE) phase_route(p, layer, bid, nb, lds);
    if constexpr (PH == PH_EXPERTS) phase_experts(p, layer, bid, nb, lds);
}

#ifndef MK_ONE_LAUNCH
#define MK_ONE_LAUNCH 1
#endif
constexpr size_t LDS_BYTES = LDS_TOTAL;

#if MK_ONE_LAUNCH
#ifndef PROBE_MASK
#define PROBE_MASK 0
#endif
#define PHASE1(PH, l, rep_) do { CParams* q_ = pp; asm volatile("" : "+s"(q_)); run_phase<PH>(*q_, l, (int)blockIdx.x, (int)gridDim.x, lds, rep_); \
    XcdBarrier b_; b_.bar = q_->bar; b_.x = xb_xcc_id(); b_.st = (volatile LAS unsigned*)(lds_raw + MISC_OFF); xcd_barrier(b_); } while (0)
#define PHASE(PH, l) do { PHASE1(PH, l, 0); if constexpr ((PROBE_MASK >> PH) & 1) { PHASE1(PH, l, 1); PHASE1(PH, l, 1); } } while (0)
__global__ void __launch_bounds__(NTHREADS, 2) k_fwd(Params p_unused) {
    CParams* pp = (CParams*)__builtin_amdgcn_kernarg_segment_ptr();
    extern __shared__ __attribute__((aligned(16))) unsigned char lds_raw[];
    float* lds = (float*)lds_raw;
    if (threadIdx.x == 0) *(uint4*)(lds_raw + MISC_OFF) = make_uint4(0u, 0u, 0u, 0u);
    __syncthreads();
    (void)xcd_barrier_post(pp->bar, (volatile LAS unsigned*)(lds_raw + MISC_OFF));
    PHASE(PH_ADA, 0);
    for (int l = 0; l < DEPTH; ++l) {
        if (l == 0) PHASE(PH_NORM1, l);
        PHASE(PH_WIN, l);
        PHASE(PH_POSTZ, l);
        PHASE(PH_UQKV, l);
        PHASE(PH_HEADNORM, l);
        PHASE(PH_ATTN, l);
        PHASE(PH_WOUT, l);
        PHASE(PH_NORM2, l);
        PHASE(PH_WQ, l);
        PHASE(PH_ROUTE, l);
        PHASE(PH_EXPERTS, l);
    }
}
#else
template <int PH>
__global__ void __launch_bounds__(NTHREADS, 4) k_phase(Params p, int layer) {
    extern __shared__ float4 lds4[];
    CParams* pp = (CParams*)__builtin_amdgcn_kernarg_segment_ptr();
    run_phase<PH>(*pp, layer, blockIdx.x, gridDim.x, (float*)lds4);
}
template <int PH>
void launch_phase(const Params& p, int layer, hipStream_t stream) {
    hipLaunchKernelGGL(k_phase<PH>, dim3(1024), dim3(NTHREADS), LDS_BYTES, stream, p, layer);
}
#endif

}

extern "C" void kernel_launch(void* const* d_in, const int* in_sizes, int n_in, void* d_out, int out_size, void* d_ws, size_t ws_size, hipStream_t stream) {
    Params p{};
    const float* const* in = (const float* const*)d_in;
    p.x_prompt = in[0]; p.x_sample = in[1]; p.cache_ckv = in[2]; p.cache_kpe = in[3]; p.cache_nak = in[4]; p.cache_nav = in[5]; p.c = in[6]; p.c_ctx = in[7];
    p.ada_w = in[8]; p.ada_b = in[9]; p.norm_mix_g = in[10]; p.norm_ffn_g = in[11]; p.w_in = in[12]; p.q_norm_g = in[13]; p.w_uq = in[14]; p.kv_norm_g = in[15]; p.w_ukv = in[16];
    p.q_head_g = in[17]; p.k_head_g = in[18]; p.naq_g = in[19]; p.nak_g = in[20]; p.rel_bias = in[21]; p.conv_w = in[22]; p.w_out = in[23]; p.peer_wq = in[24]; p.sub_keys = in[25];
    p.peer_u = in[26]; p.peer_v = in[27];
    float* out = (float*)d_out;
    p.out = out;
    p.o_ckv = out + (size_t)T * D;
    p.o_kpe = p.o_ckv + (size_t)BATCH * DEPTH * SEQ * 256;
    p.o_nak = p.o_kpe + (size_t)BATCH * DEPTH * SEQ * 64;
    p.o_nav = p.o_nak + (size_t)BATCH * DEPTH * 4 * SEQ * 128;
    char* ws = (char*)d_ws; size_t off = 0;
    auto carve = [&](size_t bytes) { void* r = ws + off; off += (bytes + 255) & ~(size_t)255; return r; };
    p.bar = (unsigned*)carve(16384);
    p.ada = (float*)carve((size_t)DEPTH * 3 * 6 * D * 4);
    p.hn = (float*)carve((size_t)T * D * 4);
    p.z_b = (bf16_t*)carve((size_t)(T + 1) * DIN * 2);
    p.rope_cs = (float*)carve((size_t)DS * 64 * 4);
    p.cqn = (float*)carve((size_t)T * 512 * 4);
    p.ckv = (float*)carve((size_t)TKV * 256 * 4);
    p.qm_b = (bf16_t*)carve((size_t)T * 1536 * 2);
    p.kvr_b = (bf16_t*)carve((size_t)TKV * 2048 * 2);
    p.km = (float*)carve((size_t)TKV * 1536 * 4);
    p.qna = (float*)carve((size_t)T * 512 * 4);
    p.kna = (float*)carve((size_t)T * 512 * 4);
    p.mix = (float*)carve((size_t)T * D * 4);
    p.qp = (float*)carve((size_t)T * D * 4);
    p.sc = (float*)carve((size_t)T * D * 4);
    p.gate = (float*)carve((size_t)T * 128 * 4);
    p.eidx = (int*)carve((size_t)T * 128 * 4);
    p.wt_in = (bf16_t*)carve((size_t)DEPTH * DINP * D * 2);
    p.wt_uq = (bf16_t*)carve((size_t)DEPTH * 1536 * 512 * 2);
    p.wt_ukv = (bf16_t*)carve((size_t)DEPTH * 2048 * 256 * 2);
    p.wt_out = (bf16_t*)carve((size_t)DEPTH * D * D * 2);
    p.wt_q = (bf16_t*)carve((size_t)DEPTH * D * D * 2);
    p.hn_b = (bf16_t*)carve((size_t)T * D * 2);
    p.cqn_b = (bf16_t*)carve((size_t)T * 512 * 2);
    p.ckv_b = (bf16_t*)carve((size_t)TKV * 256 * 2);
    p.mix_b = (bf16_t*)carve((size_t)T * D * 2);
    p.q_b = (bf16_t*)carve((size_t)T * 1536 * 2);
    p.qp_b = (bf16_t*)carve((size_t)T * D * 2);
    p.sk_b = (bf16_t*)carve((size_t)DEPTH * 8 * 2 * 128 * 128 * 2);
    p.pu8 = (unsigned char*)carve((size_t)DEPTH * 16384 * D);
    p.pv8 = (unsigned char*)carve((size_t)DEPTH * 16384 * D);
    p.su8 = (float*)carve((size_t)DEPTH * 16384 * 4);
    p.sv8 = (float*)carve((size_t)DEPTH * 16384 * 4);
    p.k_b = (bf16_t*)carve((size_t)TKV * 1536 * 2);
    p.qna_b = (bf16_t*)carve((size_t)T * 512 * 2);
    p.kna_b = (bf16_t*)carve((size_t)T * 512 * 2);
    p.cnak_b = (bf16_t*)carve((size_t)DB * 4 * PAST * 128 * 2);
    p.vt_mla_ctx = (bf16_t*)carve((size_t)BATCH * 8 * 128 * SEQ * 2);
    p.vt_mla_lat = (bf16_t*)carve((size_t)DB * 8 * 128 * (PAST + DS) * 2);
    p.vt_na_ctx = (bf16_t*)carve((size_t)BATCH * 4 * 128 * SEQ * 2);
    p.vt_na_lat = (bf16_t*)carve((size_t)DB * 4 * 128 * DS * 2);
    p.vt_na_cache = (bf16_t*)carve((size_t)DB * 4 * 128 * PAST * 2);

#if MK_ONE_LAUNCH
    static int grid = 0;
    if (!grid) {
        int dev = 0, cus = 0, per_cu = 0;
        hipGetDevice(&dev);
        hipDeviceGetAttribute(&cus, hipDeviceAttributeMultiprocessorCount, dev);
        hipFuncSetAttribute((const void*)k_fwd, hipFuncAttributeMaxDynamicSharedMemorySize, (int)LDS_BYTES);
        hipOccupancyMaxActiveBlocksPerMultiprocessor(&per_cu, k_fwd, NTHREADS, LDS_BYTES);
        if (per_cu < 1) per_cu = 1;
        grid = cus * (per_cu < 1 ? per_cu : 1);
    }
    hipMemsetAsync(p.bar, 0, XCD_BAR_WORDS * sizeof(unsigned), stream);
    hipLaunchKernelGGL(k_fwd, dim3(grid), dim3(NTHREADS), LDS_BYTES, stream, p);
#else
    launch_phase<PH_ADA>(p, 0, stream);
    for (int l = 0; l < DEPTH; ++l) {
        if (l == 0) launch_phase<PH_NORM1>(p, l, stream);
        launch_phase<PH_WIN>(p, l, stream);
        launch_phase<PH_POSTZ>(p, l, stream);
        launch_phase<PH_UQKV>(p, l, stream);
        launch_phase<PH_HEADNORM>(p, l, stream);
        launch_phase<PH_ATTN>(p, l, stream);
        launch_phase<PH_WOUT>(p, l, stream);
        launch_phase<PH_NORM2>(p, l, stream);
        launch_phase<PH_WQ>(p, l, stream);
        launch_phase<PH_ROUTE>(p, l, stream);
        launch_phase<PH_EXPERTS>(p, l, stream);
    }
#endif
}
```

```cpp
#include <hip/hip_runtime.h>
#include <stdint.h>

#define DEVI __device__ __forceinline__

#define XB_TMO      128
#define XB_XCNT(j)  (256  + 64 * (j))
#define XB_XSUB(j)  (1280 + 64 * (j))
#define XB_XGEN(j)  (2304 + 64 * (j))
#define XB_TOP      3328
#define XB_TOPGEN   3392
#define XCD_BAR_WORDS 3456
#define XB_SPIN_CAP (1u << 18)
#define LAS __attribute__((address_space(3)))

__device__ __forceinline__ unsigned xb_ld(unsigned* p)              { return __hip_atomic_load(p, __ATOMIC_RELAXED, __HIP_MEMORY_SCOPE_AGENT); }
__device__ __forceinline__ unsigned xb_add(unsigned* p, unsigned v) { return __hip_atomic_fetch_add(p, v, __ATOMIC_RELAXED, __HIP_MEMORY_SCOPE_AGENT); }
__device__ __forceinline__ unsigned xb_xcc_id() { return (unsigned)__builtin_amdgcn_s_getreg((3 << 11) | 20) & 0xFu; }
#define XB_SPIN(cond, bar) do { unsigned _sp = 0; while (cond) { __builtin_amdgcn_s_sleep(1); \
    if ((++_sp & 255u) == 0u) { if (xb_ld(&(bar)[XB_TMO])) break; if (_sp > XB_SPIN_CAP) { atomicAdd(&(bar)[XB_TMO], 1u); break; } } } } while (0)

struct XcdBarrier {
    unsigned* bar; unsigned x;
    volatile LAS unsigned* st;
};

__device__ __forceinline__ XcdBarrier xcd_barrier_post(unsigned* bar, volatile LAS unsigned* st) {
    XcdBarrier b; b.bar = bar; b.x = xb_xcc_id(); b.st = st;
    if (threadIdx.x == 0) (void)xb_add(&bar[XB_XCNT(b.x)], 1u);
    return b;
}
__device__ __forceinline__ void xcd_barrier_complete(unsigned* bar, unsigned x, unsigned& nloc, unsigned& nx) {
    const unsigned G = gridDim.x * gridDim.y * gridDim.z;
    unsigned sum, cnt, mine, sp = 0u;
    for (;;) {
        sum = 0u; cnt = 0u; mine = 0u;
#pragma unroll
        for (unsigned j = 0; j < 16; ++j) { const unsigned c = xb_ld(&bar[XB_XCNT(j)]); sum += c; cnt += (c > 0u) ? 1u : 0u; mine = (j == x) ? c : mine; }
        if (sum == G) break;
        __builtin_amdgcn_s_sleep(1);
        if ((++sp & 255u) == 0u) { if (xb_ld(&bar[XB_TMO])) break; if (sp > XB_SPIN_CAP) { atomicAdd(&bar[XB_TMO], 1u); break; } }
    }
    nloc = mine > 0u ? mine : 1u; nx = cnt > 0u ? cnt : 1u;
}

__device__ __forceinline__ void xcd_barrier(const XcdBarrier& b) {
    asm volatile("s_waitcnt vmcnt(0)" ::: "memory");
    __syncthreads();
    if (threadIdx.x == 0) {
        unsigned* bar = b.bar;
        __builtin_amdgcn_s_waitcnt(0);
        unsigned nloc = b.st[0], nx = b.st[1];
        if (nloc == 0u) { xcd_barrier_complete(bar, b.x, nloc, nx); b.st[0] = nloc; b.st[1] = nx; }
        const unsigned old = xb_add(&bar[XB_XSUB(b.x)], 1u);
        const unsigned gen = old / nloc;
        if (old + 1u == (gen + 1u) * nloc) {
            __builtin_amdgcn_fence(__ATOMIC_RELEASE, "agent");
            asm volatile("s_waitcnt vmcnt(0)" ::: "memory");
            const unsigned og = xb_add(&bar[XB_TOP], 1u);
            const unsigned tg = og / nx;
            if (og + 1u == (tg + 1u) * nx) xb_add(&bar[XB_TOPGEN], 1u);
            else XB_SPIN(xb_ld(&bar[XB_TOPGEN]) == tg, bar);
            __builtin_amdgcn_fence(__ATOMIC_ACQUIRE, "agent");
            xb_add(&bar[XB_XGEN(b.x)], 1u);
            asm volatile("s_waitcnt vmcnt(0)" ::: "memory");
        } else {
            XB_SPIN(xb_ld(&bar[XB_XGEN(b.x)]) == gen, bar);
            __builtin_amdgcn_fence(__ATOMIC_ACQUIRE, "agent");
            asm volatile("s_waitcnt vmcnt(0)" ::: "memory");
        }
    }
    __syncthreads();
}


namespace pg8 {
#define PG8_LAS __attribute__((address_space(3)))
typedef unsigned short bf16_t;
typedef short bf16x8 __attribute__((ext_vector_type(8)));
typedef float f32x4 __attribute__((ext_vector_type(4)));
typedef unsigned u32x4 __attribute__((ext_vector_type(4)));
constexpr int BM = 256, BK = 64, HALF = 128, HTB = HALF * BK * 2  , STAGE_BYTES = 8 * HTB, NXCD = 8, WGM = 8;

__host__ __device__ __forceinline__ int lds_byte(int r, int c) { const int st = (r >> 4) * 2 + (c >> 5), rr = r & 15, cc = c & 31, ob = rr * 64 + cc * 2; return st * 1024 + (ob ^ (((ob >> 9) & 1) << 5)); }
__host__ __device__ __forceinline__ void stage_rc(int b, int& R, int& C) { const int st = b / 1024, sb = b % 1024, swz = sb ^ (((sb >> 9) & 1) << 5); R = (st >> 1) * 16 + swz / 64; C = (st & 1) * 32 + (swz % 64) / 2; }
__host__ __device__ __forceinline__ int perm32(int rho) { const int n = rho >> 4, i = rho & 15; return 8 * (i >> 2) + 4 * n + (i & 3); }

struct Unit { int pm, pn; };
struct Gemm { const bf16_t* A; const bf16_t* Bt; int M, N, K; };

struct StaticOrder {
    int nM, nN, nwg, G, c;
    __host__ __device__ void init(int M, int N, int G_, int c_) { nM = M / BM; nN = N / BM; nwg = nM * nN; G = G_; c = c_; }
    __host__ __device__ bool next(int i, Unit& u) const {
        const long L = (long)i * G + c; if (L >= nwg) return false;
        int wgid = (int)L; { const int q = nwg / NXCD, r = nwg % NXCD, xcd = wgid % NXCD, off = wgid / NXCD; wgid = (xcd < r ? xcd * (q + 1) : r * (q + 1) + (xcd - r) * q) + off; }
        const int nig = WGM * nN, gid = wgid / nig, fm = gid * WGM, gsz = (nM - fm) < WGM ? (nM - fm) : WGM;
        u.pm = fm + ((wgid % nig) % gsz); u.pn = (wgid % nig) / gsz; return true;
    }
    __device__ __forceinline__ void a_ready(const Unit&) const {}
    __device__ __forceinline__ void done(const Unit&) const {}
};

__device__ __forceinline__ unsigned cvt_pk_bf16(float lo, float hi) { unsigned r; asm volatile("v_cvt_pk_bf16_f32 %0, %1, %2" : "=v"(r) : "v"(lo), "v"(hi)); return r; }
typedef float f32x2 __attribute__((ext_vector_type(2)));
template <class Epi, class Sched, bool ALIGN_EPI = false, bool SP2 = false>
__device__ __forceinline__ void gemm_phase(PG8_LAS unsigned char* lds, const Gemm g, const Sched& S, const Epi& E) {
    int tid = threadIdx.x; asm volatile("" : "+v"(tid));
    const int wid = __builtin_amdgcn_readfirstlane(tid >> 6), lane = tid & 63, wr = wid >> 2, wc = wid & 3, fr = lane & 15, fq = lane >> 4;
    const int K = g.K, nt = K / BK;
    unsigned voffA[2], voffB[2];
#pragma unroll
    for (int i = 0; i < 2; ++i) { int R, C; stage_rc(tid * 16 + i * 8192, R, C); const int Rb = Epi::PERM ? ((R & ~31) + perm32(R & 31)) : R;
        voffA[i] = (unsigned)(R * K + C) * 2u; voffB[i] = (unsigned)(Rb * K + C) * 2u; }
    const size_t kstep = (size_t)(BK * 2);
    const size_t hstep = (size_t)HALF * K * 2;
    const size_t tstep = 2 * hstep;
    const unsigned ldsw = (unsigned)wid * 1024u;
    const int aoff = lds_byte(wr * 64 + fr, fq * 8), boff = lds_byte(wc * 32 + fr, fq * 8);
#define PG8_SA(b, h) (((b) * 2 + (h)) * HTB)
#define PG8_SB(b, h) ((4 + (b) * 2 + (h)) * HTB)
#define PG8_STAGE(bufoff, gbase, voff) do { _Pragma("unroll") for (int _i = 0; _i < 2; ++_i) \
        __builtin_amdgcn_global_load_lds((const unsigned*)((const char*)(gbase) + (voff)[_i]), (PG8_LAS unsigned*)(lds + (bufoff) + ldsw + _i * 8192), 16, 0, 0); } while (0)
#define PG8_LDA(dst, b, h) do { _Pragma("unroll") for (int m = 0; m < 4; ++m) _Pragma("unroll") for (int k = 0; k < 2; ++k) dst[m][k] = *(const PG8_LAS bf16x8*)(lds + PG8_SA(b, h) + aoff + m * 2048 + k * 1024); } while (0)
#define PG8_LDB(dst, b, h) do { _Pragma("unroll") for (int n = 0; n < 2; ++n) _Pragma("unroll") for (int k = 0; k < 2; ++k) dst[n][k] = *(const PG8_LAS bf16x8*)(lds + PG8_SB(b, h) + boff + n * 2048 + k * 1024); } while (0)
#define PG8_MMA(ai, bj, At, Bt) do { __builtin_amdgcn_s_setprio(1); _Pragma("unroll") for (int m = 0; m < 4; ++m) _Pragma("unroll") for (int n = 0; n < 2; ++n) _Pragma("unroll") for (int k = 0; k < 2; ++k) \
        acc[ai][bj][m][n] = __builtin_amdgcn_mfma_f32_16x16x32_bf16(Bt[n][k], At[m][k], acc[ai][bj][m][n], 0, 0, 0); __builtin_amdgcn_s_setprio(0); } while (0)
#define PG8_WAIT_V(n) asm volatile("s_waitcnt vmcnt(" #n ")" ::: "memory")
#define PG8_WAIT_L(n) asm volatile("s_waitcnt lgkmcnt(" #n ")" ::: "memory")
#define PG8_BAR __builtin_amdgcn_s_barrier()
#define PG8_SCHED __builtin_amdgcn_sched_barrier(0)
    Unit cur, nxt; int ui = 0;
    if (!S.next(0, cur)) return;
    f32x4 acc[2][2][4][2];
#pragma unroll
    for (int a = 0; a < 2; ++a)
#pragma unroll
        for (int b = 0; b < 2; ++b)
#pragma unroll
            for (int m = 0; m < 4; ++m)
#pragma unroll
                for (int n = 0; n < 2; ++n) acc[a][b][m][n] = (f32x4){0.f, 0.f, 0.f, 0.f};
    bf16x8 At[4][2], B0[2][2], B1[2][2];
    const char* cA = (const char*)g.A + (size_t)cur.pm * tstep; const char* cB = (const char*)g.Bt + (size_t)cur.pn * tstep;
    S.a_ready(cur);
    if constexpr (SP2) {
        PG8_STAGE(PG8_SB(0, 0), cB, voffB); PG8_STAGE(PG8_SB(0, 1), cB + hstep, voffB); PG8_STAGE(PG8_SA(0, 0), cA, voffA); PG8_STAGE(PG8_SA(0, 1), cA + hstep, voffA);
        if (wr == 1) PG8_BAR;
        PG8_WAIT_V(2); PG8_BAR;
        PG8_STAGE(PG8_SB(1, 0), cB + kstep, voffB); PG8_STAGE(PG8_SA(1, 0), cA + kstep, voffA); PG8_STAGE(PG8_SB(1, 1), cB + hstep + kstep, voffB);
        PG8_WAIT_V(6); PG8_BAR;
    } else {
        PG8_STAGE(PG8_SB(0, 0), cB, voffB); PG8_STAGE(PG8_SA(0, 0), cA, voffA); PG8_STAGE(PG8_SB(0, 1), cB + hstep, voffB); PG8_STAGE(PG8_SA(0, 1), cA + hstep, voffA);
        if (wr == 1) PG8_BAR;
        PG8_WAIT_V(4); PG8_BAR;
        PG8_STAGE(PG8_SB(1, 0), cB + kstep, voffB); PG8_STAGE(PG8_SA(1, 0), cA + kstep, voffA); PG8_STAGE(PG8_SB(1, 1), cB + hstep + kstep, voffB);
        PG8_WAIT_V(6); PG8_BAR;
    }
    for (;;) {
        const bool has_next = S.next(ui + 1, nxt);
        const char* nA = has_next ? (const char*)g.A + (size_t)nxt.pm * tstep : cA; const char* nB = has_next ? (const char*)g.Bt + (size_t)nxt.pn * tstep : cB;
        for (int t = 0; t < nt; t += 2) {
            const bool last = (t == nt - 2);
            const char* a1 = cA + (size_t)(t + 1) * kstep;
            const char* a2 = last ? nA : cA + (size_t)(t + 2) * kstep; const char* b2 = last ? nB : cB + (size_t)(t + 2) * kstep;
            const char* a3 = a2 + kstep; const char* b3 = b2 + kstep;
            if (last && has_next) S.a_ready(nxt);
            if constexpr (SP2) {
            PG8_LDB(B0, 0, 0); PG8_LDB(B1, 0, 1); PG8_SCHED; PG8_LDA(At, 0, 0); PG8_STAGE(PG8_SA(1, 1), a1 + hstep, voffA);
            PG8_WAIT_V(8); PG8_WAIT_L(0); PG8_BAR; PG8_MMA(0, 0, At, B0); PG8_MMA(0, 1, At, B1); PG8_BAR; PG8_SCHED;
            PG8_LDA(At, 0, 1); PG8_STAGE(PG8_SB(0, 0), b2, voffB); PG8_STAGE(PG8_SB(0, 1), b2 + hstep, voffB); PG8_STAGE(PG8_SA(0, 0), a2, voffA);
            PG8_WAIT_V(8); PG8_WAIT_L(0); PG8_BAR; PG8_MMA(1, 0, At, B0); PG8_MMA(1, 1, At, B1); PG8_BAR; PG8_SCHED;
            PG8_LDB(B0, 1, 0); PG8_LDB(B1, 1, 1); PG8_SCHED; PG8_LDA(At, 1, 0); PG8_STAGE(PG8_SA(0, 1), a2 + hstep, voffA);
            PG8_WAIT_V(8); PG8_WAIT_L(0); PG8_BAR; PG8_MMA(0, 0, At, B0); PG8_MMA(0, 1, At, B1); PG8_BAR; PG8_SCHED;
            PG8_LDA(At, 1, 1); PG8_STAGE(PG8_SB(1, 0), b3, voffB); PG8_STAGE(PG8_SB(1, 1), b3 + hstep, voffB); PG8_STAGE(PG8_SA(1, 0), a3, voffA);
            PG8_WAIT_V(8); PG8_WAIT_L(0); PG8_BAR; PG8_MMA(1, 0, At, B0); PG8_MMA(1, 1, At, B1); PG8_BAR; PG8_SCHED;
            } else {
            PG8_LDB(B0, 0, 0); PG8_SCHED; PG8_LDA(At, 0, 0); PG8_STAGE(PG8_SA(1, 1), a1 + hstep, voffA);
            PG8_WAIT_L(8); PG8_BAR; PG8_WAIT_L(0); PG8_MMA(0, 0, At, B0); PG8_BAR; PG8_SCHED;
            PG8_LDB(B1, 0, 1); PG8_STAGE(PG8_SB(0, 0), b2, voffB);
            PG8_BAR; PG8_WAIT_L(0); PG8_MMA(0, 1, At, B1); PG8_BAR;
            PG8_LDA(At, 0, 1); PG8_STAGE(PG8_SA(0, 0), a2, voffA);
            PG8_BAR; PG8_WAIT_L(0); PG8_MMA(1, 0, At, B0); PG8_BAR; PG8_SCHED;
            PG8_STAGE(PG8_SB(0, 1), b2 + hstep, voffB);
            PG8_WAIT_V(6); PG8_BAR; PG8_MMA(1, 1, At, B1); PG8_BAR;
            PG8_LDB(B0, 1, 0); PG8_SCHED; PG8_LDA(At, 1, 0); PG8_STAGE(PG8_SA(0, 1), a2 + hstep, voffA);
            PG8_WAIT_L(8); PG8_BAR; PG8_WAIT_L(0); PG8_MMA(0, 0, At, B0); PG8_BAR; PG8_SCHED;
            PG8_LDB(B1, 1, 1); PG8_STAGE(PG8_SB(1, 0), b3, voffB);
            PG8_BAR; PG8_WAIT_L(0); PG8_MMA(0, 1, At, B1); PG8_BAR;
            PG8_LDA(At, 1, 1); PG8_STAGE(PG8_SA(1, 0), a3, voffA);
            PG8_BAR; PG8_WAIT_L(0); PG8_MMA(1, 0, At, B0); PG8_BAR; PG8_SCHED;
            PG8_STAGE(PG8_SB(1, 1), b3 + hstep, voffB);
            PG8_WAIT_V(6); PG8_BAR; PG8_MMA(1, 1, At, B1); PG8_BAR;
            }
        }
        if constexpr (ALIGN_EPI) { if (wr == 0) PG8_BAR; }
        if constexpr (!Epi::AFTER_DRAIN) { E(acc, cur, wr, wc, fr, fq); S.done(cur); }
        if (!has_next) break;
#pragma unroll
        for (int a = 0; a < 2; ++a)
#pragma unroll
            for (int b = 0; b < 2; ++b)
#pragma unroll
                for (int m = 0; m < 4; ++m)
#pragma unroll
                    for (int n = 0; n < 2; ++n) acc[a][b][m][n] = (f32x4){0.f, 0.f, 0.f, 0.f};
        cur = nxt; cA = nA; cB = nB; ++ui;
        if constexpr (ALIGN_EPI) { if (wr == 1) PG8_BAR; }
    }
    PG8_WAIT_V(0);
    if constexpr (!ALIGN_EPI) { if (wr == 0) PG8_BAR; }
    PG8_BAR;
    if constexpr (Epi::AFTER_DRAIN) { E.fused(acc, cur, wr, wc, fr, fq, lds, wid, lane); S.done(cur); }
#undef PG8_SA
#undef PG8_SB
#undef PG8_STAGE
#undef PG8_LDA
#undef PG8_LDB
#undef PG8_MMA
#undef PG8_WAIT_V
#undef PG8_WAIT_L
#undef PG8_BAR
#undef PG8_SCHED
}
}


namespace {

constexpr int D = 2048, BATCH = 32, SEQ = 256, DEPTH = 4, DB = 2, DS = 1024, PAST = 512;
constexpr int NCTX = BATCH * SEQ, NLAT = DB * DS, T = NCTX + NLAT, TKV = T + DB * PAST;
constexpr int DIN = 3904, DINP = 4096;
constexpr int EXP_NSL = 8;
constexpr int RING_OFF = 0, MISC_OFF = 131072, LDS_TOTAL = 147456;
typedef unsigned short bf16_t;
constexpr int O_CQ = 0, O_CKV = 512, O_KPE = 768, O_NAQ = 832, O_NAK = 1344, O_NAV = 1856, O_GB = 2368, O_GC = 2880, O_U = 3392;
constexpr float EPS = 1e-6f;
constexpr int NTHREADS = 512, NWAVES = NTHREADS / 64;

struct Params {
    const float *x_prompt, *x_sample, *cache_ckv, *cache_kpe, *cache_nak, *cache_nav, *c, *c_ctx;
    const float *ada_w, *ada_b, *norm_mix_g, *norm_ffn_g, *w_in, *q_norm_g, *w_uq, *kv_norm_g, *w_ukv;
    const float *q_head_g, *k_head_g, *naq_g, *nak_g, *rel_bias, *conv_w, *w_out, *peer_wq, *sub_keys, *peer_u, *peer_v;
    float* out;
    float *o_ckv, *o_kpe, *o_nak, *o_nav;
    unsigned* bar;
    float *ada, *gate;
    int* eidx;
    unsigned short *wt_in, *wt_uq, *wt_ukv, *wt_out, *wt_q;
    unsigned short *hn_b, *cqn_b, *ckv_b, *mix_b;
    unsigned char* x8g;
    unsigned short* xb;
    unsigned short *z_b, *qm_b, *kvr_b; float* rope_cs;
    unsigned short *qp_b, *sk_b;
    unsigned char *pu8, *pv8; float *su8, *sv8;
    unsigned short *k_b, *qna_b, *kna_b, *cnak_b;
    unsigned short *cnav_b;
};

typedef const __attribute__((address_space(4))) Params CParams;

DEVI int tidx() { int t = threadIdx.x; asm volatile("" : "+v"(t)); return t; }
#define WAVE_DPP_ROR(v_, n_) __builtin_bit_cast(float, __builtin_amdgcn_update_dpp(0, __builtin_bit_cast(int, (v_)), 0x120 + (n_), 0xf, 0xf, false))
DEVI float wave_sum(float v) {
    v += WAVE_DPP_ROR(v, 8); v += WAVE_DPP_ROR(v, 4); v += WAVE_DPP_ROR(v, 2); v += WAVE_DPP_ROR(v, 1);
    { const auto s = __builtin_amdgcn_permlane16_swap(__float_as_uint(v), __float_as_uint(v), false, false); v = __uint_as_float(s[0]) + __uint_as_float(s[1]); }
    { const auto s = __builtin_amdgcn_permlane32_swap(__float_as_uint(v), __float_as_uint(v), false, false); v = __uint_as_float(s[0]) + __uint_as_float(s[1]); }
    return v;
}
DEVI float wave_max(float v) {
    v = fmaxf(v, WAVE_DPP_ROR(v, 8)); v = fmaxf(v, WAVE_DPP_ROR(v, 4)); v = fmaxf(v, WAVE_DPP_ROR(v, 2)); v = fmaxf(v, WAVE_DPP_ROR(v, 1));
    { const auto s = __builtin_amdgcn_permlane16_swap(__float_as_uint(v), __float_as_uint(v), false, false); v = fmaxf(__uint_as_float(s[0]), __uint_as_float(s[1])); }
    { const auto s = __builtin_amdgcn_permlane32_swap(__float_as_uint(v), __float_as_uint(v), false, false); v = fmaxf(__uint_as_float(s[0]), __uint_as_float(s[1])); }
    return v;
}
typedef float f32x2_t __attribute__((ext_vector_type(2))); typedef __bf16 bf16x2_t __attribute__((ext_vector_type(2)));
DEVI unsigned cvtpk(float lo, float hi) { f32x2_t v = {lo, hi}; bf16x2_t b = __builtin_convertvector(v, bf16x2_t); return __builtin_bit_cast(unsigned, b); }
DEVI bf16_t f2bf(float v) { return (bf16_t)(cvtpk(v, 0.f) & 0xffffu); }
DEVI int cond_of(int t) { return t < NCTX ? 2 : (t - NCTX) / DS; }
DEVI const float* xrow(CParams& p, int layer, int t) {
    if (layer == 0) return t < NCTX ? p.x_prompt + (size_t)t * D : p.x_sample + (size_t)(t - NCTX) * D;
    return p.out + (size_t)t * D;
}

DEVI void phase_modnorm(CParams& p, int layer, int which, int bid, int nb) {
    const int lane = tidx() & 63, w = tidx() >> 6;
    const float* g = (which == 0 ? p.norm_mix_g : p.norm_ffn_g) + (size_t)layer * D;
    for (int t = bid * NWAVES + w; t < T; t += nb * NWAVES) {
        const float* x = xrow(p, layer, t);
        const bf16_t* xq = p.xb + (size_t)t * D;
        const float* ad = p.ada + ((size_t)layer * 3 + cond_of(t)) * 6 * D + (which == 0 ? 0 : 3 * D);
        float4 v[8]; float ss = 0.f;
#pragma unroll
        for (int i = 0; i < 8; ++i) {
            if (which == 0) { const pg8::f32x4 t4 = __builtin_nontemporal_load((const pg8::f32x4*)(x + i * 256 + lane * 4)); v[i] = make_float4(t4[0], t4[1], t4[2], t4[3]); }
            else { const uint2 q = *(const uint2*)(xq + i * 256 + lane * 4); v[i] = make_float4(__uint_as_float(q.x << 16), __uint_as_float(q.x & 0xffff0000u), __uint_as_float(q.y << 16), __uint_as_float(q.y & 0xffff0000u)); }
            ss += v[i].x * v[i].x + v[i].y * v[i].y + v[i].z * v[i].z + v[i].w * v[i].w; }
        ss = wave_sum(ss);
        const float r = rsqrtf(ss / D + EPS);
#pragma unroll
        for (int i = 0; i < 8; ++i) {
            const int c = i * 256 + lane * 4;
            float4 gg = *(const float4*)(g + c), sh = *(const float4*)(ad + c), sc = *(const float4*)(ad + D + c), o;
            o.x = v[i].x * r * gg.x * (1.f + sc.x) + sh.x; o.y = v[i].y * r * gg.y * (1.f + sc.y) + sh.y;
            o.z = v[i].z * r * gg.z * (1.f + sc.z) + sh.z; o.w = v[i].w * r * gg.w * (1.f + sc.w) + sh.w;
            *(uint2*)(p.hn_b + (size_t)t * D + c) = make_uint2(pg8::cvt_pk_bf16(o.x, o.y), pg8::cvt_pk_bf16(o.z, o.w));
        }
    }
}

struct EpiResidMF {
    static constexpr bool PERM = false, AFTER_DRAIN = false;
    CParams* p; int layer;
    DEVI void operator()(const pg8::f32x4 (&acc)[2][2][4][2], const pg8::Unit& u, int wr, int wc, int fr, int fq) const {
        const int row0 = u.pm * 256 + wr * 64 + fr, col0 = u.pn * 256 + wc * 32 + 4 * fq;
#pragma unroll
        for (int ai = 0; ai < 2; ++ai)
#pragma unroll
            for (int m = 0; m < 4; ++m) {
                const int r = row0 + ai * 128 + m * 16;
                const float* x = xrow(*p, 0, r);
                const float* g1 = p->ada + ((size_t)layer * 3 + cond_of(r)) * 6 * D + 2 * D;
                bf16_t* o = p->xb + (size_t)r * D;
#pragma unroll
                for (int bj = 0; bj < 2; ++bj)
#pragma unroll
                    for (int n = 0; n < 2; ++n) { const int c = col0 + bj * 128 + n * 16;
                        pg8::f32x4 xv;
                        if (layer == 0) xv = *(const pg8::f32x4*)(x + c);
                        else { const uint2 q = *(const uint2*)(o + c); xv = (pg8::f32x4){__uint_as_float(q.x << 16), __uint_as_float(q.x & 0xffff0000u), __uint_as_float(q.y << 16), __uint_as_float(q.y & 0xffff0000u)}; }
                        const pg8::f32x4 gv = *(const pg8::f32x4*)(g1 + c), v = xv + gv * acc[ai][bj][m][n];
                        *(uint2*)(o + c) = make_uint2(cvtpk(v[0], v[1]), cvtpk(v[2], v[3])); } }
    }
};
struct EpiBf16Store {
    static constexpr bool PERM = true, AFTER_DRAIN = false;
    bf16_t* O; int ldc, ncols;
    DEVI void operator()(const pg8::f32x4 (&acc)[2][2][4][2], const pg8::Unit& u, int wr, int wc, int fr, int fq) const {
        const int row0 = u.pm * 256 + wr * 64 + fr, col0 = u.pn * 256 + wc * 32 + 8 * fq;
#pragma unroll
        for (int ai = 0; ai < 2; ++ai)
#pragma unroll
            for (int m = 0; m < 4; ++m) { bf16_t* rowp = O + (size_t)(row0 + ai * 128 + m * 16) * ldc + col0;
#pragma unroll
                for (int bj = 0; bj < 2; ++bj) { const pg8::f32x4 v0 = acc[ai][bj][m][0], v1 = acc[ai][bj][m][1];
                    if (col0 + bj * 128 < ncols) *(uint4*)(rowp + bj * 128) = make_uint4(cvtpk(v0[0], v0[1]), cvtpk(v0[2], v0[3]), cvtpk(v1[0], v1[1]), cvtpk(v1[2], v1[3])); } }
    }
};
template <class Epi>
DEVI void mfma_gemm(const bf16_t* A, const bf16_t* Bt, int M, int N, int K, const Epi& E, int bid, int nb, float* lds) {
    pg8::Gemm g{A, Bt, M, N, K};
    pg8::StaticOrder S; S.init(M, N, nb, bid);
    pg8::gemm_phase<Epi, pg8::StaticOrder, true, true>((PG8_LAS unsigned char*)lds + RING_OFF, g, S, E);
    __syncthreads();
}

DEVI float rope_angle(int pos, int j) {
    const int row = pos / 64, col = pos % 64;
    const int f = j & 15;
    const float inv = powf(10000.f, -(float)f / 16.f);
    return (j < 16 ? (float)row : (float)col) * inv;
}

struct TileD { const float* W; bf16_t* Wt; int ldw, ldt; };
DEVI TileD tile_desc(CParams& p, int l, int j) {
    constexpr int N_IN = 32 * 61, N_UQ = 8 * 24, N_UKV = 4 * 32, N_SQ = 32 * 32;
    TileD d;
    if (j < N_IN) { const int k0 = (j / 61) * 64, n0 = (j % 61) * 64; d.W = p.w_in + (size_t)l * D * DIN + (size_t)k0 * DIN + n0; d.ldw = DIN; d.Wt = p.wt_in + (size_t)l * DINP * D + (size_t)n0 * D + k0; d.ldt = D; return d; }
    j -= N_IN;
    if (j < N_UQ) { const int k0 = (j / 24) * 64, n0 = (j % 24) * 64; d.W = p.w_uq + (size_t)l * 512 * 1536 + (size_t)k0 * 1536 + n0; d.ldw = 1536; d.Wt = p.wt_uq + (size_t)l * 1536 * 512 + (size_t)n0 * 512 + k0; d.ldt = 512; return d; }
    j -= N_UQ;
    if (j < N_UKV) { const int k0 = (j / 32) * 64, n0 = (j % 32) * 64; d.W = p.w_ukv + (size_t)l * 256 * 2048 + (size_t)k0 * 2048 + n0; d.ldw = 2048; d.Wt = p.wt_ukv + (size_t)l * 2048 * 256 + (size_t)n0 * 256 + k0; d.ldt = 256; return d; }
    j -= N_UKV;
    const bool isq = j >= N_SQ; if (isq) j -= N_SQ;
    const int k0 = (j / 32) * 64, n0 = (j % 32) * 64;
    d.W = (isq ? p.peer_wq : p.w_out) + (size_t)l * D * D + (size_t)k0 * D + n0; d.ldw = D; d.Wt = (isq ? p.wt_q : p.wt_out) + (size_t)l * D * D + (size_t)n0 * D + k0; d.ldt = D;
    return d;
}
DEVI void conv_weights(CParams& p, int l, int which, int rank, int nr, float* lds) {
    constexpr int N_IN = 32 * 61, PER = 32 * 61 + 8 * 24 + 4 * 32 + 2 * 32 * 32;
    const int tid = tidx();
    const int lo = which == 0 ? 0 : N_IN, hi = which == 0 ? N_IN : PER;
    for (int it = lo + rank; it < hi; it += 4 * nr) {
        float4 v[4][2]; TileD d[4];
#pragma unroll
        for (int q = 0; q < 4; ++q) {
            const int j = it + q * nr; d[q] = tile_desc(p, l, j < hi ? j : it);
#pragma unroll
            for (int rep = 0; rep < 2; ++rep) { const int k = (tid >> 4) + rep * 32, n4 = (tid & 15) * 4; const pg8::f32x4 t4 = __builtin_nontemporal_load((const pg8::f32x4*)(d[q].W + (size_t)k * d[q].ldw + n4)); v[q][rep] = make_float4(t4[0], t4[1], t4[2], t4[3]); }
        }
#pragma unroll
        for (int q = 0; q < 4; ++q) {
            float (*tl)[65] = (float (*)[65])(lds + q * 64 * 65);
#pragma unroll
            for (int rep = 0; rep < 2; ++rep) { const int k = (tid >> 4) + rep * 32, n4 = (tid & 15) * 4; tl[k][n4] = v[q][rep].x; tl[k][n4 + 1] = v[q][rep].y; tl[k][n4 + 2] = v[q][rep].z; tl[k][n4 + 3] = v[q][rep].w; }
        }
        __syncthreads();
#pragma unroll
        for (int q = 0; q < 4; ++q) {
            if (it + q * nr < hi) {
                float (*tl)[65] = (float (*)[65])(lds + q * 64 * 65);
                const int n = tid >> 3, k8 = (tid & 7) * 8;
                uint4 o;
                o.x = cvtpk(tl[k8 + 0][n], tl[k8 + 1][n]); o.y = cvtpk(tl[k8 + 2][n], tl[k8 + 3][n]); o.z = cvtpk(tl[k8 + 4][n], tl[k8 + 5][n]); o.w = cvtpk(tl[k8 + 6][n], tl[k8 + 7][n]);
                *(uint4*)(d[q].Wt + (size_t)n * d[q].ldt + k8) = o;
            }
        }
        __syncthreads();
    }
    constexpr int NSK = 8 * 2 * 128 * 128 / 4;
    if (which == 1)
    for (int i = rank * NTHREADS + tidx(); i < NSK; i += nr * NTHREADS) {
        const float4 v = *(const float4*)(p.sub_keys + ((size_t)l * NSK + i) * 4);
        *(uint2*)(p.sk_b + ((size_t)l * NSK + i) * 4) = make_uint2(cvtpk(v.x, v.y), cvtpk(v.z, v.w));
    }
    constexpr int NZ = (DINP - DIN) * D / 8;
    if (which == 0)
    for (int i = rank * NTHREADS + tidx(); i < NZ; i += nr * NTHREADS) *(uint4*)(p.wt_in + ((size_t)l * DINP + DIN) * D + (size_t)i * 8) = make_uint4(0u, 0u, 0u, 0u);
}
DEVI void conv_table(CParams& p, int l, bool isv, int rank, int nr) {
    const int lane = tidx() & 63, w = tidx() >> 6;
    for (int e = rank * NWAVES + w; e < 16384; e += nr * NWAVES) {
        const float* src = (isv ? p.peer_v : p.peer_u) + ((size_t)l * 16384 + e) * D;
        float4 v[8]; float mx = 0.f;
#pragma unroll
        for (int i = 0; i < 8; ++i) { const pg8::f32x4 t4 = __builtin_nontemporal_load((const pg8::f32x4*)(src + i * 256 + lane * 4)); v[i] = make_float4(t4[0], t4[1], t4[2], t4[3]); mx = fmaxf(mx, fmaxf(fmaxf(fabsf(v[i].x), fabsf(v[i].y)), fmaxf(fabsf(v[i].z), fabsf(v[i].w)))); }
        mx = wave_max(mx);
        const float scale = mx > 0.f ? mx * (1.f / 6.f) : 1.f, inv = 1.f / scale;
        unsigned char* dst = (isv ? p.pv8 : p.pu8) + ((size_t)l * EXP_NSL * 16384 + e) * 128 + lane * 2;
#pragma unroll
        for (int i = 0; i < 8; ++i) {
            unsigned pk = 0;
            pk = __builtin_amdgcn_cvt_scalef32_pk_fp4_f32(pk, v[i].x * inv, v[i].y * inv, 1.0f, 0);
            pk = __builtin_amdgcn_cvt_scalef32_pk_fp4_f32(pk, v[i].z * inv, v[i].w * inv, 1.0f, 1);
            *(unsigned short*)(dst + (size_t)i * 16384 * 128) = (unsigned short)pk;
        }
        if (lane == 0) (isv ? p.sv8 : p.su8)[(size_t)l * 16384 + e] = scale;
    }
}
DEVI void conv_ada(CParams& p, int l, int rank, int nr, float* lds, int ib, int ie) {
    float* sv = lds;
    float* red = lds + 3 * D;
    const int tid = tidx(), lane = tid & 63, w = tid >> 6;
    __syncthreads();
    for (int i = tid; i < 3 * D; i += NTHREADS) {
        const int j = i / D, k = i % D;
        const float v = j < 2 ? p.c[j * D + k] : p.c_ctx[k];
        sv[i] = v / (1.f + __expf(-v));
    }
    __syncthreads();
    constexpr int NIT = 6 * D / 256;
    static_assert(NIT == 48, "item split below assumes 48 items per layer");
    for (int it = ib + rank; it < ie; it += nr) {
        const int n4 = it * 256 + lane * 4;
        const float* W = p.ada_w + (size_t)l * D * 6 * D + n4;
        float4 a0 = make_float4(0.f, 0.f, 0.f, 0.f), a1 = a0, a2 = a0;
        const int k0 = w * (D / NWAVES);
#pragma unroll 1
        for (int kb = k0; kb < k0 + D / NWAVES; kb += 32) {
            pg8::f32x4 wv[32];
#pragma unroll
            for (int i = 0; i < 32; ++i) wv[i] = __builtin_nontemporal_load((const pg8::f32x4*)(W + (size_t)(kb + i) * 6 * D));
#pragma unroll
            for (int i = 0; i < 32; ++i) {
                const float s0 = sv[kb + i], s1 = sv[D + kb + i], s2 = sv[2 * D + kb + i];
                a0.x += s0 * wv[i][0]; a0.y += s0 * wv[i][1]; a0.z += s0 * wv[i][2]; a0.w += s0 * wv[i][3];
                a1.x += s1 * wv[i][0]; a1.y += s1 * wv[i][1]; a1.z += s1 * wv[i][2]; a1.w += s1 * wv[i][3];
                a2.x += s2 * wv[i][0]; a2.y += s2 * wv[i][1]; a2.z += s2 * wv[i][2]; a2.w += s2 * wv[i][3];
            }
        }
        float4* red4 = (float4*)red;
        red4[(w * 3 + 0) * 64 + lane] = a0; red4[(w * 3 + 1) * 64 + lane] = a1; red4[(w * 3 + 2) * 64 + lane] = a2;
        __syncthreads();
        if (tid < 192) {
            const int j = tid / 64, ln = tid % 64;
            float4 s4 = make_float4(0.f, 0.f, 0.f, 0.f);
            for (int ww = 0; ww < NWAVES; ++ww) { const float4 v = red4[(ww * 3 + j) * 64 + ln]; s4.x += v.x; s4.y += v.y; s4.z += v.z; s4.w += v.w; }
            const int nn = it * 256 + ln * 4;
            const float4 b = *(const float4*)(p.ada_b + (size_t)l * 6 * D + nn);
            *(float4*)(p.ada + ((size_t)l * 3 + j) * 6 * D + nn) = make_float4(s4.x + b.x, s4.y + b.y, s4.z + b.z, s4.w + b.w);
        }
        __syncthreads();
    }
}
DEVI void phase_prologue(CParams& p, int bid, int nb, float* lds) {
    for (int i = bid * NTHREADS + tidx(); i < DS * 32; i += nb * NTHREADS) {
        const int pos = i >> 5, j = i & 31;
        const float ang = rope_angle(pos, j);
        p.rope_cs[(size_t)pos * 64 + j] = cosf(ang); p.rope_cs[(size_t)pos * 64 + 32 + j] = sinf(ang);
    }
    if (nb > 96) { if (bid < 48) conv_ada(p, 0, bid, 48, lds, 0, 48); else conv_weights(p, 0, 0, bid - 48, nb - 48, lds); return; }
    conv_ada(p, 0, bid, nb, lds, 0, 48);
    conv_weights(p, 0, 0, bid, nb, lds);
}
DEVI bool gemm_idle_rank(int U, int bid, int nb, int& rank, int& nr) {
    const int rem = U % nb;
    if (rem == 0) { rank = bid; nr = nb; return true; }
    if (bid < rem) return false;
    rank = bid - rem; nr = nb - rem; return true;
}

DEVI float bf_lo(unsigned v) { return __uint_as_float(v << 16); }
DEVI float bf_hi(unsigned v) { return __uint_as_float(v & 0xffff0000u); }
DEVI void unpack8(const uint4& v, float (&f)[8]) { f[0] = bf_lo(v.x); f[1] = bf_hi(v.x); f[2] = bf_lo(v.y); f[3] = bf_hi(v.y); f[4] = bf_lo(v.z); f[5] = bf_hi(v.z); f[6] = bf_lo(v.w); f[7] = bf_hi(v.w); }
DEVI uint4 pack8(const float (&f)[8]) { return make_uint4(cvtpk(f[0], f[1]), cvtpk(f[2], f[3]), cvtpk(f[4], f[5]), cvtpk(f[6], f[7])); }
DEVI void phase_postz(CParams& p, int layer, int bid, int nb) {
    const int lane = tidx() & 63, w = tidx() >> 6;
    for (int r = bid * NWAVES + w; r < TKV; r += nb * NWAVES) {
        if (r >= T) {
            const int b = (r - T) / PAST, j = (r - T) % PAST;
            const float4 v = *(const float4*)(p.cache_ckv + (((size_t)b * DEPTH + layer) * PAST + j) * 256 + lane * 4);
            *(uint2*)(p.ckv_b + (size_t)r * 256 + lane * 4) = make_uint2(cvtpk(v.x, v.y), cvtpk(v.z, v.w));
            continue;
        }
        const bf16_t* z = p.z_b + (size_t)r * DIN;
        const bool ctx = r < NCTX;
        const int b = ctx ? r / SEQ : (r - NCTX) / DS, s = ctx ? r % SEQ : (r - NCTX) % DS, S = ctx ? SEQ : DS;
        const bool hp = s > 0, hn = s < S - 1;
        const uint4 zero4 = make_uint4(0u, 0u, 0u, 0u);
        const uint4 cq4 = *(const uint4*)(z + O_CQ + lane * 8);
        const uint2 ckv2 = *(const uint2*)(z + O_CKV + lane * 4);
        const bf16_t kpe1 = z[O_KPE + lane];
        const uint4 naq4 = *(const uint4*)(z + O_NAQ + lane * 8), nak4 = *(const uint4*)(z + O_NAK + lane * 8), nav4 = *(const uint4*)(z + O_NAV + lane * 8);
        const uint4 gb4 = *(const uint4*)(z + O_GB + lane * 8), gc4 = *(const uint4*)(z + O_GC + lane * 8), u4 = *(const uint4*)(z + O_U + lane * 8);
        const uint4 gcm4 = hp ? *(const uint4*)(z - DIN + O_GC + lane * 8) : zero4, um4 = hp ? *(const uint4*)(z - DIN + O_U + lane * 8) : zero4;
        const uint4 gcp4 = hn ? *(const uint4*)(z + DIN + O_GC + lane * 8) : zero4, up4 = hn ? *(const uint4*)(z + DIN + O_U + lane * 8) : zero4;
        float cw[24];
        {
            const float* cwp = p.conv_w + ((size_t)layer * 512 + lane * 8) * 3;
#pragma unroll
            for (int q = 0; q < 6; ++q) { const float4 v = *(const float4*)(cwp + q * 4); cw[q * 4] = v.x; cw[q * 4 + 1] = v.y; cw[q * 4 + 2] = v.z; cw[q * 4 + 3] = v.w; }
        }
        float gq[8], gkv[4], gnq[8], gnk[8];
        {
            const float4 a = *(const float4*)(p.q_norm_g + layer * 512 + lane * 8), c = *(const float4*)(p.q_norm_g + layer * 512 + lane * 8 + 4);
            gq[0] = a.x; gq[1] = a.y; gq[2] = a.z; gq[3] = a.w; gq[4] = c.x; gq[5] = c.y; gq[6] = c.z; gq[7] = c.w;
            const float4 k = *(const float4*)(p.kv_norm_g + layer * 256 + lane * 4); gkv[0] = k.x; gkv[1] = k.y; gkv[2] = k.z; gkv[3] = k.w;
            const int d0 = (lane & 15) * 8;
            const float4 e = *(const float4*)(p.naq_g + layer * 128 + d0), f = *(const float4*)(p.naq_g + layer * 128 + d0 + 4);
            gnq[0] = e.x; gnq[1] = e.y; gnq[2] = e.z; gnq[3] = e.w; gnq[4] = f.x; gnq[5] = f.y; gnq[6] = f.z; gnq[7] = f.w;
            const float4 g = *(const float4*)(p.nak_g + layer * 128 + d0), hh = *(const float4*)(p.nak_g + layer * 128 + d0 + 4);
            gnk[0] = g.x; gnk[1] = g.y; gnk[2] = g.z; gnk[3] = g.w; gnk[4] = hh.x; gnk[5] = hh.y; gnk[6] = hh.z; gnk[7] = hh.w;
        }
        float cq[8], naq[8], nak[8], nav[8], ckv[4];
        unpack8(cq4, cq); unpack8(naq4, naq); unpack8(nak4, nak); unpack8(nav4, nav);
        ckv[0] = bf_lo(ckv2.x); ckv[1] = bf_hi(ckv2.x); ckv[2] = bf_lo(ckv2.y); ckv[3] = bf_hi(ckv2.y);
        float s_cq = 0.f, s_kv = 0.f, s_nq = 0.f, s_nk = 0.f;
#pragma unroll
        for (int i = 0; i < 8; ++i) { s_cq += cq[i] * cq[i]; s_nq += naq[i] * naq[i]; s_nk += nak[i] * nak[i]; }
#pragma unroll
        for (int i = 0; i < 4; ++i) s_kv += ckv[i] * ckv[i];
#pragma unroll
        for (int o = 1; o < 16; o <<= 1) { s_cq += __shfl_xor(s_cq, o); s_kv += __shfl_xor(s_kv, o); s_nq += __shfl_xor(s_nq, o); s_nk += __shfl_xor(s_nk, o); }
        s_cq += __shfl_xor(s_cq, 16); s_kv += __shfl_xor(s_kv, 16); s_cq += __shfl_xor(s_cq, 32); s_kv += __shfl_xor(s_kv, 32);
        const float r_cq = rsqrtf(s_cq / 512.f + EPS), r_kv = rsqrtf(s_kv / 256.f + EPS), r_nq = rsqrtf(s_nq / 128.f + EPS), r_nk = rsqrtf(s_nk / 128.f + EPS);
#pragma unroll
        for (int i = 0; i < 8; ++i) { cq[i] *= r_cq * gq[i]; naq[i] *= r_nq * gnq[i]; nak[i] *= r_nk * gnk[i]; }
#pragma unroll
        for (int i = 0; i < 4; ++i) ckv[i] *= r_kv * gkv[i];
        *(uint4*)(p.cqn_b + (size_t)r * 512 + lane * 8) = pack8(cq);
        *(uint2*)(p.ckv_b + (size_t)r * 256 + lane * 4) = make_uint2(cvtpk(ckv[0], ckv[1]), cvtpk(ckv[2], ckv[3]));
        *(uint4*)(p.qna_b + (size_t)r * 512 + lane * 8) = pack8(naq);
        *(uint4*)(p.kna_b + (size_t)r * 512 + lane * 8) = pack8(nak);
        if (ctx) {
            const size_t oc = ((size_t)b * DEPTH + layer) * SEQ + s;
            *(float4*)(p.o_ckv + oc * 256 + lane * 4) = make_float4(ckv[0], ckv[1], ckv[2], ckv[3]);
            p.o_kpe[oc * 64 + lane] = __uint_as_float((unsigned)kpe1 << 16);
            const int hd = lane >> 4, d0 = (lane & 15) * 8;
            const size_t on = ((((size_t)b * DEPTH + layer) * 4 + hd) * SEQ + s) * 128 + d0;
            *(float4*)(p.o_nak + on) = make_float4(nak[0], nak[1], nak[2], nak[3]); *(float4*)(p.o_nak + on + 4) = make_float4(nak[4], nak[5], nak[6], nak[7]);
            *(float4*)(p.o_nav + on) = make_float4(nav[0], nav[1], nav[2], nav[3]); *(float4*)(p.o_nav + on + 4) = make_float4(nav[4], nav[5], nav[6], nav[7]);
        }
        {
            float gb[8], gc[8], uu[8], gcm[8], um[8], gcp[8], up[8], o[8];
            unpack8(gb4, gb); unpack8(gc4, gc); unpack8(u4, uu); unpack8(gcm4, gcm); unpack8(um4, um); unpack8(gcp4, gcp); unpack8(up4, up);
#pragma unroll
            for (int i = 0; i < 8; ++i) o[i] = gb[i] * (gcm[i] * um[i] * cw[i * 3] + gc[i] * uu[i] * cw[i * 3 + 1] + gcp[i] * up[i] * cw[i * 3 + 2]);
            *(uint4*)(p.mix_b + (size_t)r * D + 1536 + lane * 8) = pack8(o);
        }
    }
}

DEVI void phase_headnorm(CParams& p, int layer, int bid, int nb, float* lds) {
    const int lane = tidx() & 63, w = tidx() >> 6;
    for (int r = bid * NWAVES + w; r < TKV; r += nb * NWAVES) {
        const bf16_t* kv = p.kvr_b + (size_t)r * 2048;
        const int cc = lane & 15, hA = lane >> 4, hB = 4 + (lane >> 4);
        float ka[8], kb[8], pe[8];
        unpack8(*(const uint4*)(kv + hA * 256 + cc * 8), ka);
        unpack8(*(const uint4*)(kv + hB * 256 + cc * 8), kb);
        const int kc = lane & 7, hh = lane >> 3;
        if (r < T) unpack8(*(const uint4*)(p.z_b + (size_t)r * DIN + O_KPE + kc * 8), pe);
        else {
            const int b = (r - T) / PAST, j = (r - T) % PAST;
            const float* cp = p.cache_kpe + (((size_t)b * DEPTH + layer) * PAST + j) * 64 + kc * 8;
            const float4 a = *(const float4*)cp, c = *(const float4*)(cp + 4);
            pe[0] = a.x; pe[1] = a.y; pe[2] = a.z; pe[3] = a.w; pe[4] = c.x; pe[5] = c.y; pe[6] = c.z; pe[7] = c.w;
        }
        float gn[8], gp[8];
        {
            const float* g = p.k_head_g + layer * 192;
            const float4 a = *(const float4*)(g + cc * 8), c = *(const float4*)(g + cc * 8 + 4), e = *(const float4*)(g + 128 + kc * 8), f = *(const float4*)(g + 128 + kc * 8 + 4);
            gn[0] = a.x; gn[1] = a.y; gn[2] = a.z; gn[3] = a.w; gn[4] = c.x; gn[5] = c.y; gn[6] = c.z; gn[7] = c.w;
            gp[0] = e.x; gp[1] = e.y; gp[2] = e.z; gp[3] = e.w; gp[4] = f.x; gp[5] = f.y; gp[6] = f.z; gp[7] = f.w;
        }
        float sa = 0.f, sb = 0.f, sp = 0.f;
#pragma unroll
        for (int i = 0; i < 8; ++i) { sa += ka[i] * ka[i]; sb += kb[i] * kb[i]; sp += pe[i] * pe[i]; }
#pragma unroll
        for (int o = 1; o < 16; o <<= 1) { sa += __shfl_xor(sa, o); sb += __shfl_xor(sb, o); }
        sp += __shfl_xor(sp, 1); sp += __shfl_xor(sp, 2); sp += __shfl_xor(sp, 4);
        const float rA = rsqrtf((sa + sp) / 192.f + EPS), rB = rsqrtf((sb + sp) / 192.f + EPS);
        const float sa_h = __shfl(sa, (hh & 3) * 16), sb_h = __shfl(sb, (hh & 3) * 16);
        const float rP = rsqrtf(((hh < 4 ? sa_h : sb_h) + sp) / 192.f + EPS);
#pragma unroll
        for (int i = 0; i < 8; ++i) { ka[i] *= rA * gn[i]; kb[i] *= rB * gn[i]; pe[i] *= rP * gp[i]; }
        if (r >= NCTX && r < T) {
            const int pos = (r - NCTX) % DS, j0 = (kc & 3) * 8;
            const float* cs = p.rope_cs + (size_t)pos * 64 + j0;
            const float4 c0 = *(const float4*)cs, c1 = *(const float4*)(cs + 4), s0 = *(const float4*)(cs + 32), s1 = *(const float4*)(cs + 36);
            const float cv[8] = {c0.x, c0.y, c0.z, c0.w, c1.x, c1.y, c1.z, c1.w}, sn[8] = {s0.x, s0.y, s0.z, s0.w, s1.x, s1.y, s1.z, s1.w};
#pragma unroll
            for (int i = 0; i < 8; ++i) {
                const float other = __shfl_xor(pe[i], 4);
                pe[i] = kc < 4 ? pe[i] * cv[i] - other * sn[i] : other * sn[i] + pe[i] * cv[i];
            }
        }
        bf16_t* ko = p.k_b + (size_t)r * 1536;
        *(uint4*)(ko + hA * 192 + cc * 8) = pack8(ka);
        *(uint4*)(ko + hB * 192 + cc * 8) = pack8(kb);
        *(uint4*)(ko + hh * 192 + 128 + kc * 8) = pack8(pe);
    }
    for (int i = bid * NTHREADS + tidx(); i < DB * 4 * PAST * 128 / 4; i += nb * NTHREADS) {
        const int e = i * 4, bh = e / (PAST * 128), rem = e % (PAST * 128), b = bh / 4, h = bh % 4;
        const pg8::f32x4 t4 = __builtin_nontemporal_load((const pg8::f32x4*)(p.cache_nak + (((size_t)b * DEPTH + layer) * 4 + h) * PAST * 128 + rem)); const float4 v = make_float4(t4[0], t4[1], t4[2], t4[3]);
        *(uint2*)(p.cnak_b + (size_t)e) = make_uint2(cvtpk(v.x, v.y), cvtpk(v.z, v.w));
    }
    for (int i = bid * NTHREADS + tidx(); i < DB * 4 * PAST * 128 / 4; i += nb * NTHREADS) {
        const int e = i * 4, bh = e / (PAST * 128), rem = e % (PAST * 128), b = bh / 4, h = bh % 4;
        const pg8::f32x4 t4 = __builtin_nontemporal_load((const pg8::f32x4*)(p.cache_nav + (((size_t)b * DEPTH + layer) * 4 + h) * PAST * 128 + rem)); const float4 v = make_float4(t4[0], t4[1], t4[2], t4[3]);
        *(uint2*)(p.cnav_b + (size_t)e) = make_uint2(cvtpk(v.x, v.y), cvtpk(v.z, v.w));
    }
}

typedef short bf16x8_t __attribute__((ext_vector_type(8)));
typedef short bf16x4_t __attribute__((ext_vector_type(4)));
typedef __attribute__((address_space(3))) bf16x4_t lds_bf16x4_t;
typedef float f32x16_t __attribute__((ext_vector_type(16)));
#define MFMA32(a, b, c) __builtin_amdgcn_mfma_f32_32x32x16_bf16((a), (b), (c), 0, 0, 0)
DEVI int crow(int reg, int h) { return (reg & 3) + 8 * (reg >> 2) + 4 * h; }

#ifndef QK_AHEAD
#define QK_AHEAD 4
#endif
#ifndef PV_AHEAD
#define PV_AHEAD 4
#endif
constexpr int QG_OFF = 98304;
struct AttnBlk {
    const bf16_t* q; int qstride;
    const bf16_t *k0, *vt0; int ks0, ldv0, nst0;
    const bf16_t *k1, *vt1; int ks1, ldv1, nst1;
    bf16_t* out; float scale;
    const float *qg, *rope; int pos0;
    const float* bias; int row0, rs_min;
};
template <int DQ, bool LOCAL, bool QNORM, bool SPLIT>
DEVI void attn_block(const AttnBlk& u, float* ldsf) {
    constexpr int KROW = DQ * 2 + 16, VROW = 320, KBYTES = 64 * KROW, STAGE = KBYTES + 64 * VROW;
    constexpr int KCH = DQ / 8, NKC = 64 * KCH / NTHREADS;
    unsigned char* lds = (unsigned char*)ldsf;
    const int tid = tidx(), lane = tid & 63, w = tid >> 6, r = lane & 31, h = lane >> 5;
    const int wq = SPLIT ? (w >> 1) : w, kh = __builtin_amdgcn_readfirstlane(w & 1);
    bf16x8_t qf[DQ / 16];
    {
        const bf16_t* qrow = u.q + (size_t)(wq * 32 + r) * u.qstride + 8 * h;
#pragma unroll
        for (int kk = 0; kk < DQ / 16; ++kk) qf[kk] = *(const bf16x8_t*)(qrow + kk * 16);
    }
    if constexpr (QNORM) {
        float ss = 0.f;
#pragma unroll
        for (int kk = 0; kk < DQ / 16; ++kk) { float t8[8]; unpack8(__builtin_bit_cast(uint4, qf[kk]), t8);
#pragma unroll
            for (int i = 0; i < 8; ++i) ss += t8[i] * t8[i]; }
        ss += __shfl_xor(ss, 32);
        const float rr = rsqrtf(ss / (float)DQ + EPS);
        const float* gl = ldsf + QG_OFF / 4 + 8 * h;
#pragma unroll 1
        for (int g = 0; g < DQ / 64; ++g) {
#pragma unroll
            for (int j = 0; j < 4; ++j) {
                const float4 g0 = *(const float4*)(gl + (g * 4 + j) * 16), g1 = *(const float4*)(gl + (g * 4 + j) * 16 + 4);
                float t8[8]; unpack8(__builtin_bit_cast(uint4, qf[j]), t8);
                t8[0] *= rr * g0.x; t8[1] *= rr * g0.y; t8[2] *= rr * g0.z; t8[3] *= rr * g0.w; t8[4] *= rr * g1.x; t8[5] *= rr * g1.y; t8[6] *= rr * g1.z; t8[7] *= rr * g1.w;
                qf[j] = __builtin_bit_cast(bf16x8_t, pack8(t8));
            }
            bf16x8_t t0 = qf[0], t1 = qf[1], t2 = qf[2], t3 = qf[3];
#pragma unroll
            for (int k2 = 0; k2 + 4 < DQ / 16; ++k2) qf[k2] = qf[k2 + 4];
            qf[DQ / 16 - 4] = t0; qf[DQ / 16 - 3] = t1; qf[DQ / 16 - 2] = t2; qf[DQ / 16 - 1] = t3;
        }
        if (u.rope) {
            const float* cs = u.rope + (size_t)(u.pos0 + wq * 32 + r) * 64 + 8 * h;
#pragma unroll
            for (int k2 = 0; k2 < 2; ++k2) {
                const float4 c0 = *(const float4*)(cs + k2 * 16), c1 = *(const float4*)(cs + k2 * 16 + 4), s0 = *(const float4*)(cs + 32 + k2 * 16), s1 = *(const float4*)(cs + 32 + k2 * 16 + 4);
                const float cv[8] = {c0.x, c0.y, c0.z, c0.w, c1.x, c1.y, c1.z, c1.w}, sn[8] = {s0.x, s0.y, s0.z, s0.w, s1.x, s1.y, s1.z, s1.w};
                float x1[8], x2[8];
                unpack8(__builtin_bit_cast(uint4, qf[8 + k2]), x1); unpack8(__builtin_bit_cast(uint4, qf[10 + k2]), x2);
#pragma unroll
                for (int i = 0; i < 8; ++i) { const float a = x1[i], b = x2[i]; x1[i] = a * cv[i] - b * sn[i]; x2[i] = a * sn[i] + b * cv[i]; }
                qf[8 + k2] = __builtin_bit_cast(bf16x8_t, pack8(x1)); qf[10 + k2] = __builtin_bit_cast(bf16x8_t, pack8(x2));
            }
        }
    }
    f32x16_t ot[4];
#pragma unroll
    for (int b = 0; b < 4; ++b)
#pragma unroll
        for (int i = 0; i < 16; ++i) ot[b][i] = 0.f;
    float m = -INFINITY, l = 0.f;
    const float sc2 = u.scale * 1.4426950408889634f;
    const int myqr = u.row0 + (w >> 1), myc0 = (w & 1) * 32, myrs = min(max(myqr - 4, 0), 8);
    const int nst = u.nst0 + u.nst1;
    uint4 kr0, kr1, kr2, vr0, vr1;
    kr2 = make_uint4(0u, 0u, 0u, 0u);
    const int krow0 = tid / KCH, kcol0 = tid % KCH, krow1 = (tid + NTHREADS) / KCH, kcol1 = (tid + NTHREADS) % KCH, krow2 = (tid + 2 * NTHREADS) / KCH, kcol2 = (tid + 2 * NTHREADS) % KCH;
    const int vrow0 = tid >> 4, vc0 = tid & 15;
    const int voff = (4 * h + ((lane & 15) >> 2)) * VROW + (16 * ((lane >> 4) & 1) + 4 * (lane & 3)) * 2;
#define STAGE_LOAD(s_) do { const int s__ = (s_); const bf16_t *kp, *vp; int ks, ldv; \
        if (s__ < u.nst0) { kp = u.k0 + (size_t)s__ * 64 * u.ks0; ks = u.ks0; vp = u.vt0 + (size_t)s__ * 64 * u.ldv0; ldv = u.ldv0; } \
        else { const int s1 = s__ - u.nst0; kp = u.k1 + (size_t)s1 * 64 * u.ks1; ks = u.ks1; vp = u.vt1 + (size_t)s1 * 64 * u.ldv1; ldv = u.ldv1; } \
        kr0 = *(const uint4*)(kp + (size_t)krow0 * ks + kcol0 * 8); kr1 = *(const uint4*)(kp + (size_t)krow1 * ks + kcol1 * 8); \
        if constexpr (NKC == 3) kr2 = *(const uint4*)(kp + (size_t)krow2 * ks + kcol2 * 8); \
        vr0 = *(const uint4*)(vp + (size_t)vrow0 * ldv + vc0 * 8); vr1 = *(const uint4*)(vp + (size_t)(vrow0 + 32) * ldv + vc0 * 8); } while (0)
#define STAGE_STORE(buf_) do { unsigned char* base = lds + (buf_) * STAGE; \
        *(uint4*)(base + krow0 * KROW + kcol0 * 16) = kr0; *(uint4*)(base + krow1 * KROW + kcol1 * 16) = kr1; \
        if constexpr (NKC == 3) *(uint4*)(base + krow2 * KROW + kcol2 * 16) = kr2; \
        *(uint4*)(base + KBYTES + vrow0 * VROW + vc0 * 16) = vr0; *(uint4*)(base + KBYTES + (vrow0 + 32) * VROW + vc0 * 16) = vr1; } while (0)
    if (__builtin_amdgcn_readfirstlane(w) >= 4) __builtin_amdgcn_s_setprio(2);
    STAGE_LOAD(0); STAGE_STORE(0);
    __syncthreads();
    for (int s = 0; s < nst; ++s) {
        if (s + 1 < nst) STAGE_LOAD(s + 1);
        const unsigned char* kb = lds + (s & 1) * STAGE;
        const unsigned char* vb = kb + KBYTES;
        int lrow = -1; bool active = true;
        if (LOCAL && s >= u.nst0) { lrow = u.rs_min + (s - u.nst0); active = lrow >= myrs && lrow < myrs + 8; }
        if (active)
#pragma unroll
        for (int si = 0; si < (SPLIT ? 1 : 2); ++si) {
            const int sub = SPLIT ? kh : si;
            f32x16_t st;
#pragma unroll
            for (int i = 0; i < 16; ++i) st[i] = 0.f;
            {
                const unsigned char* krow = kb + (sub * 32 + r) * KROW + 16 * h;
                constexpr int NKK = DQ / 16;
                bf16x8_t kf[NKK];
#pragma unroll
                for (int kk = 0; kk < QK_AHEAD; ++kk) kf[kk] = *(const bf16x8_t*)(krow + kk * 32);
                __builtin_amdgcn_sched_barrier(0);
#pragma unroll
                for (int kk = 0; kk < NKK; kk += 2) {
                    if (kk + QK_AHEAD < NKK) { kf[kk + QK_AHEAD] = *(const bf16x8_t*)(krow + (kk + QK_AHEAD) * 32); kf[kk + QK_AHEAD + 1] = *(const bf16x8_t*)(krow + (kk + QK_AHEAD + 1) * 32); }
                    st = MFMA32(kf[kk], qf[kk], st); st = MFMA32(kf[kk + 1], qf[kk + 1], st);
                    __builtin_amdgcn_sched_barrier(0);
                }
            }
            float sv[16], mx = -INFINITY, kf_ = 1.f;
            if (LOCAL && lrow >= 0) {
                const int qc = myc0 + r, cs = min(max(qc - 8, 0), 48);
                const float* brow = u.bias + (lrow - myqr + 7) * 31 + (15 - qc);
#pragma unroll
                for (int i = 0; i < 16; ++i) {
                    const int kc = sub * 32 + crow(i, h);
                    const bool valid = kc >= cs && kc < cs + 16;
                    const float bv = valid ? brow[kc] * 1.4426950408889634f : 0.f;
                    sv[i] = valid ? st[i] * sc2 + bv : -INFINITY; mx = fmaxf(mx, sv[i]);
                }
            } else {
#pragma unroll
                for (int i = 0; i < 16; ++i) { sv[i] = st[i]; mx = fmaxf(mx, st[i]); }
                mx *= sc2; kf_ = sc2;
            }
            { const auto mxs = __builtin_amdgcn_permlane32_swap(__float_as_uint(mx), __float_as_uint(mx), false, false); mx = fmaxf(__uint_as_float(mxs[0]), __uint_as_float(mxs[1])); }
            const float mnew = mx > m + 8.f ? mx : m;
            const bool grew = mnew > m;
            const float alpha = __builtin_amdgcn_exp2f(m - mnew);
            m = mnew;
            float ls = 0.f;
#pragma unroll
            for (int i = 0; i < 16; ++i) { sv[i] = __builtin_amdgcn_exp2f(__builtin_fmaf(sv[i], kf_, -mnew)); ls += sv[i]; }
            l = l * alpha + ls;
            if (__any(grew)) {
#pragma unroll
                for (int b = 0; b < 4; ++b)
#pragma unroll
                    for (int i = 0; i < 16; ++i) ot[b][i] *= alpha;
            }
            {
                bf16x8_t xs[2];
#pragma unroll
                for (int s2 = 0; s2 < 2; ++s2) {
                    uint4 pk; pk.x = cvtpk(sv[8 * s2 + 0], sv[8 * s2 + 1]); pk.y = cvtpk(sv[8 * s2 + 2], sv[8 * s2 + 3]); pk.z = cvtpk(sv[8 * s2 + 4], sv[8 * s2 + 5]); pk.w = cvtpk(sv[8 * s2 + 6], sv[8 * s2 + 7]);
                    xs[s2] = __builtin_bit_cast(bf16x8_t, pk);
                }
                const unsigned char* va0 = vb + voff + sub * 32 * VROW;
#define VFRAG(j_) __builtin_shufflevector(__builtin_amdgcn_ds_read_tr16_b64_v4i16((lds_bf16x4_t*)(va0 + 16 * ((j_) >> 2) * VROW + 64 * ((j_) & 3))), \
                                          __builtin_amdgcn_ds_read_tr16_b64_v4i16((lds_bf16x4_t*)(va0 + (16 * ((j_) >> 2) + 8) * VROW + 64 * ((j_) & 3))), 0, 1, 2, 3, 4, 5, 6, 7)
                bf16x8_t vf[8];
#pragma unroll
                for (int j = 0; j < PV_AHEAD; ++j) vf[j] = VFRAG(j);
                __builtin_amdgcn_sched_barrier(0);
#pragma unroll
                for (int j = 0; j < 8; j += 2) {
                    if (j + PV_AHEAD < 8) { vf[j + PV_AHEAD] = VFRAG(j + PV_AHEAD); vf[j + PV_AHEAD + 1] = VFRAG(j + PV_AHEAD + 1); }
                    ot[j & 3] = MFMA32(vf[j], xs[j >> 2], ot[j & 3]); ot[(j + 1) & 3] = MFMA32(vf[j + 1], xs[(j + 1) >> 2], ot[(j + 1) & 3]);
                    __builtin_amdgcn_sched_barrier(0);
                }
#undef VFRAG
            }
        }
        if (s + 1 < nst) STAGE_STORE((s + 1) & 1);
        __syncthreads();
    }
    __builtin_amdgcn_s_setprio(0);
    if constexpr (SPLIT) {
        float* mg = ldsf + (size_t)wq * 66 * 64 + lane;
        if (kh) {
#pragma unroll
            for (int b = 0; b < 4; ++b)
#pragma unroll
                for (int i = 0; i < 16; ++i) mg[(b * 16 + i) * 64] = ot[b][i];
            mg[64 * 64] = m; mg[65 * 64] = l;
        }
        __syncthreads();
        if (!kh) {
            const float mo = mg[64 * 64], lo_ = mg[65 * 64];
            const float mm = fmaxf(m, mo), fa = __builtin_amdgcn_exp2f(m - mm), fb = __builtin_amdgcn_exp2f(mo - mm);
            l = l * fa + lo_ * fb;
#pragma unroll
            for (int b = 0; b < 4; ++b)
#pragma unroll
                for (int i = 0; i < 16; ++i) ot[b][i] = ot[b][i] * fa + mg[(b * 16 + i) * 64] * fb;
        }
        __syncthreads();
        if (kh) return;
    }
    l += __shfl_xor(l, 32);
    const float inv = 1.f / l;
    bf16_t* orow = u.out + (size_t)(wq * 32 + r) * D;
#pragma unroll
    for (int b = 0; b < 4; ++b)
#pragma unroll
        for (int g = 0; g < 4; ++g)
            *(uint2*)(orow + 32 * b + 8 * g + 4 * h) = make_uint2(cvtpk(ot[b][4 * g] * inv, ot[b][4 * g + 1] * inv), cvtpk(ot[b][4 * g + 2] * inv, ot[b][4 * g + 3] * inv));
}
#undef STAGE_LOAD
#undef STAGE_STORE
DEVI void attn_block_dispatch(CParams& p, int layer, int kind, int idx, float* lds) {
    AttnBlk u;
    u.k1 = nullptr; u.vt1 = nullptr; u.ks1 = 0; u.ldv1 = 0; u.nst1 = 0; u.bias = nullptr; u.row0 = 0; u.rs_min = 0; u.qg = nullptr; u.rope = nullptr; u.pos0 = 0;
    if (kind == 1) {
        const int qb = idx % 4, h = (idx / 4) % 4, b = idx / 16, t0 = NCTX + b * DS + qb * 256;
        const int rlo = min(max(4 * qb - 4, 0), 8), rhi = min(max(4 * qb + 3 - 4, 0), 8) + 8;
        u.q = p.qna_b + (size_t)t0 * 512 + h * 128; u.qstride = 512; u.scale = 0.08838834764831845f;
        u.k0 = p.cnak_b + ((size_t)(b * 4 + h) * PAST) * 128; u.ks0 = 128; u.vt0 = p.cnav_b + ((size_t)(b * 4 + h) * PAST) * 128; u.ldv0 = 128; u.nst0 = PAST / 64;
        u.k1 = p.kna_b + (size_t)(NCTX + b * DS + rlo * 64) * 512 + h * 128; u.ks1 = 512; u.vt1 = p.z_b + (size_t)(NCTX + b * DS + rlo * 64) * DIN + O_NAV + h * 128; u.ldv1 = DIN; u.nst1 = rhi - rlo;
        u.bias = p.rel_bias + ((size_t)layer * 4 + h) * 15 * 31; u.row0 = 4 * qb; u.rs_min = rlo;
        u.out = p.mix_b + (size_t)t0 * D + 1024 + h * 128;
        attn_block<128, true, false, false>(u, lds);
    } else if (kind == 0) {
        const int qb = idx % 8, h = (idx / 8) % 8, b = idx / 64, t0 = NCTX + b * DS + qb * 128;
        u.q = p.qm_b + (size_t)t0 * 1536 + h * 192; u.qstride = 1536; u.scale = 0.07216878364870322f; u.qg = p.q_head_g + layer * 192; u.rope = p.rope_cs; u.pos0 = qb * 128;
        u.k0 = p.k_b + (size_t)(T + b * PAST) * 1536 + h * 192; u.ks0 = 1536; u.vt0 = p.kvr_b + (size_t)(T + b * PAST) * 2048 + h * 256 + 128; u.ldv0 = 2048; u.nst0 = PAST / 64;
        u.k1 = p.k_b + (size_t)(NCTX + b * DS) * 1536 + h * 192; u.ks1 = 1536; u.vt1 = p.kvr_b + (size_t)(NCTX + b * DS) * 2048 + h * 256 + 128; u.ldv1 = 2048; u.nst1 = DS / 64;
        u.out = p.mix_b + (size_t)t0 * D + h * 128;
        attn_block<192, false, true, true>(u, lds);
    } else if (kind == 2) {
        const int h = idx % 8, b = idx / 8, t0 = b * SEQ;
        u.q = p.qm_b + (size_t)t0 * 1536 + h * 192; u.qstride = 1536; u.scale = 0.07216878364870322f; u.qg = p.q_head_g + layer * 192;
        u.k0 = p.k_b + (size_t)t0 * 1536 + h * 192; u.ks0 = 1536; u.vt0 = p.kvr_b + (size_t)t0 * 2048 + h * 256 + 128; u.ldv0 = 2048; u.nst0 = SEQ / 64;
        u.out = p.mix_b + (size_t)t0 * D + h * 128;
        attn_block<192, false, true, false>(u, lds);
    } else {
        const int h = idx % 4, b = idx / 4, t0 = b * SEQ;
        u.q = p.qna_b + (size_t)t0 * 512 + h * 128; u.qstride = 512; u.scale = 0.08838834764831845f;
        u.k0 = p.kna_b + (size_t)t0 * 512 + h * 128; u.ks0 = 512; u.vt0 = p.z_b + (size_t)t0 * DIN + O_NAV + h * 128; u.ldv0 = DIN; u.nst0 = SEQ / 64;
        u.out = p.mix_b + (size_t)t0 * D + 1024 + h * 128;
        attn_block<128, false, false, false>(u, lds);
    }
}
#ifndef ATTN_ROLE
#define ATTN_ROLE 0
#endif
DEVI void phase_attn(CParams& p, int layer, int bid, int nb, float* lds, int rep = 0) {
    const int role = rep ? ATTN_ROLE : 0;
    constexpr int N_LNA = DB * 4 * (DS / 256), N_HV = DB * 8 * (DS / 128), N_CM = BATCH * 8, N_CN = BATCH * 4;
    const int nA = nb / 8, nH = nb / 2, nL = nb - nA - nH;
    if (tidx() < 192) lds[QG_OFF / 4 + tidx()] = p.q_head_g[layer * 192 + tidx()];
    __syncthreads();
    if (bid < nA) {
        if (role != 0 && role != 1) return;
        for (int it = bid; it < N_LNA; it += nA) attn_block_dispatch(p, layer, 1, it, lds);
    } else if (bid < nA + nH) {
        if (role != 0 && role != 2) return;
        for (int it = bid - nA; it < N_HV; it += nH) attn_block_dispatch(p, layer, 0, it, lds);
        if (bid - nA < N_CN) attn_block_dispatch(p, layer, 3, bid - nA, lds);
    } else {
        if (role != 0 && role != 3) return;
        const int ncn0 = nH < N_CN ? nH : N_CN;
        for (int it = bid - nA - nH; it < N_CM + N_CN - ncn0; it += nL) {
            if (it < N_CM) attn_block_dispatch(p, layer, 2, it, lds); else attn_block_dispatch(p, layer, 3, ncn0 + it - N_CM, lds);
        }
    }
}

template <int N, int K, int J>
DEVI void bitonic_stage(float (&v)[N]) {
#pragma unroll
    for (int i = 0; i < N; ++i) {
        const int l = i ^ J;
        if (l > i) { const bool desc = ((i & K) == 0); const float a = v[i], b = v[l], mx = fmaxf(a, b), mn = fminf(a, b); v[i] = desc ? mx : mn; v[l] = desc ? mn : mx; }
    }
}
template <int N, int K, int J> DEVI void bitonic_j(float (&v)[N]) { bitonic_stage<N, K, J>(v); if constexpr (J > 1) bitonic_j<N, K, J / 2>(v); }
template <int N, int K> DEVI void bitonic_k(float (&v)[N]) { bitonic_j<N, K, K / 2>(v); if constexpr (K < N) bitonic_k<N, K * 2>(v); }
template <int N> DEVI void bitonic_sort_desc(float (&v)[N]) { bitonic_k<N, 2>(v); }
DEVI void merge_top16(float (&a)[16], const float (&b)[16]) {
#pragma unroll
    for (int i = 0; i < 16; ++i) a[i] = fmaxf(a[i], b[15 - i]);
    bitonic_j<16, 16, 8>(a);
}
constexpr int cand_ab(int idx) { int n = 0; for (int a = 0; a < 16; ++a) for (int b = 0; b < 16; ++b) if ((a + 1) * (b + 1) <= 16) { if (n == idx) return a * 16 + b; ++n; } return -1; }
template <int CH, int I>
DEVI void cand_fill(float (&c)[16], const float (&s1)[16], const float (&s2)[16]) {
    constexpr int ab = cand_ab(CH * 16 + I);
    if constexpr (ab >= 0) c[I] = __uint_as_float((__float_as_uint(s1[ab >> 4] + s2[ab & 15]) & ~255u) | (unsigned)ab); else c[I] = -INFINITY;
    if constexpr (I + 1 < 16) cand_fill<CH, I + 1>(c, s1, s2);
}
DEVI float packkey(float v, unsigned id, unsigned mask) { return __uint_as_float((__float_as_uint(v) & ~mask) | id); }

DEVI void phase_route(CParams& p, int layer, int bid, int nb, float* lds) {
    const int lane = tidx() & 63, w = __builtin_amdgcn_readfirstlane(tidx() >> 6), r = lane & 31, h = lane >> 5;
    constexpr int SKROW = 272;
    unsigned char* skl = (unsigned char*)lds;
    unsigned char* ix = skl + 256 * SKROW + w * 2048;
    const int nparts = nb / 8, hh = bid & 7, part = bid >> 3;
    if (part >= nparts) return;
    constexpr int NTILE = T / 32;
    const int per = (NTILE + nparts - 1) / nparts, tile_lo = part * per, tile_hi = min(NTILE, tile_lo + per);
    {
        const bf16_t* src = p.sk_b + ((size_t)layer * 8 + hh) * 2 * 128 * 128;
        for (int c = tidx(); c < 256 * 16; c += NTHREADS) { const int row = c >> 4, ch = c & 15; *(uint4*)(skl + row * SKROW + ch * 16) = *(const uint4*)(src + (size_t)row * 128 + ch * 8); }
    }
    __syncthreads();
    for (int tt = tile_lo + w; tt < tile_hi; tt += NWAVES) {
        const int t0 = tt * 32;
        float s12[2][16];
#pragma unroll
        for (int pp = 0; pp < 2; ++pp) {
            bf16x8_t qf[8];
            const bf16_t* qrow = p.qp_b + (size_t)(t0 + r) * D + hh * 256 + pp * 128 + 8 * h;
#pragma unroll
            for (int kk = 0; kk < 8; ++kk) qf[kk] = *(const bf16x8_t*)(qrow + kk * 16);
            const unsigned char* sk = skl + (pp * 128 + r) * SKROW + 16 * h;
            float top[16];
#pragma unroll
            for (int i = 0; i < 16; ++i) top[i] = -INFINITY;
#pragma unroll 1
            for (int blk = 0; blk < 4; ++blk) {
                const unsigned char* skb = sk + blk * 32 * SKROW;
                f32x16_t acc;
#pragma unroll
                for (int i = 0; i < 16; ++i) acc[i] = 0.f;
                {
                    bf16x8_t sf[8];
#pragma unroll
                    for (int kk = 0; kk < 4; ++kk) sf[kk] = *(const bf16x8_t*)(skb + kk * 32);
                    __builtin_amdgcn_sched_barrier(0);
#pragma unroll
                    for (int kk = 0; kk < 8; kk += 2) {
                        if (kk + 4 < 8) { sf[kk + 4] = *(const bf16x8_t*)(skb + (kk + 4) * 32); sf[kk + 5] = *(const bf16x8_t*)(skb + (kk + 5) * 32); }
                        acc = MFMA32(sf[kk], qf[kk], acc); acc = MFMA32(sf[kk + 1], qf[kk + 1], acc);
                        __builtin_amdgcn_sched_barrier(0);
                    }
                }
                float c[16];
#pragma unroll
                for (int i = 0; i < 16; ++i) c[i] = packkey(acc[i], (unsigned)(32 * blk + crow(i, h)), 127u);
                bitonic_sort_desc<16>(c);
                merge_top16(top, c);
            }
            float o[16];
#pragma unroll
            for (int i = 0; i < 16; ++i) { const auto sw = __builtin_amdgcn_permlane32_swap(__float_as_uint(top[i]), __float_as_uint(top[i]), false, false); top[i] = __uint_as_float(sw[0]); o[i] = __uint_as_float(sw[1]); }
            merge_top16(top, o);
#pragma unroll
            for (int i = 0; i < 16; ++i) { s12[pp][i] = top[i]; ix[(pp * 16 + i) * 64 + lane] = (unsigned char)(__float_as_uint(top[i]) & 127u); }
        }
        float best[16];
        {
            float c[16];
            cand_fill<0, 0>(best, s12[0], s12[1]); bitonic_sort_desc<16>(best);
            cand_fill<1, 0>(c, s12[0], s12[1]); bitonic_sort_desc<16>(c); merge_top16(best, c);
            cand_fill<2, 0>(c, s12[0], s12[1]); bitonic_sort_desc<16>(c); merge_top16(best, c);
            cand_fill<3, 0>(c, s12[0], s12[1]); bitonic_sort_desc<16>(c); merge_top16(best, c);
        }
        __builtin_amdgcn_wave_barrier();
        float g[16], sum = 0.f; int ex[16];
        const float mx = __uint_as_float(__float_as_uint(best[0]) & ~255u);
#pragma unroll
        for (int k = 0; k < 16; ++k) {
            const unsigned bits = __float_as_uint(best[k]), id = bits & 255u;
            g[k] = __expf(__uint_as_float(bits & ~255u) - mx); sum += g[k];
            ex[k] = (int)ix[(id >> 4) * 64 + lane] * 128 + (int)ix[(16 + (id & 15)) * 64 + lane];
        }
        const float inv = 1.f / sum;
        if (h == 0) {
            int* eo = p.eidx + (size_t)(t0 + r) * 128 + hh * 16; float* go = p.gate + (size_t)(t0 + r) * 128 + hh * 16;
#pragma unroll
            for (int k = 0; k < 16; k += 4) { *(int4*)(eo + k) = make_int4(ex[k], ex[k + 1], ex[k + 2], ex[k + 3]); *(float4*)(go + k) = make_float4(g[k] * inv, g[k + 1] * inv, g[k + 2] * inv, g[k + 3] * inv); }
        }
        __builtin_amdgcn_wave_barrier();
    }
}

typedef float f32x2v __attribute__((ext_vector_type(2)));
typedef float f32x4v __attribute__((ext_vector_type(4)));
constexpr int EXP_TOK = 5, EXP_SROW = 144, EXP_STAGE = 64 * EXP_SROW, EXP_EI_OFF = EXP_STAGE, EXP_AU_OFF = EXP_EI_OFF + 2560, EXP_WAVE_LDS = EXP_AU_OFF + 2560;
DEVI float gelu_exact(float v) { return 0.5f * v * (1.f + erff(v * 0.70710678118654752f)); }
DEVI long mk64(unsigned lo, unsigned hi) { return (long)(((unsigned long)hi << 32) | lo); }
#ifndef EXP_PROBE
#define EXP_PROBE 0
#endif
struct ExpVL { uint4 v[16]; };
typedef int v8i_t __attribute__((ext_vector_type(8)));
struct ExpUL { uint4 v[8]; uint4 b[4]; };
DEVI void exp_loadu(ExpUL& L, const unsigned char* U, const int* ei, const unsigned char* x8row, int c, int k, int hf, int lane) {
    const int g8 = lane >> 3, s8 = lane & 7, q4 = lane >> 4;
    const unsigned char* Us = U + (size_t)c * 16384 * 128 + s8 * 16;
#pragma unroll
    for (int i = 0; i < 8; ++i) L.v[i] = *(const uint4*)(Us + (size_t)ei[k * 128 + g8 * 16 + hf * 8 + i] * 128);
    const unsigned char* xp = x8row + c * 256 + q4 * 16;
    L.b[0] = *(const uint4*)xp; L.b[1] = *(const uint4*)(xp + 64); L.b[2] = *(const uint4*)(xp + 128); L.b[3] = *(const uint4*)(xp + 192);
}
DEVI void exp_compu(const ExpUL& L, unsigned char* sb, float* au, int k, int hf, int lane) {
    const int g8 = lane >> 3, s8 = lane & 7, r16 = lane & 15, q4 = lane >> 4;
    const v8i_t B0 = {(int)L.b[0].x, (int)L.b[0].y, (int)L.b[0].z, (int)L.b[0].w, (int)L.b[1].x, (int)L.b[1].y, (int)L.b[1].z, (int)L.b[1].w};
    const v8i_t B1 = {(int)L.b[2].x, (int)L.b[2].y, (int)L.b[2].z, (int)L.b[2].w, (int)L.b[3].x, (int)L.b[3].y, (int)L.b[3].z, (int)L.b[3].w};
#pragma unroll
    for (int ii = 0; ii < 8; ++ii) *(uint4*)(sb + (g8 * 8 + ii) * EXP_SROW + s8 * 16) = make_uint4(L.v[ii].x, L.v[ii].y, L.v[ii].z, L.v[ii].w);
    __builtin_amdgcn_wave_barrier();
#pragma unroll
    for (int G = 0; G < 4; ++G) {
        float* ak = au + k * 128 + (2 * G + (q4 >> 1)) * 16 + hf * 8 + 4 * (q4 & 1);
        const float4 cin = *(const float4*)ak;
        f32x4v acc = {cin.x, cin.y, cin.z, cin.w};
        const unsigned char* ar = sb + (G * 16 + r16) * EXP_SROW + q4 * 16;
        const uint4 a0 = *(const uint4*)ar, a1 = *(const uint4*)(ar + 64);
        const v8i_t A0 = {(int)a0.x, (int)a0.y, (int)a0.z, (int)a0.w, 0, 0, 0, 0}, A1 = {(int)a1.x, (int)a1.y, (int)a1.z, (int)a1.w, 0, 0, 0, 0};
        acc = __builtin_amdgcn_mfma_scale_f32_16x16x128_f8f6f4(A0, B0, acc, 4, 0, 0, 0x7F7F7F7F, 0, 0x7F7F7F7F);
        acc = __builtin_amdgcn_mfma_scale_f32_16x16x128_f8f6f4(A1, B1, acc, 4, 0, 0, 0x7F7F7F7F, 0, 0x7F7F7F7F);
        if (r16 == 0) *(float4*)ak = make_float4(acc[0], acc[1], acc[2], acc[3]);
    }
    __builtin_amdgcn_wave_barrier();
}
DEVI void exp_loadv(ExpVL& L, const unsigned char* V, const int* ei, int c, int k, int g8, int s8) {
    const unsigned char* Vs = V + (size_t)c * 16384 * 128 + s8 * 16;
#pragma unroll
    for (int i = 0; i < 16; ++i) L.v[i] = *(const uint4*)(Vs + (size_t)ei[k * 128 + g8 * 16 + i] * 128);
}
DEVI float dpp_ror8(float v) { return __builtin_bit_cast(float, __builtin_amdgcn_update_dpp(0, __builtin_bit_cast(int, v), 0x128, 0xf, 0xf, false)); }
DEVI void exp_compv(const ExpVL& L, const float* wl, bf16_t* xrow_, float* yrow_, const float* g2row, float* ssq, int c, int k, int g8, int s8, bool b5, bool b4, bool b3, bool do_store) {
    const int col = c * 256 + s8 * 32 + 4 * g8;
    const uint2 xq = *(const uint2*)(xrow_ + col); const float4 g2 = *(const float4*)(g2row + col);
    const float4 x1 = make_float4(__uint_as_float(xq.x << 16), __uint_as_float(xq.x & 0xffff0000u), __uint_as_float(xq.y << 16), __uint_as_float(xq.y & 0xffff0000u));
    f32x2v o[16];
#pragma unroll
    for (int j = 0; j < 16; ++j) o[j] = (f32x2v){0.f, 0.f};
#pragma unroll
    for (int i = 0; i < 16; ++i) {
        const float wg1 = wl[k * 128 + g8 * 16 + i]; const f32x2v wg = {wg1, wg1};
        const unsigned qq[4] = {L.v[i].x, L.v[i].y, L.v[i].z, L.v[i].w};
#pragma unroll
        for (int d = 0; d < 4; ++d) {
            o[4 * d + 0] = __builtin_elementwise_fma(__builtin_amdgcn_cvt_scalef32_pk_f32_fp4(qq[d], 1.0f, 0), wg, o[4 * d + 0]);
            o[4 * d + 1] = __builtin_elementwise_fma(__builtin_amdgcn_cvt_scalef32_pk_f32_fp4(qq[d], 1.0f, 1), wg, o[4 * d + 1]);
            o[4 * d + 2] = __builtin_elementwise_fma(__builtin_amdgcn_cvt_scalef32_pk_f32_fp4(qq[d], 1.0f, 2), wg, o[4 * d + 2]);
            o[4 * d + 3] = __builtin_elementwise_fma(__builtin_amdgcn_cvt_scalef32_pk_f32_fp4(qq[d], 1.0f, 3), wg, o[4 * d + 3]);
        }
    }
    f32x2v r8[8];
#pragma unroll
    for (int j = 0; j < 8; ++j) {
        const auto sx = __builtin_amdgcn_permlane32_swap(__float_as_uint(o[j].x), __float_as_uint(o[8 + j].x), false, false);
        const auto sy = __builtin_amdgcn_permlane32_swap(__float_as_uint(o[j].y), __float_as_uint(o[8 + j].y), false, false);
        r8[j] = (f32x2v){__uint_as_float(sx[0]) + __uint_as_float(sx[1]), __uint_as_float(sy[0]) + __uint_as_float(sy[1])};
    }
    f32x2v r4[4];
#pragma unroll
    for (int j = 0; j < 4; ++j) {
        const auto sx = __builtin_amdgcn_permlane16_swap(__float_as_uint(r8[j].x), __float_as_uint(r8[4 + j].x), false, false);
        const auto sy = __builtin_amdgcn_permlane16_swap(__float_as_uint(r8[j].y), __float_as_uint(r8[4 + j].y), false, false);
        r4[j] = (f32x2v){__uint_as_float(sx[0]) + __uint_as_float(sx[1]), __uint_as_float(sy[0]) + __uint_as_float(sy[1])};
    }
    (void)b5; (void)b4;
    f32x2v r2[2];
#pragma unroll
    for (int j = 0; j < 2; ++j) {
        const f32x2v lo = r4[j], hi = r4[2 + j];
        const f32x2v slo = {lo.x + dpp_ror8(lo.x), lo.y + dpp_ror8(lo.y)}, shi = {hi.x + dpp_ror8(hi.x), hi.y + dpp_ror8(hi.y)};
        r2[j] = b3 ? shi : slo;
    }
    const float4 xv = make_float4(x1.x + g2.x * r2[0].x, x1.y + g2.y * r2[0].y, x1.z + g2.z * r2[1].x, x1.w + g2.w * r2[1].y);
    if (do_store) {
        if (yrow_) *(float4*)(yrow_ + col) = xv;
        else {
            const unsigned p0 = cvtpk(xv.x, xv.y), p1 = cvtpk(xv.z, xv.w);
            *(uint2*)(xrow_ + col) = make_uint2(p0, p1);
            const float r0 = __uint_as_float(p0 << 16), r1 = __uint_as_float(p0 & 0xffff0000u), r2 = __uint_as_float(p1 << 16), r3 = __uint_as_float(p1 & 0xffff0000u);
            ssq[k * 64] += (r0 * r0 + r1 * r1) + (r2 * r2 + r3 * r3);
        }
    } else asm volatile("" :: "v"(xv.x), "v"(xv.y), "v"(xv.z), "v"(xv.w));
}
DEVI void phase_experts(CParams& p, int layer, int bid, int nb, float* ldsf) {
    const int w = __builtin_amdgcn_readfirstlane(tidx() >> 6);
    unsigned char* wb = (unsigned char*)ldsf + w * EXP_WAVE_LDS;
    unsigned char* sb = wb;
    float* wl = (float*)wb;
    int* ei = (int*)(wb + EXP_EI_OFF);
    float* au = (float*)(wb + EXP_AU_OFF);
    const unsigned char* U = p.pu8 + (size_t)layer * EXP_NSL * 16384 * 128;
    const unsigned char* V = p.pv8 + (size_t)layer * EXP_NSL * 16384 * 128;
    const float* SU = p.su8 + (size_t)layer * 16384;
    const float* SV = p.sv8 + (size_t)layer * 16384;
    const int gw = bid * NWAVES + w, nw = nb * NWAVES;
#pragma unroll 1
    for (int prep = 0; prep < (EXP_PROBE == 3 ? 2 : 1); ++prep)
    for (int tb = gw; tb < T; tb += nw * EXP_TOK) {
        int nv = 0;
#pragma unroll
        for (int k = 0; k < EXP_TOK; ++k) nv += (tb + k * nw < T) ? 1 : 0;
#pragma unroll 1
        for (int k = 0; k < nv; ++k) {
            const int t = tb + k * nw, lane = tidx() & 63;
#pragma unroll
            for (int j = 0; j < 4; ++j) {
                float f[8]; unpack8(*(const uint4*)(p.hn_b + (size_t)t * D + j * 512 + lane * 8), f);
                int lo = 0, hi = 0;
                lo = __builtin_amdgcn_cvt_pk_fp8_f32(f[0], f[1], lo, false); lo = __builtin_amdgcn_cvt_pk_fp8_f32(f[2], f[3], lo, true);
                hi = __builtin_amdgcn_cvt_pk_fp8_f32(f[4], f[5], hi, false); hi = __builtin_amdgcn_cvt_pk_fp8_f32(f[6], f[7], hi, true);
                *(int2*)(p.x8g + (size_t)t * D + j * 512 + lane * 8) = make_int2(lo, hi);
            }
            *(int2*)(ei + k * 128 + lane * 2) = *(const int2*)(p.eidx + (size_t)t * 128 + lane * 2);
            *(float2*)(au + k * 128 + lane * 2) = make_float2(0.f, 0.f);
        }
        asm volatile("s_waitcnt vmcnt(0)" ::: "memory");
        __builtin_amdgcn_wave_barrier();
        const int nst = EXP_NSL * nv;
        {
        const int lu = tidx() & 63;
#define EXP_X8ROW(k_) (p.x8g + (size_t)(tb + (k_) * nw) * D)
#pragma unroll 1
        for (int urep = 0; urep < (EXP_PROBE == 1 ? 3 : 1); ++urep) {
            ExpUL LA, LB;
            int c = 0, k = 0;
            exp_loadu(LA, U, ei, EXP_X8ROW(0), 0, 0, 0, lu);
#pragma unroll 1
            for (int st = 0; st < nst; ++st) {
                int k1 = k + 1, c1 = c; if (k1 == nv) { k1 = 0; ++c1; }
                if (c1 == EXP_NSL) { c1 = EXP_NSL - 1; k1 = nv - 1; }
                exp_loadu(LB, U, ei, EXP_X8ROW(k), c, k, 1, lu);
                exp_compu(LA, sb, au, k, 0, lu);
                exp_loadu(LA, U, ei, EXP_X8ROW(k1), c1, k1, 0, lu);
                exp_compu(LB, sb, au, k, 1, lu);
                c = c1; k = k1;
            }
            if (EXP_PROBE == 1 && urep < 2) { __builtin_amdgcn_wave_barrier();
#pragma unroll 1
                for (int kk = 0; kk < nv; ++kk) *(float2*)(au + kk * 128 + lu * 2) = make_float2(0.f, 0.f);
                __builtin_amdgcn_wave_barrier(); }
        }
#undef EXP_X8ROW
        }
        __builtin_amdgcn_wave_barrier();
#pragma unroll 1
        for (int k = 0; k < nv; ++k) {
            const int t = tb + k * nw, lane = tidx() & 63;
#pragma unroll
            for (int j = 0; j < 2; ++j) {
                const int slot = lane + 64 * j, idx = ei[k * 128 + slot];
                const float a = au[k * 128 + slot] * SU[idx];
                wl[k * 128 + slot] = p.gate[(size_t)t * 128 + slot] * gelu_exact(a) * SV[idx];
            }
        }
        __builtin_amdgcn_wave_barrier();
        const int lv = tidx() & 63, g8 = lv >> 3, s8 = lv & 7;
        float* ssq = au + lv;
#pragma unroll
        for (int k = 0; k < EXP_TOK; ++k) ssq[k * 64] = 0.f;
        const bool b5 = lv & 32, b4 = lv & 16, b3 = lv & 8;
#pragma unroll 1
        for (int vrep = 0; vrep < (EXP_PROBE == 2 ? 3 : 1); ++vrep) {
            const bool do_store = EXP_PROBE == 3 ? (prep == 1) : ((EXP_PROBE != 2) || vrep == 2);
            ExpVL LA, LB;
            int c = 0, k = 0;
#define EXP_XROW(k_) (p.xb + (size_t)(tb + (k_) * nw) * D)
#define EXP_YROW(k_) (layer + 1 < DEPTH ? (float*)nullptr : p.out + (size_t)(tb + (k_) * nw) * D)
#define EXP_G2ROW(k_) (p.ada + ((size_t)layer * 3 + cond_of(tb + (k_) * nw)) * 6 * D + 5 * D)
            exp_loadv(LA, V, ei, 0, 0, g8, s8);
#pragma unroll 1
            for (int st = 0; st < nst; st += 2) {
                int k1 = k + 1, c1 = c; if (k1 == nv) { k1 = 0; ++c1; }
                int k2 = k1 + 1, c2 = c1; if (k2 == nv) { k2 = 0; ++c2; }
                if (c2 == EXP_NSL) { c2 = EXP_NSL - 1; k2 = nv - 1; }
                exp_loadv(LB, V, ei, c1, k1, g8, s8);
                exp_compv(LA, wl, EXP_XROW(k), EXP_YROW(k), EXP_G2ROW(k), ssq, c, k, g8, s8, b5, b4, b3, do_store);
                exp_loadv(LA, V, ei, c2, k2, g8, s8);
                exp_compv(LB, wl, EXP_XROW(k1), EXP_YROW(k1), EXP_G2ROW(k1), ssq, c1, k1, g8, s8, b5, b4, b3, do_store);
                c = c2; k = k2;
            }
#undef EXP_XROW
#undef EXP_YROW
#undef EXP_G2ROW
        }
        __builtin_amdgcn_wave_barrier();
        if (layer + 1 < DEPTH && (EXP_PROBE != 3 || prep == 1)) {
            asm volatile("s_waitcnt vmcnt(0)" ::: "memory");
#pragma unroll 1
            for (int k = 0; k < nv; ++k) {
                const int t = tb + k * nw, lane = tidx() & 63;
                const float ss = wave_sum(au[k * 64 + lane]);
                const float rr = rsqrtf(ss / D + EPS);
                const float* g = p.norm_mix_g + (size_t)(layer + 1) * D;
                const float* ad = p.ada + ((size_t)(layer + 1) * 3 + cond_of(t)) * 6 * D;
                const unsigned long long* xr = (const unsigned long long*)(p.xb + (size_t)t * D);
#pragma unroll
                for (int j = 0; j < 4; ++j) {
                    const int cb = j * 512 + lane * 8;
                    float xv[8];
#pragma unroll
                    for (int q = 0; q < 2; ++q) { const unsigned long long u2 = __hip_atomic_load(xr + (cb >> 2) + q, __ATOMIC_RELAXED, __HIP_MEMORY_SCOPE_AGENT); const unsigned lo = (unsigned)u2, hi = (unsigned)(u2 >> 32);
                        xv[4 * q] = __uint_as_float(lo << 16); xv[4 * q + 1] = __uint_as_float(lo & 0xffff0000u); xv[4 * q + 2] = __uint_as_float(hi << 16); xv[4 * q + 3] = __uint_as_float(hi & 0xffff0000u); }
                    float hv[8];
#pragma unroll
                    for (int q = 0; q < 2; ++q) {
                        const float4 gg = *(const float4*)(g + cb + q * 4), sh = *(const float4*)(ad + cb + q * 4), sc = *(const float4*)(ad + D + cb + q * 4);
                        hv[q * 4 + 0] = xv[q * 4 + 0] * rr * gg.x * (1.f + sc.x) + sh.x; hv[q * 4 + 1] = xv[q * 4 + 1] * rr * gg.y * (1.f + sc.y) + sh.y;
                        hv[q * 4 + 2] = xv[q * 4 + 2] * rr * gg.z * (1.f + sc.z) + sh.z; hv[q * 4 + 3] = xv[q * 4 + 3] * rr * gg.w * (1.f + sc.w) + sh.w;
                    }
                    *(uint4*)(p.hn_b + (size_t)t * D + cb) = pack8(hv);
                }
            }
        }
        __builtin_amdgcn_wave_barrier();
    }
}

enum { PH_ADA = 0, PH_NORM1, PH_WIN, PH_POSTZ, PH_UQKV, PH_HEADNORM, PH_ATTN, PH_WOUT, PH_NORM2, PH_WQ, PH_SCORES, PH_ROUTE, PH_EXPERTS, PH_COUNT };

DEVI void tail_table_ada(CParams& p, int layer, bool isv, int rk, int nr, float* lds) {
    const int ib = isv ? 24 : 0;
    if (layer + 1 >= DEPTH) { conv_table(p, layer, isv, rk, nr); return; }
    if (nr > 48) {
        if (rk < 24) conv_ada(p, layer + 1, rk, 24, lds, ib, ib + 24); else conv_table(p, layer, isv, rk - 24, nr - 24);
    } else { conv_table(p, layer, isv, rk, nr); conv_ada(p, layer + 1, rk, nr, lds, ib, ib + 24); }
}
template <int PH>
DEVI void run_phase(CParams& p, int layer, int bid, int nb, float* lds, int rep = 0) {
    if constexpr (PH == PH_ADA) phase_prologue(p, bid, nb, lds);
    if constexpr (PH == PH_NORM1) phase_modnorm(p, layer, 0, bid, nb);
    if constexpr (PH == PH_WIN) {
        int rk = 0, nr = 1; const bool idle = rep == 0 && gemm_idle_rank((T / 256) * (DINP / 256), bid, nb, rk, nr);
        const bool first = idle && (rk & 1);
        if (first) { conv_weights(p, layer, 1, rk, nr, lds); if (layer + 1 < DEPTH) conv_weights(p, layer + 1, 0, rk, nr, lds); __syncthreads(); }
        mfma_gemm(p.hn_b, p.wt_in + (size_t)layer * DINP * D, T, DINP, D, EpiBf16Store{p.z_b, DIN, DIN}, bid, nb, lds);
        if (idle && !first) { conv_weights(p, layer, 1, rk, nr, lds); if (layer + 1 < DEPTH) conv_weights(p, layer + 1, 0, rk, nr, lds); } }
    if constexpr (PH == PH_POSTZ) phase_postz(p, layer, bid, nb);
    if constexpr (PH == PH_UQKV) {
        mfma_gemm(p.cqn_b, p.wt_uq + (size_t)layer * 1536 * 512, T, 1536, 512, EpiBf16Store{p.qm_b, 1536, 1536}, bid, nb, lds);
        mfma_gemm(p.ckv_b, p.wt_ukv + (size_t)layer * 2048 * 256, TKV, 2048, 256, EpiBf16Store{p.kvr_b, 2048, 2048}, bid, nb, lds);
    }
    if constexpr (PH == PH_HEADNORM) phase_headnorm(p, layer, bid, nb, lds);
    if constexpr (PH == PH_ATTN) phase_attn(p, layer, bid, nb, lds, rep);
    if constexpr (PH == PH_WOUT) {
        int rk = 0, nr = 1; const bool idle = rep == 0 && gemm_idle_rank((T / 256) * (D / 256), bid, nb, rk, nr);
        const bool first = idle && (rk & 1);
        if (first) { tail_table_ada(p, layer, false, rk, nr, lds); __syncthreads(); }
        mfma_gemm(p.mix_b, p.wt_out + (size_t)layer * D * D, T, D, D, EpiResidMF{&p, layer}, bid, nb, lds);
        if (idle && !first) tail_table_ada(p, layer, false, rk, nr, lds); }
    if constexpr (PH == PH_NORM2) phase_modnorm(p, layer, 1, bid, nb);
    if constexpr (PH == PH_WQ) {
        int rk = 0, nr = 1; const bool idle = rep == 0 && gemm_idle_rank((T / 256) * (D / 256), bid, nb, rk, nr);
        const bool first = idle && (rk & 1);
        if (first) { tail_table_ada(p, layer, true, rk, nr, lds); __syncthreads(); }
        mfma_gemm(p.hn_b, p.wt_q + (size_t)layer * D * D, T, D, D, EpiBf16Store{p.qp_b, D, D}, bid, nb, lds);
        if (idle && !first) tail_table_ada(p, layer, true, rk, nr, lds); }
    if constexpr (PH == PH_ROUTE) phase_route(p, layer, bid, nb, lds);
    if constexpr (PH == PH_EXPERTS) phase_experts(p, layer, bid, nb, lds);
}

#ifndef MK_ONE_LAUNCH
#define MK_ONE_LAUNCH 1
#endif
constexpr size_t LDS_BYTES = LDS_TOTAL;

#if MK_ONE_LAUNCH
#ifndef PROBE_MASK
#define PROBE_MASK 0
#endif
#define PHASE1(PH, l, rep_) do { CParams* q_ = pp; asm volatile("" : "+s"(q_)); run_phase<PH>(*q_, l, (int)blockIdx.x, (int)gridDim.x, lds, rep_); \
    XcdBarrier b_; b_.bar = q_->bar; b_.x = xb_xcc_id(); b_.st = (volatile LAS unsigned*)(lds_raw + MISC_OFF); xcd_barrier(b_); } while (0)
#define PHASE(PH, l) do { PHASE1(PH, l, 0); if constexpr ((PROBE_MASK >> PH) & 1) { PHASE1(PH, l, 1); PHASE1(PH, l, 1); } } while (0)
__global__ void __launch_bounds__(NTHREADS, 2) k_fwd(Params p_unused) {
    CParams* pp = (CParams*)__builtin_amdgcn_kernarg_segment_ptr();
    extern __shared__ __attribute__((aligned(16))) unsigned char lds_raw[];
    float* lds = (float*)lds_raw;
    if (threadIdx.x == 0) *(uint4*)(lds_raw + MISC_OFF) = make_uint4(0u, 0u, 0u, 0u);
    __syncthreads();
    (void)xcd_barrier_post(pp->bar, (volatile LAS unsigned*)(lds_raw + MISC_OFF));
    PHASE(PH_ADA, 0);
    for (int l = 0; l < DEPTH; ++l) {
        if (l == 0) PHASE(PH_NORM1, l);
        PHASE(PH_WIN, l);
        PHASE(PH_POSTZ, l);
        PHASE(PH_UQKV, l);
        PHASE(PH_HEADNORM, l);
        PHASE(PH_ATTN, l);
        PHASE(PH_WOUT, l);
#ifdef PROBE_WOUT0
        if (l == 0) { PHASE1(PH_WOUT, l, 1); PHASE1(PH_WOUT, l, 1); }
#endif
        PHASE(PH_NORM2, l);
        PHASE(PH_WQ, l);
        PHASE(PH_ROUTE, l);
        PHASE(PH_EXPERTS, l);
    }
}
#endif

}

extern "C" void kernel_launch(void* const* d_in, const int* in_sizes, int n_in, void* d_out, int out_size, void* d_ws, size_t ws_size, hipStream_t stream) {
    Params p{};
    const float* const* in = (const float* const*)d_in;
    p.x_prompt = in[0]; p.x_sample = in[1]; p.cache_ckv = in[2]; p.cache_kpe = in[3]; p.cache_nak = in[4]; p.cache_nav = in[5]; p.c = in[6]; p.c_ctx = in[7];
    p.ada_w = in[8]; p.ada_b = in[9]; p.norm_mix_g = in[10]; p.norm_ffn_g = in[11]; p.w_in = in[12]; p.q_norm_g = in[13]; p.w_uq = in[14]; p.kv_norm_g = in[15]; p.w_ukv = in[16];
    p.q_head_g = in[17]; p.k_head_g = in[18]; p.naq_g = in[19]; p.nak_g = in[20]; p.rel_bias = in[21]; p.conv_w = in[22]; p.w_out = in[23]; p.peer_wq = in[24]; p.sub_keys = in[25];
    p.peer_u = in[26]; p.peer_v = in[27];
    float* out = (float*)d_out;
    p.out = out;
    p.o_ckv = out + (size_t)T * D;
    p.o_kpe = p.o_ckv + (size_t)BATCH * DEPTH * SEQ * 256;
    p.o_nak = p.o_kpe + (size_t)BATCH * DEPTH * SEQ * 64;
    p.o_nav = p.o_nak + (size_t)BATCH * DEPTH * 4 * SEQ * 128;
    char* ws = (char*)d_ws; size_t off = 0;
    auto carve = [&](size_t bytes) { void* r = ws + off; off += (bytes + 255) & ~(size_t)255; return r; };
    p.bar = (unsigned*)carve(16384);
    p.ada = (float*)carve((size_t)DEPTH * 3 * 6 * D * 4);
    p.z_b = (bf16_t*)carve((size_t)(T + 1) * DIN * 2);
    p.rope_cs = (float*)carve((size_t)DS * 64 * 4);
    p.qm_b = (bf16_t*)carve((size_t)T * 1536 * 2);
    p.kvr_b = (bf16_t*)carve((size_t)TKV * 2048 * 2);
    p.gate = (float*)carve((size_t)T * 128 * 4);
    p.eidx = (int*)carve((size_t)T * 128 * 4);
    p.wt_in = (bf16_t*)carve((size_t)DEPTH * DINP * D * 2);
    p.wt_uq = (bf16_t*)carve((size_t)DEPTH * 1536 * 512 * 2);
    p.wt_ukv = (bf16_t*)carve((size_t)DEPTH * 2048 * 256 * 2);
    p.wt_out = (bf16_t*)carve((size_t)DEPTH * D * D * 2);
    p.wt_q = (bf16_t*)carve((size_t)DEPTH * D * D * 2);
    p.hn_b = (bf16_t*)carve((size_t)T * D * 2);
    p.cqn_b = (bf16_t*)carve((size_t)T * 512 * 2);
    p.ckv_b = (bf16_t*)carve((size_t)TKV * 256 * 2);
    p.mix_b = (bf16_t*)carve((size_t)T * D * 2);
    p.xb = (bf16_t*)carve((size_t)T * D * 2);
    p.x8g = (unsigned char*)carve((size_t)T * D);
    p.qp_b = (bf16_t*)carve((size_t)T * D * 2);
    p.sk_b = (bf16_t*)carve((size_t)DEPTH * 8 * 2 * 128 * 128 * 2);
    p.pu8 = (unsigned char*)carve((size_t)DEPTH * 16384 * D / 2);
    p.pv8 = (unsigned char*)carve((size_t)DEPTH * 16384 * D / 2);
    p.su8 = (float*)carve((size_t)DEPTH * 16384 * 4);
    p.sv8 = (float*)carve((size_t)DEPTH * 16384 * 4);
    p.k_b = (bf16_t*)carve((size_t)TKV * 1536 * 2);
    p.qna_b = (bf16_t*)carve((size_t)T * 512 * 2);
    p.kna_b = (bf16_t*)carve((size_t)T * 512 * 2);
    p.cnak_b = (bf16_t*)carve((size_t)DB * 4 * PAST * 128 * 2);
    p.cnav_b = (bf16_t*)carve((size_t)DB * 4 * PAST * 128 * 2);

#if MK_ONE_LAUNCH
    static int grid = 0;
    if (!grid) {
        int dev = 0, cus = 0, per_cu = 0;
        hipGetDevice(&dev);
        hipDeviceGetAttribute(&cus, hipDeviceAttributeMultiprocessorCount, dev);
        hipFuncSetAttribute((const void*)k_fwd, hipFuncAttributeMaxDynamicSharedMemorySize, (int)LDS_BYTES);
        hipOccupancyMaxActiveBlocksPerMultiprocessor(&per_cu, k_fwd, NTHREADS, LDS_BYTES);
        if (per_cu < 1) per_cu = 1;
        grid = cus * (per_cu < 1 ? per_cu : 1);
    }
    hipMemsetAsync(p.bar, 0, XCD_BAR_WORDS * sizeof(unsigned), stream);
    hipLaunchKernelGGL(k_fwd, dim3(grid), dim3(NTHREADS), LDS_BYTES, stream, p);
#endif
}
```

```cpp
#include <hip/hip_runtime.h>
#include <stdint.h>

#define DEVI __device__ __forceinline__

#define XB_TMO      128
#define XB_XCNT(j)  (256  + 64 * (j))
#define XB_XSUB(j)  (1280 + 64 * (j))
#define XB_XGEN(j)  (2304 + 64 * (j))
#define XB_TOP      3328
#define XB_TOPGEN   3392
#define XCD_BAR_WORDS 3456
#define XB_SPIN_CAP (1u << 18)
#define LAS __attribute__((address_space(3)))

__device__ __forceinline__ unsigned xb_ld(unsigned* p)              { return __hip_atomic_load(p, __ATOMIC_RELAXED, __HIP_MEMORY_SCOPE_AGENT); }
__device__ __forceinline__ unsigned xb_add(unsigned* p, unsigned v) { return __hip_atomic_fetch_add(p, v, __ATOMIC_RELAXED, __HIP_MEMORY_SCOPE_AGENT); }
__device__ __forceinline__ unsigned xb_xcc_id() { return (unsigned)__builtin_amdgcn_s_getreg((3 << 11) | 20) & 0xFu; }
#define XB_SPIN(cond, bar) do { unsigned _sp = 0; while (cond) { __builtin_amdgcn_s_sleep(1); \
    if ((++_sp & 255u) == 0u) { if (xb_ld(&(bar)[XB_TMO])) break; if (_sp > XB_SPIN_CAP) { atomicAdd(&(bar)[XB_TMO], 1u); break; } } } } while (0)

struct XcdBarrier {
    unsigned* bar; unsigned x;
    volatile LAS unsigned* st;
};

__device__ __forceinline__ XcdBarrier xcd_barrier_post(unsigned* bar, volatile LAS unsigned* st) {
    XcdBarrier b; b.bar = bar; b.x = xb_xcc_id(); b.st = st;
    if (threadIdx.x == 0) (void)xb_add(&bar[XB_XCNT(b.x)], 1u);
    return b;
}
__device__ __forceinline__ void xcd_barrier_complete(unsigned* bar, unsigned x, unsigned& nloc, unsigned& nx) {
    const unsigned G = gridDim.x * gridDim.y * gridDim.z;
    unsigned sum, cnt, mine, sp = 0u;
    for (;;) {
        sum = 0u; cnt = 0u; mine = 0u;
#pragma unroll
        for (unsigned j = 0; j < 16; ++j) { const unsigned c = xb_ld(&bar[XB_XCNT(j)]); sum += c; cnt += (c > 0u) ? 1u : 0u; mine = (j == x) ? c : mine; }
        if (sum == G) break;
        __builtin_amdgcn_s_sleep(1);
        if ((++sp & 255u) == 0u) { if (xb_ld(&bar[XB_TMO])) break; if (sp > XB_SPIN_CAP) { atomicAdd(&bar[XB_TMO], 1u); break; } }
    }
    nloc = mine > 0u ? mine : 1u; nx = cnt > 0u ? cnt : 1u;
}

__device__ __forceinline__ void xcd_barrier(const XcdBarrier& b) {
    asm volatile("s_waitcnt vmcnt(0)" ::: "memory");
    __syncthreads();
    if (threadIdx.x == 0) {
        unsigned* bar = b.bar;
        __builtin_amdgcn_s_waitcnt(0);
        unsigned nloc = b.st[0], nx = b.st[1];
        if (nloc == 0u) { xcd_barrier_complete(bar, b.x, nloc, nx); b.st[0] = nloc; b.st[1] = nx; }
        const unsigned old = xb_add(&bar[XB_XSUB(b.x)], 1u);
        const unsigned gen = old / nloc;
        if (old + 1u == (gen + 1u) * nloc) {
            __builtin_amdgcn_fence(__ATOMIC_RELEASE, "agent");
            asm volatile("s_waitcnt vmcnt(0)" ::: "memory");
            const unsigned og = xb_add(&bar[XB_TOP], 1u);
            const unsigned tg = og / nx;
            if (og + 1u == (tg + 1u) * nx) xb_add(&bar[XB_TOPGEN], 1u);
            else XB_SPIN(xb_ld(&bar[XB_TOPGEN]) == tg, bar);
            __builtin_amdgcn_fence(__ATOMIC_ACQUIRE, "agent");
            xb_add(&bar[XB_XGEN(b.x)], 1u);
            asm volatile("s_waitcnt vmcnt(0)" ::: "memory");
        } else {
            XB_SPIN(xb_ld(&bar[XB_XGEN(b.x)]) == gen, bar);
            __builtin_amdgcn_fence(__ATOMIC_ACQUIRE, "agent");
            asm volatile("s_waitcnt vmcnt(0)" ::: "memory");
        }
    }
    __syncthreads();
}


namespace pg8 {
#define PG8_LAS __attribute__((address_space(3)))
typedef unsigned short bf16_t;
typedef short bf16x8 __attribute__((ext_vector_type(8)));
typedef float f32x4 __attribute__((ext_vector_type(4)));
typedef unsigned u32x4 __attribute__((ext_vector_type(4)));
constexpr int BM = 256, BK = 64, HALF = 128, HTB = HALF * BK * 2  , STAGE_BYTES = 8 * HTB, NXCD = 8, WGM = 8;

__host__ __device__ __forceinline__ int lds_byte(int r, int c) { const int st = (r >> 4) * 2 + (c >> 5), rr = r & 15, cc = c & 31, ob = rr * 64 + cc * 2; return st * 1024 + (ob ^ (((ob >> 9) & 1) << 5)); }
__host__ __device__ __forceinline__ void stage_rc(int b, int& R, int& C) { const int st = b / 1024, sb = b % 1024, swz = sb ^ (((sb >> 9) & 1) << 5); R = (st >> 1) * 16 + swz / 64; C = (st & 1) * 32 + (swz % 64) / 2; }
__host__ __device__ __forceinline__ int perm32(int rho) { const int n = rho >> 4, i = rho & 15; return 8 * (i >> 2) + 4 * n + (i & 3); }

struct Unit { int pm, pn; };
struct Gemm { const bf16_t* A; const bf16_t* Bt; int M, N, K; };

struct StaticOrder {
    int nM, nN, nwg, G, c;
    __host__ __device__ void init(int M, int N, int G_, int c_) { nM = M / BM; nN = N / BM; nwg = nM * nN; G = G_; c = c_; }
    __host__ __device__ bool next(int i, Unit& u) const {
        const long L = (long)i * G + c; if (L >= nwg) return false;
        int wgid = (int)L; { const int q = nwg / NXCD, r = nwg % NXCD, xcd = wgid % NXCD, off = wgid / NXCD; wgid = (xcd < r ? xcd * (q + 1) : r * (q + 1) + (xcd - r) * q) + off; }
        const int nig = WGM * nN, gid = wgid / nig, fm = gid * WGM, gsz = (nM - fm) < WGM ? (nM - fm) : WGM;
        u.pm = fm + ((wgid % nig) % gsz); u.pn = (wgid % nig) / gsz; return true;
    }
    __device__ __forceinline__ void a_ready(const Unit&) const {}
    __device__ __forceinline__ void done(const Unit&) const {}
};

__device__ __forceinline__ unsigned cvt_pk_bf16(float lo, float hi) { unsigned r; asm volatile("v_cvt_pk_bf16_f32 %0, %1, %2" : "=v"(r) : "v"(lo), "v"(hi)); return r; }
typedef float f32x2 __attribute__((ext_vector_type(2)));
template <class Epi, class Sched, bool ALIGN_EPI = false, bool SP2 = false>
__device__ __forceinline__ void gemm_phase(PG8_LAS unsigned char* lds, const Gemm g, const Sched& S, const Epi& E) {
    int tid = threadIdx.x; asm volatile("" : "+v"(tid));
    const int wid = __builtin_amdgcn_readfirstlane(tid >> 6), lane = tid & 63, wr = wid >> 2, wc = wid & 3, fr = lane & 15, fq = lane >> 4;
    const int K = g.K, nt = K / BK;
    unsigned voffA[2], voffB[2];
#pragma unroll
    for (int i = 0; i < 2; ++i) { int R, C; stage_rc(tid * 16 + i * 8192, R, C); const int Rb = Epi::PERM ? ((R & ~31) + perm32(R & 31)) : R;
        voffA[i] = (unsigned)(R * K + C) * 2u; voffB[i] = (unsigned)(Rb * K + C) * 2u; }
    const size_t kstep = (size_t)(BK * 2);
    const size_t hstep = (size_t)HALF * K * 2;
    const size_t tstep = 2 * hstep;
    const unsigned ldsw = (unsigned)wid * 1024u;
    const int aoff = lds_byte(wr * 64 + fr, fq * 8), boff = lds_byte(wc * 32 + fr, fq * 8);
#define PG8_SA(b, h) (((b) * 2 + (h)) * HTB)
#define PG8_SB(b, h) ((4 + (b) * 2 + (h)) * HTB)
#define PG8_STAGE(bufoff, gbase, voff) do { _Pragma("unroll") for (int _i = 0; _i < 2; ++_i) \
        __builtin_amdgcn_global_load_lds((const unsigned*)((const char*)(gbase) + (voff)[_i]), (PG8_LAS unsigned*)(lds + (bufoff) + ldsw + _i * 8192), 16, 0, 0); } while (0)
#define PG8_LDA(dst, b, h) do { _Pragma("unroll") for (int m = 0; m < 4; ++m) _Pragma("unroll") for (int k = 0; k < 2; ++k) dst[m][k] = *(const PG8_LAS bf16x8*)(lds + PG8_SA(b, h) + aoff + m * 2048 + k * 1024); } while (0)
#define PG8_LDB(dst, b, h) do { _Pragma("unroll") for (int n = 0; n < 2; ++n) _Pragma("unroll") for (int k = 0; k < 2; ++k) dst[n][k] = *(const PG8_LAS bf16x8*)(lds + PG8_SB(b, h) + boff + n * 2048 + k * 1024); } while (0)
#define PG8_MMA(ai, bj, At, Bt) do { __builtin_amdgcn_s_setprio(1); _Pragma("unroll") for (int m = 0; m < 4; ++m) _Pragma("unroll") for (int n = 0; n < 2; ++n) _Pragma("unroll") for (int k = 0; k < 2; ++k) \
        acc[ai][bj][m][n] = __builtin_amdgcn_mfma_f32_16x16x32_bf16(Bt[n][k], At[m][k], acc[ai][bj][m][n], 0, 0, 0); __builtin_amdgcn_s_setprio(0); } while (0)
#define PG8_WAIT_V(n) asm volatile("s_waitcnt vmcnt(" #n ")" ::: "memory")
#define PG8_WAIT_L(n) asm volatile("s_waitcnt lgkmcnt(" #n ")" ::: "memory")
#define PG8_BAR __builtin_amdgcn_s_barrier()
#define PG8_SCHED __builtin_amdgcn_sched_barrier(0)
    Unit cur, nxt; int ui = 0;
    if (!S.next(0, cur)) return;
    f32x4 acc[2][2][4][2];
#pragma unroll
    for (int a = 0; a < 2; ++a)
#pragma unroll
        for (int b = 0; b < 2; ++b)
#pragma unroll
            for (int m = 0; m < 4; ++m)
#pragma unroll
                for (int n = 0; n < 2; ++n) acc[a][b][m][n] = (f32x4){0.f, 0.f, 0.f, 0.f};
    bf16x8 At[4][2], B0[2][2], B1[2][2];
    const char* cA = (const char*)g.A + (size_t)cur.pm * tstep; const char* cB = (const char*)g.Bt + (size_t)cur.pn * tstep;
    S.a_ready(cur);
    if constexpr (SP2) {
        PG8_STAGE(PG8_SB(0, 0), cB, voffB); PG8_STAGE(PG8_SB(0, 1), cB + hstep, voffB); PG8_STAGE(PG8_SA(0, 0), cA, voffA); PG8_STAGE(PG8_SA(0, 1), cA + hstep, voffA);
        if (wr == 1) PG8_BAR;
        PG8_WAIT_V(2); PG8_BAR;
        PG8_STAGE(PG8_SB(1, 0), cB + kstep, voffB); PG8_STAGE(PG8_SA(1, 0), cA + kstep, voffA); PG8_STAGE(PG8_SB(1, 1), cB + hstep + kstep, voffB);
        PG8_WAIT_V(6); PG8_BAR;
    } else {
        PG8_STAGE(PG8_SB(0, 0), cB, voffB); PG8_STAGE(PG8_SA(0, 0), cA, voffA); PG8_STAGE(PG8_SB(0, 1), cB + hstep, voffB); PG8_STAGE(PG8_SA(0, 1), cA + hstep, voffA);
        if (wr == 1) PG8_BAR;
        PG8_WAIT_V(4); PG8_BAR;
        PG8_STAGE(PG8_SB(1, 0), cB + kstep, voffB); PG8_STAGE(PG8_SA(1, 0), cA + kstep, voffA); PG8_STAGE(PG8_SB(1, 1), cB + hstep + kstep, voffB);
        PG8_WAIT_V(6); PG8_BAR;
    }
    for (;;) {
        const bool has_next = S.next(ui + 1, nxt);
        const char* nA = has_next ? (const char*)g.A + (size_t)nxt.pm * tstep : cA; const char* nB = has_next ? (const char*)g.Bt + (size_t)nxt.pn * tstep : cB;
        for (int t = 0; t < nt; t += 2) {
            const bool last = (t == nt - 2);
            const char* a1 = cA + (size_t)(t + 1) * kstep;
            const char* a2 = last ? nA : cA + (size_t)(t + 2) * kstep; const char* b2 = last ? nB : cB + (size_t)(t + 2) * kstep;
            const char* a3 = a2 + kstep; const char* b3 = b2 + kstep;
            if (last && has_next) S.a_ready(nxt);
            if constexpr (SP2) {
            PG8_LDB(B0, 0, 0); PG8_LDB(B1, 0, 1); PG8_SCHED; PG8_LDA(At, 0, 0); PG8_STAGE(PG8_SA(1, 1), a1 + hstep, voffA);
            PG8_WAIT_V(8); PG8_WAIT_L(0); PG8_BAR; PG8_MMA(0, 0, At, B0); PG8_MMA(0, 1, At, B1); PG8_BAR; PG8_SCHED;
            PG8_LDA(At, 0, 1); PG8_STAGE(PG8_SB(0, 0), b2, voffB); PG8_STAGE(PG8_SB(0, 1), b2 + hstep, voffB); PG8_STAGE(PG8_SA(0, 0), a2, voffA);
            PG8_WAIT_V(8); PG8_WAIT_L(0); PG8_BAR; PG8_MMA(1, 0, At, B0); PG8_MMA(1, 1, At, B1); PG8_BAR; PG8_SCHED;
            PG8_LDB(B0, 1, 0); PG8_LDB(B1, 1, 1); PG8_SCHED; PG8_LDA(At, 1, 0); PG8_STAGE(PG8_SA(0, 1), a2 + hstep, voffA);
            PG8_WAIT_V(8); PG8_WAIT_L(0); PG8_BAR; PG8_MMA(0, 0, At, B0); PG8_MMA(0, 1, At, B1); PG8_BAR; PG8_SCHED;
            PG8_LDA(At, 1, 1); PG8_STAGE(PG8_SB(1, 0), b3, voffB); PG8_STAGE(PG8_SB(1, 1), b3 + hstep, voffB); PG8_STAGE(PG8_SA(1, 0), a3, voffA);
            PG8_WAIT_V(8); PG8_WAIT_L(0); PG8_BAR; PG8_MMA(1, 0, At, B0); PG8_MMA(1, 1, At, B1); PG8_BAR; PG8_SCHED;
            } else {
            PG8_LDB(B0, 0, 0); PG8_SCHED; PG8_LDA(At, 0, 0); PG8_STAGE(PG8_SA(1, 1), a1 + hstep, voffA);
            PG8_WAIT_L(8); PG8_BAR; PG8_WAIT_L(0); PG8_MMA(0, 0, At, B0); PG8_BAR; PG8_SCHED;
            PG8_LDB(B1, 0, 1); PG8_STAGE(PG8_SB(0, 0), b2, voffB);
            PG8_BAR; PG8_WAIT_L(0); PG8_MMA(0, 1, At, B1); PG8_BAR;
            PG8_LDA(At, 0, 1); PG8_STAGE(PG8_SA(0, 0), a2, voffA);
            PG8_BAR; PG8_WAIT_L(0); PG8_MMA(1, 0, At, B0); PG8_BAR; PG8_SCHED;
            PG8_STAGE(PG8_SB(0, 1), b2 + hstep, voffB);
            PG8_WAIT_V(6); PG8_BAR; PG8_MMA(1, 1, At, B1); PG8_BAR;
            PG8_LDB(B0, 1, 0); PG8_SCHED; PG8_LDA(At, 1, 0); PG8_STAGE(PG8_SA(0, 1), a2 + hstep, voffA);
            PG8_WAIT_L(8); PG8_BAR; PG8_WAIT_L(0); PG8_MMA(0, 0, At, B0); PG8_BAR; PG8_SCHED;
            PG8_LDB(B1, 1, 1); PG8_STAGE(PG8_SB(1, 0), b3, voffB);
            PG8_BAR; PG8_WAIT_L(0); PG8_MMA(0, 1, At, B1); PG8_BAR;
            PG8_LDA(At, 1, 1); PG8_STAGE(PG8_SA(1, 0), a3, voffA);
            PG8_BAR; PG8_WAIT_L(0); PG8_MMA(1, 0, At, B0); PG8_BAR; PG8_SCHED;
            PG8_STAGE(PG8_SB(1, 1), b3 + hstep, voffB);
            PG8_WAIT_V(6); PG8_BAR; PG8_MMA(1, 1, At, B1); PG8_BAR;
            }
        }
        if constexpr (ALIGN_EPI) { if (wr == 0) PG8_BAR; }
        if constexpr (!Epi::AFTER_DRAIN) { E(acc, cur, wr, wc, fr, fq); S.done(cur); }
        if (!has_next) break;
#pragma unroll
        for (int a = 0; a < 2; ++a)
#pragma unroll
            for (int b = 0; b < 2; ++b)
#pragma unroll
                for (int m = 0; m < 4; ++m)
#pragma unroll
                    for (int n = 0; n < 2; ++n) acc[a][b][m][n] = (f32x4){0.f, 0.f, 0.f, 0.f};
        cur = nxt; cA = nA; cB = nB; ++ui;
        if constexpr (ALIGN_EPI) { if (wr == 1) PG8_BAR; }
    }
    PG8_WAIT_V(0);
    if constexpr (!ALIGN_EPI) { if (wr == 0) PG8_BAR; }
    PG8_BAR;
    if constexpr (Epi::AFTER_DRAIN) { E.fused(acc, cur, wr, wc, fr, fq, lds, wid, lane); S.done(cur); }
#undef PG8_SA
#undef PG8_SB
#undef PG8_STAGE
#undef PG8_LDA
#undef PG8_LDB
#undef PG8_MMA
#undef PG8_WAIT_V
#undef PG8_WAIT_L
#undef PG8_BAR
#undef PG8_SCHED
}
}


namespace {

constexpr int D = 2048, BATCH = 32, SEQ = 256, DEPTH = 4, DB = 2, DS = 1024, PAST = 512;
constexpr int NCTX = BATCH * SEQ, NLAT = DB * DS, T = NCTX + NLAT, TKV = T + DB * PAST;
constexpr int DIN = 3904, DINP = 4096;
constexpr int EXP_NSL = 8;
constexpr int RING_OFF = 0, MISC_OFF = 131072, LDS_TOTAL = 147456;
typedef unsigned short bf16_t;
constexpr int O_CQ = 0, O_CKV = 512, O_KPE = 768, O_NAQ = 832, O_NAK = 1344, O_NAV = 1856, O_GB = 2368, O_GC = 2880, O_U = 3392;
constexpr float EPS = 1e-6f;
constexpr int NTHREADS = 512, NWAVES = NTHREADS / 64;

struct Params {
    const float *x_prompt, *x_sample, *cache_ckv, *cache_kpe, *cache_nak, *cache_nav, *c, *c_ctx;
    const float *ada_w, *ada_b, *norm_mix_g, *norm_ffn_g, *w_in, *q_norm_g, *w_uq, *kv_norm_g, *w_ukv;
    const float *q_head_g, *k_head_g, *naq_g, *nak_g, *rel_bias, *conv_w, *w_out, *peer_wq, *sub_keys, *peer_u, *peer_v;
    float* out;
    float *o_ckv, *o_kpe, *o_nak, *o_nav;
    unsigned* bar;
    float *ada, *gate;
    int* eidx;
    unsigned short *wt_in, *wt_uq, *wt_ukv, *wt_out, *wt_q;
    unsigned short *hn_b, *cqn_b, *ckv_b, *mix_b;
    unsigned char* x8g;
    unsigned short* xb;
    unsigned short *z_b, *qm_b, *kvr_b; float* rope_cs;
    unsigned short *qp_b, *sk_b;
    unsigned char *pu8, *pv8; float *su8, *sv8;
    unsigned short *k_b, *qna_b, *kna_b, *cnak_b;
    unsigned short *cnav_b;
};

typedef const __attribute__((address_space(4))) Params CParams;

DEVI int tidx() { int t = threadIdx.x; asm volatile("" : "+v"(t)); return t; }
#define WAVE_DPP_ROR(v_, n_) __builtin_bit_cast(float, __builtin_amdgcn_update_dpp(0, __builtin_bit_cast(int, (v_)), 0x120 + (n_), 0xf, 0xf, false))
DEVI float wave_sum(float v) {
    v += WAVE_DPP_ROR(v, 8); v += WAVE_DPP_ROR(v, 4); v += WAVE_DPP_ROR(v, 2); v += WAVE_DPP_ROR(v, 1);
    { const auto s = __builtin_amdgcn_permlane16_swap(__float_as_uint(v), __float_as_uint(v), false, false); v = __uint_as_float(s[0]) + __uint_as_float(s[1]); }
    { const auto s = __builtin_amdgcn_permlane32_swap(__float_as_uint(v), __float_as_uint(v), false, false); v = __uint_as_float(s[0]) + __uint_as_float(s[1]); }
    return v;
}
DEVI float wave_max(float v) {
    v = fmaxf(v, WAVE_DPP_ROR(v, 8)); v = fmaxf(v, WAVE_DPP_ROR(v, 4)); v = fmaxf(v, WAVE_DPP_ROR(v, 2)); v = fmaxf(v, WAVE_DPP_ROR(v, 1));
    { const auto s = __builtin_amdgcn_permlane16_swap(__float_as_uint(v), __float_as_uint(v), false, false); v = fmaxf(__uint_as_float(s[0]), __uint_as_float(s[1])); }
    { const auto s = __builtin_amdgcn_permlane32_swap(__float_as_uint(v), __float_as_uint(v), false, false); v = fmaxf(__uint_as_float(s[0]), __uint_as_float(s[1])); }
    return v;
}
typedef float f32x2_t __attribute__((ext_vector_type(2))); typedef __bf16 bf16x2_t __attribute__((ext_vector_type(2)));
DEVI unsigned cvtpk(float lo, float hi) { f32x2_t v = {lo, hi}; bf16x2_t b = __builtin_convertvector(v, bf16x2_t); return __builtin_bit_cast(unsigned, b); }
DEVI bf16_t f2bf(float v) { return (bf16_t)(cvtpk(v, 0.f) & 0xffffu); }
DEVI int cond_of(int t) { return t < NCTX ? 2 : (t - NCTX) / DS; }
DEVI const float* xrow(CParams& p, int layer, int t) {
    if (layer == 0) return t < NCTX ? p.x_prompt + (size_t)t * D : p.x_sample + (size_t)(t - NCTX) * D;
    return p.out + (size_t)t * D;
}

DEVI void phase_modnorm(CParams& p, int layer, int which, int bid, int nb) {
    const int lane = tidx() & 63, w = tidx() >> 6;
    const float* g = (which == 0 ? p.norm_mix_g : p.norm_ffn_g) + (size_t)layer * D;
    for (int t = bid * NWAVES + w; t < T; t += nb * NWAVES) {
        const float* x = xrow(p, layer, t);
        const bf16_t* xq = p.xb + (size_t)t * D;
        const float* ad = p.ada + ((size_t)layer * 3 + cond_of(t)) * 6 * D + (which == 0 ? 0 : 3 * D);
        float4 v[8]; float ss = 0.f;
#pragma unroll
        for (int i = 0; i < 8; ++i) {
            if (which == 0) { const pg8::f32x4 t4 = __builtin_nontemporal_load((const pg8::f32x4*)(x + i * 256 + lane * 4)); v[i] = make_float4(t4[0], t4[1], t4[2], t4[3]); }
            else { const uint2 q = *(const uint2*)(xq + i * 256 + lane * 4); v[i] = make_float4(__uint_as_float(q.x << 16), __uint_as_float(q.x & 0xffff0000u), __uint_as_float(q.y << 16), __uint_as_float(q.y & 0xffff0000u)); }
            ss += v[i].x * v[i].x + v[i].y * v[i].y + v[i].z * v[i].z + v[i].w * v[i].w; }
        ss = wave_sum(ss);
        const float r = rsqrtf(ss / D + EPS);
#pragma unroll
        for (int i = 0; i < 8; ++i) {
            const int c = i * 256 + lane * 4;
            float4 gg = *(const float4*)(g + c), sh = *(const float4*)(ad + c), sc = *(const float4*)(ad + D + c), o;
            o.x = v[i].x * r * gg.x * (1.f + sc.x) + sh.x; o.y = v[i].y * r * gg.y * (1.f + sc.y) + sh.y;
            o.z = v[i].z * r * gg.z * (1.f + sc.z) + sh.z; o.w = v[i].w * r * gg.w * (1.f + sc.w) + sh.w;
            *(uint2*)(p.hn_b + (size_t)t * D + c) = make_uint2(pg8::cvt_pk_bf16(o.x, o.y), pg8::cvt_pk_bf16(o.z, o.w));
        }
    }
}

struct EpiResidMF {
    static constexpr bool PERM = false, AFTER_DRAIN = false;
    CParams* p; int layer;
    DEVI void operator()(const pg8::f32x4 (&acc)[2][2][4][2], const pg8::Unit& u, int wr, int wc, int fr, int fq) const {
        const int row0 = u.pm * 256 + wr * 64 + fr, col0 = u.pn * 256 + wc * 32 + 4 * fq;
#pragma unroll
        for (int ai = 0; ai < 2; ++ai)
#pragma unroll
            for (int m = 0; m < 4; ++m) {
                const int r = row0 + ai * 128 + m * 16;
                const float* x = xrow(*p, 0, r);
                const float* g1 = p->ada + ((size_t)layer * 3 + cond_of(r)) * 6 * D + 2 * D;
                bf16_t* o = p->xb + (size_t)r * D;
#pragma unroll
                for (int bj = 0; bj < 2; ++bj)
#pragma unroll
                    for (int n = 0; n < 2; ++n) { const int c = col0 + bj * 128 + n * 16;
                        pg8::f32x4 xv;
                        if (layer == 0) xv = *(const pg8::f32x4*)(x + c);
                        else { const uint2 q = *(const uint2*)(o + c); xv = (pg8::f32x4){__uint_as_float(q.x << 16), __uint_as_float(q.x & 0xffff0000u), __uint_as_float(q.y << 16), __uint_as_float(q.y & 0xffff0000u)}; }
                        const pg8::f32x4 gv = *(const pg8::f32x4*)(g1 + c), v = xv + gv * acc[ai][bj][m][n];
                        *(uint2*)(o + c) = make_uint2(cvtpk(v[0], v[1]), cvtpk(v[2], v[3])); } }
    }
};
struct EpiBf16Store {
    static constexpr bool PERM = true, AFTER_DRAIN = false;
    bf16_t* O; int ldc, ncols;
    DEVI void operator()(const pg8::f32x4 (&acc)[2][2][4][2], const pg8::Unit& u, int wr, int wc, int fr, int fq) const {
        const int row0 = u.pm * 256 + wr * 64 + fr, col0 = u.pn * 256 + wc * 32 + 8 * fq;
#pragma unroll
        for (int ai = 0; ai < 2; ++ai)
#pragma unroll
            for (int m = 0; m < 4; ++m) { bf16_t* rowp = O + (size_t)(row0 + ai * 128 + m * 16) * ldc + col0;
#pragma unroll
                for (int bj = 0; bj < 2; ++bj) { const pg8::f32x4 v0 = acc[ai][bj][m][0], v1 = acc[ai][bj][m][1];
                    if (col0 + bj * 128 < ncols) *(uint4*)(rowp + bj * 128) = make_uint4(cvtpk(v0[0], v0[1]), cvtpk(v0[2], v0[3]), cvtpk(v1[0], v1[1]), cvtpk(v1[2], v1[3])); } }
    }
};
template <class Epi>
DEVI void mfma_gemm(const bf16_t* A, const bf16_t* Bt, int M, int N, int K, const Epi& E, int bid, int nb, float* lds) {
    pg8::Gemm g{A, Bt, M, N, K};
    pg8::StaticOrder S; S.init(M, N, nb, bid);
    pg8::gemm_phase<Epi, pg8::StaticOrder, true, true>((PG8_LAS unsigned char*)lds + RING_OFF, g, S, E);
    __syncthreads();
}

DEVI float rope_angle(int pos, int j) {
    const int row = pos / 64, col = pos % 64;
    const int f = j & 15;
    const float inv = powf(10000.f, -(float)f / 16.f);
    return (j < 16 ? (float)row : (float)col) * inv;
}

struct TileD { const float* W; bf16_t* Wt; int ldw, ldt; };
DEVI TileD tile_desc(CParams& p, int l, int j) {
    constexpr int N_IN = 32 * 61, N_UQ = 8 * 24, N_UKV = 4 * 32, N_SQ = 32 * 32;
    TileD d;
    if (j < N_IN) { const int k0 = (j / 61) * 64, n0 = (j % 61) * 64; d.W = p.w_in + (size_t)l * D * DIN + (size_t)k0 * DIN + n0; d.ldw = DIN; d.Wt = p.wt_in + (size_t)l * DINP * D + (size_t)n0 * D + k0; d.ldt = D; return d; }
    j -= N_IN;
    if (j < N_UQ) { const int k0 = (j / 24) * 64, n0 = (j % 24) * 64; d.W = p.w_uq + (size_t)l * 512 * 1536 + (size_t)k0 * 1536 + n0; d.ldw = 1536; d.Wt = p.wt_uq + (size_t)l * 1536 * 512 + (size_t)n0 * 512 + k0; d.ldt = 512; return d; }
    j -= N_UQ;
    if (j < N_UKV) { const int k0 = (j / 32) * 64, n0 = (j % 32) * 64; d.W = p.w_ukv + (size_t)l * 256 * 2048 + (size_t)k0 * 2048 + n0; d.ldw = 2048; d.Wt = p.wt_ukv + (size_t)l * 2048 * 256 + (size_t)n0 * 256 + k0; d.ldt = 256; return d; }
    j -= N_UKV;
    const bool isq = j >= N_SQ; if (isq) j -= N_SQ;
    const int k0 = (j / 32) * 64, n0 = (j % 32) * 64;
    d.W = (isq ? p.peer_wq : p.w_out) + (size_t)l * D * D + (size_t)k0 * D + n0; d.ldw = D; d.Wt = (isq ? p.wt_q : p.wt_out) + (size_t)l * D * D + (size_t)n0 * D + k0; d.ldt = D;
    return d;
}
DEVI void conv_weights(CParams& p, int l, int which, int rank, int nr, float* lds) {
    constexpr int N_IN = 32 * 61, PER = 32 * 61 + 8 * 24 + 4 * 32 + 2 * 32 * 32;
    const int tid = tidx();
    const int lo = which == 0 ? 0 : N_IN, hi = which == 0 ? N_IN : PER;
    for (int it = lo + rank; it < hi; it += 4 * nr) {
        float4 v[4][2]; TileD d[4];
#pragma unroll
        for (int q = 0; q < 4; ++q) {
            const int j = it + q * nr; d[q] = tile_desc(p, l, j < hi ? j : it);
#pragma unroll
            for (int rep = 0; rep < 2; ++rep) { const int k = (tid >> 4) + rep * 32, n4 = (tid & 15) * 4; const pg8::f32x4 t4 = __builtin_nontemporal_load((const pg8::f32x4*)(d[q].W + (size_t)k * d[q].ldw + n4)); v[q][rep] = make_float4(t4[0], t4[1], t4[2], t4[3]); }
        }
#pragma unroll
        for (int q = 0; q < 4; ++q) {
            float (*tl)[65] = (float (*)[65])(lds + q * 64 * 65);
#pragma unroll
            for (int rep = 0; rep < 2; ++rep) { const int k = (tid >> 4) + rep * 32, n4 = (tid & 15) * 4; tl[k][n4] = v[q][rep].x; tl[k][n4 + 1] = v[q][rep].y; tl[k][n4 + 2] = v[q][rep].z; tl[k][n4 + 3] = v[q][rep].w; }
        }
        __syncthreads();
#pragma unroll
        for (int q = 0; q < 4; ++q) {
            if (it + q * nr < hi) {
                float (*tl)[65] = (float (*)[65])(lds + q * 64 * 65);
                const int n = tid >> 3, k8 = (tid & 7) * 8;
                uint4 o;
                o.x = cvtpk(tl[k8 + 0][n], tl[k8 + 1][n]); o.y = cvtpk(tl[k8 + 2][n], tl[k8 + 3][n]); o.z = cvtpk(tl[k8 + 4][n], tl[k8 + 5][n]); o.w = cvtpk(tl[k8 + 6][n], tl[k8 + 7][n]);
                *(uint4*)(d[q].Wt + (size_t)n * d[q].ldt + k8) = o;
            }
        }
        __syncthreads();
    }
    constexpr int NSK = 8 * 2 * 128 * 128 / 4;
    if (which == 1)
    for (int i = rank * NTHREADS + tidx(); i < NSK; i += nr * NTHREADS) {
        const float4 v = *(const float4*)(p.sub_keys + ((size_t)l * NSK + i) * 4);
        *(uint2*)(p.sk_b + ((size_t)l * NSK + i) * 4) = make_uint2(cvtpk(v.x, v.y), cvtpk(v.z, v.w));
    }
    constexpr int NZ = (DINP - DIN) * D / 8;
    if (which == 0)
    for (int i = rank * NTHREADS + tidx(); i < NZ; i += nr * NTHREADS) *(uint4*)(p.wt_in + ((size_t)l * DINP + DIN) * D + (size_t)i * 8) = make_uint4(0u, 0u, 0u, 0u);
}
DEVI void conv_table(CParams& p, int l, bool isv, int rank, int nr) {
    const int lane = tidx() & 63, w = tidx() >> 6;
    for (int e = rank * NWAVES + w; e < 16384; e += nr * NWAVES) {
        const float* src = (isv ? p.peer_v : p.peer_u) + ((size_t)l * 16384 + e) * D;
        float4 v[8]; float mx = 0.f;
#pragma unroll
        for (int i = 0; i < 8; ++i) { const pg8::f32x4 t4 = __builtin_nontemporal_load((const pg8::f32x4*)(src + i * 256 + lane * 4)); v[i] = make_float4(t4[0], t4[1], t4[2], t4[3]); mx = fmaxf(mx, fmaxf(fmaxf(fabsf(v[i].x), fabsf(v[i].y)), fmaxf(fabsf(v[i].z), fabsf(v[i].w)))); }
        mx = wave_max(mx);
        const float scale = mx > 0.f ? mx * (1.f / 6.f) : 1.f, inv = 1.f / scale;
        unsigned char* dst = (isv ? p.pv8 : p.pu8) + ((size_t)l * EXP_NSL * 16384 + e) * 128 + lane * 2;
#pragma unroll
        for (int i = 0; i < 8; ++i) {
            unsigned pk = 0;
            pk = __builtin_amdgcn_cvt_scalef32_pk_fp4_f32(pk, v[i].x * inv, v[i].y * inv, 1.0f, 0);
            pk = __builtin_amdgcn_cvt_scalef32_pk_fp4_f32(pk, v[i].z * inv, v[i].w * inv, 1.0f, 1);
            *(unsigned short*)(dst + (size_t)i * 16384 * 128) = (unsigned short)pk;
        }
        if (lane == 0) (isv ? p.sv8 : p.su8)[(size_t)l * 16384 + e] = scale;
    }
}
DEVI void conv_ada(CParams& p, int l, int rank, int nr, float* lds, int ib, int ie) {
    float* sv = lds;
    float* red = lds + 3 * D;
    const int tid = tidx(), lane = tid & 63, w = tid >> 6;
    __syncthreads();
    for (int i = tid; i < 3 * D; i += NTHREADS) {
        const int j = i / D, k = i % D;
        const float v = j < 2 ? p.c[j * D + k] : p.c_ctx[k];
        sv[i] = v / (1.f + __expf(-v));
    }
    __syncthreads();
    constexpr int NIT = 6 * D / 256;
    static_assert(NIT == 48, "item split below assumes 48 items per layer");
    for (int it = ib + rank; it < ie; it += nr) {
        const int n4 = it * 256 + lane * 4;
        const float* W = p.ada_w + (size_t)l * D * 6 * D + n4;
        float4 a0 = make_float4(0.f, 0.f, 0.f, 0.f), a1 = a0, a2 = a0;
        const int k0 = w * (D / NWAVES);
#pragma unroll 1
        for (int kb = k0; kb < k0 + D / NWAVES; kb += 32) {
            pg8::f32x4 wv[32];
#pragma unroll
            for (int i = 0; i < 32; ++i) wv[i] = __builtin_nontemporal_load((const pg8::f32x4*)(W + (size_t)(kb + i) * 6 * D));
#pragma unroll
            for (int i = 0; i < 32; ++i) {
                const float s0 = sv[kb + i], s1 = sv[D + kb + i], s2 = sv[2 * D + kb + i];
                a0.x += s0 * wv[i][0]; a0.y += s0 * wv[i][1]; a0.z += s0 * wv[i][2]; a0.w += s0 * wv[i][3];
                a1.x += s1 * wv[i][0]; a1.y += s1 * wv[i][1]; a1.z += s1 * wv[i][2]; a1.w += s1 * wv[i][3];
                a2.x += s2 * wv[i][0]; a2.y += s2 * wv[i][1]; a2.z += s2 * wv[i][2]; a2.w += s2 * wv[i][3];
            }
        }
        float4* red4 = (float4*)red;
        red4[(w * 3 + 0) * 64 + lane] = a0; red4[(w * 3 + 1) * 64 + lane] = a1; red4[(w * 3 + 2) * 64 + lane] = a2;
        __syncthreads();
        if (tid < 192) {
            const int j = tid / 64, ln = tid % 64;
            float4 s4 = make_float4(0.f, 0.f, 0.f, 0.f);
            for (int ww = 0; ww < NWAVES; ++ww) { const float4 v = red4[(ww * 3 + j) * 64 + ln]; s4.x += v.x; s4.y += v.y; s4.z += v.z; s4.w += v.w; }
            const int nn = it * 256 + ln * 4;
            const float4 b = *(const float4*)(p.ada_b + (size_t)l * 6 * D + nn);
            *(float4*)(p.ada + ((size_t)l * 3 + j) * 6 * D + nn) = make_float4(s4.x + b.x, s4.y + b.y, s4.z + b.z, s4.w + b.w);
        }
        __syncthreads();
    }
}
DEVI void phase_prologue(CParams& p, int bid, int nb, float* lds) {
    for (int i = bid * NTHREADS + tidx(); i < DS * 32; i += nb * NTHREADS) {
        const int pos = i >> 5, j = i & 31;
        const float ang = rope_angle(pos, j);
        p.rope_cs[(size_t)pos * 64 + j] = cosf(ang); p.rope_cs[(size_t)pos * 64 + 32 + j] = sinf(ang);
    }
    if (nb > 96) { if (bid < 48) conv_ada(p, 0, bid, 48, lds, 0, 48); else conv_weights(p, 0, 0, bid - 48, nb - 48, lds); return; }
    conv_ada(p, 0, bid, nb, lds, 0, 48);
    conv_weights(p, 0, 0, bid, nb, lds);
}
DEVI bool gemm_idle_rank(int U, int bid, int nb, int& rank, int& nr) {
    const int rem = U % nb;
    if (rem == 0) { rank = bid; nr = nb; return true; }
    if (bid < rem) return false;
    rank = bid - rem; nr = nb - rem; return true;
}

DEVI float bf_lo(unsigned v) { return __uint_as_float(v << 16); }
DEVI float bf_hi(unsigned v) { return __uint_as_float(v & 0xffff0000u); }
DEVI void unpack8(const uint4& v, float (&f)[8]) { f[0] = bf_lo(v.x); f[1] = bf_hi(v.x); f[2] = bf_lo(v.y); f[3] = bf_hi(v.y); f[4] = bf_lo(v.z); f[5] = bf_hi(v.z); f[6] = bf_lo(v.w); f[7] = bf_hi(v.w); }
DEVI uint4 pack8(const float (&f)[8]) { return make_uint4(cvtpk(f[0], f[1]), cvtpk(f[2], f[3]), cvtpk(f[4], f[5]), cvtpk(f[6], f[7])); }
DEVI void phase_postz(CParams& p, int layer, int bid, int nb) {
    const int lane = tidx() & 63, w = tidx() >> 6;
    for (int r = bid * NWAVES + w; r < TKV; r += nb * NWAVES) {
        if (r >= T) {
            const int b = (r - T) / PAST, j = (r - T) % PAST;
            const float4 v = *(const float4*)(p.cache_ckv + (((size_t)b * DEPTH + layer) * PAST + j) * 256 + lane * 4);
            *(uint2*)(p.ckv_b + (size_t)r * 256 + lane * 4) = make_uint2(cvtpk(v.x, v.y), cvtpk(v.z, v.w));
            continue;
        }
        const bf16_t* z = p.z_b + (size_t)r * DIN;
        const bool ctx = r < NCTX;
        const int b = ctx ? r / SEQ : (r - NCTX) / DS, s = ctx ? r % SEQ : (r - NCTX) % DS, S = ctx ? SEQ : DS;
        const bool hp = s > 0, hn = s < S - 1;
        const uint4 zero4 = make_uint4(0u, 0u, 0u, 0u);
        const uint4 cq4 = *(const uint4*)(z + O_CQ + lane * 8);
        const uint2 ckv2 = *(const uint2*)(z + O_CKV + lane * 4);
        const bf16_t kpe1 = z[O_KPE + lane];
        const uint4 naq4 = *(const uint4*)(z + O_NAQ + lane * 8), nak4 = *(const uint4*)(z + O_NAK + lane * 8), nav4 = *(const uint4*)(z + O_NAV + lane * 8);
        const uint4 gb4 = *(const uint4*)(z + O_GB + lane * 8), gc4 = *(const uint4*)(z + O_GC + lane * 8), u4 = *(const uint4*)(z + O_U + lane * 8);
        const uint4 gcm4 = hp ? *(const uint4*)(z - DIN + O_GC + lane * 8) : zero4, um4 = hp ? *(const uint4*)(z - DIN + O_U + lane * 8) : zero4;
        const uint4 gcp4 = hn ? *(const uint4*)(z + DIN + O_GC + lane * 8) : zero4, up4 = hn ? *(const uint4*)(z + DIN + O_U + lane * 8) : zero4;
        float cw[24];
        {
            const float* cwp = p.conv_w + ((size_t)layer * 512 + lane * 8) * 3;
#pragma unroll
            for (int q = 0; q < 6; ++q) { const float4 v = *(const float4*)(cwp + q * 4); cw[q * 4] = v.x; cw[q * 4 + 1] = v.y; cw[q * 4 + 2] = v.z; cw[q * 4 + 3] = v.w; }
        }
        float gq[8], gkv[4], gnq[8], gnk[8];
        {
            const float4 a = *(const float4*)(p.q_norm_g + layer * 512 + lane * 8), c = *(const float4*)(p.q_norm_g + layer * 512 + lane * 8 + 4);
            gq[0] = a.x; gq[1] = a.y; gq[2] = a.z; gq[3] = a.w; gq[4] = c.x; gq[5] = c.y; gq[6] = c.z; gq[7] = c.w;
            const float4 k = *(const float4*)(p.kv_norm_g + layer * 256 + lane * 4); gkv[0] = k.x; gkv[1] = k.y; gkv[2] = k.z; gkv[3] = k.w;
            const int d0 = (lane & 15) * 8;
            const float4 e = *(const float4*)(p.naq_g + layer * 128 + d0), f = *(const float4*)(p.naq_g + layer * 128 + d0 + 4);
            gnq[0] = e.x; gnq[1] = e.y; gnq[2] = e.z; gnq[3] = e.w; gnq[4] = f.x; gnq[5] = f.y; gnq[6] = f.z; gnq[7] = f.w;
            const float4 g = *(const float4*)(p.nak_g + layer * 128 + d0), hh = *(const float4*)(p.nak_g + layer * 128 + d0 + 4);
            gnk[0] = g.x; gnk[1] = g.y; gnk[2] = g.z; gnk[3] = g.w; gnk[4] = hh.x; gnk[5] = hh.y; gnk[6] = hh.z; gnk[7] = hh.w;
        }
        float cq[8], naq[8], nak[8], nav[8], ckv[4];
        unpack8(cq4, cq); unpack8(naq4, naq); unpack8(nak4, nak); unpack8(nav4, nav);
        ckv[0] = bf_lo(ckv2.x); ckv[1] = bf_hi(ckv2.x); ckv[2] = bf_lo(ckv2.y); ckv[3] = bf_hi(ckv2.y);
        float s_cq = 0.f, s_kv = 0.f, s_nq = 0.f, s_nk = 0.f;
#pragma unroll
        for (int i = 0; i < 8; ++i) { s_cq += cq[i] * cq[i]; s_nq += naq[i] * naq[i]; s_nk += nak[i] * nak[i]; }
#pragma unroll
        for (int i = 0; i < 4; ++i) s_kv += ckv[i] * ckv[i];
#pragma unroll
        for (int o = 1; o < 16; o <<= 1) { s_cq += __shfl_xor(s_cq, o); s_kv += __shfl_xor(s_kv, o); s_nq += __shfl_xor(s_nq, o); s_nk += __shfl_xor(s_nk, o); }
        s_cq += __shfl_xor(s_cq, 16); s_kv += __shfl_xor(s_kv, 16); s_cq += __shfl_xor(s_cq, 32); s_kv += __shfl_xor(s_kv, 32);
        const float r_cq = rsqrtf(s_cq / 512.f + EPS), r_kv = rsqrtf(s_kv / 256.f + EPS), r_nq = rsqrtf(s_nq / 128.f + EPS), r_nk = rsqrtf(s_nk / 128.f + EPS);
#pragma unroll
        for (int i = 0; i < 8; ++i) { cq[i] *= r_cq * gq[i]; naq[i] *= r_nq * gnq[i]; nak[i] *= r_nk * gnk[i]; }
#pragma unroll
        for (int i = 0; i < 4; ++i) ckv[i] *= r_kv * gkv[i];
        *(uint4*)(p.cqn_b + (size_t)r * 512 + lane * 8) = pack8(cq);
        *(uint2*)(p.ckv_b + (size_t)r * 256 + lane * 4) = make_uint2(cvtpk(ckv[0], ckv[1]), cvtpk(ckv[2], ckv[3]));
        *(uint4*)(p.qna_b + (size_t)r * 512 + lane * 8) = pack8(naq);
        *(uint4*)(p.kna_b + (size_t)r * 512 + lane * 8) = pack8(nak);
        if (ctx) {
            const size_t oc = ((size_t)b * DEPTH + layer) * SEQ + s;
            *(float4*)(p.o_ckv + oc * 256 + lane * 4) = make_float4(ckv[0], ckv[1], ckv[2], ckv[3]);
            p.o_kpe[oc * 64 + lane] = __uint_as_float((unsigned)kpe1 << 16);
            const int hd = lane >> 4, d0 = (lane & 15) * 8;
            const size_t on = ((((size_t)b * DEPTH + layer) * 4 + hd) * SEQ + s) * 128 + d0;
            *(float4*)(p.o_nak + on) = make_float4(nak[0], nak[1], nak[2], nak[3]); *(float4*)(p.o_nak + on + 4) = make_float4(nak[4], nak[5], nak[6], nak[7]);
            *(float4*)(p.o_nav + on) = make_float4(nav[0], nav[1], nav[2], nav[3]); *(float4*)(p.o_nav + on + 4) = make_float4(nav[4], nav[5], nav[6], nav[7]);
        }
        {
            float gb[8], gc[8], uu[8], gcm[8], um[8], gcp[8], up[8], o[8];
            unpack8(gb4, gb); unpack8(gc4, gc); unpack8(u4, uu); unpack8(gcm4, gcm); unpack8(um4, um); unpack8(gcp4, gcp); unpack8(up4, up);
#pragma unroll
            for (int i = 0; i < 8; ++i) o[i] = gb[i] * (gcm[i] * um[i] * cw[i * 3] + gc[i] * uu[i] * cw[i * 3 + 1] + gcp[i] * up[i] * cw[i * 3 + 2]);
            *(uint4*)(p.mix_b + (size_t)r * D + 1536 + lane * 8) = pack8(o);
        }
    }
}

DEVI void phase_headnorm(CParams& p, int layer, int bid, int nb, float* lds) {
    const int lane = tidx() & 63, w = tidx() >> 6;
    for (int r = bid * NWAVES + w; r < TKV; r += nb * NWAVES) {
        const bf16_t* kv = p.kvr_b + (size_t)r * 2048;
        const int cc = lane & 15, hA = lane >> 4, hB = 4 + (lane >> 4);
        float ka[8], kb[8], pe[8];
        unpack8(*(const uint4*)(kv + hA * 256 + cc * 8), ka);
        unpack8(*(const uint4*)(kv + hB * 256 + cc * 8), kb);
        const int kc = lane & 7, hh = lane >> 3;
        if (r < T) unpack8(*(const uint4*)(p.z_b + (size_t)r * DIN + O_KPE + kc * 8), pe);
        else {
            const int b = (r - T) / PAST, j = (r - T) % PAST;
            const float* cp = p.cache_kpe + (((size_t)b * DEPTH + layer) * PAST + j) * 64 + kc * 8;
            const pg8::f32x4 a = __builtin_nontemporal_load((const pg8::f32x4*)cp), c = __builtin_nontemporal_load((const pg8::f32x4*)(cp + 4));
            pe[0] = a[0]; pe[1] = a[1]; pe[2] = a[2]; pe[3] = a[3]; pe[4] = c[0]; pe[5] = c[1]; pe[6] = c[2]; pe[7] = c[3];
        }
        float gn[8], gp[8];
        {
            const float* g = p.k_head_g + layer * 192;
            const float4 a = *(const float4*)(g + cc * 8), c = *(const float4*)(g + cc * 8 + 4), e = *(const float4*)(g + 128 + kc * 8), f = *(const float4*)(g + 128 + kc * 8 + 4);
            gn[0] = a.x; gn[1] = a.y; gn[2] = a.z; gn[3] = a.w; gn[4] = c.x; gn[5] = c.y; gn[6] = c.z; gn[7] = c.w;
            gp[0] = e.x; gp[1] = e.y; gp[2] = e.z; gp[3] = e.w; gp[4] = f.x; gp[5] = f.y; gp[6] = f.z; gp[7] = f.w;
        }
        float sa = 0.f, sb = 0.f, sp = 0.f;
#pragma unroll
        for (int i = 0; i < 8; ++i) { sa += ka[i] * ka[i]; sb += kb[i] * kb[i]; sp += pe[i] * pe[i]; }
#pragma unroll
        for (int o = 1; o < 16; o <<= 1) { sa += __shfl_xor(sa, o); sb += __shfl_xor(sb, o); }
        sp += __shfl_xor(sp, 1); sp += __shfl_xor(sp, 2); sp += __shfl_xor(sp, 4);
        const float rA = rsqrtf((sa + sp) / 192.f + EPS), rB = rsqrtf((sb + sp) / 192.f + EPS);
        const float sa_h = __shfl(sa, (hh & 3) * 16), sb_h = __shfl(sb, (hh & 3) * 16);
        const float rP = rsqrtf(((hh < 4 ? sa_h : sb_h) + sp) / 192.f + EPS);
#pragma unroll
        for (int i = 0; i < 8; ++i) { ka[i] *= rA * gn[i]; kb[i] *= rB * gn[i]; pe[i] *= rP * gp[i]; }
        if (r >= NCTX && r < T) {
            const int pos = (r - NCTX) % DS, j0 = (kc & 3) * 8;
            const float* cs = p.rope_cs + (size_t)pos * 64 + j0;
            const float4 c0 = *(const float4*)cs, c1 = *(const float4*)(cs + 4), s0 = *(const float4*)(cs + 32), s1 = *(const float4*)(cs + 36);
            const float cv[8] = {c0.x, c0.y, c0.z, c0.w, c1.x, c1.y, c1.z, c1.w}, sn[8] = {s0.x, s0.y, s0.z, s0.w, s1.x, s1.y, s1.z, s1.w};
#pragma unroll
            for (int i = 0; i < 8; ++i) {
                const float other = __shfl_xor(pe[i], 4);
                pe[i] = kc < 4 ? pe[i] * cv[i] - other * sn[i] : other * sn[i] + pe[i] * cv[i];
            }
        }
        bf16_t* ko = p.k_b + (size_t)r * 1536;
        *(uint4*)(ko + hA * 192 + cc * 8) = pack8(ka);
        *(uint4*)(ko + hB * 192 + cc * 8) = pack8(kb);
        *(uint4*)(ko + hh * 192 + 128 + kc * 8) = pack8(pe);
    }
    for (int i = bid * NTHREADS + tidx(); i < DB * 4 * PAST * 128 / 4; i += nb * NTHREADS) {
        const int e = i * 4, bh = e / (PAST * 128), rem = e % (PAST * 128), b = bh / 4, h = bh % 4;
        const pg8::f32x4 t4 = __builtin_nontemporal_load((const pg8::f32x4*)(p.cache_nak + (((size_t)b * DEPTH + layer) * 4 + h) * PAST * 128 + rem)); const float4 v = make_float4(t4[0], t4[1], t4[2], t4[3]);
        *(uint2*)(p.cnak_b + (size_t)e) = make_uint2(cvtpk(v.x, v.y), cvtpk(v.z, v.w));
    }
    for (int i = bid * NTHREADS + tidx(); i < DB * 4 * PAST * 128 / 4; i += nb * NTHREADS) {
        const int e = i * 4, bh = e / (PAST * 128), rem = e % (PAST * 128), b = bh / 4, h = bh % 4;
        const pg8::f32x4 t4 = __builtin_nontemporal_load((const pg8::f32x4*)(p.cache_nav + (((size_t)b * DEPTH + layer) * 4 + h) * PAST * 128 + rem)); const float4 v = make_float4(t4[0], t4[1], t4[2], t4[3]);
        *(uint2*)(p.cnav_b + (size_t)e) = make_uint2(cvtpk(v.x, v.y), cvtpk(v.z, v.w));
    }
}

typedef short bf16x8_t __attribute__((ext_vector_type(8)));
typedef short bf16x4_t __attribute__((ext_vector_type(4)));
typedef __attribute__((address_space(3))) bf16x4_t lds_bf16x4_t;
typedef float f32x16_t __attribute__((ext_vector_type(16)));
#define MFMA32(a, b, c) __builtin_amdgcn_mfma_f32_32x32x16_bf16((a), (b), (c), 0, 0, 0)
DEVI int crow(int reg, int h) { return (reg & 3) + 8 * (reg >> 2) + 4 * h; }

#ifndef QK_AHEAD
#define QK_AHEAD 4
#endif
#ifndef PV_AHEAD
#define PV_AHEAD 4
#endif
constexpr int QG_OFF = 98304;
struct AttnBlk {
    const bf16_t* q; int qstride;
    const bf16_t *k0, *vt0; int ks0, ldv0, nst0;
    const bf16_t *k1, *vt1; int ks1, ldv1, nst1;
    bf16_t* out; float scale;
    const float *qg, *rope; int pos0;
    const float* bias; int row0, rs_min;
};
template <int DQ, bool LOCAL, bool QNORM, bool SPLIT>
DEVI void attn_block(const AttnBlk& u, float* ldsf) {
    constexpr int KROW = DQ * 2 + 16, VROW = 320, KBYTES = 64 * KROW, STAGE = KBYTES + 64 * VROW;
    constexpr int KCH = DQ / 8, NKC = 64 * KCH / NTHREADS;
    unsigned char* lds = (unsigned char*)ldsf;
    const int tid = tidx(), lane = tid & 63, w = tid >> 6, r = lane & 31, h = lane >> 5;
    const int wq = SPLIT ? (w >> 1) : w, kh = __builtin_amdgcn_readfirstlane(w & 1);
    bf16x8_t qf[DQ / 16];
    {
        const bf16_t* qrow = u.q + (size_t)(wq * 32 + r) * u.qstride + 8 * h;
#pragma unroll
        for (int kk = 0; kk < DQ / 16; ++kk) qf[kk] = *(const bf16x8_t*)(qrow + kk * 16);
    }
    if constexpr (QNORM) {
        float ss = 0.f;
#pragma unroll
        for (int kk = 0; kk < DQ / 16; ++kk) { float t8[8]; unpack8(__builtin_bit_cast(uint4, qf[kk]), t8);
#pragma unroll
            for (int i = 0; i < 8; ++i) ss += t8[i] * t8[i]; }
        ss += __shfl_xor(ss, 32);
        const float rr = rsqrtf(ss / (float)DQ + EPS);
        const float* gl = ldsf + QG_OFF / 4 + 8 * h;
#pragma unroll 1
        for (int g = 0; g < DQ / 64; ++g) {
#pragma unroll
            for (int j = 0; j < 4; ++j) {
                const float4 g0 = *(const float4*)(gl + (g * 4 + j) * 16), g1 = *(const float4*)(gl + (g * 4 + j) * 16 + 4);
                float t8[8]; unpack8(__builtin_bit_cast(uint4, qf[j]), t8);
                t8[0] *= rr * g0.x; t8[1] *= rr * g0.y; t8[2] *= rr * g0.z; t8[3] *= rr * g0.w; t8[4] *= rr * g1.x; t8[5] *= rr * g1.y; t8[6] *= rr * g1.z; t8[7] *= rr * g1.w;
                qf[j] = __builtin_bit_cast(bf16x8_t, pack8(t8));
            }
            bf16x8_t t0 = qf[0], t1 = qf[1], t2 = qf[2], t3 = qf[3];
#pragma unroll
            for (int k2 = 0; k2 + 4 < DQ / 16; ++k2) qf[k2] = qf[k2 + 4];
            qf[DQ / 16 - 4] = t0; qf[DQ / 16 - 3] = t1; qf[DQ / 16 - 2] = t2; qf[DQ / 16 - 1] = t3;
        }
        if (u.rope) {
            const float* cs = u.rope + (size_t)(u.pos0 + wq * 32 + r) * 64 + 8 * h;
#pragma unroll
            for (int k2 = 0; k2 < 2; ++k2) {
                const float4 c0 = *(const float4*)(cs + k2 * 16), c1 = *(const float4*)(cs + k2 * 16 + 4), s0 = *(const float4*)(cs + 32 + k2 * 16), s1 = *(const float4*)(cs + 32 + k2 * 16 + 4);
                const float cv[8] = {c0.x, c0.y, c0.z, c0.w, c1.x, c1.y, c1.z, c1.w}, sn[8] = {s0.x, s0.y, s0.z, s0.w, s1.x, s1.y, s1.z, s1.w};
                float x1[8], x2[8];
                unpack8(__builtin_bit_cast(uint4, qf[8 + k2]), x1); unpack8(__builtin_bit_cast(uint4, qf[10 + k2]), x2);
#pragma unroll
                for (int i = 0; i < 8; ++i) { const float a = x1[i], b = x2[i]; x1[i] = a * cv[i] - b * sn[i]; x2[i] = a * sn[i] + b * cv[i]; }
                qf[8 + k2] = __builtin_bit_cast(bf16x8_t, pack8(x1)); qf[10 + k2] = __builtin_bit_cast(bf16x8_t, pack8(x2));
            }
        }
    }
    f32x16_t ot[4];
#pragma unroll
    for (int b = 0; b < 4; ++b)
#pragma unroll
        for (int i = 0; i < 16; ++i) ot[b][i] = 0.f;
    float m = -INFINITY, l = 0.f;
    const float sc2 = u.scale * 1.4426950408889634f;
    const int myqr = u.row0 + (w >> 1), myc0 = (w & 1) * 32, myrs = min(max(myqr - 4, 0), 8);
    const int nst = u.nst0 + u.nst1;
    uint4 kr0, kr1, kr2, vr0, vr1;
    kr2 = make_uint4(0u, 0u, 0u, 0u);
    const int krow0 = tid / KCH, kcol0 = tid % KCH, krow1 = (tid + NTHREADS) / KCH, kcol1 = (tid + NTHREADS) % KCH, krow2 = (tid + 2 * NTHREADS) / KCH, kcol2 = (tid + 2 * NTHREADS) % KCH;
    const int vrow0 = tid >> 4, vc0 = tid & 15;
    const int voff = (4 * h + ((lane & 15) >> 2)) * VROW + (16 * ((lane >> 4) & 1) + 4 * (lane & 3)) * 2;
#define STAGE_LOAD(s_) do { const int s__ = (s_); const bf16_t *kp, *vp; int ks, ldv; \
        if (s__ < u.nst0) { kp = u.k0 + (size_t)s__ * 64 * u.ks0; ks = u.ks0; vp = u.vt0 + (size_t)s__ * 64 * u.ldv0; ldv = u.ldv0; } \
        else { const int s1 = s__ - u.nst0; kp = u.k1 + (size_t)s1 * 64 * u.ks1; ks = u.ks1; vp = u.vt1 + (size_t)s1 * 64 * u.ldv1; ldv = u.ldv1; } \
        kr0 = *(const uint4*)(kp + (size_t)krow0 * ks + kcol0 * 8); kr1 = *(const uint4*)(kp + (size_t)krow1 * ks + kcol1 * 8); \
        if constexpr (NKC == 3) kr2 = *(const uint4*)(kp + (size_t)krow2 * ks + kcol2 * 8); \
        vr0 = *(const uint4*)(vp + (size_t)vrow0 * ldv + vc0 * 8); vr1 = *(const uint4*)(vp + (size_t)(vrow0 + 32) * ldv + vc0 * 8); } while (0)
#define STAGE_STORE(buf_) do { unsigned char* base = lds + (buf_) * STAGE; \
        *(uint4*)(base + krow0 * KROW + kcol0 * 16) = kr0; *(uint4*)(base + krow1 * KROW + kcol1 * 16) = kr1; \
        if constexpr (NKC == 3) *(uint4*)(base + krow2 * KROW + kcol2 * 16) = kr2; \
        *(uint4*)(base + KBYTES + vrow0 * VROW + vc0 * 16) = vr0; *(uint4*)(base + KBYTES + (vrow0 + 32) * VROW + vc0 * 16) = vr1; } while (0)
    if (__builtin_amdgcn_readfirstlane(w) >= 4) __builtin_amdgcn_s_setprio(2);
    STAGE_LOAD(0); STAGE_STORE(0);
    __syncthreads();
    for (int s = 0; s < nst; ++s) {
        if (s + 1 < nst) STAGE_LOAD(s + 1);
        const unsigned char* kb = lds + (s & 1) * STAGE;
        const unsigned char* vb = kb + KBYTES;
        int lrow = -1; bool active = true;
        if (LOCAL && s >= u.nst0) { lrow = u.rs_min + (s - u.nst0); active = lrow >= myrs && lrow < myrs + 8; }
        if (active)
#pragma unroll
        for (int si = 0; si < (SPLIT ? 1 : 2); ++si) {
            const int sub = SPLIT ? kh : si;
            f32x16_t st;
#pragma unroll
            for (int i = 0; i < 16; ++i) st[i] = 0.f;
            {
                const unsigned char* krow = kb + (sub * 32 + r) * KROW + 16 * h;
                constexpr int NKK = DQ / 16;
                bf16x8_t kf[NKK];
#pragma unroll
                for (int kk = 0; kk < QK_AHEAD; ++kk) kf[kk] = *(const bf16x8_t*)(krow + kk * 32);
                __builtin_amdgcn_sched_barrier(0);
#pragma unroll
                for (int kk = 0; kk < NKK; kk += 2) {
                    if (kk + QK_AHEAD < NKK) { kf[kk + QK_AHEAD] = *(const bf16x8_t*)(krow + (kk + QK_AHEAD) * 32); kf[kk + QK_AHEAD + 1] = *(const bf16x8_t*)(krow + (kk + QK_AHEAD + 1) * 32); }
                    st = MFMA32(kf[kk], qf[kk], st); st = MFMA32(kf[kk + 1], qf[kk + 1], st);
                    __builtin_amdgcn_sched_barrier(0);
                }
            }
            float sv[16], mx = -INFINITY, kf_ = 1.f;
            if (LOCAL && lrow >= 0) {
                const int qc = myc0 + r, cs = min(max(qc - 8, 0), 48);
                const float* brow = u.bias + (lrow - myqr + 7) * 31 + (15 - qc);
#pragma unroll
                for (int i = 0; i < 16; ++i) {
                    const int kc = sub * 32 + crow(i, h);
                    const bool valid = kc >= cs && kc < cs + 16;
                    const float bv = valid ? brow[kc] * 1.4426950408889634f : 0.f;
                    sv[i] = valid ? st[i] * sc2 + bv : -INFINITY; mx = fmaxf(mx, sv[i]);
                }
            } else {
#pragma unroll
                for (int i = 0; i < 16; ++i) { sv[i] = st[i]; mx = fmaxf(mx, st[i]); }
                mx *= sc2; kf_ = sc2;
            }
            { const auto mxs = __builtin_amdgcn_permlane32_swap(__float_as_uint(mx), __float_as_uint(mx), false, false); mx = fmaxf(__uint_as_float(mxs[0]), __uint_as_float(mxs[1])); }
            const float mnew = mx > m + 8.f ? mx : m;
            const bool grew = mnew > m;
            const float alpha = __builtin_amdgcn_exp2f(m - mnew);
            m = mnew;
            float ls = 0.f;
#pragma unroll
            for (int i = 0; i < 16; ++i) { sv[i] = __builtin_amdgcn_exp2f(__builtin_fmaf(sv[i], kf_, -mnew)); ls += sv[i]; }
            l = l * alpha + ls;
            if (__any(grew)) {
#pragma unroll
                for (int b = 0; b < 4; ++b)
#pragma unroll
                    for (int i = 0; i < 16; ++i) ot[b][i] *= alpha;
            }
            {
                bf16x8_t xs[2];
#pragma unroll
                for (int s2 = 0; s2 < 2; ++s2) {
                    uint4 pk; pk.x = cvtpk(sv[8 * s2 + 0], sv[8 * s2 + 1]); pk.y = cvtpk(sv[8 * s2 + 2], sv[8 * s2 + 3]); pk.z = cvtpk(sv[8 * s2 + 4], sv[8 * s2 + 5]); pk.w = cvtpk(sv[8 * s2 + 6], sv[8 * s2 + 7]);
                    xs[s2] = __builtin_bit_cast(bf16x8_t, pk);
                }
                const unsigned char* va0 = vb + voff + sub * 32 * VROW;
#define VFRAG(j_) __builtin_shufflevector(__builtin_amdgcn_ds_read_tr16_b64_v4i16((lds_bf16x4_t*)(va0 + 16 * ((j_) >> 2) * VROW + 64 * ((j_) & 3))), \
                                          __builtin_amdgcn_ds_read_tr16_b64_v4i16((lds_bf16x4_t*)(va0 + (16 * ((j_) >> 2) + 8) * VROW + 64 * ((j_) & 3))), 0, 1, 2, 3, 4, 5, 6, 7)
                bf16x8_t vf[8];
#pragma unroll
                for (int j = 0; j < PV_AHEAD; ++j) vf[j] = VFRAG(j);
                __builtin_amdgcn_sched_barrier(0);
#pragma unroll
                for (int j = 0; j < 8; j += 2) {
                    if (j + PV_AHEAD < 8) { vf[j + PV_AHEAD] = VFRAG(j + PV_AHEAD); vf[j + PV_AHEAD + 1] = VFRAG(j + PV_AHEAD + 1); }
                    ot[j & 3] = MFMA32(vf[j], xs[j >> 2], ot[j & 3]); ot[(j + 1) & 3] = MFMA32(vf[j + 1], xs[(j + 1) >> 2], ot[(j + 1) & 3]);
                    __builtin_amdgcn_sched_barrier(0);
                }
#undef VFRAG
            }
        }
        if (s + 1 < nst) STAGE_STORE((s + 1) & 1);
        __syncthreads();
    }
    __builtin_amdgcn_s_setprio(0);
    if constexpr (SPLIT) {
        float* mg = ldsf + (size_t)wq * 66 * 64 + lane;
        if (kh) {
#pragma unroll
            for (int b = 0; b < 4; ++b)
#pragma unroll
                for (int i = 0; i < 16; ++i) mg[(b * 16 + i) * 64] = ot[b][i];
            mg[64 * 64] = m; mg[65 * 64] = l;
        }
        __syncthreads();
        if (!kh) {
            const float mo = mg[64 * 64], lo_ = mg[65 * 64];
            const float mm = fmaxf(m, mo), fa = __builtin_amdgcn_exp2f(m - mm), fb = __builtin_amdgcn_exp2f(mo - mm);
            l = l * fa + lo_ * fb;
#pragma unroll
            for (int b = 0; b < 4; ++b)
#pragma unroll
                for (int i = 0; i < 16; ++i) ot[b][i] = ot[b][i] * fa + mg[(b * 16 + i) * 64] * fb;
        }
        __syncthreads();
        if (kh) return;
    }
    l += __shfl_xor(l, 32);
    const float inv = 1.f / l;
    bf16_t* orow = u.out + (size_t)(wq * 32 + r) * D;
#pragma unroll
    for (int b = 0; b < 4; ++b)
#pragma unroll
        for (int g = 0; g < 4; ++g)
            *(uint2*)(orow + 32 * b + 8 * g + 4 * h) = make_uint2(cvtpk(ot[b][4 * g] * inv, ot[b][4 * g + 1] * inv), cvtpk(ot[b][4 * g + 2] * inv, ot[b][4 * g + 3] * inv));
}
#undef STAGE_LOAD
#undef STAGE_STORE
DEVI void attn_block_dispatch(CParams& p, int layer, int kind, int idx, float* lds) {
    AttnBlk u;
    u.k1 = nullptr; u.vt1 = nullptr; u.ks1 = 0; u.ldv1 = 0; u.nst1 = 0; u.bias = nullptr; u.row0 = 0; u.rs_min = 0; u.qg = nullptr; u.rope = nullptr; u.pos0 = 0;
    if (kind == 1) {
        const int qb = idx % 4, h = (idx / 4) % 4, b = idx / 16, t0 = NCTX + b * DS + qb * 256;
        const int rlo = min(max(4 * qb - 4, 0), 8), rhi = min(max(4 * qb + 3 - 4, 0), 8) + 8;
        u.q = p.qna_b + (size_t)t0 * 512 + h * 128; u.qstride = 512; u.scale = 0.08838834764831845f;
        u.k0 = p.cnak_b + ((size_t)(b * 4 + h) * PAST) * 128; u.ks0 = 128; u.vt0 = p.cnav_b + ((size_t)(b * 4 + h) * PAST) * 128; u.ldv0 = 128; u.nst0 = PAST / 64;
        u.k1 = p.kna_b + (size_t)(NCTX + b * DS + rlo * 64) * 512 + h * 128; u.ks1 = 512; u.vt1 = p.z_b + (size_t)(NCTX + b * DS + rlo * 64) * DIN + O_NAV + h * 128; u.ldv1 = DIN; u.nst1 = rhi - rlo;
        u.bias = p.rel_bias + ((size_t)layer * 4 + h) * 15 * 31; u.row0 = 4 * qb; u.rs_min = rlo;
        u.out = p.mix_b + (size_t)t0 * D + 1024 + h * 128;
        attn_block<128, true, false, false>(u, lds);
    } else if (kind == 0) {
        const int qb = idx % 8, h = (idx / 8) % 8, b = idx / 64, t0 = NCTX + b * DS + qb * 128;
        u.q = p.qm_b + (size_t)t0 * 1536 + h * 192; u.qstride = 1536; u.scale = 0.07216878364870322f; u.qg = p.q_head_g + layer * 192; u.rope = p.rope_cs; u.pos0 = qb * 128;
        u.k0 = p.k_b + (size_t)(T + b * PAST) * 1536 + h * 192; u.ks0 = 1536; u.vt0 = p.kvr_b + (size_t)(T + b * PAST) * 2048 + h * 256 + 128; u.ldv0 = 2048; u.nst0 = PAST / 64;
        u.k1 = p.k_b + (size_t)(NCTX + b * DS) * 1536 + h * 192; u.ks1 = 1536; u.vt1 = p.kvr_b + (size_t)(NCTX + b * DS) * 2048 + h * 256 + 128; u.ldv1 = 2048; u.nst1 = DS / 64;
        u.out = p.mix_b + (size_t)t0 * D + h * 128;
        attn_block<192, false, true, true>(u, lds);
    } else if (kind == 2) {
        const int h = idx % 8, b = idx / 8, t0 = b * SEQ;
        u.q = p.qm_b + (size_t)t0 * 1536 + h * 192; u.qstride = 1536; u.scale = 0.07216878364870322f; u.qg = p.q_head_g + layer * 192;
        u.k0 = p.k_b + (size_t)t0 * 1536 + h * 192; u.ks0 = 1536; u.vt0 = p.kvr_b + (size_t)t0 * 2048 + h * 256 + 128; u.ldv0 = 2048; u.nst0 = SEQ / 64;
        u.out = p.mix_b + (size_t)t0 * D + h * 128;
        attn_block<192, false, true, false>(u, lds);
    } else {
        const int h = idx % 4, b = idx / 4, t0 = b * SEQ;
        u.q = p.qna_b + (size_t)t0 * 512 + h * 128; u.qstride = 512; u.scale = 0.08838834764831845f;
        u.k0 = p.kna_b + (size_t)t0 * 512 + h * 128; u.ks0 = 512; u.vt0 = p.z_b + (size_t)t0 * DIN + O_NAV + h * 128; u.ldv0 = DIN; u.nst0 = SEQ / 64;
        u.out = p.mix_b + (size_t)t0 * D + 1024 + h * 128;
        attn_block<128, false, false, false>(u, lds);
    }
}
#ifndef ATTN_ROLE
#define ATTN_ROLE 0
#endif
DEVI void phase_attn(CParams& p, int layer, int bid, int nb, float* lds, int rep = 0) {
    const int role = rep ? ATTN_ROLE : 0;
    constexpr int N_LNA = DB * 4 * (DS / 256), N_HV = DB * 8 * (DS / 128), N_CM = BATCH * 8, N_CN = BATCH * 4;
    const int nA = nb / 8, nH = nb / 2, nL = nb - nA - nH;
    if (tidx() < 192) lds[QG_OFF / 4 + tidx()] = p.q_head_g[layer * 192 + tidx()];
    __syncthreads();
    if (bid < nA) {
        if (role != 0 && role != 1) return;
        for (int it = bid; it < N_LNA; it += nA) attn_block_dispatch(p, layer, 1, it, lds);
    } else if (bid < nA + nH) {
        if (role != 0 && role != 2) return;
        for (int it = bid - nA; it < N_HV; it += nH) attn_block_dispatch(p, layer, 0, it, lds);
        if (bid - nA < N_CN) attn_block_dispatch(p, layer, 3, bid - nA, lds);
    } else {
        if (role != 0 && role != 3) return;
        const int ncn0 = nH < N_CN ? nH : N_CN;
        for (int it = bid - nA - nH; it < N_CM + N_CN - ncn0; it += nL) {
            if (it < N_CM) attn_block_dispatch(p, layer, 2, it, lds); else attn_block_dispatch(p, layer, 3, ncn0 + it - N_CM, lds);
        }
    }
}

template <int N, int K, int J>
DEVI void bitonic_stage(float (&v)[N]) {
#pragma unroll
    for (int i = 0; i < N; ++i) {
        const int l = i ^ J;
        if (l > i) { const bool desc = ((i & K) == 0); const float a = v[i], b = v[l], mx = fmaxf(a, b), mn = fminf(a, b); v[i] = desc ? mx : mn; v[l] = desc ? mn : mx; }
    }
}
template <int N, int K, int J> DEVI void bitonic_j(float (&v)[N]) { bitonic_stage<N, K, J>(v); if constexpr (J > 1) bitonic_j<N, K, J / 2>(v); }
template <int N, int K> DEVI void bitonic_k(float (&v)[N]) { bitonic_j<N, K, K / 2>(v); if constexpr (K < N) bitonic_k<N, K * 2>(v); }
template <int N> DEVI void bitonic_sort_desc(float (&v)[N]) { bitonic_k<N, 2>(v); }
DEVI void merge_top16(float (&a)[16], const float (&b)[16]) {
#pragma unroll
    for (int i = 0; i < 16; ++i) a[i] = fmaxf(a[i], b[15 - i]);
    bitonic_j<16, 16, 8>(a);
}
constexpr int cand_ab(int idx) { int n = 0; for (int a = 0; a < 16; ++a) for (int b = 0; b < 16; ++b) if ((a + 1) * (b + 1) <= 16) { if (n == idx) return a * 16 + b; ++n; } return -1; }
template <int CH, int I>
DEVI void cand_fill(float (&c)[16], const float (&s1)[16], const float (&s2)[16]) {
    constexpr int ab = cand_ab(CH * 16 + I);
    if constexpr (ab >= 0) c[I] = __uint_as_float((__float_as_uint(s1[ab >> 4] + s2[ab & 15]) & ~255u) | (unsigned)ab); else c[I] = -INFINITY;
    if constexpr (I + 1 < 16) cand_fill<CH, I + 1>(c, s1, s2);
}
DEVI float packkey(float v, unsigned id, unsigned mask) { return __uint_as_float((__float_as_uint(v) & ~mask) | id); }

DEVI void phase_route(CParams& p, int layer, int bid, int nb, float* lds) {
    const int lane = tidx() & 63, w = __builtin_amdgcn_readfirstlane(tidx() >> 6), r = lane & 31, h = lane >> 5;
    constexpr int SKROW = 272;
    unsigned char* skl = (unsigned char*)lds;
    unsigned char* ix = skl + 256 * SKROW + w * 2048;
    const int nparts = nb / 8, hh = bid & 7, part = bid >> 3;
    if (part >= nparts) return;
    constexpr int NTILE = T / 32;
    const int per = (NTILE + nparts - 1) / nparts, tile_lo = part * per, tile_hi = min(NTILE, tile_lo + per);
    {
        const bf16_t* src = p.sk_b + ((size_t)layer * 8 + hh) * 2 * 128 * 128;
        for (int c = tidx(); c < 256 * 16; c += NTHREADS) { const int row = c >> 4, ch = c & 15; *(uint4*)(skl + row * SKROW + ch * 16) = *(const uint4*)(src + (size_t)row * 128 + ch * 8); }
    }
    __syncthreads();
    for (int tt = tile_lo + w; tt < tile_hi; tt += NWAVES) {
        const int t0 = tt * 32;
        float s12[2][16];
#pragma unroll
        for (int pp = 0; pp < 2; ++pp) {
            bf16x8_t qf[8];
            const bf16_t* qrow = p.qp_b + (size_t)(t0 + r) * D + hh * 256 + pp * 128 + 8 * h;
#pragma unroll
            for (int kk = 0; kk < 8; ++kk) qf[kk] = *(const bf16x8_t*)(qrow + kk * 16);
            const unsigned char* sk = skl + (pp * 128 + r) * SKROW + 16 * h;
            float top[16];
#pragma unroll
            for (int i = 0; i < 16; ++i) top[i] = -INFINITY;
#pragma unroll 1
            for (int blk = 0; blk < 4; ++blk) {
                const unsigned char* skb = sk + blk * 32 * SKROW;
                f32x16_t acc;
#pragma unroll
                for (int i = 0; i < 16; ++i) acc[i] = 0.f;
                {
                    bf16x8_t sf[8];
#pragma unroll
                    for (int kk = 0; kk < 4; ++kk) sf[kk] = *(const bf16x8_t*)(skb + kk * 32);
                    __builtin_amdgcn_sched_barrier(0);
#pragma unroll
                    for (int kk = 0; kk < 8; kk += 2) {
                        if (kk + 4 < 8) { sf[kk + 4] = *(const bf16x8_t*)(skb + (kk + 4) * 32); sf[kk + 5] = *(const bf16x8_t*)(skb + (kk + 5) * 32); }
                        acc = MFMA32(sf[kk], qf[kk], acc); acc = MFMA32(sf[kk + 1], qf[kk + 1], acc);
                        __builtin_amdgcn_sched_barrier(0);
                    }
                }
                float c[16];
#pragma unroll
                for (int i = 0; i < 16; ++i) c[i] = packkey(acc[i], (unsigned)(32 * blk + crow(i, h)), 127u);
                bitonic_sort_desc<16>(c);
                merge_top16(top, c);
            }
            float o[16];
#pragma unroll
            for (int i = 0; i < 16; ++i) { const auto sw = __builtin_amdgcn_permlane32_swap(__float_as_uint(top[i]), __float_as_uint(top[i]), false, false); top[i] = __uint_as_float(sw[0]); o[i] = __uint_as_float(sw[1]); }
            merge_top16(top, o);
#pragma unroll
            for (int i = 0; i < 16; ++i) { s12[pp][i] = top[i]; ix[(pp * 16 + i) * 64 + lane] = (unsigned char)(__float_as_uint(top[i]) & 127u); }
        }
        float best[16];
        {
            float c[16];
            cand_fill<0, 0>(best, s12[0], s12[1]); bitonic_sort_desc<16>(best);
            cand_fill<1, 0>(c, s12[0], s12[1]); bitonic_sort_desc<16>(c); merge_top16(best, c);
            cand_fill<2, 0>(c, s12[0], s12[1]); bitonic_sort_desc<16>(c); merge_top16(best, c);
            cand_fill<3, 0>(c, s12[0], s12[1]); bitonic_sort_desc<16>(c); merge_top16(best, c);
        }
        __builtin_amdgcn_wave_barrier();
        float g[16], sum = 0.f; int ex[16];
        const float mx = __uint_as_float(__float_as_uint(best[0]) & ~255u);
#pragma unroll
        for (int k = 0; k < 16; ++k) {
            const unsigned bits = __float_as_uint(best[k]), id = bits & 255u;
            g[k] = __expf(__uint_as_float(bits & ~255u) - mx); sum += g[k];
            ex[k] = (int)ix[(id >> 4) * 64 + lane] * 128 + (int)ix[(16 + (id & 15)) * 64 + lane];
        }
        const float inv = 1.f / sum;
        if (h == 0) {
            int* eo = p.eidx + (size_t)(t0 + r) * 128 + hh * 16; float* go = p.gate + (size_t)(t0 + r) * 128 + hh * 16;
#pragma unroll
            for (int k = 0; k < 16; k += 4) { *(int4*)(eo + k) = make_int4(ex[k], ex[k + 1], ex[k + 2], ex[k + 3]); *(float4*)(go + k) = make_float4(g[k] * inv, g[k + 1] * inv, g[k + 2] * inv, g[k + 3] * inv); }
        }
        __builtin_amdgcn_wave_barrier();
    }
}

typedef float f32x2v __attribute__((ext_vector_type(2)));
typedef float f32x4v __attribute__((ext_vector_type(4)));
constexpr int EXP_TOK = 5, EXP_SROW = 144, EXP_STAGE = 64 * EXP_SROW, EXP_EI_OFF = EXP_STAGE, EXP_AU_OFF = EXP_EI_OFF + 2560, EXP_WAVE_LDS = EXP_AU_OFF + 2560;
DEVI float gelu_exact(float v) { return 0.5f * v * (1.f + erff(v * 0.70710678118654752f)); }
DEVI long mk64(unsigned lo, unsigned hi) { return (long)(((unsigned long)hi << 32) | lo); }
#ifndef EXP_PROBE
#define EXP_PROBE 0
#endif
struct ExpVL { uint4 v[16]; };
typedef int v8i_t __attribute__((ext_vector_type(8)));
struct ExpUL { uint4 v[8]; uint4 b[4]; };
DEVI void exp_loadu(ExpUL& L, const unsigned char* U, const int* ei, const unsigned char* x8row, int c, int k, int hf, int lane) {
    const int g8 = lane >> 3, s8 = lane & 7, q4 = lane >> 4;
    const unsigned char* Us = U + (size_t)c * 16384 * 128 + s8 * 16;
#pragma unroll
    for (int i = 0; i < 8; ++i) L.v[i] = *(const uint4*)(Us + (size_t)ei[k * 128 + g8 * 16 + hf * 8 + i] * 128);
    const unsigned char* xp = x8row + c * 256 + q4 * 16;
    L.b[0] = *(const uint4*)xp; L.b[1] = *(const uint4*)(xp + 64); L.b[2] = *(const uint4*)(xp + 128); L.b[3] = *(const uint4*)(xp + 192);
}
DEVI void exp_compu(const ExpUL& L, unsigned char* sb, float* au, int k, int hf, int lane) {
    const int g8 = lane >> 3, s8 = lane & 7, r16 = lane & 15, q4 = lane >> 4;
    const v8i_t B0 = {(int)L.b[0].x, (int)L.b[0].y, (int)L.b[0].z, (int)L.b[0].w, (int)L.b[1].x, (int)L.b[1].y, (int)L.b[1].z, (int)L.b[1].w};
    const v8i_t B1 = {(int)L.b[2].x, (int)L.b[2].y, (int)L.b[2].z, (int)L.b[2].w, (int)L.b[3].x, (int)L.b[3].y, (int)L.b[3].z, (int)L.b[3].w};
#pragma unroll
    for (int ii = 0; ii < 8; ++ii) *(uint4*)(sb + (g8 * 8 + ii) * EXP_SROW + s8 * 16) = make_uint4(L.v[ii].x, L.v[ii].y, L.v[ii].z, L.v[ii].w);
    __builtin_amdgcn_wave_barrier();
#pragma unroll
    for (int G = 0; G < 4; ++G) {
        float* ak = au + k * 128 + (2 * G + (q4 >> 1)) * 16 + hf * 8 + 4 * (q4 & 1);
        const float4 cin = *(const float4*)ak;
        f32x4v acc = {cin.x, cin.y, cin.z, cin.w};
        const unsigned char* ar = sb + (G * 16 + r16) * EXP_SROW + q4 * 16;
        const uint4 a0 = *(const uint4*)ar, a1 = *(const uint4*)(ar + 64);
        const v8i_t A0 = {(int)a0.x, (int)a0.y, (int)a0.z, (int)a0.w, 0, 0, 0, 0}, A1 = {(int)a1.x, (int)a1.y, (int)a1.z, (int)a1.w, 0, 0, 0, 0};
        acc = __builtin_amdgcn_mfma_scale_f32_16x16x128_f8f6f4(A0, B0, acc, 4, 0, 0, 0x7F7F7F7F, 0, 0x7F7F7F7F);
        acc = __builtin_amdgcn_mfma_scale_f32_16x16x128_f8f6f4(A1, B1, acc, 4, 0, 0, 0x7F7F7F7F, 0, 0x7F7F7F7F);
        if (r16 == 0) *(float4*)ak = make_float4(acc[0], acc[1], acc[2], acc[3]);
    }
    __builtin_amdgcn_wave_barrier();
}
DEVI void exp_loadv(ExpVL& L, const unsigned char* V, const int* ei, int c, int k, int g8, int s8) {
    const unsigned char* Vs = V + (size_t)c * 16384 * 128 + s8 * 16;
#pragma unroll
    for (int i = 0; i < 16; ++i) L.v[i] = *(const uint4*)(Vs + (size_t)ei[k * 128 + g8 * 16 + i] * 128);
}
DEVI float dpp_ror8(float v) { return __builtin_bit_cast(float, __builtin_amdgcn_update_dpp(0, __builtin_bit_cast(int, v), 0x128, 0xf, 0xf, false)); }
DEVI void exp_compv(const ExpVL& L, const float* wl, bf16_t* xrow_, float* yrow_, const float* g2row, float* ssq, int c, int k, int g8, int s8, bool b5, bool b4, bool b3, bool do_store) {
    const int col = c * 256 + s8 * 32 + 4 * g8;
    const uint2 xq = *(const uint2*)(xrow_ + col); const float4 g2 = *(const float4*)(g2row + col);
    const float4 x1 = make_float4(__uint_as_float(xq.x << 16), __uint_as_float(xq.x & 0xffff0000u), __uint_as_float(xq.y << 16), __uint_as_float(xq.y & 0xffff0000u));
    f32x2v o[16];
#pragma unroll
    for (int j = 0; j < 16; ++j) o[j] = (f32x2v){0.f, 0.f};
#pragma unroll
    for (int i = 0; i < 16; ++i) {
        const float wg1 = wl[k * 128 + g8 * 16 + i]; const f32x2v wg = {wg1, wg1};
        const unsigned qq[4] = {L.v[i].x, L.v[i].y, L.v[i].z, L.v[i].w};
#pragma unroll
        for (int d = 0; d < 4; ++d) {
            o[4 * d + 0] = __builtin_elementwise_fma(__builtin_amdgcn_cvt_scalef32_pk_f32_fp4(qq[d], 1.0f, 0), wg, o[4 * d + 0]);
            o[4 * d + 1] = __builtin_elementwise_fma(__builtin_amdgcn_cvt_scalef32_pk_f32_fp4(qq[d], 1.0f, 1), wg, o[4 * d + 1]);
            o[4 * d + 2] = __builtin_elementwise_fma(__builtin_amdgcn_cvt_scalef32_pk_f32_fp4(qq[d], 1.0f, 2), wg, o[4 * d + 2]);
            o[4 * d + 3] = __builtin_elementwise_fma(__builtin_amdgcn_cvt_scalef32_pk_f32_fp4(qq[d], 1.0f, 3), wg, o[4 * d + 3]);
        }
    }
    f32x2v r8[8];
#pragma unroll
    for (int j = 0; j < 8; ++j) {
        const auto sx = __builtin_amdgcn_permlane32_swap(__float_as_uint(o[j].x), __float_as_uint(o[8 + j].x), false, false);
        const auto sy = __builtin_amdgcn_permlane32_swap(__float_as_uint(o[j].y), __float_as_uint(o[8 + j].y), false, false);
        r8[j] = (f32x2v){__uint_as_float(sx[0]) + __uint_as_float(sx[1]), __uint_as_float(sy[0]) + __uint_as_float(sy[1])};
    }
    f32x2v r4[4];
#pragma unroll
    for (int j = 0; j < 4; ++j) {
        const auto sx = __builtin_amdgcn_permlane16_swap(__float_as_uint(r8[j].x), __float_as_uint(r8[4 + j].x), false, false);
        const auto sy = __builtin_amdgcn_permlane16_swap(__float_as_uint(r8[j].y), __float_as_uint(r8[4 + j].y), false, false);
        r4[j] = (f32x2v){__uint_as_float(sx[0]) + __uint_as_float(sx[1]), __uint_as_float(sy[0]) + __uint_as_float(sy[1])};
    }
    (void)b5; (void)b4;
    f32x2v r2[2];
#pragma unroll
    for (int j = 0; j < 2; ++j) {
        const f32x2v lo = r4[j], hi = r4[2 + j];
        const f32x2v slo = {lo.x + dpp_ror8(lo.x), lo.y + dpp_ror8(lo.y)}, shi = {hi.x + dpp_ror8(hi.x), hi.y + dpp_ror8(hi.y)};
        r2[j] = b3 ? shi : slo;
    }
    const float4 xv = make_float4(x1.x + g2.x * r2[0].x, x1.y + g2.y * r2[0].y, x1.z + g2.z * r2[1].x, x1.w + g2.w * r2[1].y);
    if (do_store) {
        if (yrow_) *(float4*)(yrow_ + col) = xv;
        else {
            const unsigned p0 = cvtpk(xv.x, xv.y), p1 = cvtpk(xv.z, xv.w);
            *(uint2*)(xrow_ + col) = make_uint2(p0, p1);
            const float r0 = __uint_as_float(p0 << 16), r1 = __uint_as_float(p0 & 0xffff0000u), r2 = __uint_as_float(p1 << 16), r3 = __uint_as_float(p1 & 0xffff0000u);
            ssq[k * 64] += (r0 * r0 + r1 * r1) + (r2 * r2 + r3 * r3);
        }
    } else asm volatile("" :: "v"(xv.x), "v"(xv.y), "v"(xv.z), "v"(xv.w));
}
DEVI void phase_experts(CParams& p, int layer, int bid, int nb, float* ldsf) {
    const int w = __builtin_amdgcn_readfirstlane(tidx() >> 6);
    unsigned char* wb = (unsigned char*)ldsf + w * EXP_WAVE_LDS;
    unsigned char* sb = wb;
    float* wl = (float*)wb;
    int* ei = (int*)(wb + EXP_EI_OFF);
    float* au = (float*)(wb + EXP_AU_OFF);
    const unsigned char* U = p.pu8 + (size_t)layer * EXP_NSL * 16384 * 128;
    const unsigned char* V = p.pv8 + (size_t)layer * EXP_NSL * 16384 * 128;
    const float* SU = p.su8 + (size_t)layer * 16384;
    const float* SV = p.sv8 + (size_t)layer * 16384;
    const int gw = bid * NWAVES + w, nw = nb * NWAVES;
#pragma unroll 1
    for (int prep = 0; prep < (EXP_PROBE == 3 ? 2 : 1); ++prep)
    for (int tb = gw; tb < T; tb += nw * EXP_TOK) {
        int nv = 0;
#pragma unroll
        for (int k = 0; k < EXP_TOK; ++k) nv += (tb + k * nw < T) ? 1 : 0;
#pragma unroll 1
        for (int k = 0; k < nv; ++k) {
            const int t = tb + k * nw, lane = tidx() & 63;
#pragma unroll
            for (int j = 0; j < 4; ++j) {
                float f[8]; unpack8(*(const uint4*)(p.hn_b + (size_t)t * D + j * 512 + lane * 8), f);
                int lo = 0, hi = 0;
                lo = __builtin_amdgcn_cvt_pk_fp8_f32(f[0], f[1], lo, false); lo = __builtin_amdgcn_cvt_pk_fp8_f32(f[2], f[3], lo, true);
                hi = __builtin_amdgcn_cvt_pk_fp8_f32(f[4], f[5], hi, false); hi = __builtin_amdgcn_cvt_pk_fp8_f32(f[6], f[7], hi, true);
                *(int2*)(p.x8g + (size_t)t * D + j * 512 + lane * 8) = make_int2(lo, hi);
            }
            *(int2*)(ei + k * 128 + lane * 2) = *(const int2*)(p.eidx + (size_t)t * 128 + lane * 2);
            *(float2*)(au + k * 128 + lane * 2) = make_float2(0.f, 0.f);
        }
        asm volatile("s_waitcnt vmcnt(0)" ::: "memory");
        __builtin_amdgcn_wave_barrier();
        const int nst = EXP_NSL * nv;
        {
        const int lu = tidx() & 63;
#define EXP_X8ROW(k_) (p.x8g + (size_t)(tb + (k_) * nw) * D)
#pragma unroll 1
        for (int urep = 0; urep < (EXP_PROBE == 1 ? 3 : 1); ++urep) {
            ExpUL LA, LB;
            int c = 0, k = 0;
            exp_loadu(LA, U, ei, EXP_X8ROW(0), 0, 0, 0, lu);
#pragma unroll 1
            for (int st = 0; st < nst; ++st) {
                int k1 = k + 1, c1 = c; if (k1 == nv) { k1 = 0; ++c1; }
                if (c1 == EXP_NSL) { c1 = EXP_NSL - 1; k1 = nv - 1; }
                exp_loadu(LB, U, ei, EXP_X8ROW(k), c, k, 1, lu);
                exp_compu(LA, sb, au, k, 0, lu);
                exp_loadu(LA, U, ei, EXP_X8ROW(k1), c1, k1, 0, lu);
                exp_compu(LB, sb, au, k, 1, lu);
                c = c1; k = k1;
            }
            if (EXP_PROBE == 1 && urep < 2) { __builtin_amdgcn_wave_barrier();
#pragma unroll 1
                for (int kk = 0; kk < nv; ++kk) *(float2*)(au + kk * 128 + lu * 2) = make_float2(0.f, 0.f);
                __builtin_amdgcn_wave_barrier(); }
        }
#undef EXP_X8ROW
        }
        __builtin_amdgcn_wave_barrier();
#pragma unroll 1
        for (int k = 0; k < nv; ++k) {
            const int t = tb + k * nw, lane = tidx() & 63;
#pragma unroll
            for (int j = 0; j < 2; ++j) {
                const int slot = lane + 64 * j, idx = ei[k * 128 + slot];
                const float a = au[k * 128 + slot] * SU[idx];
                wl[k * 128 + slot] = p.gate[(size_t)t * 128 + slot] * gelu_exact(a) * SV[idx];
            }
        }
        __builtin_amdgcn_wave_barrier();
        const int lv = tidx() & 63, g8 = lv >> 3, s8 = lv & 7;
        float* ssq = au + lv;
#pragma unroll
        for (int k = 0; k < EXP_TOK; ++k) ssq[k * 64] = 0.f;
        const bool b5 = lv & 32, b4 = lv & 16, b3 = lv & 8;
#pragma unroll 1
        for (int vrep = 0; vrep < (EXP_PROBE == 2 ? 3 : 1); ++vrep) {
            const bool do_store = EXP_PROBE == 3 ? (prep == 1) : ((EXP_PROBE != 2) || vrep == 2);
            ExpVL LA, LB;
            int c = 0, k = 0;
#define EXP_XROW(k_) (p.xb + (size_t)(tb + (k_) * nw) * D)
#define EXP_YROW(k_) (layer + 1 < DEPTH ? (float*)nullptr : p.out + (size_t)(tb + (k_) * nw) * D)
#define EXP_G2ROW(k_) (p.ada + ((size_t)layer * 3 + cond_of(tb + (k_) * nw)) * 6 * D + 5 * D)
            exp_loadv(LA, V, ei, 0, 0, g8, s8);
#pragma unroll 1
            for (int st = 0; st < nst; st += 2) {
                int k1 = k + 1, c1 = c; if (k1 == nv) { k1 = 0; ++c1; }
                int k2 = k1 + 1, c2 = c1; if (k2 == nv) { k2 = 0; ++c2; }
                if (c2 == EXP_NSL) { c2 = EXP_NSL - 1; k2 = nv - 1; }
                exp_loadv(LB, V, ei, c1, k1, g8, s8);
                exp_compv(LA, wl, EXP_XROW(k), EXP_YROW(k), EXP_G2ROW(k), ssq, c, k, g8, s8, b5, b4, b3, do_store);
                exp_loadv(LA, V, ei, c2, k2, g8, s8);
                exp_compv(LB, wl, EXP_XROW(k1), EXP_YROW(k1), EXP_G2ROW(k1), ssq, c1, k1, g8, s8, b5, b4, b3, do_store);
                c = c2; k = k2;
            }
#undef EXP_XROW
#undef EXP_YROW
#undef EXP_G2ROW
        }
        __builtin_amdgcn_wave_barrier();
        if (layer + 1 < DEPTH && (EXP_PROBE != 3 || prep == 1)) {
            asm volatile("s_waitcnt vmcnt(0)" ::: "memory");
#pragma unroll 1
            for (int k = 0; k < nv; ++k) {
                const int t = tb + k * nw, lane = tidx() & 63;
                const float ss = wave_sum(au[k * 64 + lane]);
                const float rr = rsqrtf(ss / D + EPS);
                const float* g = p.norm_mix_g + (size_t)(layer + 1) * D;
                const float* ad = p.ada + ((size_t)(layer + 1) * 3 + cond_of(t)) * 6 * D;
                const unsigned long long* xr = (const unsigned long long*)(p.xb + (size_t)t * D);
#pragma unroll
                for (int j = 0; j < 4; ++j) {
                    const int cb = j * 512 + lane * 8;
                    float xv[8];
#pragma unroll
                    for (int q = 0; q < 2; ++q) { const unsigned long long u2 = __hip_atomic_load(xr + (cb >> 2) + q, __ATOMIC_RELAXED, __HIP_MEMORY_SCOPE_AGENT); const unsigned lo = (unsigned)u2, hi = (unsigned)(u2 >> 32);
                        xv[4 * q] = __uint_as_float(lo << 16); xv[4 * q + 1] = __uint_as_float(lo & 0xffff0000u); xv[4 * q + 2] = __uint_as_float(hi << 16); xv[4 * q + 3] = __uint_as_float(hi & 0xffff0000u); }
                    float hv[8];
#pragma unroll
                    for (int q = 0; q < 2; ++q) {
                        const float4 gg = *(const float4*)(g + cb + q * 4), sh = *(const float4*)(ad + cb + q * 4), sc = *(const float4*)(ad + D + cb + q * 4);
                        hv[q * 4 + 0] = xv[q * 4 + 0] * rr * gg.x * (1.f + sc.x) + sh.x; hv[q * 4 + 1] = xv[q * 4 + 1] * rr * gg.y * (1.f + sc.y) + sh.y;
                        hv[q * 4 + 2] = xv[q * 4 + 2] * rr * gg.z * (1.f + sc.z) + sh.z; hv[q * 4 + 3] = xv[q * 4 + 3] * rr * gg.w * (1.f + sc.w) + sh.w;
                    }
                    *(uint4*)(p.hn_b + (size_t)t * D + cb) = pack8(hv);
                }
            }
        }
        __builtin_amdgcn_wave_barrier();
    }
}

enum { PH_ADA = 0, PH_NORM1, PH_WIN, PH_POSTZ, PH_UQKV, PH_HEADNORM, PH_ATTN, PH_WOUT, PH_NORM2, PH_WQ, PH_SCORES, PH_ROUTE, PH_EXPERTS, PH_COUNT };

DEVI void tail_table_ada(CParams& p, int layer, bool isv, int rk, int nr, float* lds) {
    const int ib = isv ? 24 : 0;
    if (layer + 1 >= DEPTH) { conv_table(p, layer, isv, rk, nr); return; }
    if (nr > 48) {
        if (rk < 24) conv_ada(p, layer + 1, rk, 24, lds, ib, ib + 24); else conv_table(p, layer, isv, rk - 24, nr - 24);
    } else { conv_table(p, layer, isv, rk, nr); conv_ada(p, layer + 1, rk, nr, lds, ib, ib + 24); }
}
template <int PH>
DEVI void run_phase(CParams& p, int layer, int bid, int nb, float* lds, int rep = 0) {
    if constexpr (PH == PH_ADA) phase_prologue(p, bid, nb, lds);
    if constexpr (PH == PH_NORM1) phase_modnorm(p, layer, 0, bid, nb);
    if constexpr (PH == PH_WIN) {
        int rk = 0, nr = 1; const bool idle = rep == 0 && gemm_idle_rank((T / 256) * (DINP / 256), bid, nb, rk, nr);
        const bool first = idle && (rk & 1);
        if (first) { conv_weights(p, layer, 1, rk, nr, lds); if (layer + 1 < DEPTH) conv_weights(p, layer + 1, 0, rk, nr, lds); __syncthreads(); }
        mfma_gemm(p.hn_b, p.wt_in + (size_t)layer * DINP * D, T, DINP, D, EpiBf16Store{p.z_b, DIN, DIN}, bid, nb, lds);
        if (idle && !first) { conv_weights(p, layer, 1, rk, nr, lds); if (layer + 1 < DEPTH) conv_weights(p, layer + 1, 0, rk, nr, lds); } }
    if constexpr (PH == PH_POSTZ) phase_postz(p, layer, bid, nb);
    if constexpr (PH == PH_UQKV) {
        mfma_gemm(p.cqn_b, p.wt_uq + (size_t)layer * 1536 * 512, T, 1536, 512, EpiBf16Store{p.qm_b, 1536, 1536}, bid, nb, lds);
        mfma_gemm(p.ckv_b, p.wt_ukv + (size_t)layer * 2048 * 256, TKV, 2048, 256, EpiBf16Store{p.kvr_b, 2048, 2048}, bid, nb, lds);
    }
    if constexpr (PH == PH_HEADNORM) phase_headnorm(p, layer, bid, nb, lds);
    if constexpr (PH == PH_ATTN) phase_attn(p, layer, bid, nb, lds, rep);
    if constexpr (PH == PH_WOUT) {
        int rk = 0, nr = 1; const bool idle = rep == 0 && gemm_idle_rank((T / 256) * (D / 256), bid, nb, rk, nr);
        const bool first = idle && (rk & 1);
        if (first) { tail_table_ada(p, layer, false, rk, nr, lds); __syncthreads(); }
        mfma_gemm(p.mix_b, p.wt_out + (size_t)layer * D * D, T, D, D, EpiResidMF{&p, layer}, bid, nb, lds);
        if (idle && !first) tail_table_ada(p, layer, false, rk, nr, lds); }
    if constexpr (PH == PH_NORM2) phase_modnorm(p, layer, 1, bid, nb);
    if constexpr (PH == PH_WQ) {
        int rk = 0, nr = 1; const bool idle = rep == 0 && gemm_idle_rank((T / 256) * (D / 256), bid, nb, rk, nr);
        const bool first = idle && (rk & 1);
        if (first) { tail_table_ada(p, layer, true, rk, nr, lds); __syncthreads(); }
        mfma_gemm(p.hn_b, p.wt_q + (size_t)layer * D * D, T, D, D, EpiBf16Store{p.qp_b, D, D}, bid, nb, lds);
        if (idle && !first) tail_table_ada(p, layer, true, rk, nr, lds); }
    if constexpr (PH == PH_ROUTE) phase_route(p, layer, bid, nb, lds);
    if constexpr (PH == PH_EXPERTS) phase_experts(p, layer, bid, nb, lds);
}

#ifndef MK_ONE_LAUNCH
#define MK_ONE_LAUNCH 1
#endif
constexpr size_t LDS_BYTES = LDS_TOTAL;

#if MK_ONE_LAUNCH
#ifndef PROBE_MASK
#define PROBE_MASK 0
#endif
#define PHASE1(PH, l, rep_) do { CParams* q_ = pp; asm volatile("" : "+s"(q_)); run_phase<PH>(*q_, l, (int)blockIdx.x, (int)gridDim.x, lds, rep_); \
    XcdBarrier b_; b_.bar = q_->bar; b_.x = xb_xcc_id(); b_.st = (volatile LAS unsigned*)(lds_raw + MISC_OFF); xcd_barrier(b_); } while (0)
#define PHASE(PH, l) do { PHASE1(PH, l, 0); if constexpr ((PROBE_MASK >> PH) & 1) { PHASE1(PH, l, 1); PHASE1(PH, l, 1); } } while (0)
__global__ void __launch_bounds__(NTHREADS, 2) k_fwd(Params p_unused) {
    CParams* pp = (CParams*)__builtin_amdgcn_kernarg_segment_ptr();
    extern __shared__ __attribute__((aligned(16))) unsigned char lds_raw[];
    float* lds = (float*)lds_raw;
    if (threadIdx.x == 0) *(uint4*)(lds_raw + MISC_OFF) = make_uint4(0u, 0u, 0u, 0u);
    __syncthreads();
    (void)xcd_barrier_post(pp->bar, (volatile LAS unsigned*)(lds_raw + MISC_OFF));
    PHASE(PH_ADA, 0);
    for (int l = 0; l < DEPTH; ++l) {
        if (l == 0) PHASE(PH_NORM1, l);
        PHASE(PH_WIN, l);
        PHASE(PH_POSTZ, l);
        PHASE(PH_UQKV, l);
        PHASE(PH_HEADNORM, l);
        PHASE(PH_ATTN, l);
        PHASE(PH_WOUT, l);
#ifdef PROBE_WOUT0
        if (l == 0) { PHASE1(PH_WOUT, l, 1); PHASE1(PH_WOUT, l, 1); }
#endif
        PHASE(PH_NORM2, l);
        PHASE(PH_WQ, l);
        PHASE(PH_ROUTE, l);
        PHASE(PH_EXPERTS, l);
    }
}
#endif

}

extern "C" void kernel_launch(void* const* d_in, const int* in_sizes, int n_in, void* d_out, int out_size, void* d_ws, size_t ws_size, hipStream_t stream) {
    Params p{};
    const float* const* in = (const float* const*)d_in;
    p.x_prompt = in[0]; p.x_sample = in[1]; p.cache_ckv = in[2]; p.cache_kpe = in[3]; p.cache_nak = in[4]; p.cache_nav = in[5]; p.c = in[6]; p.c_ctx = in[7];
    p.ada_w = in[8]; p.ada_b = in[9]; p.norm_mix_g = in[10]; p.norm_ffn_g = in[11]; p.w_in = in[12]; p.q_norm_g = in[13]; p.w_uq = in[14]; p.kv_norm_g = in[15]; p.w_ukv = in[16];
    p.q_head_g = in[17]; p.k_head_g = in[18]; p.naq_g = in[19]; p.nak_g = in[20]; p.rel_bias = in[21]; p.conv_w = in[22]; p.w_out = in[23]; p.peer_wq = in[24]; p.sub_keys = in[25];
    p.peer_u = in[26]; p.peer_v = in[27];
    float* out = (float*)d_out;
    p.out = out;
    p.o_ckv = out + (size_t)T * D;
    p.o_kpe = p.o_ckv + (size_t)BATCH * DEPTH * SEQ * 256;
    p.o_nak = p.o_kpe + (size_t)BATCH * DEPTH * SEQ * 64;
    p.o_nav = p.o_nak + (size_t)BATCH * DEPTH * 4 * SEQ * 128;
    char* ws = (char*)d_ws; size_t off = 0;
    auto carve = [&](size_t bytes) { void* r = ws + off; off += (bytes + 255) & ~(size_t)255; return r; };
    p.bar = (unsigned*)carve(16384);
    p.ada = (float*)carve((size_t)DEPTH * 3 * 6 * D * 4);
    p.z_b = (bf16_t*)carve((size_t)(T + 1) * DIN * 2);
    p.rope_cs = (float*)carve((size_t)DS * 64 * 4);
    p.qm_b = (bf16_t*)carve((size_t)T * 1536 * 2);
    p.kvr_b = (bf16_t*)carve((size_t)TKV * 2048 * 2);
    p.gate = (float*)carve((size_t)T * 128 * 4);
    p.eidx = (int*)carve((size_t)T * 128 * 4);
    p.wt_in = (bf16_t*)carve((size_t)DEPTH * DINP * D * 2);
    p.wt_uq = (bf16_t*)carve((size_t)DEPTH * 1536 * 512 * 2);
    p.wt_ukv = (bf16_t*)carve((size_t)DEPTH * 2048 * 256 * 2);
    p.wt_out = (bf16_t*)carve((size_t)DEPTH * D * D * 2);
    p.wt_q = (bf16_t*)carve((size_t)DEPTH * D * D * 2);
    p.hn_b = (bf16_t*)carve((size_t)T * D * 2);
    p.cqn_b = (bf16_t*)carve((size_t)T * 512 * 2);
    p.ckv_b = (bf16_t*)carve((size_t)TKV * 256 * 2);
    p.mix_b = (bf16_t*)carve((size_t)T * D * 2);
    p.xb = (bf16_t*)carve((size_t)T * D * 2);
    p.x8g = (unsigned char*)carve((size_t)T * D);
    p.qp_b = (bf16_t*)carve((size_t)T * D * 2);
    p.sk_b = (bf16_t*)carve((size_t)DEPTH * 8 * 2 * 128 * 128 * 2);
    p.pu8 = (unsigned char*)carve((size_t)DEPTH * 16384 * D / 2);
    p.pv8 = (unsigned char*)carve((size_t)DEPTH * 16384 * D / 2);
    p.su8 = (float*)carve((size_t)DEPTH * 16384 * 4);
    p.sv8 = (float*)carve((size_t)DEPTH * 16384 * 4);
    p.k_b = (bf16_t*)carve((size_t)TKV * 1536 * 2);
    p.qna_b = (bf16_t*)carve((size_t)T * 512 * 2);
    p.kna_b = (bf16_t*)carve((size_t)T * 512 * 2);
    p.cnak_b = (bf16_t*)carve((size_t)DB * 4 * PAST * 128 * 2);
    p.cnav_b = (bf16_t*)carve((size_t)DB * 4 * PAST * 128 * 2);

#if MK_ONE_LAUNCH
    static int grid = 0;
    if (!grid) {
        int dev = 0, cus = 0, per_cu = 0;
        hipGetDevice(&dev);
        hipDeviceGetAttribute(&cus, hipDeviceAttributeMultiprocessorCount, dev);
        hipFuncSetAttribute((const void*)k_fwd, hipFuncAttributeMaxDynamicSharedMemorySize, (int)LDS_BYTES);
        hipOccupancyMaxActiveBlocksPerMultiprocessor(&per_cu, k_fwd, NTHREADS, LDS_BYTES);
        if (per_cu < 1) per_cu = 1;
        grid = cus * (per_cu < 1 ? per_cu : 1);
    }
    hipMemsetAsync(p.bar, 0, XCD_BAR_WORDS * sizeof(unsigned), stream);
    hipLaunchKernelGGL(k_fwd, dim3(grid), dim3(NTHREADS), LDS_BYTES, stream, p);
#endif
}
```
